# Optimizing an MI355X kernel written in HIP

```python
import jax, jax.numpy as jnp
from jax import lax
import numpy as np

D_MODEL = 1024
BATCH = 4
SEQ = 4096
DEPTH = 1

ATTN_HEAD_DIM = 64
ATTN_WIDTH = D_MODEL // 2
ATTN_HEADS = ATTN_WIDTH // ATTN_HEAD_DIM
GLA_HEADS = 4
GLA_VAL_WIDTH = D_MODEL // 2
GLA_KEY_WIDTH = GLA_VAL_WIDTH // 2
GLA_DK = GLA_KEY_WIDTH // GLA_HEADS
GLA_DV = GLA_VAL_WIDTH // GLA_HEADS
GLA_GATE_RANK = 16
GLA_TAU = 16.0
GLA_CHUNK = 64
MIX_WIDTH = ATTN_WIDTH + GLA_VAL_WIDTH
IN_SPLITS = (ATTN_WIDTH, ATTN_WIDTH, ATTN_WIDTH,
             GLA_KEY_WIDTH, GLA_KEY_WIDTH, GLA_VAL_WIDTH, GLA_VAL_WIDTH, 2 * GLA_GATE_RANK)
IN_WIDTH = sum(IN_SPLITS)

DILATED_BRANCHES = ((128, 1), (512, 4), (2048, 16))
HALF_SPAN = 64
T5_BUCKETS = 32
T5_MAX_DISTANCE = 1024
NEG_INF = -1e30

N_EXPERTS = 32
TOP_K = 4
D_FF = D_MODEL
SWIGLU_LIMIT = 7.0
SWIGLU_ALPHA = 1.702
MOE_BLOCK = 128

NORM_EPS = 1e-5

kernel_name = "hybrid_dilated_attn_gla_moe_encoder"


def _rmsnorm(x, g):
    xf = x.astype(jnp.float32)
    y = xf * lax.rsqrt(jnp.mean(xf * xf, axis=-1, keepdims=True) + NORM_EPS)
    return (y * g.astype(jnp.float32)).astype(x.dtype)


def _t5_bucket(rel):
    nb = T5_BUCKETS // 2
    max_exact = nb // 2
    n = np.abs(rel)
    large = max_exact + (np.log(np.maximum(n, 1).astype(np.float32) / max_exact)
                         / np.log(T5_MAX_DISTANCE / max_exact) * (nb - max_exact)).astype(np.int32)
    large = np.minimum(large, nb - 1)
    return (np.where(rel > 0, nb, 0) + np.where(n < max_exact, n, large)).astype(np.int32)


def _dilated_branch(q, k, v, rel_bias, dil):
    B, S, H, Dh = q.shape
    L = S // dil
    blk = HALF_SPAN
    nb = -(-L // blk)
    Lp = nb * blk
    N = B * dil

    def to_res(t):
        return t.reshape(B, L, dil, H, Dh).transpose(0, 2, 3, 1, 4).reshape(N, H, L, Dh)

    def windows(t):
        tp = jnp.pad(to_res(t), ((0, 0), (0, 0), (blk, Lp - L + blk), (0, 0))).reshape(N, H, nb + 2, blk, Dh)
        return jnp.concatenate([tp[:, :, :-2], tp[:, :, 1:-1], tp[:, :, 2:]], axis=3)

    qb = jnp.pad(to_res(q), ((0, 0), (0, 0), (0, Lp - L), (0, 0))).reshape(N, H, nb, blk, Dh)
    kw, vw = windows(k), windows(v)

    s_idx = np.arange(blk)[:, None]
    t_idx = np.arange(3 * blk)[None, :]
    off = t_idx - blk - s_idx
    bias = jnp.transpose(rel_bias[_t5_bucket(off * dil)], (2, 0, 1)).astype(jnp.float32)
    ki = np.arange(nb)[:, None, None] * blk + t_idx - blk
    valid = (ki >= 0) & (ki < L) & (np.abs(off) <= HALF_SPAN)

    logits = jnp.einsum('nhbqd,nhbkd->nhbqk', qb, kw).astype(jnp.float32) * (Dh ** -0.5)
    logits = jnp.where(valid[None, None], logits + bias[None, :, None], NEG_INF)
    m = jnp.max(logits, axis=-1, keepdims=True)
    p = jnp.exp(logits - m)
    den = jnp.sum(p, axis=-1)
    out = jnp.einsum('nhbqk,nhbkd->nhbqd', p, vw.astype(jnp.float32)) / den[..., None]
    lse = m[..., 0] + jnp.log(den)
    out = out.reshape(N, H, Lp, Dh)[:, :, :L]
    lse = lse.reshape(N, H, Lp)[:, :, :L]
    out = out.reshape(B, dil, H, L, Dh).transpose(0, 3, 1, 2, 4).reshape(B, S, H, Dh)
    lse = lse.reshape(B, dil, H, L).transpose(0, 3, 1, 2).reshape(B, S, H)
    return out, lse


def _dilated_attention(q, k, v, rel_bias):
    B, S = q.shape[:2]
    res = [_dilated_branch(q, k, v, rel_bias, d) for (_, d) in DILATED_BRANCHES]
    outs = jnp.stack([r[0] for r in res])
    lses = jnp.stack([r[1] for r in res])
    w = jax.nn.softmax(lses, axis=0)
    out = jnp.sum(w[..., None] * outs, axis=0)
    return out.reshape(B, S, ATTN_WIDTH).astype(q.dtype)


def _gla_chunked(q, k, v, log_a):
    B, H, S, dk = q.shape
    dv = v.shape[-1]
    C = GLA_CHUNK
    nc = S // C
    q, k, log_a = (t.reshape(B, H, nc, C, dk) for t in (q, k, log_a))
    v = v.reshape(B, H, nc, C, dv)
    b = jnp.cumsum(log_a, axis=3)
    G = b[:, :, :, -1]
    qd = q * jnp.exp(b)
    kd = k * jnp.exp(-b)
    tri = np.tril(np.ones((C, C), dtype=bool))
    A = jnp.where(tri, jnp.einsum('bhncd,bhnsd->bhncs', qd, kd), 0.0)
    o_intra = jnp.einsum('bhncs,bhnse->bhnce', A, v)
    kst = k * jnp.exp(G[:, :, :, None, :] - b)
    dS = jnp.einsum('bhncd,bhnce->bhnde', kst, v)

    def step(state, inp):
        dS_n, decay_n = inp
        return decay_n[..., None] * state + dS_n, state

    _, S_prev = lax.scan(step, jnp.zeros((B, H, dk, dv), jnp.float32),
                         (dS.transpose(2, 0, 1, 3, 4), jnp.exp(G).transpose(2, 0, 1, 3)))
    S_prev = S_prev.transpose(1, 2, 0, 3, 4)
    o_inter = jnp.einsum('bhncd,bhnde->bhnce', qd, S_prev)
    return (o_intra + o_inter).reshape(B, H, S, dv)


def _bi_gla(q, k, v, out_gate, z_low, wg_f, bg_f, wg_b, bg_b, norm_g):
    B, S = q.shape[:2]
    f32 = jnp.float32

    def heads(t, d):
        return t.astype(f32).reshape(B, S, GLA_HEADS, d).transpose(0, 2, 1, 3)

    qh = heads(q, GLA_DK) * (GLA_DK ** -0.5)
    kh = heads(k, GLA_DK)
    vh = heads(v, GLA_DV)
    z = z_low.astype(f32)
    la_f = heads(jax.nn.log_sigmoid(z[..., :GLA_GATE_RANK] @ wg_f.astype(f32) + bg_f.astype(f32)) / GLA_TAU, GLA_DK)
    la_b = heads(jax.nn.log_sigmoid(z[..., GLA_GATE_RANK:] @ wg_b.astype(f32) + bg_b.astype(f32)) / GLA_TAU, GLA_DK)
    fwd = _gla_chunked(qh, kh, vh, la_f)
    flip = lambda t: jnp.flip(t, axis=2)
    bwd = flip(_gla_chunked(flip(qh), flip(kh), flip(vh), flip(la_b)))
    o = fwd + bwd
    o = o * lax.rsqrt(jnp.mean(o * o, axis=-1, keepdims=True) + NORM_EPS)
    o = o.transpose(0, 2, 1, 3).reshape(B, S, GLA_VAL_WIDTH) * norm_g.astype(f32)
    return (o * jax.nn.silu(out_gate.astype(f32))).astype(q.dtype)


def _moe(h, router_w, router_b, w1, b1, w2, b2):
    B, S, D = h.shape
    T = B * S
    xf = h.reshape(T, D)
    logits = (xf @ router_w + router_b).astype(jnp.float32)
    topv, topi = lax.top_k(logits, TOP_K)
    gates = jax.nn.softmax(topv, axis=-1)
    flat_e = topi.reshape(-1).astype(jnp.int32)
    flat_tok = jnp.broadcast_to(jnp.arange(T, dtype=jnp.int32)[:, None], (T, TOP_K)).reshape(-1)
    flat_g = gates.reshape(-1)
    order = jnp.argsort(flat_e)
    se = flat_e[order]
    counts = jnp.bincount(flat_e, length=N_EXPERTS)
    starts = jnp.cumsum(counts) - counts
    pcounts = (counts + MOE_BLOCK - 1) // MOE_BLOCK * MOE_BLOCK
    pends = jnp.cumsum(pcounts)
    pstarts = pends - pcounts
    dest = (pstarts[se] + jnp.arange(T * TOP_K, dtype=jnp.int32) - starts[se]).astype(jnp.int32)
    P = T * TOP_K + N_EXPERTS * MOE_BLOCK
    nblk = P // MOE_BLOCK
    buf_tok = jnp.zeros((P,), jnp.int32).at[dest].set(flat_tok[order])
    buf_gate = jnp.zeros((P,), jnp.float32).at[dest].set(flat_g[order])
    block_e = jnp.clip(jnp.searchsorted(pends, jnp.arange(nblk) * MOE_BLOCK, side='right'),
                       0, N_EXPERTS - 1).astype(jnp.int32)
    xin = xf[buf_tok].reshape(nblk, MOE_BLOCK, D)

    def expert_block(args):
        xb, e = args
        hh = xb @ w1[e] + b1[e]
        x_glu = jnp.minimum(hh[..., ::2], SWIGLU_LIMIT)
        x_lin = jnp.clip(hh[..., 1::2], -SWIGLU_LIMIT, SWIGLU_LIMIT)
        act = x_glu * jax.nn.sigmoid(SWIGLU_ALPHA * x_glu) * (x_lin + 1.0)
        return act @ w2[e] + b2[e]

    y = lax.map(expert_block, (xin, block_e)).reshape(P, D)
    out = jnp.zeros((T, D), jnp.float32).at[buf_tok].add(y.astype(jnp.float32) * buf_gate[:, None])
    return out.reshape(B, S, D).astype(h.dtype)


def setup_inputs(seed: int = 0) -> dict:
    key = jax.random.key(seed)
    ks = jax.random.split(key, 20)
    f32 = jnp.float32
    nrm = lambda k, shape, s: jax.random.normal(k, shape, f32) * s
    return {
        "x": nrm(ks[0], (BATCH, SEQ, D_MODEL), 1.0),
        "norm1_g": 1.0 + nrm(ks[1], (DEPTH, D_MODEL), 0.02),
        "w_in": nrm(ks[2], (DEPTH, D_MODEL, IN_WIDTH), D_MODEL ** -0.5),
        "rel_bias": nrm(ks[3], (T5_BUCKETS, ATTN_HEADS), 0.5),
        "gla_wg_fwd": nrm(ks[4], (DEPTH, GLA_GATE_RANK, GLA_KEY_WIDTH), GLA_GATE_RANK ** -0.5),
        "gla_bg_fwd": nrm(ks[5], (DEPTH, GLA_KEY_WIDTH), 0.1),
        "gla_wg_bwd": nrm(ks[6], (DEPTH, GLA_GATE_RANK, GLA_KEY_WIDTH), GLA_GATE_RANK ** -0.5),
        "gla_bg_bwd": nrm(ks[7], (DEPTH, GLA_KEY_WIDTH), 0.1),
        "gla_norm_g": 1.0 + nrm(ks[8], (DEPTH, GLA_VAL_WIDTH), 0.02),
        "w_out": nrm(ks[9], (DEPTH, MIX_WIDTH, D_MODEL), MIX_WIDTH ** -0.5),
        "norm2_g": 1.0 + nrm(ks[10], (DEPTH, D_MODEL), 0.02),
        "router_w": nrm(ks[11], (DEPTH, D_MODEL, N_EXPERTS), D_MODEL ** -0.5),
        "router_b": nrm(ks[12], (DEPTH, N_EXPERTS), 0.01),
        "moe_w1": nrm(ks[13], (DEPTH, N_EXPERTS, D_MODEL, 2 * D_FF), D_MODEL ** -0.5),
        "moe_b1": nrm(ks[14], (DEPTH, N_EXPERTS, 2 * D_FF), 0.01),
        "moe_w2": nrm(ks[15], (DEPTH, N_EXPERTS, D_FF, D_MODEL), D_FF ** -0.5),
        "moe_b2": nrm(ks[16], (DEPTH, N_EXPERTS, D_MODEL), 0.01),
        "final_g": 1.0 + nrm(ks[17], (D_MODEL,), 0.02),
    }


def reference(x, norm1_g, w_in, rel_bias, gla_wg_fwd, gla_bg_fwd, gla_wg_bwd, gla_bg_bwd,
              gla_norm_g, w_out, norm2_g, router_w, router_b, moe_w1, moe_b1, moe_w2, moe_b2,
              final_g):
    B, S, _ = x.shape
    split_pts = np.cumsum(IN_SPLITS)[:-1].tolist()
    for l in range(DEPTH):
        n = _rmsnorm(x, norm1_g[l])
        proj = n @ w_in[l]
        aq, ak, av, gq, gk, gv, gout, gz = jnp.split(proj, split_pts, axis=-1)
        hsplit = lambda t: t.reshape(B, S, ATTN_HEADS, ATTN_HEAD_DIM)
        a = _dilated_attention(hsplit(aq), hsplit(ak), hsplit(av), rel_bias)
        g = _bi_gla(gq, gk, gv, gout, gz, gla_wg_fwd[l], gla_bg_fwd[l],
                    gla_wg_bwd[l], gla_bg_bwd[l], gla_norm_g[l])
        x = x + jnp.concatenate([a, g], axis=-1) @ w_out[l]
        x = x + _moe(_rmsnorm(x, norm2_g[l]), router_w[l], router_b[l],
                     moe_w1[l], moe_b1[l], moe_w2[l], moe_b2[l])
    return _rmsnorm(x, final_g)
```

```cpp
#include <hip/hip_runtime.h>
#include <stdint.h>

namespace cfg {
constexpr int D = 1024, B = 4, S = 4096, T = B * S;
constexpr int AH = 8;
constexpr int GH = 4;
constexpr int INW = 3104;
constexpr int C_AQ = 0, C_AK = 512, C_AV = 1024, C_GQ = 1536, C_GK = 1792, C_GV = 2048, C_GO = 2560, C_GZ = 3072;
constexpr int NE = 32, DFF = 1024;
constexpr float EPS = 1e-5f;
}
using namespace cfg;

__device__ const unsigned char T5TAB[387] = {
11,11,11,11,11,11,11,11,11,11,11,11,11,11,11,10,10,10,10,10,10,10,10,10,10,10,10,10,10,10,10,10,10,10,10,10,10,10,9,9,9,9,9,9,9,9,9,9,9,9,8,8,8,8,8,8,8,7,6,5,4,3,2,1,0,17,18,19,20,21,22,23,24,24,24,24,24,24,24,25,25,25,25,25,25,25,25,25,25,25,25,26,26,26,26,26,26,26,26,26,26,26,26,26,26,26,26,26,26,26,26,26,26,26,27,27,27,27,27,27,27,27,27,27,27,27,27,27,27,
13,13,13,13,13,13,13,13,13,13,13,13,13,13,13,13,13,13,13,13,13,13,13,12,12,12,12,12,12,12,12,12,12,12,12,12,12,12,12,12,12,12,11,11,11,11,11,11,11,11,11,11,10,10,10,10,10,10,9,9,9,8,8,4,0,20,24,24,25,25,25,26,26,26,26,26,26,27,27,27,27,27,27,27,27,27,27,28,28,28,28,28,28,28,28,28,28,28,28,28,28,28,28,28,28,28,29,29,29,29,29,29,29,29,29,29,29,29,29,29,29,29,29,29,29,29,29,29,29,
15,15,15,15,15,15,15,15,15,15,15,15,15,15,15,15,15,15,15,15,15,15,15,15,15,15,15,15,15,15,14,14,14,14,14,14,14,14,14,14,14,14,14,14,14,13,13,13,13,13,13,13,13,13,12,12,12,12,12,11,11,10,10,9,0,25,26,26,27,27,28,28,28,28,28,29,29,29,29,29,29,29,29,29,30,30,30,30,30,30,30,30,30,30,30,30,30,30,30,31,31,31,31,31,31,31,31,31,31,31,31,31,31,31,31,31,31,31,31,31,31,31,31,31,31,31,31,31,31};

__device__ __forceinline__ float wave_sum(float v) {
#pragma unroll
    for (int o = 32; o > 0; o >>= 1) v += __shfl_xor(v, o);
    return v;
}

__global__ void __launch_bounds__(256) nv_rmsnorm(const float* __restrict__ x, const float* __restrict__ g, float* __restrict__ y, int rows) {
    int row = blockIdx.x * 4 + (threadIdx.x >> 6), lane = threadIdx.x & 63;
    if (row >= rows) return;
    const float* xr = x + (size_t)row * D;
    float v[16]; float ss = 0.f;
#pragma unroll
    for (int i = 0; i < 16; ++i) { v[i] = xr[lane + 64 * i]; ss += v[i] * v[i]; }
    ss = wave_sum(ss);
    float r = rsqrtf(ss * (1.0f / D) + EPS);
#pragma unroll
    for (int i = 0; i < 16; ++i) y[(size_t)row * D + lane + 64 * i] = v[i] * r * g[lane + 64 * i];
}

enum { EPI_STORE = 0, EPI_RESID = 1, EPI_SWIGLU = 2 };
template <int EPI>
__global__ void __launch_bounds__(256) nv_gemm(const float* __restrict__ A, int lda, const int* __restrict__ rowmap, int rshift,
                                               const int* __restrict__ Mptr, int Mfix,
                                               const float* __restrict__ Bm, int ldb, int N, int K,
                                               float* __restrict__ C, int ldc,
                                               const float* __restrict__ aux1, const float* __restrict__ aux2) {
    __shared__ float As[16][68];
    __shared__ float Bs[16][64];
    const int M = Mptr ? *Mptr : Mfix;
    const int m0 = blockIdx.y * 64, n0 = blockIdx.x * 64;
    if (m0 >= M) return;
    const int tid = threadIdx.x, tx = tid & 15, ty = tid >> 4;
    float acc[4][4];
#pragma unroll
    for (int i = 0; i < 4; ++i)
#pragma unroll
        for (int j = 0; j < 4; ++j) acc[i][j] = 0.f;
    const int ar = tid >> 2, ak = (tid & 3) * 4;
    const int arow = m0 + ar; const bool av = arow < M;
    const int srcrow = av ? (rowmap ? (rowmap[arow] >> rshift) : arow) : 0;
    const float* ap = A + (size_t)srcrow * lda + ak;
    const int bk = tid >> 4, bn = (tid & 15) * 4;
    const bool bv = (n0 + bn) < N;
    for (int k0 = 0; k0 < K; k0 += 16) {
        float4 a4 = av ? *(const float4*)(ap + k0) : make_float4(0.f, 0.f, 0.f, 0.f);
        float4 b4 = bv ? *(const float4*)(Bm + (size_t)(k0 + bk) * ldb + n0 + bn) : make_float4(0.f, 0.f, 0.f, 0.f);
        As[ak + 0][ar] = a4.x; As[ak + 1][ar] = a4.y; As[ak + 2][ar] = a4.z; As[ak + 3][ar] = a4.w;
        *(float4*)&Bs[bk][bn] = b4;
        __syncthreads();
#pragma unroll
        for (int kk = 0; kk < 16; ++kk) {
            float4 a = *(const float4*)&As[kk][ty * 4];
            float4 b = *(const float4*)&Bs[kk][tx * 4];
            float aa[4] = {a.x, a.y, a.z, a.w}, bb[4] = {b.x, b.y, b.z, b.w};
#pragma unroll
            for (int i = 0; i < 4; ++i)
#pragma unroll
                for (int j = 0; j < 4; ++j) acc[i][j] = fmaf(aa[i], bb[j], acc[i][j]);
        }
        __syncthreads();
    }
#pragma unroll
    for (int i = 0; i < 4; ++i) {
        const int row = m0 + ty * 4 + i;
        if (row >= M) continue;
        const int col = n0 + tx * 4;
        if (col >= N) continue;
        if (EPI == EPI_STORE) {
#pragma unroll
            for (int j = 0; j < 4; ++j) C[(size_t)row * ldc + col + j] = acc[i][j];
        } else if (EPI == EPI_RESID) {
#pragma unroll
            for (int j = 0; j < 4; ++j) C[(size_t)row * ldc + col + j] = aux1[(size_t)row * ldc + col + j] + acc[i][j];
        } else if (EPI == EPI_SWIGLU) {
#pragma unroll
            for (int j = 0; j < 4; j += 2) {
                float glu = acc[i][j] + aux1[col + j], lin = acc[i][j + 1] + aux1[col + j + 1];
                glu = fminf(glu, 7.0f); lin = fminf(fmaxf(lin, -7.0f), 7.0f);
                float sg = 1.0f / (1.0f + expf(-1.702f * glu));
                C[(size_t)row * ldc + (col + j) / 2] = glu * sg * (lin + 1.0f);
            }
        }
    }
}

__global__ void __launch_bounds__(256) nv_attn(const float* __restrict__ proj, const float* __restrict__ rel_bias, float* __restrict__ mix) {
    const int wid = blockIdx.x * 4 + (threadIdx.x >> 6), lane = threadIdx.x & 63;
    const int h = wid & 7, tok = wid >> 3, b = tok / S, pos = tok % S;
    const float q = proj[(size_t)tok * INW + C_AQ + h * 64 + lane];
    float outs[3], lses[3];
#pragma unroll
    for (int br = 0; br < 3; ++br) {
        const int dil = (br == 0) ? 1 : (br == 1 ? 4 : 16);
        float m = -3.0e38f, l = 0.f, o = 0.f;
        for (int j = -64; j <= 64; ++j) {
            const int kp = pos + j * dil;
            if (kp < 0 || kp >= S) continue;
            const size_t kr = (size_t)(b * S + kp) * INW;
            float d = wave_sum(q * proj[kr + C_AK + h * 64 + lane]);
            float logit = d * 0.125f + rel_bias[T5TAB[br * 129 + j + 64] * AH + h];
            float mn = fmaxf(m, logit);
            float sc = expf(m - mn), p = expf(logit - mn);
            l = l * sc + p; o = o * sc + p * proj[kr + C_AV + h * 64 + lane];
            m = mn;
        }
        outs[br] = o / l; lses[br] = m + logf(l);
    }
    float mm = fmaxf(lses[0], fmaxf(lses[1], lses[2]));
    float w0 = expf(lses[0] - mm), w1 = expf(lses[1] - mm), w2 = expf(lses[2] - mm);
    float ws = w0 + w1 + w2;
    mix[(size_t)tok * D + h * 64 + lane] = (w0 * outs[0] + w1 * outs[1] + w2 * outs[2]) / ws;
}

__global__ void __launch_bounds__(256) nv_la(const float* __restrict__ proj, const float* __restrict__ wgf, const float* __restrict__ bgf,
                                             const float* __restrict__ wgb, const float* __restrict__ bgb, float* __restrict__ ea) {
    const int tok = blockIdx.x, col = threadIdx.x;
#pragma unroll
    for (int dir = 0; dir < 2; ++dir) {
        const float* wg = dir ? wgb : wgf; const float* bg = dir ? bgb : bgf;
        float a = bg[col];
        for (int r = 0; r < 16; ++r) a += proj[(size_t)tok * INW + C_GZ + dir * 16 + r] * wg[r * 256 + col];
        float ls = fminf(a, 0.f) - log1pf(expf(-fabsf(a)));
        ea[((size_t)dir * T + tok) * 256 + col] = expf(ls * (1.0f / 16.0f));
    }
}

__global__ void __launch_bounds__(128) nv_gla(const float* __restrict__ proj, const float* __restrict__ ea, float* __restrict__ og) {
    const int e = threadIdx.x, bhd = blockIdx.x, dir = bhd & 1, h = (bhd >> 1) & 3, b = bhd >> 3;
    float st[64];
#pragma unroll
    for (int d = 0; d < 64; ++d) st[d] = 0.f;
    for (int i = 0; i < S; ++i) {
        const int pos = dir ? (S - 1 - i) : i;
        const size_t tok = (size_t)b * S + pos;
        const float* pr = proj + tok * INW;
        const float* ar = ea + ((size_t)dir * T + tok) * 256 + h * 64;
        const float v = pr[C_GV + h * 128 + e];
        float o = 0.f;
#pragma unroll
        for (int d = 0; d < 64; ++d) {
            st[d] = fmaf(ar[d], st[d], pr[C_GK + h * 64 + d] * v);
            o = fmaf(pr[C_GQ + h * 64 + d] * 0.125f, st[d], o);
        }
        og[((size_t)dir * T + tok) * 512 + h * 128 + e] = o;
    }
}

__global__ void __launch_bounds__(256) nv_gla_out(const float* __restrict__ proj, const float* __restrict__ og, const float* __restrict__ ng, float* __restrict__ mix) {
    const int wid = blockIdx.x * 4 + (threadIdx.x >> 6), lane = threadIdx.x & 63;
    const int h = wid & 3, tok = wid >> 2;
    float o0 = og[(size_t)tok * 512 + h * 128 + lane] + og[((size_t)T + tok) * 512 + h * 128 + lane];
    float o1 = og[(size_t)tok * 512 + h * 128 + 64 + lane] + og[((size_t)T + tok) * 512 + h * 128 + 64 + lane];
    float ss = wave_sum(o0 * o0 + o1 * o1);
    float r = rsqrtf(ss * (1.0f / 128.0f) + EPS);
    float g0 = proj[(size_t)tok * INW + C_GO + h * 128 + lane], g1 = proj[(size_t)tok * INW + C_GO + h * 128 + 64 + lane];
    mix[(size_t)tok * D + 512 + h * 128 + lane] = o0 * r * ng[h * 128 + lane] * (g0 / (1.0f + expf(-g0)));
    mix[(size_t)tok * D + 512 + h * 128 + 64 + lane] = o1 * r * ng[h * 128 + 64 + lane] * (g1 / (1.0f + expf(-g1)));
}

__global__ void __launch_bounds__(256) nv_route(const float* __restrict__ x1, const float* __restrict__ g2, const float* __restrict__ rw, const float* __restrict__ rb,
                                                float* __restrict__ xn2, int* __restrict__ topi, float* __restrict__ gate) {
    __shared__ float xs[4][1024];
    __shared__ float lg[4][32];
    const int w = threadIdx.x >> 6, lane = threadIdx.x & 63, tok = blockIdx.x * 4 + w;
    const float* xr = x1 + (size_t)tok * D;
    float v[16]; float ss = 0.f;
#pragma unroll
    for (int i = 0; i < 16; ++i) { v[i] = xr[lane + 64 * i]; ss += v[i] * v[i]; }
    ss = wave_sum(ss);
    const float r = rsqrtf(ss * (1.0f / D) + EPS);
#pragma unroll
    for (int i = 0; i < 16; ++i) { float y = v[i] * r * g2[lane + 64 * i]; xs[w][lane + 64 * i] = y; xn2[(size_t)tok * D + lane + 64 * i] = y; }
    __syncthreads();
    const int e = lane & 31, half = lane >> 5;
    float a = 0.f;
    for (int k = half * 512; k < half * 512 + 512; ++k) a = fmaf(xs[w][k], rw[k * 32 + e], a);
    a += __shfl_xor(a, 32);
    if (lane < 32) lg[w][lane] = a + rb[lane];
    __syncthreads();
    if (lane == 0) {
        float bv[4]; int bi[4];
        unsigned used = 0u;
#pragma unroll
        for (int k = 0; k < 4; ++k) {
            float best = -3.0e38f; int bidx = 0;
            for (int j = 0; j < 32; ++j) { float x = lg[w][j]; if (!((used >> j) & 1u) && x > best) { best = x; bidx = j; } }
            used |= 1u << bidx; bv[k] = best; bi[k] = bidx;
        }
        float e0 = 1.0f, e1 = expf(bv[1] - bv[0]), e2 = expf(bv[2] - bv[0]), e3 = expf(bv[3] - bv[0]);
        float s = e0 + e1 + e2 + e3;
        topi[tok * 4 + 0] = bi[0]; topi[tok * 4 + 1] = bi[1]; topi[tok * 4 + 2] = bi[2]; topi[tok * 4 + 3] = bi[3];
        gate[tok * 4 + 0] = e0 / s; gate[tok * 4 + 1] = e1 / s; gate[tok * 4 + 2] = e2 / s; gate[tok * 4 + 3] = e3 / s;
    }
}

__global__ void nv_lists(const int* __restrict__ topi, int* __restrict__ lists, int* __restrict__ counts) {
    const int e = threadIdx.x;
    int c = 0;
    for (int s = 0; s < T * 4; ++s) if (topi[s] == e) lists[e * T + c++] = s;
    counts[e] = c;
}

__global__ void __launch_bounds__(256) nv_moe2(const float* __restrict__ A, const int* __restrict__ slots, const int* __restrict__ Mptr,
                                               const float* __restrict__ Bm, float* __restrict__ x2, const float* __restrict__ b2, const float* __restrict__ gate) {
    __shared__ float As[16][68];
    __shared__ float Bs[16][64];
    const int M = *Mptr;
    const int m0 = blockIdx.y * 64, n0 = blockIdx.x * 64;
    if (m0 >= M) return;
    const int tid = threadIdx.x, tx = tid & 15, ty = tid >> 4;
    float acc[4][4];
#pragma unroll
    for (int i = 0; i < 4; ++i)
#pragma unroll
        for (int j = 0; j < 4; ++j) acc[i][j] = 0.f;
    const int ar = tid >> 2, ak = (tid & 3) * 4;
    const int arow = m0 + ar; const bool av = arow < M;
    const float* ap = A + (size_t)(av ? arow : 0) * DFF + ak;
    const int bk = tid >> 4, bn = (tid & 15) * 4;
    for (int k0 = 0; k0 < DFF; k0 += 16) {
        float4 a4 = av ? *(const float4*)(ap + k0) : make_float4(0.f, 0.f, 0.f, 0.f);
        float4 b4 = *(const float4*)(Bm + (size_t)(k0 + bk) * D + n0 + bn);
        As[ak + 0][ar] = a4.x; As[ak + 1][ar] = a4.y; As[ak + 2][ar] = a4.z; As[ak + 3][ar] = a4.w;
        *(float4*)&Bs[bk][bn] = b4;
        __syncthreads();
#pragma unroll
        for (int kk = 0; kk < 16; ++kk) {
            float4 a = *(const float4*)&As[kk][ty * 4];
            float4 b = *(const float4*)&Bs[kk][tx * 4];
            float aa[4] = {a.x, a.y, a.z, a.w}, bb[4] = {b.x, b.y, b.z, b.w};
#pragma unroll
            for (int i = 0; i < 4; ++i)
#pragma unroll
                for (int j = 0; j < 4; ++j) acc[i][j] = fmaf(aa[i], bb[j], acc[i][j]);
        }
        __syncthreads();
    }
#pragma unroll
    for (int i = 0; i < 4; ++i) {
        const int row = m0 + ty * 4 + i;
        if (row >= M) continue;
        const int col = n0 + tx * 4;
        const int slot = slots[row]; const int tok = slot >> 2; const float gt = gate[slot];
#pragma unroll
        for (int j = 0; j < 4; ++j) x2[(size_t)tok * D + col + j] += gt * (acc[i][j] + b2[col + j]);
    }
}

extern "C" void kernel_launch(void* const* d_in, const int* in_sizes, int n_in, void* d_out, int out_size, void* d_ws, size_t ws_size, hipStream_t stream) {
    const float* x = (const float*)d_in[0];
    const float* norm1_g = (const float*)d_in[1];
    const float* w_in = (const float*)d_in[2];
    const float* rel_bias = (const float*)d_in[3];
    const float* wgf = (const float*)d_in[4];
    const float* bgf = (const float*)d_in[5];
    const float* wgb = (const float*)d_in[6];
    const float* bgb = (const float*)d_in[7];
    const float* gla_ng = (const float*)d_in[8];
    const float* w_out = (const float*)d_in[9];
    const float* norm2_g = (const float*)d_in[10];
    const float* router_w = (const float*)d_in[11];
    const float* router_b = (const float*)d_in[12];
    const float* w1 = (const float*)d_in[13];
    const float* b1 = (const float*)d_in[14];
    const float* w2 = (const float*)d_in[15];
    const float* b2 = (const float*)d_in[16];
    const float* final_g = (const float*)d_in[17];
    float* out = (float*)d_out;

    char* ws = (char*)d_ws;
    size_t off = 0;
    auto take = [&](size_t bytes) { char* p = ws + off; off += (bytes + 255) & ~(size_t)255; return p; };
    float* xn = (float*)take((size_t)T * D * 4);
    float* x1 = (float*)take((size_t)T * D * 4);
    float* x2 = (float*)take((size_t)T * D * 4);
    float* mix = (float*)take((size_t)T * D * 4);
    int* topi = (int*)take((size_t)T * 4 * 4);
    float* gate = (float*)take((size_t)T * 4 * 4);
    int* lists = (int*)take((size_t)NE * T * 4);
    int* counts = (int*)take(256);
    char* big = take((size_t)T * INW * 4 + (size_t)2 * T * 256 * 4 + (size_t)2 * T * 512 * 4);
    float* proj = (float*)big;
    float* ea = (float*)(big + (size_t)T * INW * 4);
    float* og = (float*)(big + (size_t)T * INW * 4 + (size_t)2 * T * 256 * 4);
    float* hact = (float*)big;

    nv_rmsnorm<<<T / 4, 256, 0, stream>>>(x, norm1_g, xn, T);
    nv_gemm<EPI_STORE><<<dim3((INW + 63) / 64, T / 64), 256, 0, stream>>>(xn, D, nullptr, 0, nullptr, T, w_in, INW, INW, D, proj, INW, nullptr, nullptr);
    nv_attn<<<T * AH / 4, 256, 0, stream>>>(proj, rel_bias, mix);
    nv_la<<<T, 256, 0, stream>>>(proj, wgf, bgf, wgb, bgb, ea);
    nv_gla<<<B * GH * 2, 128, 0, stream>>>(proj, ea, og);
    nv_gla_out<<<T * GH / 4, 256, 0, stream>>>(proj, og, gla_ng, mix);
    nv_gemm<EPI_RESID><<<dim3(D / 64, T / 64), 256, 0, stream>>>(mix, D, nullptr, 0, nullptr, T, w_out, D, D, D, x1, D, x, nullptr);
    nv_route<<<T / 4, 256, 0, stream>>>(x1, norm2_g, router_w, router_b, xn, topi, gate);
    nv_lists<<<1, 32, 0, stream>>>(topi, lists, counts);
    (void)hipMemcpyAsync(x2, x1, (size_t)T * D * 4, hipMemcpyDeviceToDevice, stream);
    for (int e = 0; e < NE; ++e) {
        nv_gemm<EPI_SWIGLU><<<dim3(2 * DFF / 64, T / 64), 256, 0, stream>>>(xn, D, lists + (size_t)e * T, 2, counts + e, 0,
                                                                          w1 + (size_t)e * D * 2 * DFF, 2 * DFF, 2 * DFF, D, hact, DFF, b1 + (size_t)e * 2 * DFF, nullptr);
        nv_moe2<<<dim3(D / 64, T / 64), 256, 0, stream>>>(hact, lists + (size_t)e * T, counts + e, w2 + (size_t)e * DFF * D, x2, b2 + (size_t)e * D, gate);
    }
    nv_rmsnorm<<<T / 4, 256, 0, stream>>>(x2, final_g, out, T);
}
```

```cpp
#define STAGE 6
#include <hip/hip_runtime.h>
#include <stdint.h>

namespace cfg {
constexpr int D = 1024, B = 4, S = 4096, T = B * S;
constexpr int AH = 8;
constexpr int GH = 4;
constexpr int INW = 3104;
constexpr int C_AQ = 0, C_AK = 512, C_AV = 1024, C_GQ = 1536, C_GK = 1792, C_GV = 2048, C_GO = 2560, C_GZ = 3072;
constexpr int NE = 32, DFF = 1024;
constexpr float EPS = 1e-5f;
}
using namespace cfg;

__device__ const unsigned char T5TAB[387] = {
11,11,11,11,11,11,11,11,11,11,11,11,11,11,11,10,10,10,10,10,10,10,10,10,10,10,10,10,10,10,10,10,10,10,10,10,10,10,9,9,9,9,9,9,9,9,9,9,9,9,8,8,8,8,8,8,8,7,6,5,4,3,2,1,0,17,18,19,20,21,22,23,24,24,24,24,24,24,24,25,25,25,25,25,25,25,25,25,25,25,25,26,26,26,26,26,26,26,26,26,26,26,26,26,26,26,26,26,26,26,26,26,26,26,27,27,27,27,27,27,27,27,27,27,27,27,27,27,27,
13,13,13,13,13,13,13,13,13,13,13,13,13,13,13,13,13,13,13,13,13,13,13,12,12,12,12,12,12,12,12,12,12,12,12,12,12,12,12,12,12,12,11,11,11,11,11,11,11,11,11,11,10,10,10,10,10,10,9,9,9,8,8,4,0,20,24,24,25,25,25,26,26,26,26,26,26,27,27,27,27,27,27,27,27,27,27,28,28,28,28,28,28,28,28,28,28,28,28,28,28,28,28,28,28,28,29,29,29,29,29,29,29,29,29,29,29,29,29,29,29,29,29,29,29,29,29,29,29,
15,15,15,15,15,15,15,15,15,15,15,15,15,15,15,15,15,15,15,15,15,15,15,15,15,15,15,15,15,15,14,14,14,14,14,14,14,14,14,14,14,14,14,14,14,13,13,13,13,13,13,13,13,13,12,12,12,12,12,11,11,10,10,9,0,25,26,26,27,27,28,28,28,28,28,29,29,29,29,29,29,29,29,29,30,30,30,30,30,30,30,30,30,30,30,30,30,30,30,31,31,31,31,31,31,31,31,31,31,31,31,31,31,31,31,31,31,31,31,31,31,31,31,31,31,31,31,31,31};

__device__ __forceinline__ float wave_sum(float v) {
#pragma unroll
    for (int o = 32; o > 0; o >>= 1) v += __shfl_xor(v, o);
    return v;
}

__global__ void __launch_bounds__(256) nv_rmsnorm(const float* __restrict__ x, const float* __restrict__ g, float* __restrict__ y, int rows) {
    int row = blockIdx.x * 4 + (threadIdx.x >> 6), lane = threadIdx.x & 63;
    if (row >= rows) return;
    const float* xr = x + (size_t)row * D;
    float v[16]; float ss = 0.f;
#pragma unroll
    for (int i = 0; i < 16; ++i) { v[i] = xr[lane + 64 * i]; ss += v[i] * v[i]; }
    ss = wave_sum(ss);
    float r = rsqrtf(ss * (1.0f / D) + EPS);
#pragma unroll
    for (int i = 0; i < 16; ++i) y[(size_t)row * D + lane + 64 * i] = v[i] * r * g[lane + 64 * i];
}

enum { EPI_STORE = 0, EPI_RESID = 1, EPI_SWIGLU = 2 };
template <int EPI>
__global__ void __launch_bounds__(256) nv_gemm(const float* __restrict__ A, int lda, const int* __restrict__ rowmap, int rshift,
                                               const int* __restrict__ Mptr, int Mfix,
                                               const float* __restrict__ Bm, int ldb, int N, int K,
                                               float* __restrict__ C, int ldc,
                                               const float* __restrict__ aux1, const float* __restrict__ aux2) {
    __shared__ float As[16][68];
    __shared__ float Bs[16][64];
    const int M = Mptr ? *Mptr : Mfix;
    const int m0 = blockIdx.y * 64, n0 = blockIdx.x * 64;
    if (m0 >= M) return;
    const int tid = threadIdx.x, tx = tid & 15, ty = tid >> 4;
    float acc[4][4];
#pragma unroll
    for (int i = 0; i < 4; ++i)
#pragma unroll
        for (int j = 0; j < 4; ++j) acc[i][j] = 0.f;
    const int ar = tid >> 2, ak = (tid & 3) * 4;
    const int arow = m0 + ar; const bool av = arow < M;
    const int srcrow = av ? (rowmap ? (rowmap[arow] >> rshift) : arow) : 0;
    const float* ap = A + (size_t)srcrow * lda + ak;
    const int bk = tid >> 4, bn = (tid & 15) * 4;
    const bool bv = (n0 + bn) < N;
    for (int k0 = 0; k0 < K; k0 += 16) {
        float4 a4 = av ? *(const float4*)(ap + k0) : make_float4(0.f, 0.f, 0.f, 0.f);
        float4 b4 = bv ? *(const float4*)(Bm + (size_t)(k0 + bk) * ldb + n0 + bn) : make_float4(0.f, 0.f, 0.f, 0.f);
        As[ak + 0][ar] = a4.x; As[ak + 1][ar] = a4.y; As[ak + 2][ar] = a4.z; As[ak + 3][ar] = a4.w;
        *(float4*)&Bs[bk][bn] = b4;
        __syncthreads();
#pragma unroll
        for (int kk = 0; kk < 16; ++kk) {
            float4 a = *(const float4*)&As[kk][ty * 4];
            float4 b = *(const float4*)&Bs[kk][tx * 4];
            float aa[4] = {a.x, a.y, a.z, a.w}, bb[4] = {b.x, b.y, b.z, b.w};
#pragma unroll
            for (int i = 0; i < 4; ++i)
#pragma unroll
                for (int j = 0; j < 4; ++j) acc[i][j] = fmaf(aa[i], bb[j], acc[i][j]);
        }
        __syncthreads();
    }
#pragma unroll
    for (int i = 0; i < 4; ++i) {
        const int row = m0 + ty * 4 + i;
        if (row >= M) continue;
        const int col = n0 + tx * 4;
        if (col >= N) continue;
        if (EPI == EPI_STORE) {
#pragma unroll
            for (int j = 0; j < 4; ++j) C[(size_t)row * ldc + col + j] = acc[i][j];
        } else if (EPI == EPI_RESID) {
#pragma unroll
            for (int j = 0; j < 4; ++j) C[(size_t)row * ldc + col + j] = aux1[(size_t)row * ldc + col + j] + acc[i][j];
        } else if (EPI == EPI_SWIGLU) {
#pragma unroll
            for (int j = 0; j < 4; j += 2) {
                float glu = acc[i][j] + aux1[col + j], lin = acc[i][j + 1] + aux1[col + j + 1];
                glu = fminf(glu, 7.0f); lin = fminf(fmaxf(lin, -7.0f), 7.0f);
                float sg = 1.0f / (1.0f + expf(-1.702f * glu));
                C[(size_t)row * ldc + (col + j) / 2] = glu * sg * (lin + 1.0f);
            }
        }
    }
}

__global__ void __launch_bounds__(256) nv_attn(const float* __restrict__ proj, const float* __restrict__ rel_bias, float* __restrict__ mix) {
    const int wid = blockIdx.x * 4 + (threadIdx.x >> 6), lane = threadIdx.x & 63;
    const int h = wid & 7, tok = wid >> 3, b = tok / S, pos = tok % S;
    const float q = proj[(size_t)tok * INW + C_AQ + h * 64 + lane];
    float outs[3], lses[3];
#pragma unroll
    for (int br = 0; br < 3; ++br) {
        const int dil = (br == 0) ? 1 : (br == 1 ? 4 : 16);
        float m = -3.0e38f, l = 0.f, o = 0.f;
        for (int j = -64; j <= 64; ++j) {
            const int kp = pos + j * dil;
            if (kp < 0 || kp >= S) continue;
            const size_t kr = (size_t)(b * S + kp) * INW;
            float d = wave_sum(q * proj[kr + C_AK + h * 64 + lane]);
            float logit = d * 0.125f + rel_bias[T5TAB[br * 129 + j + 64] * AH + h];
            float mn = fmaxf(m, logit);
            float sc = expf(m - mn), p = expf(logit - mn);
            l = l * sc + p; o = o * sc + p * proj[kr + C_AV + h * 64 + lane];
            m = mn;
        }
        outs[br] = o / l; lses[br] = m + logf(l);
    }
    float mm = fmaxf(lses[0], fmaxf(lses[1], lses[2]));
    float w0 = expf(lses[0] - mm), w1 = expf(lses[1] - mm), w2 = expf(lses[2] - mm);
    float ws = w0 + w1 + w2;
    mix[(size_t)tok * D + h * 64 + lane] = (w0 * outs[0] + w1 * outs[1] + w2 * outs[2]) / ws;
}

__global__ void __launch_bounds__(256) nv_la(const float* __restrict__ proj, const float* __restrict__ wgf, const float* __restrict__ bgf,
                                             const float* __restrict__ wgb, const float* __restrict__ bgb, float* __restrict__ ea) {
    const int tok = blockIdx.x, col = threadIdx.x;
#pragma unroll
    for (int dir = 0; dir < 2; ++dir) {
        const float* wg = dir ? wgb : wgf; const float* bg = dir ? bgb : bgf;
        float a = bg[col];
        for (int r = 0; r < 16; ++r) a += proj[(size_t)tok * INW + C_GZ + dir * 16 + r] * wg[r * 256 + col];
        float ls = fminf(a, 0.f) - log1pf(expf(-fabsf(a)));
        ea[((size_t)dir * T + tok) * 256 + col] = expf(ls * (1.0f / 16.0f));
    }
}

__global__ void __launch_bounds__(128) nv_gla(const float* __restrict__ proj, const float* __restrict__ ea, float* __restrict__ og) {
    const int e = threadIdx.x, bhd = blockIdx.x, dir = bhd & 1, h = (bhd >> 1) & 3, b = bhd >> 3;
    float st[64];
#pragma unroll
    for (int d = 0; d < 64; ++d) st[d] = 0.f;
    for (int i = 0; i < S; ++i) {
        const int pos = dir ? (S - 1 - i) : i;
        const size_t tok = (size_t)b * S + pos;
        const float* pr = proj + tok * INW;
        const float* ar = ea + ((size_t)dir * T + tok) * 256 + h * 64;
        const float v = pr[C_GV + h * 128 + e];
        float o = 0.f;
#pragma unroll
        for (int d = 0; d < 64; ++d) {
            st[d] = fmaf(ar[d], st[d], pr[C_GK + h * 64 + d] * v);
            o = fmaf(pr[C_GQ + h * 64 + d] * 0.125f, st[d], o);
        }
        og[((size_t)dir * T + tok) * 512 + h * 128 + e] = o;
    }
}

__global__ void __launch_bounds__(256) nv_gla_out(const float* __restrict__ proj, const float* __restrict__ og, const float* __restrict__ ng, float* __restrict__ mix) {
    const int wid = blockIdx.x * 4 + (threadIdx.x >> 6), lane = threadIdx.x & 63;
    const int h = wid & 3, tok = wid >> 2;
    float o0 = og[(size_t)tok * 512 + h * 128 + lane] + og[((size_t)T + tok) * 512 + h * 128 + lane];
    float o1 = og[(size_t)tok * 512 + h * 128 + 64 + lane] + og[((size_t)T + tok) * 512 + h * 128 + 64 + lane];
    float ss = wave_sum(o0 * o0 + o1 * o1);
    float r = rsqrtf(ss * (1.0f / 128.0f) + EPS);
    float g0 = proj[(size_t)tok * INW + C_GO + h * 128 + lane], g1 = proj[(size_t)tok * INW + C_GO + h * 128 + 64 + lane];
    mix[(size_t)tok * D + 512 + h * 128 + lane] = o0 * r * ng[h * 128 + lane] * (g0 / (1.0f + expf(-g0)));
    mix[(size_t)tok * D + 512 + h * 128 + 64 + lane] = o1 * r * ng[h * 128 + 64 + lane] * (g1 / (1.0f + expf(-g1)));
}

__global__ void __launch_bounds__(256) nv_route(const float* __restrict__ x1, const float* __restrict__ g2, const float* __restrict__ rw, const float* __restrict__ rb,
                                                float* __restrict__ xn2, int* __restrict__ topi, float* __restrict__ gate) {
    __shared__ float xs[4][1024];
    __shared__ float lg[4][32];
    const int w = threadIdx.x >> 6, lane = threadIdx.x & 63, tok = blockIdx.x * 4 + w;
    const float* xr = x1 + (size_t)tok * D;
    float v[16]; float ss = 0.f;
#pragma unroll
    for (int i = 0; i < 16; ++i) { v[i] = xr[lane + 64 * i]; ss += v[i] * v[i]; }
    ss = wave_sum(ss);
    const float r = rsqrtf(ss * (1.0f / D) + EPS);
#pragma unroll
    for (int i = 0; i < 16; ++i) { float y = v[i] * r * g2[lane + 64 * i]; xs[w][lane + 64 * i] = y; xn2[(size_t)tok * D + lane + 64 * i] = y; }
    __syncthreads();
    const int e = lane & 31, half = lane >> 5;
    float a = 0.f;
    for (int k = half * 512; k < half * 512 + 512; ++k) a = fmaf(xs[w][k], rw[k * 32 + e], a);
    a += __shfl_xor(a, 32);
    if (lane < 32) lg[w][lane] = a + rb[lane];
    __syncthreads();
    if (lane == 0) {
        float bv[4]; int bi[4];
        unsigned used = 0u;
#pragma unroll
        for (int k = 0; k < 4; ++k) {
            float best = -3.0e38f; int bidx = 0;
            for (int j = 0; j < 32; ++j) { float x = lg[w][j]; if (!((used >> j) & 1u) && x > best) { best = x; bidx = j; } }
            used |= 1u << bidx; bv[k] = best; bi[k] = bidx;
        }
        float e0 = 1.0f, e1 = expf(bv[1] - bv[0]), e2 = expf(bv[2] - bv[0]), e3 = expf(bv[3] - bv[0]);
        float s = e0 + e1 + e2 + e3;
        topi[tok * 4 + 0] = bi[0]; topi[tok * 4 + 1] = bi[1]; topi[tok * 4 + 2] = bi[2]; topi[tok * 4 + 3] = bi[3];
        gate[tok * 4 + 0] = e0 / s; gate[tok * 4 + 1] = e1 / s; gate[tok * 4 + 2] = e2 / s; gate[tok * 4 + 3] = e3 / s;
    }
}

__global__ void nv_lists(const int* __restrict__ topi, int* __restrict__ lists, int* __restrict__ counts) {
    const int e = threadIdx.x;
    int c = 0;
    for (int s = 0; s < T * 4; ++s) if (topi[s] == e) lists[e * T + c++] = s;
    counts[e] = c;
}

__global__ void __launch_bounds__(256) nv_moe2(const float* __restrict__ A, const int* __restrict__ slots, const int* __restrict__ Mptr,
                                               const float* __restrict__ Bm, float* __restrict__ x2, const float* __restrict__ b2, const float* __restrict__ gate) {
    __shared__ float As[16][68];
    __shared__ float Bs[16][64];
    const int M = *Mptr;
    const int m0 = blockIdx.y * 64, n0 = blockIdx.x * 64;
    if (m0 >= M) return;
    const int tid = threadIdx.x, tx = tid & 15, ty = tid >> 4;
    float acc[4][4];
#pragma unroll
    for (int i = 0; i < 4; ++i)
#pragma unroll
        for (int j = 0; j < 4; ++j) acc[i][j] = 0.f;
    const int ar = tid >> 2, ak = (tid & 3) * 4;
    const int arow = m0 + ar; const bool av = arow < M;
    const float* ap = A + (size_t)(av ? arow : 0) * DFF + ak;
    const int bk = tid >> 4, bn = (tid & 15) * 4;
    for (int k0 = 0; k0 < DFF; k0 += 16) {
        float4 a4 = av ? *(const float4*)(ap + k0) : make_float4(0.f, 0.f, 0.f, 0.f);
        float4 b4 = *(const float4*)(Bm + (size_t)(k0 + bk) * D + n0 + bn);
        As[ak + 0][ar] = a4.x; As[ak + 1][ar] = a4.y; As[ak + 2][ar] = a4.z; As[ak + 3][ar] = a4.w;
        *(float4*)&Bs[bk][bn] = b4;
        __syncthreads();
#pragma unroll
        for (int kk = 0; kk < 16; ++kk) {
            float4 a = *(const float4*)&As[kk][ty * 4];
            float4 b = *(const float4*)&Bs[kk][tx * 4];
            float aa[4] = {a.x, a.y, a.z, a.w}, bb[4] = {b.x, b.y, b.z, b.w};
#pragma unroll
            for (int i = 0; i < 4; ++i)
#pragma unroll
                for (int j = 0; j < 4; ++j) acc[i][j] = fmaf(aa[i], bb[j], acc[i][j]);
        }
        __syncthreads();
    }
#pragma unroll
    for (int i = 0; i < 4; ++i) {
        const int row = m0 + ty * 4 + i;
        if (row >= M) continue;
        const int col = n0 + tx * 4;
        const int slot = slots[row]; const int tok = slot >> 2; const float gt = gate[slot];
#pragma unroll
        for (int j = 0; j < 4; ++j) x2[(size_t)tok * D + col + j] += gt * (acc[i][j] + b2[col + j]);
    }
}


#include <hip/hip_cooperative_groups.h>
namespace cg = cooperative_groups;

typedef unsigned short u16;
typedef short bf16x8 __attribute__((ext_vector_type(8)));
typedef short s16x4 __attribute__((ext_vector_type(4)));
typedef float f32x4 __attribute__((ext_vector_type(4)));
typedef __bf16 bfv2 __attribute__((ext_vector_type(2)));
typedef float fv2 __attribute__((ext_vector_type(2)));
#define LDS_AS __attribute__((address_space(3)))

constexpr int LDS_BYTES = 72 * 1024;
constexpr int NSLOT = T * 4;

struct Params {
    const float *x, *g1, *w_in, *rel_bias, *wgf, *bgf, *wgb, *bgb, *gla_ng, *w_out, *g2, *rw, *rb, *w1, *b1, *w2, *b2, *gf;
    float* out;
    u16* xn;
    u16* proj;
    u16* abr;
    float* lse;
    float* dS;
    float* dec;
    u16* Sp;
    u16* mix;
    float* x1;
    u16* xn2;
    int* counts;
    int* lists;
    float* gate;
    u16* act;
    u16* y;
    int ph_lo, ph_hi;
};

__device__ __forceinline__ int tid_opaque() { int t = threadIdx.x; asm volatile("" : "+v"(t)); return t; }
__device__ __forceinline__ float bf2f(u16 v) { return __uint_as_float((unsigned)v << 16); }
__device__ __forceinline__ unsigned pack2(float a, float b) {
    fv2 v = {a, b};
    bfv2 r = __builtin_convertvector(v, bfv2);
    return __builtin_bit_cast(unsigned, r);
}
__device__ __forceinline__ u16 f2bf(float a) { return (u16)(pack2(a, 0.f) & 0xffffu); }
__device__ __forceinline__ float lo2f(unsigned u) { return __uint_as_float(u << 16); }
__device__ __forceinline__ float hi2f(unsigned u) { return __uint_as_float(u & 0xffff0000u); }
__device__ __forceinline__ int tile_off(int row, int chunk) { return row * 128 + ((chunk ^ (row & 7)) << 4); }
__device__ __forceinline__ bf16x8 lds_frag(const char* base, int row, int chunk) { return *(const bf16x8*)(base + tile_off(row, chunk)); }
__device__ __forceinline__ s16x4 tr_read(const char* p) {
    return __builtin_amdgcn_ds_read_tr16_b64_v4i16((LDS_AS s16x4*)(p));
}
__device__ __forceinline__ bf16x8 cat4(s16x4 a, s16x4 b) { bf16x8 r = {a[0], a[1], a[2], a[3], b[0], b[1], b[2], b[3]}; return r; }
__device__ __forceinline__ float logsig(float a) { return fminf(a, 0.f) - log1pf(expf(-fabsf(a))); }

__device__ void ph_norm1(const Params& p) {
    const int lane = threadIdx.x & 63, gw = blockIdx.x * 4 + (threadIdx.x >> 6), nw = gridDim.x * 4;
    if (blockIdx.x == 0 && threadIdx.x < 32) p.counts[threadIdx.x] = 0;
    for (int row = gw; row < T; row += nw) {
        const float4* xr = (const float4*)(p.x + (size_t)row * D);
        float4 v[4]; float ss = 0.f;
#pragma unroll
        for (int i = 0; i < 4; ++i) { v[i] = xr[lane + 64 * i]; ss += v[i].x * v[i].x + v[i].y * v[i].y + v[i].z * v[i].z + v[i].w * v[i].w; }
        ss = wave_sum(ss);
        const float r = rsqrtf(ss * (1.0f / D) + EPS);
#pragma unroll
        for (int i = 0; i < 4; ++i) {
            const float4 g = ((const float4*)p.g1)[lane + 64 * i];
            uint2 o; o.x = pack2(v[i].x * r * g.x, v[i].y * r * g.y); o.y = pack2(v[i].z * r * g.z, v[i].w * r * g.w);
            *(uint2*)(p.xn + (size_t)row * D + (lane + 64 * i) * 4) = o;
        }
    }
}

__device__ __forceinline__ void gemm_mainloop(char* lds, const u16* a0, const u16* a1, const u16* a2, const u16* a3,
                                              const float* bp, int ldb, bool bvalid, int nk, f32x4 (&acc)[4][4]) {
    const int t = tid_opaque(), l = t & 63, w = t >> 6;
    const int wm = w >> 1, wn = w & 1;
    const int ar = t >> 3, ac = t & 7;
    const int kg = l & 7, ng = w * 8 + (l >> 3);
    uint4 av[4]; float4 bv[8];
#pragma unroll
    for (int m = 0; m < 4; ++m)
#pragma unroll
        for (int n = 0; n < 4; ++n) acc[m][n] = (f32x4){0.f, 0.f, 0.f, 0.f};

    auto gload = [&](int kt) {
        av[0] = *(const uint4*)(a0 + kt * 64); av[1] = *(const uint4*)(a1 + kt * 64);
        av[2] = *(const uint4*)(a2 + kt * 64); av[3] = *(const uint4*)(a3 + kt * 64);
        const float* b = bp + (size_t)kt * 64 * ldb;
#pragma unroll
        for (int j = 0; j < 8; ++j) bv[j] = bvalid ? *(const float4*)(b + (size_t)j * ldb) : make_float4(0.f, 0.f, 0.f, 0.f);
    };
    auto lstore = [&](int buf) {
        char* As = lds + buf * 32768; char* Bs = As + 16384;
#pragma unroll
        for (int i = 0; i < 4; ++i) *(uint4*)(As + tile_off(ar + 32 * i, ac)) = av[i];
        {
            uint4 q;
            q.x = pack2(bv[0].x, bv[1].x); q.y = pack2(bv[2].x, bv[3].x); q.z = pack2(bv[4].x, bv[5].x); q.w = pack2(bv[6].x, bv[7].x);
            *(uint4*)(Bs + tile_off(4 * ng + 0, kg)) = q;
            q.x = pack2(bv[0].y, bv[1].y); q.y = pack2(bv[2].y, bv[3].y); q.z = pack2(bv[4].y, bv[5].y); q.w = pack2(bv[6].y, bv[7].y);
            *(uint4*)(Bs + tile_off(4 * ng + 1, kg)) = q;
            q.x = pack2(bv[0].z, bv[1].z); q.y = pack2(bv[2].z, bv[3].z); q.z = pack2(bv[4].z, bv[5].z); q.w = pack2(bv[6].z, bv[7].z);
            *(uint4*)(Bs + tile_off(4 * ng + 2, kg)) = q;
            q.x = pack2(bv[0].w, bv[1].w); q.y = pack2(bv[2].w, bv[3].w); q.z = pack2(bv[4].w, bv[5].w); q.w = pack2(bv[6].w, bv[7].w);
            *(uint4*)(Bs + tile_off(4 * ng + 3, kg)) = q;
        }
    };
    gload(0);
    lstore(0);
    __syncthreads();
    for (int kt = 0; kt < nk; ++kt) {
        const int cur = kt & 1;
        if (kt + 1 < nk) gload(kt + 1);
        const char* As = lds + cur * 32768; const char* Bs = As + 16384;
#pragma unroll
        for (int ks = 0; ks < 2; ++ks) {
            bf16x8 af[4], bf[4];
#pragma unroll
            for (int m = 0; m < 4; ++m) af[m] = lds_frag(As, wm * 64 + m * 16 + (l & 15), ks * 4 + (l >> 4));
#pragma unroll
            for (int n = 0; n < 4; ++n) bf[n] = lds_frag(Bs, wn * 64 + n * 16 + (l & 15), ks * 4 + (l >> 4));
#pragma unroll
            for (int m = 0; m < 4; ++m)
#pragma unroll
                for (int n = 0; n < 4; ++n) acc[m][n] = __builtin_amdgcn_mfma_f32_16x16x32_bf16(bf[n], af[m], acc[m][n], 0, 0, 0);
        }
        if (kt + 1 < nk) lstore(cur ^ 1);
        __syncthreads();
    }
}

__device__ void ph_proj(const Params& p, char* lds) {
    const int t = tid_opaque(), l = t & 63, w = t >> 6, wm = w >> 1, wn = w & 1;
    const int ar = t >> 3, ac = t & 7, kg = l & 7, ng = w * 8 + (l >> 3);
    constexpr int MT = T / 128, NT = (INW + 127) / 128;
    for (int tile = blockIdx.x; tile < MT * NT; tile += gridDim.x) {
        const int m0 = (tile % MT) * 128, n0 = (tile / MT) * 128;
        const u16* ab = p.xn + (size_t)(m0 + ar) * D + ac * 8;
        const bool bvalid = (n0 + 4 * ng) < INW;
        const float* bp = p.w_in + (size_t)(8 * kg) * INW + n0 + 4 * ng;
        f32x4 acc[4][4];
        gemm_mainloop(lds, ab, ab + 32 * D, ab + 64 * D, ab + 96 * D, bp, INW, bvalid, D / 64, acc);
#pragma unroll
        for (int m = 0; m < 4; ++m) {
            const int row = m0 + wm * 64 + m * 16 + (l & 15);
#pragma unroll
            for (int n = 0; n < 4; ++n) {
                const int col = n0 + wn * 64 + n * 16 + (l >> 4) * 4;
                if (col < INW) {
                    uint2 o; o.x = pack2(acc[m][n][0], acc[m][n][1]); o.y = pack2(acc[m][n][2], acc[m][n][3]);
                    *(uint2*)(p.proj + (size_t)row * INW + col) = o;
                }
            }
        }
    }
}

constexpr int AT_K = 0, AT_V = 24576, AT_Q = 24576 + 30720, AT_BIAS = AT_Q + 8192;
__device__ void attn_item(const Params& p, char* lds, int it) {
    const int t = tid_opaque(), l = t & 63, w = t >> 6, i16 = l & 15, g = l >> 4;
    const int idx = it & 63, br = (it >> 6) % 3, h = (it / 192) & 7, b = it / 1536;
    const int dsh = br * 2, L = S >> dsh, nbl = L >> 6;
    const int res = idx / nbl, qb = idx % nbl;
    char* Ks = lds + AT_K; char* Vs = lds + AT_V; char* Qs = lds + AT_Q; float* biasf = (float*)(lds + AT_BIAS);
    __syncthreads();
#pragma unroll
    for (int i = 0; i < 6; ++i) {
        const int j = t + 256 * i, row = j >> 3, c = j & 7;
        const int ki = 64 * (qb - 1) + row;
        uint4 kv = make_uint4(0u, 0u, 0u, 0u), vv = kv;
        if (ki >= 0 && ki < L) {
            const size_t base = (size_t)(b * S + res + (ki << dsh)) * INW + h * 64 + c * 8;
            kv = *(const uint4*)(p.proj + base + C_AK);
            vv = *(const uint4*)(p.proj + base + C_AV);
        }
        *(uint4*)(Ks + tile_off(row, c)) = kv;
        *(uint4*)(Vs + row * 160 + c * 16) = vv;
    }
#pragma unroll
    for (int i = 0; i < 2; ++i) {
        const int j = t + 256 * i, row = j >> 3, c = j & 7;
        const size_t base = (size_t)(b * S + res + ((64 * qb + row) << dsh)) * INW + C_AQ + h * 64 + c * 8;
        *(uint4*)(Qs + tile_off(row, c)) = *(const uint4*)(p.proj + base);
    }
    if (t < 129) biasf[t] = p.rel_bias[T5TAB[br * 129 + t] * AH + h];
    __syncthreads();

    const bf16x8 qf0 = lds_frag(Qs, 16 * w + i16, g), qf1 = lds_frag(Qs, 16 * w + i16, 4 + g);
    f32x4 sc[10];
#pragma unroll
    for (int i = 0; i < 10; ++i) {
        const int tt = min(w + i, 11);
        const bf16x8 k0 = lds_frag(Ks, 16 * tt + i16, g), k1 = lds_frag(Ks, 16 * tt + i16, 4 + g);
        f32x4 a = {0.f, 0.f, 0.f, 0.f};
        a = __builtin_amdgcn_mfma_f32_16x16x32_bf16(k0, qf0, a, 0, 0, 0);
        a = __builtin_amdgcn_mfma_f32_16x16x32_bf16(k1, qf1, a, 0, 0, 0);
        sc[i] = a;
    }
    const int sq = 16 * w + i16;
    float mx = -3.0e38f;
#pragma unroll
    for (int i = 0; i < 10; ++i) {
#pragma unroll
        for (int r = 0; r < 4; ++r) {
            const int tk = 16 * (w + i) + 4 * g + r;
            const int off = tk - 64 - sq;
            const int ki = 64 * (qb - 1) + tk;
            const bool valid = (w + i <= 11) && (off >= -64) && (off <= 64) && (ki >= 0) && (ki < L);
            const float lg = valid ? (sc[i][r] * 0.125f + biasf[valid ? off + 64 : 0]) : -1.0e30f;
            sc[i][r] = lg;
            mx = fmaxf(mx, lg);
        }
    }
    mx = fmaxf(mx, __shfl_xor(mx, 16)); mx = fmaxf(mx, __shfl_xor(mx, 32));
    float ls = 0.f;
#pragma unroll
    for (int i = 0; i < 10; ++i) {
#pragma unroll
        for (int r = 0; r < 4; ++r) { const float e = (sc[i][r] > -1.0e29f) ? __expf(sc[i][r] - mx) : 0.f; sc[i][r] = e; ls += e; }
    }
    ls += __shfl_xor(ls, 16); ls += __shfl_xor(ls, 32);

    f32x4 oa[4];
#pragma unroll
    for (int e = 0; e < 4; ++e) oa[e] = (f32x4){0.f, 0.f, 0.f, 0.f};
#pragma unroll
    for (int i2 = 0; i2 < 5; ++i2) {
        const int tta = min(w + 2 * i2, 11), ttb = min(w + 2 * i2 + 1, 11);
        uint4 pu;
        pu.x = pack2(sc[2 * i2][0], sc[2 * i2][1]); pu.y = pack2(sc[2 * i2][2], sc[2 * i2][3]);
        pu.z = pack2(sc[2 * i2 + 1][0], sc[2 * i2 + 1][1]); pu.w = pack2(sc[2 * i2 + 1][2], sc[2 * i2 + 1][3]);
        const bf16x8 pf = __builtin_bit_cast(bf16x8, pu);
#pragma unroll
        for (int et = 0; et < 4; ++et) {
            const s16x4 va = tr_read(Vs + (16 * tta + 4 * g + (i16 >> 2)) * 160 + (16 * et + 4 * (i16 & 3)) * 2);
            const s16x4 vb = tr_read(Vs + (16 * ttb + 4 * g + (i16 >> 2)) * 160 + (16 * et + 4 * (i16 & 3)) * 2);
            oa[et] = __builtin_amdgcn_mfma_f32_16x16x32_bf16(cat4(va, vb), pf, oa[et], 0, 0, 0);
        }
    }
    const float inv = 1.0f / ls;
    const size_t tok = (size_t)b * S + res + ((64 * qb + sq) << dsh);
#pragma unroll
    for (int et = 0; et < 4; ++et) {
        uint2 o; o.x = pack2(oa[et][0] * inv, oa[et][1] * inv); o.y = pack2(oa[et][2] * inv, oa[et][3] * inv);
        *(uint2*)(p.abr + ((size_t)br * T + tok) * 512 + h * 64 + 16 * et + 4 * g) = o;
    }
    if (g == 0) p.lse[((size_t)br * T + tok) * 8 + h] = mx + __logf(ls);
}

constexpr int GL_ZS = 0, GL_TOT = 8192, GL_T0 = 10240;
__device__ __forceinline__ void gla_prep(const Params& p, char* lds, int h, int t0, float (&bfv)[16], float (&bbv)[16], float& Gf, float& Gb) {
    const int t = tid_opaque(), d = t & 63, w = t >> 6;
    float* zs = (float*)(lds + GL_ZS); float* tot = (float*)(lds + GL_TOT);
    __syncthreads();
    {
        const uint4 zz = *(const uint4*)(p.proj + (size_t)(t0 + (t >> 2)) * INW + C_GZ + (t & 3) * 8);
        float* zd = zs + (t >> 2) * 32 + (t & 3) * 8;
        zd[0] = lo2f(zz.x); zd[1] = hi2f(zz.x); zd[2] = lo2f(zz.y); zd[3] = hi2f(zz.y);
        zd[4] = lo2f(zz.z); zd[5] = hi2f(zz.z); zd[6] = lo2f(zz.w); zd[7] = hi2f(zz.w);
    }
    float wf[16], wb[16];
#pragma unroll
    for (int r = 0; r < 16; ++r) { wf[r] = p.wgf[r * 256 + h * 64 + d]; wb[r] = p.wgb[r * 256 + h * 64 + d]; }
    const float biasf = p.bgf[h * 64 + d], biasb = p.bgb[h * 64 + d];
    __syncthreads();
#pragma unroll
    for (int i = 0; i < 16; ++i) {
        const float* zr = zs + (16 * w + i) * 32;
        float af = biasf, ab = biasb;
#pragma unroll
        for (int r = 0; r < 16; ++r) { af = fmaf(zr[r], wf[r], af); ab = fmaf(zr[16 + r], wb[r], ab); }
        bfv[i] = logsig(af) * (1.0f / 16.0f); bbv[i] = logsig(ab) * (1.0f / 16.0f);
    }
#pragma unroll
    for (int i = 1; i < 16; ++i) bfv[i] += bfv[i - 1];
#pragma unroll
    for (int i = 14; i >= 0; --i) bbv[i] += bbv[i + 1];
    tot[(0 * 4 + w) * 64 + d] = bfv[15];
    tot[(1 * 4 + w) * 64 + d] = bbv[0];
    __syncthreads();
    float offf = 0.f, offb = 0.f; Gf = 0.f; Gb = 0.f;
#pragma unroll
    for (int ww = 0; ww < 4; ++ww) {
        const float a = tot[(0 * 4 + ww) * 64 + d], c = tot[(1 * 4 + ww) * 64 + d];
        Gf += a; Gb += c;
        if (ww < w) offf += a;
        if (ww > w) offb += c;
    }
#pragma unroll
    for (int i = 0; i < 16; ++i) { bfv[i] += offf; bbv[i] += offb; }
}

constexpr int GD_KF = GL_T0, GD_KB = GD_KF + 64 * 160, GD_VT = GD_KB + 64 * 160;
__device__ void gla_ds_item(const Params& p, char* lds, int it) {
    const int t = tid_opaque(), l = t & 63, w = t >> 6, d = l, i16 = l & 15, g = l >> 4;
    const int n = it & 63, h = (it >> 6) & 3, b = it >> 8;
    const int t0 = b * S + n * 64;
    float bfv[16], bbv[16], Gf, Gb;
    gla_prep(p, lds, h, t0, bfv, bbv, Gf, Gb);
    char* KF = lds + GD_KF; char* KB = lds + GD_KB; char* VT = lds + GD_VT;
#pragma unroll
    for (int i = 0; i < 16; ++i) {
        const int s = 16 * w + i;
        const float kk = bf2f(p.proj[(size_t)(t0 + s) * INW + C_GK + h * 64 + d]);
        *(u16*)(KF + s * 160 + d * 2) = f2bf(kk * __expf(Gf - bfv[i]));
        *(u16*)(KB + s * 160 + d * 2) = f2bf(kk * __expf(Gb - bbv[i]));
    }
#pragma unroll
    for (int i = 0; i < 4; ++i) {
        const int j = t + 256 * i, row = j >> 4, c = j & 15;
        *(uint4*)(VT + row * 288 + c * 16) = *(const uint4*)(p.proj + (size_t)(t0 + row) * INW + C_GV + h * 128 + c * 8);
    }
    if (w == 0) { p.dec[((size_t)it * 2 + 0) * 64 + d] = __expf(Gf); p.dec[((size_t)it * 2 + 1) * 64 + d] = __expf(Gb); }
    __syncthreads();
#pragma unroll
    for (int dir = 0; dir < 2; ++dir) {
        const char* KX = dir ? KB : KF;
        f32x4 acc[2][4];
#pragma unroll
        for (int a = 0; a < 2; ++a)
#pragma unroll
            for (int c = 0; c < 4; ++c) acc[a][c] = (f32x4){0.f, 0.f, 0.f, 0.f};
#pragma unroll
        for (int ks = 0; ks < 2; ++ks) {
            const int r0 = ks * 32 + 8 * g + (i16 >> 2);
            bf16x8 af[2], bf[4];
#pragma unroll
            for (int a = 0; a < 2; ++a) {
                const int e0 = 16 * (2 * w + a) + 4 * (i16 & 3);
                af[a] = cat4(tr_read(VT + r0 * 288 + e0 * 2), tr_read(VT + (r0 + 4) * 288 + e0 * 2));
            }
#pragma unroll
            for (int c = 0; c < 4; ++c) {
                const int d0 = 16 * c + 4 * (i16 & 3);
                bf[c] = cat4(tr_read(KX + r0 * 160 + d0 * 2), tr_read(KX + (r0 + 4) * 160 + d0 * 2));
            }
#pragma unroll
            for (int a = 0; a < 2; ++a)
#pragma unroll
                for (int c = 0; c < 4; ++c) acc[a][c] = __builtin_amdgcn_mfma_f32_16x16x32_bf16(af[a], bf[c], acc[a][c], 0, 0, 0);
        }
        float* dst = p.dS + ((size_t)it * 2 + dir) * 128 * 64;
#pragma unroll
        for (int a = 0; a < 2; ++a)
#pragma unroll
            for (int c = 0; c < 4; ++c)
#pragma unroll
                for (int r = 0; r < 4; ++r) dst[(16 * (2 * w + a) + 4 * g + r) * 64 + 16 * c + i16] = acc[a][c][r];
    }
}

__device__ void gla_scan_block(const Params& p, int blk) {
    const int gid = blk * 256 + threadIdx.x;
    const int d = gid & 63, e = (gid >> 6) & 127, dir = (gid >> 13) & 1, bh = gid >> 14;
    float s = 0.f;
    for (int step = 0; step < 64; ++step) {
        const int n = dir ? (63 - step) : step;
        const size_t item = ((size_t)(bh * 64 + n)) * 2 + dir;
        p.Sp[(item * 128 + e) * 64 + d] = f2bf(s);
        s = fmaf(p.dec[item * 64 + d], s, p.dS[(item * 128 + e) * 64 + d]);
    }
}

__device__ void attn_combine_block(const Params& p, int blk) {
    const int gid = blk * 256 + threadIdx.x;
    const int tok = gid >> 6, c = gid & 63, h = c >> 3;
    const float l0 = p.lse[((size_t)0 * T + tok) * 8 + h], l1 = p.lse[((size_t)1 * T + tok) * 8 + h], l2 = p.lse[((size_t)2 * T + tok) * 8 + h];
    const float mm = fmaxf(l0, fmaxf(l1, l2));
    float w0 = __expf(l0 - mm), w1 = __expf(l1 - mm), w2 = __expf(l2 - mm);
    const float inv = 1.0f / (w0 + w1 + w2);
    w0 *= inv; w1 *= inv; w2 *= inv;
    const uint4 a0 = *(const uint4*)(p.abr + ((size_t)0 * T + tok) * 512 + c * 8);
    const uint4 a1 = *(const uint4*)(p.abr + ((size_t)1 * T + tok) * 512 + c * 8);
    const uint4 a2 = *(const uint4*)(p.abr + ((size_t)2 * T + tok) * 512 + c * 8);
    uint4 o;
    o.x = pack2(w0 * lo2f(a0.x) + w1 * lo2f(a1.x) + w2 * lo2f(a2.x), w0 * hi2f(a0.x) + w1 * hi2f(a1.x) + w2 * hi2f(a2.x));
    o.y = pack2(w0 * lo2f(a0.y) + w1 * lo2f(a1.y) + w2 * lo2f(a2.y), w0 * hi2f(a0.y) + w1 * hi2f(a1.y) + w2 * hi2f(a2.y));
    o.z = pack2(w0 * lo2f(a0.z) + w1 * lo2f(a1.z) + w2 * lo2f(a2.z), w0 * hi2f(a0.z) + w1 * hi2f(a1.z) + w2 * hi2f(a2.z));
    o.w = pack2(w0 * lo2f(a0.w) + w1 * lo2f(a1.w) + w2 * lo2f(a2.w), w0 * hi2f(a0.w) + w1 * hi2f(a1.w) + w2 * hi2f(a2.w));
    *(uint4*)(p.mix + (size_t)tok * D + c * 8) = o;
}

constexpr int GO_QF = GL_T0, GO_QB = GO_QF + 8192, GO_KF = GO_QB + 8192, GO_KB = GO_KF + 8192, GO_VT = GO_KB + 8192, GO_AM = GL_ZS;
__device__ void gla_out_item(const Params& p, char* lds, int it) {
    const int t = tid_opaque(), l = t & 63, w = t >> 6, d = l, i16 = l & 15, g = l >> 4;
    const int n = it & 63, h = (it >> 6) & 3, b = it >> 8;
    const int t0 = b * S + n * 64;
    float bfv[16], bbv[16], Gf, Gb;
    gla_prep(p, lds, h, t0, bfv, bbv, Gf, Gb);
    char* QF = lds + GO_QF; char* QB = lds + GO_QB; char* KF = lds + GO_KF; char* KB = lds + GO_KB; char* VT = lds + GO_VT; char* AM = lds + GO_AM;
#pragma unroll
    for (int i = 0; i < 16; ++i) {
        const int s = 16 * w + i;
        const size_t rb = (size_t)(t0 + s) * INW + h * 64 + d;
        const float qq = bf2f(p.proj[rb + C_GQ]) * 0.125f, kk = bf2f(p.proj[rb + C_GK]);
        const int o = tile_off(s, d >> 3) + (d & 7) * 2;
        const float ef = __expf(bfv[i]), eb = __expf(bbv[i]);
        *(u16*)(QF + o) = f2bf(qq * ef);
        *(u16*)(KF + o) = f2bf(kk / ef);
        *(u16*)(QB + o) = f2bf(qq * eb);
        *(u16*)(KB + o) = f2bf(kk / eb);
    }
#pragma unroll
    for (int i = 0; i < 4; ++i) {
        const int j = t + 256 * i, row = j >> 4, c = j & 15;
        *(uint4*)(VT + row * 288 + c * 16) = *(const uint4*)(p.proj + (size_t)(t0 + row) * INW + C_GV + h * 128 + c * 8);
    }
    __syncthreads();
    const int cq = 16 * w + i16;
    const bf16x8 qf0 = lds_frag(QF, cq, g), qf1 = lds_frag(QF, cq, 4 + g);
    const bf16x8 qb0 = lds_frag(QB, cq, g), qb1 = lds_frag(QB, cq, 4 + g);
#pragma unroll
    for (int st = 0; st < 4; ++st) {
        f32x4 af = {0.f, 0.f, 0.f, 0.f}, ab = {0.f, 0.f, 0.f, 0.f};
        af = __builtin_amdgcn_mfma_f32_16x16x32_bf16(lds_frag(KF, 16 * st + i16, g), qf0, af, 0, 0, 0);
        af = __builtin_amdgcn_mfma_f32_16x16x32_bf16(lds_frag(KF, 16 * st + i16, 4 + g), qf1, af, 0, 0, 0);
        ab = __builtin_amdgcn_mfma_f32_16x16x32_bf16(lds_frag(KB, 16 * st + i16, g), qb0, ab, 0, 0, 0);
        ab = __builtin_amdgcn_mfma_f32_16x16x32_bf16(lds_frag(KB, 16 * st + i16, 4 + g), qb1, ab, 0, 0, 0);
        float am[4];
#pragma unroll
        for (int r = 0; r < 4; ++r) {
            const int s = 16 * st + 4 * g + r;
            am[r] = (s <= cq ? af[r] : 0.f) + (s >= cq ? ab[r] : 0.f);
        }
        const int s0 = 16 * st + 4 * g;
        uint2 o; o.x = pack2(am[0], am[1]); o.y = pack2(am[2], am[3]);
        *(uint2*)(AM + tile_off(cq, s0 >> 3) + (s0 & 7) * 2) = o;
    }
    __syncthreads();
    f32x4 oc[8];
#pragma unroll
    for (int et = 0; et < 8; ++et) oc[et] = (f32x4){0.f, 0.f, 0.f, 0.f};
    const u16* SF = p.Sp + ((size_t)it * 2 + 0) * 128 * 64;
    const u16* SB = p.Sp + ((size_t)it * 2 + 1) * 128 * 64;
#pragma unroll
    for (int ks = 0; ks < 2; ++ks) {
        const bf16x8 amf = lds_frag(AM, cq, ks * 4 + g);
        const bf16x8 qff = ks ? qf1 : qf0, qbf = ks ? qb1 : qb0;
        const int r0 = ks * 32 + 8 * g + (i16 >> 2);
#pragma unroll
        for (int et = 0; et < 8; ++et) {
            const int e0 = 16 * et + 4 * (i16 & 3);
            const bf16x8 vf = cat4(tr_read(VT + r0 * 288 + e0 * 2), tr_read(VT + (r0 + 4) * 288 + e0 * 2));
            oc[et] = __builtin_amdgcn_mfma_f32_16x16x32_bf16(vf, amf, oc[et], 0, 0, 0);
            const bf16x8 sf = *(const bf16x8*)(SF + (16 * et + i16) * 64 + ks * 32 + 8 * g);
            oc[et] = __builtin_amdgcn_mfma_f32_16x16x32_bf16(sf, qff, oc[et], 0, 0, 0);
            const bf16x8 sb = *(const bf16x8*)(SB + (16 * et + i16) * 64 + ks * 32 + 8 * g);
            oc[et] = __builtin_amdgcn_mfma_f32_16x16x32_bf16(sb, qbf, oc[et], 0, 0, 0);
        }
    }
    float ss = 0.f;
#pragma unroll
    for (int et = 0; et < 8; ++et)
#pragma unroll
        for (int r = 0; r < 4; ++r) ss += oc[et][r] * oc[et][r];
    ss += __shfl_xor(ss, 16); ss += __shfl_xor(ss, 32);
    const float rstd = rsqrtf(ss * (1.0f / 128.0f) + EPS);
    const size_t tok = (size_t)t0 + cq;
#pragma unroll
    for (int et = 0; et < 8; ++et) {
        const int e = 16 * et + 4 * g;
        const uint2 gg = *(const uint2*)(p.proj + tok * INW + C_GO + h * 128 + e);
        const float4 ng = *(const float4*)(p.gla_ng + h * 128 + e);
        const float g0 = lo2f(gg.x), g1 = hi2f(gg.x), g2 = lo2f(gg.y), g3 = hi2f(gg.y);
        uint2 o;
        o.x = pack2(oc[et][0] * rstd * ng.x * (g0 / (1.0f + __expf(-g0))), oc[et][1] * rstd * ng.y * (g1 / (1.0f + __expf(-g1))));
        o.y = pack2(oc[et][2] * rstd * ng.z * (g2 / (1.0f + __expf(-g2))), oc[et][3] * rstd * ng.w * (g3 / (1.0f + __expf(-g3))));
        *(uint2*)(p.mix + tok * D + 512 + h * 128 + e) = o;
    }
}

__device__ void ph_outproj(const Params& p, char* lds) {
    const int t = tid_opaque(), l = t & 63, w = t >> 6, wm = w >> 1, wn = w & 1;
    const int ar = t >> 3, ac = t & 7, kg = l & 7, ng = w * 8 + (l >> 3);
    constexpr int MT = T / 128, NT = D / 128;
    for (int tile = blockIdx.x; tile < MT * NT; tile += gridDim.x) {
        const int m0 = (tile % MT) * 128, n0 = (tile / MT) * 128;
        const u16* ab = p.mix + (size_t)(m0 + ar) * D + ac * 8;
        const float* bp = p.w_out + (size_t)(8 * kg) * D + n0 + 4 * ng;
        f32x4 acc[4][4];
        gemm_mainloop(lds, ab, ab + 32 * D, ab + 64 * D, ab + 96 * D, bp, D, true, D / 64, acc);
#pragma unroll
        for (int m = 0; m < 4; ++m) {
            const int row = m0 + wm * 64 + m * 16 + (l & 15);
#pragma unroll
            for (int n = 0; n < 4; ++n) {
                const int col = n0 + wn * 64 + n * 16 + (l >> 4) * 4;
                const float4 xv = *(const float4*)(p.x + (size_t)row * D + col);
                float4 o; o.x = xv.x + acc[m][n][0]; o.y = xv.y + acc[m][n][1]; o.z = xv.z + acc[m][n][2]; o.w = xv.w + acc[m][n][3];
                *(float4*)(p.x1 + (size_t)row * D + col) = o;
            }
        }
    }
}

constexpr int RT_XS = 0, RT_PART = 32768, RT_LG = 32768 + 8192;
__device__ void ph_route(const Params& p, char* lds) {
    const int t = tid_opaque(), lane = t & 63, w = t >> 6;
    float* xs = (float*)(lds + RT_XS); float* part = (float*)(lds + RT_PART); float* lg = (float*)(lds + RT_LG);
    for (int it = blockIdx.x; it < T / 8; it += gridDim.x) {
        const int tok0 = it * 8;
        __syncthreads();
#pragma unroll
        for (int tt = 0; tt < 2; ++tt) {
            const int tl = 2 * w + tt, tok = tok0 + tl;
            const float4* xr = (const float4*)(p.x1 + (size_t)tok * D);
            float4 v[4]; float ss = 0.f;
#pragma unroll
            for (int i = 0; i < 4; ++i) { v[i] = xr[lane + 64 * i]; ss += v[i].x * v[i].x + v[i].y * v[i].y + v[i].z * v[i].z + v[i].w * v[i].w; }
            ss = wave_sum(ss);
            const float r = rsqrtf(ss * (1.0f / D) + EPS);
#pragma unroll
            for (int i = 0; i < 4; ++i) {
                const float4 gq = ((const float4*)p.g2)[lane + 64 * i];
                float4 yv; yv.x = v[i].x * r * gq.x; yv.y = v[i].y * r * gq.y; yv.z = v[i].z * r * gq.z; yv.w = v[i].w * r * gq.w;
                ((float4*)(xs + tl * 1024))[lane + 64 * i] = yv;
                uint2 o; o.x = pack2(yv.x, yv.y); o.y = pack2(yv.z, yv.w);
                *(uint2*)(p.xn2 + (size_t)tok * D + (lane + 64 * i) * 4) = o;
            }
        }
        __syncthreads();
        {
            const int e = t & 31, ksl = t >> 5;
            float a[8];
#pragma unroll
            for (int k = 0; k < 8; ++k) a[k] = 0.f;
            for (int k = ksl * 128; k < ksl * 128 + 128; ++k) {
                const float wv = p.rw[k * 32 + e];
#pragma unroll
                for (int tk = 0; tk < 8; ++tk) a[tk] = fmaf(xs[tk * 1024 + k], wv, a[tk]);
            }
#pragma unroll
            for (int tk = 0; tk < 8; ++tk) part[(ksl * 8 + tk) * 32 + e] = a[tk];
        }
        __syncthreads();
        {
            const int tk = t >> 5, e = t & 31;
            float sacc = 0.f;
#pragma unroll
            for (int ksl = 0; ksl < 8; ++ksl) sacc += part[(ksl * 8 + tk) * 32 + e];
            lg[tk * 32 + e] = sacc + p.rb[e];
        }
        __syncthreads();
        if (t < 8) {
            const int tok = tok0 + t;
            float bv[4]; int bi[4];
            unsigned used = 0u;
#pragma unroll
            for (int k = 0; k < 4; ++k) {
                float best = -3.0e38f; int bidx = 0;
                for (int j = 0; j < 32; ++j) { const float xv = lg[t * 32 + j]; if (!((used >> j) & 1u) && xv > best) { best = xv; bidx = j; } }
                used |= 1u << bidx; bv[k] = best; bi[k] = bidx;
            }
            const float e1 = expf(bv[1] - bv[0]), e2 = expf(bv[2] - bv[0]), e3 = expf(bv[3] - bv[0]);
            const float inv = 1.0f / (1.0f + e1 + e2 + e3);
            const float gs[4] = {inv, e1 * inv, e2 * inv, e3 * inv};
#pragma unroll
            for (int k = 0; k < 4; ++k) {
                const int slot = tok * 4 + k;
                const int pos = atomicAdd(&p.counts[bi[k]], 1);
                p.lists[bi[k] * T + pos] = slot;
                p.gate[slot] = gs[k];
            }
        }
    }
}

constexpr int MO_META = 65536;
__device__ __forceinline__ void moe_meta(const Params& p, int* meta) {
    __syncthreads();
    if (threadIdx.x == 0) {
        int mp = 0, rbse = 0;
        for (int e = 0; e < NE; ++e) {
            const int c = p.counts[e];
            meta[128 + e] = c; meta[160 + e] = mp; meta[200 + e] = rbse;
            mp += (c + 127) >> 7; rbse += c;
        }
        meta[160 + NE] = mp; meta[200 + NE] = rbse;
    }
    __syncthreads();
}

__device__ void ph_moe1(const Params& p, char* lds) {
    const int t = tid_opaque(), l = t & 63, w = t >> 6, wm = w >> 1, wn = w & 1;
    const int ar = t >> 3, ac = t & 7, kg = l & 7, ng = w * 8 + (l >> 3);
    int* meta = (int*)(lds + MO_META);
    moe_meta(p, meta);
    const int ntiles = meta[160 + NE] * 16;
    for (int tile = blockIdx.x; tile < ntiles; tile += gridDim.x) {
        const int gm = tile >> 4, nt = tile & 15;
        int e = 0;
        while (meta[160 + e + 1] <= gm) ++e;
        const int mi = gm - meta[160 + e], cnt = meta[128 + e], n0 = nt * 128;
        __syncthreads();
        if (t < 128) { const int i = mi * 128 + t; meta[t] = (i < cnt) ? p.lists[e * T + i] : -1; }
        __syncthreads();
        const int fallback = meta[0];
        const u16* ap[4];
#pragma unroll
        for (int i = 0; i < 4; ++i) { int sl = meta[ar + 32 * i]; if (sl < 0) sl = fallback; ap[i] = p.xn2 + (size_t)(sl >> 2) * D + ac * 8; }
        const float* bp = p.w1 + (size_t)e * D * (2 * DFF) + (size_t)(8 * kg) * (2 * DFF) + n0 + 4 * ng;
        f32x4 acc[4][4];
        gemm_mainloop(lds, ap[0], ap[1], ap[2], ap[3], bp, 2 * DFF, true, D / 64, acc);
        const float* b1e = p.b1 + (size_t)e * 2 * DFF;
        const int rowbase = meta[200 + e] + mi * 128;
#pragma unroll
        for (int m = 0; m < 4; ++m) {
            const int rl = wm * 64 + m * 16 + (l & 15);
            if (meta[rl] < 0) continue;
#pragma unroll
            for (int n = 0; n < 4; ++n) {
                const int col = n0 + wn * 64 + n * 16 + (l >> 4) * 4;
                const float4 bb = *(const float4*)(b1e + col);
                float g0 = fminf(acc[m][n][0] + bb.x, 7.0f), l0 = fminf(fmaxf(acc[m][n][1] + bb.y, -7.0f), 7.0f);
                float g1 = fminf(acc[m][n][2] + bb.z, 7.0f), l1 = fminf(fmaxf(acc[m][n][3] + bb.w, -7.0f), 7.0f);
                const float a0 = g0 / (1.0f + __expf(-1.702f * g0)) * (l0 + 1.0f);
                const float a1 = g1 / (1.0f + __expf(-1.702f * g1)) * (l1 + 1.0f);
                *(unsigned*)(p.act + (size_t)(rowbase + rl) * DFF + (col >> 1)) = pack2(a0, a1);
            }
        }
    }
}

__device__ void ph_moe2(const Params& p, char* lds) {
    const int t = tid_opaque(), l = t & 63, w = t >> 6, wm = w >> 1, wn = w & 1;
    const int ar = t >> 3, ac = t & 7, kg = l & 7, ng = w * 8 + (l >> 3);
    int* meta = (int*)(lds + MO_META);
    moe_meta(p, meta);
    const int ntiles = meta[160 + NE] * 8;
    for (int tile = blockIdx.x; tile < ntiles; tile += gridDim.x) {
        const int gm = tile >> 3, nt = tile & 7;
        int e = 0;
        while (meta[160 + e + 1] <= gm) ++e;
        const int mi = gm - meta[160 + e], cnt = meta[128 + e], n0 = nt * 128;
        __syncthreads();
        if (t < 128) { const int i = mi * 128 + t; meta[t] = (i < cnt) ? p.lists[e * T + i] : -1; }
        __syncthreads();
        const int rowbase = meta[200 + e] + mi * 128;
        const int nvalid = min(128, cnt - mi * 128);
        const u16* ap[4];
#pragma unroll
        for (int i = 0; i < 4; ++i) { const int r = min(ar + 32 * i, nvalid - 1); ap[i] = p.act + (size_t)(rowbase + r) * DFF + ac * 8; }
        const float* bp = p.w2 + (size_t)e * DFF * D + (size_t)(8 * kg) * D + n0 + 4 * ng;
        f32x4 acc[4][4];
        gemm_mainloop(lds, ap[0], ap[1], ap[2], ap[3], bp, D, true, DFF / 64, acc);
        const float* b2e = p.b2 + (size_t)e * D;
#pragma unroll
        for (int m = 0; m < 4; ++m) {
            const int rl = wm * 64 + m * 16 + (l & 15);
            const int slot = meta[rl];
            if (slot < 0) continue;
            const float gt = p.gate[slot];
#pragma unroll
            for (int n = 0; n < 4; ++n) {
                const int col = n0 + wn * 64 + n * 16 + (l >> 4) * 4;
                const float4 bb = *(const float4*)(b2e + col);
                uint2 o;
                o.x = pack2(gt * (acc[m][n][0] + bb.x), gt * (acc[m][n][1] + bb.y));
                o.y = pack2(gt * (acc[m][n][2] + bb.z), gt * (acc[m][n][3] + bb.w));
                *(uint2*)(p.y + (size_t)slot * D + col) = o;
            }
        }
    }
}

__device__ void ph_final(const Params& p) {
    const int lane = threadIdx.x & 63, gw = blockIdx.x * 4 + (threadIdx.x >> 6), nw = gridDim.x * 4;
    for (int tok = gw; tok < T; tok += nw) {
        float4 v[4]; float ss = 0.f;
#pragma unroll
        for (int i = 0; i < 4; ++i) {
            v[i] = ((const float4*)(p.x1 + (size_t)tok * D))[lane + 64 * i];
#pragma unroll
            for (int k = 0; k < 4; ++k) {
                const uint2 yy = *(const uint2*)(p.y + ((size_t)tok * 4 + k) * D + (lane + 64 * i) * 4);
                v[i].x += lo2f(yy.x); v[i].y += hi2f(yy.x); v[i].z += lo2f(yy.y); v[i].w += hi2f(yy.y);
            }
            ss += v[i].x * v[i].x + v[i].y * v[i].y + v[i].z * v[i].z + v[i].w * v[i].w;
        }
        ss = wave_sum(ss);
        const float r = rsqrtf(ss * (1.0f / D) + EPS);
#pragma unroll
        for (int i = 0; i < 4; ++i) {
            const float4 g = ((const float4*)p.gf)[lane + 64 * i];
            float4 o; o.x = v[i].x * r * g.x; o.y = v[i].y * r * g.y; o.z = v[i].z * r * g.z; o.w = v[i].w * r * g.w;
            ((float4*)(p.out + (size_t)tok * D))[lane + 64 * i] = o;
        }
    }
}

enum { PH_NORM1 = 0, PH_PROJ, PH_MIX1, PH_MIX2, PH_MIX3, PH_OUTPROJ, PH_ROUTE, PH_MOE1, PH_MOE2, PH_FINAL, PH_END };
constexpr int N_GLA_ITEMS = B * GH * 64, N_ATT_ITEMS = B * AH * 3 * 64;

__global__ void __launch_bounds__(256, 2) mega(Params p) {
    extern __shared__ __attribute__((aligned(16))) char lds[];
    cg::grid_group grid = cg::this_grid();
    for (int ph = p.ph_lo; ph < p.ph_hi; ++ph) {
        switch (ph) {
        case PH_NORM1: ph_norm1(p); break;
        case PH_PROJ: ph_proj(p, lds); break;
        case PH_MIX1:
            for (int it = blockIdx.x; it < N_GLA_ITEMS; it += gridDim.x) gla_ds_item(p, lds, it);
            for (int it = blockIdx.x; it < N_ATT_ITEMS; it += gridDim.x) attn_item(p, lds, it);
            break;
        case PH_MIX2:
            for (int it = blockIdx.x; it < 1024; it += gridDim.x) gla_scan_block(p, it);
            for (int it = blockIdx.x; it < T * 64 / 256; it += gridDim.x) attn_combine_block(p, it);
            break;
        case PH_MIX3:
            for (int it = blockIdx.x; it < N_GLA_ITEMS; it += gridDim.x) gla_out_item(p, lds, it);
            break;
        case PH_OUTPROJ: ph_outproj(p, lds); break;
        case PH_ROUTE: ph_route(p, lds); break;
        case PH_MOE1: ph_moe1(p, lds); break;
        case PH_MOE2: ph_moe2(p, lds); break;
        case PH_FINAL: ph_final(p); break;
        default: break;
        }
        if (ph + 1 < p.ph_hi) grid.sync();
    }
}

#ifndef STAGE
#define STAGE 6
#endif

__global__ void __launch_bounds__(256) cvt_bf16_f32(const u16* __restrict__ src, int lds_, float* __restrict__ dst, int ldd, int rows, int cols) {
    const size_t n = (size_t)rows * cols;
    for (size_t i = (size_t)blockIdx.x * 256 + threadIdx.x; i < n; i += (size_t)gridDim.x * 256) {
        const size_t r = i / cols, c = i % cols;
        dst[r * ldd + c] = bf2f(src[r * lds_ + c]);
    }
}

#include <cstdio>
extern "C" void kernel_launch(void* const* d_in, const int* in_sizes, int n_in, void* d_out, int out_size, void* d_ws, size_t ws_size, hipStream_t stream) {
    const float* x = (const float*)d_in[0];
    const float* norm1_g = (const float*)d_in[1];
    const float* w_in = (const float*)d_in[2];
    const float* rel_bias = (const float*)d_in[3];
    const float* wgf = (const float*)d_in[4];
    const float* bgf = (const float*)d_in[5];
    const float* wgb = (const float*)d_in[6];
    const float* bgb = (const float*)d_in[7];
    const float* gla_ng = (const float*)d_in[8];
    const float* w_out = (const float*)d_in[9];
    const float* norm2_g = (const float*)d_in[10];
    const float* router_w = (const float*)d_in[11];
    const float* router_b = (const float*)d_in[12];
    const float* w1 = (const float*)d_in[13];
    const float* b1 = (const float*)d_in[14];
    const float* w2 = (const float*)d_in[15];
    const float* b2 = (const float*)d_in[16];
    const float* final_g = (const float*)d_in[17];
    float* out = (float*)d_out;

    static int grid_blocks = 0;
    if (!grid_blocks) {
        int dev = 0, cus = 0, per_cu = 0;
        hipGetDevice(&dev);
        hipDeviceGetAttribute(&cus, hipDeviceAttributeMultiprocessorCount, dev);
        hipFuncSetAttribute((const void*)mega, hipFuncAttributeMaxDynamicSharedMemorySize, LDS_BYTES);
        hipOccupancyMaxActiveBlocksPerMultiprocessor(&per_cu, mega, 256, LDS_BYTES);
        if (per_cu > 2) per_cu = 2;
        if (per_cu < 1) per_cu = 1;
        grid_blocks = cus * per_cu;
    }

    char* ws = (char*)d_ws;
    size_t off = 0;
    auto take = [&](size_t bytes) { char* p = ws + off; off += (bytes + 255) & ~(size_t)255; return p; };
    Params p{};
    p.x = x; p.g1 = norm1_g; p.w_in = w_in; p.rel_bias = rel_bias; p.wgf = wgf; p.bgf = bgf; p.wgb = wgb; p.bgb = bgb; p.gla_ng = gla_ng;
    p.w_out = w_out; p.g2 = norm2_g; p.rw = router_w; p.rb = router_b; p.w1 = w1; p.b1 = b1; p.w2 = w2; p.b2 = b2; p.gf = final_g; p.out = out;
    p.xn = (u16*)take((size_t)T * D * 2);
    p.proj = (u16*)take((size_t)T * INW * 2);
    p.abr = (u16*)take((size_t)3 * T * 512 * 2);
    p.lse = (float*)take((size_t)3 * T * 8 * 4);
    p.dS = (float*)take((size_t)B * GH * 64 * 2 * 128 * 64 * 4);
    p.dec = (float*)take((size_t)B * GH * 64 * 2 * 64 * 4);
    p.Sp = (u16*)take((size_t)B * GH * 64 * 2 * 128 * 64 * 2);
    p.mix = (u16*)take((size_t)T * D * 2);
    p.x1 = (float*)take((size_t)T * D * 4);
    p.xn2 = (u16*)take((size_t)T * D * 2);
    p.counts = (int*)take(256);
    p.lists = (int*)take((size_t)NE * T * 4);
    p.gate = (float*)take((size_t)NSLOT * 4);
    const size_t off_shared = off;
    p.act = (u16*)take((size_t)NSLOT * DFF * 2);
    p.y = (u16*)take((size_t)NSLOT * D * 2);

    auto run_fast = [&](int lo, int hi) {
        p.ph_lo = lo; p.ph_hi = hi;
        void* args[] = {&p};
        hipError_t e = hipLaunchCooperativeKernel((const void*)mega, dim3(grid_blocks), dim3(256), args, LDS_BYTES, stream);
        if (e != hipSuccess) fprintf(stderr, "cooperative launch failed: %s (grid %d)\n", hipGetErrorString(e), grid_blocks);
    };

#if STAGE >= 6
    run_fast(PH_NORM1, PH_END);
#else
    off = off_shared;
    float* n_xn = (float*)take((size_t)T * D * 4);
    float* n_x2 = (float*)take((size_t)T * D * 4);
    float* n_mix = (float*)take((size_t)T * D * 4);
    int* n_topi = (int*)take((size_t)T * 4 * 4);
    char* big = take((size_t)T * INW * 4 + (size_t)2 * T * 256 * 4 + (size_t)2 * T * 512 * 4);
    float* n_proj = (float*)big;
    float* n_ea = (float*)(big + (size_t)T * INW * 4);
    float* n_og = (float*)(big + (size_t)T * INW * 4 + (size_t)2 * T * 256 * 4);
    float* n_hact = (float*)big;
    float* n_x1 = p.x1;
    int* n_lists = p.lists; int* n_counts = p.counts; float* n_gate = p.gate;

#if STAGE == 1
    run_fast(PH_NORM1, PH_PROJ + 1);
#elif STAGE == 2
    run_fast(PH_NORM1, PH_MIX2 + 1);
#elif STAGE == 3
    run_fast(PH_NORM1, PH_MIX3 + 1);
#elif STAGE == 4
    run_fast(PH_NORM1, PH_OUTPROJ + 1);
#elif STAGE == 5
    run_fast(PH_NORM1, PH_ROUTE + 1);
#endif
#if STAGE <= 2
    cvt_bf16_f32<<<2048, 256, 0, stream>>>(p.proj, INW, n_proj, INW, T, INW);
#if STAGE == 1
    nv_attn<<<T * AH / 4, 256, 0, stream>>>(n_proj, rel_bias, n_mix);
#else
    cvt_bf16_f32<<<2048, 256, 0, stream>>>(p.mix, D, n_mix, D, T, 512);
#endif
    nv_la<<<T, 256, 0, stream>>>(n_proj, wgf, bgf, wgb, bgb, n_ea);
    nv_gla<<<B * GH * 2, 128, 0, stream>>>(n_proj, n_ea, n_og);
    nv_gla_out<<<T * GH / 4, 256, 0, stream>>>(n_proj, n_og, gla_ng, n_mix);
#endif
#if STAGE == 3
    cvt_bf16_f32<<<2048, 256, 0, stream>>>(p.mix, D, n_mix, D, T, D);
#endif
#if STAGE <= 3
    nv_gemm<EPI_RESID><<<dim3(D / 64, T / 64), 256, 0, stream>>>(n_mix, D, nullptr, 0, nullptr, T, w_out, D, D, D, n_x1, D, x, nullptr);
#endif
#if STAGE <= 4
    nv_route<<<T / 4, 256, 0, stream>>>(n_x1, norm2_g, router_w, router_b, n_xn, n_topi, n_gate);
    nv_lists<<<1, 32, 0, stream>>>(n_topi, n_lists, n_counts);
#endif
#if STAGE == 5
    cvt_bf16_f32<<<2048, 256, 0, stream>>>(p.xn2, D, n_xn, D, T, D);
#endif
    (void)hipMemcpyAsync(n_x2, n_x1, (size_t)T * D * 4, hipMemcpyDeviceToDevice, stream);
    for (int e = 0; e < NE; ++e) {
        nv_gemm<EPI_SWIGLU><<<dim3(2 * DFF / 64, T / 64), 256, 0, stream>>>(n_xn, D, n_lists + (size_t)e * T, 2, n_counts + e, 0,
                                                                          w1 + (size_t)e * D * 2 * DFF, 2 * DFF, 2 * DFF, D, n_hact, DFF, b1 + (size_t)e * 2 * DFF, nullptr);
        nv_moe2<<<dim3(D / 64, T / 64), 256, 0, stream>>>(n_hact, n_lists + (size_t)e * T, n_counts + e, w2 + (size_t)e * DFF * D, n_x2, b2 + (size_t)e * D, n_gate);
    }
    nv_rmsnorm<<<T / 4, 256, 0, stream>>>(n_x2, final_g, out, T);
#endif
}
```

```cpp
#define STAGE 6
#include <hip/hip_runtime.h>
#include <stdint.h>

namespace cfg {
constexpr int D = 1024, B = 4, S = 4096, T = B * S;
constexpr int AH = 8;
constexpr int GH = 4;
constexpr int INW = 3104;
constexpr int C_AQ = 0, C_AK = 512, C_AV = 1024, C_GQ = 1536, C_GK = 1792, C_GV = 2048, C_GO = 2560, C_GZ = 3072;
constexpr int NE = 32, DFF = 1024;
constexpr float EPS = 1e-5f;
}
using namespace cfg;

__device__ const unsigned char T5TAB[387] = {
11,11,11,11,11,11,11,11,11,11,11,11,11,11,11,10,10,10,10,10,10,10,10,10,10,10,10,10,10,10,10,10,10,10,10,10,10,10,9,9,9,9,9,9,9,9,9,9,9,9,8,8,8,8,8,8,8,7,6,5,4,3,2,1,0,17,18,19,20,21,22,23,24,24,24,24,24,24,24,25,25,25,25,25,25,25,25,25,25,25,25,26,26,26,26,26,26,26,26,26,26,26,26,26,26,26,26,26,26,26,26,26,26,26,27,27,27,27,27,27,27,27,27,27,27,27,27,27,27,
13,13,13,13,13,13,13,13,13,13,13,13,13,13,13,13,13,13,13,13,13,13,13,12,12,12,12,12,12,12,12,12,12,12,12,12,12,12,12,12,12,12,11,11,11,11,11,11,11,11,11,11,10,10,10,10,10,10,9,9,9,8,8,4,0,20,24,24,25,25,25,26,26,26,26,26,26,27,27,27,27,27,27,27,27,27,27,28,28,28,28,28,28,28,28,28,28,28,28,28,28,28,28,28,28,28,29,29,29,29,29,29,29,29,29,29,29,29,29,29,29,29,29,29,29,29,29,29,29,
15,15,15,15,15,15,15,15,15,15,15,15,15,15,15,15,15,15,15,15,15,15,15,15,15,15,15,15,15,15,14,14,14,14,14,14,14,14,14,14,14,14,14,14,14,13,13,13,13,13,13,13,13,13,12,12,12,12,12,11,11,10,10,9,0,25,26,26,27,27,28,28,28,28,28,29,29,29,29,29,29,29,29,29,30,30,30,30,30,30,30,30,30,30,30,30,30,30,30,31,31,31,31,31,31,31,31,31,31,31,31,31,31,31,31,31,31,31,31,31,31,31,31,31,31,31,31,31,31};

__device__ __forceinline__ float wave_sum(float v) {
#pragma unroll
    for (int o = 32; o > 0; o >>= 1) v += __shfl_xor(v, o);
    return v;
}

__global__ void __launch_bounds__(256) nv_rmsnorm(const float* __restrict__ x, const float* __restrict__ g, float* __restrict__ y, int rows) {
    int row = blockIdx.x * 4 + (threadIdx.x >> 6), lane = threadIdx.x & 63;
    if (row >= rows) return;
    const float* xr = x + (size_t)row * D;
    float v[16]; float ss = 0.f;
#pragma unroll
    for (int i = 0; i < 16; ++i) { v[i] = xr[lane + 64 * i]; ss += v[i] * v[i]; }
    ss = wave_sum(ss);
    float r = rsqrtf(ss * (1.0f / D) + EPS);
#pragma unroll
    for (int i = 0; i < 16; ++i) y[(size_t)row * D + lane + 64 * i] = v[i] * r * g[lane + 64 * i];
}

enum { EPI_STORE = 0, EPI_RESID = 1, EPI_SWIGLU = 2 };
template <int EPI>
__global__ void __launch_bounds__(256) nv_gemm(const float* __restrict__ A, int lda, const int* __restrict__ rowmap, int rshift,
                                               const int* __restrict__ Mptr, int Mfix,
                                               const float* __restrict__ Bm, int ldb, int N, int K,
                                               float* __restrict__ C, int ldc,
                                               const float* __restrict__ aux1, const float* __restrict__ aux2) {
    __shared__ float As[16][68];
    __shared__ float Bs[16][64];
    const int M = Mptr ? *Mptr : Mfix;
    const int m0 = blockIdx.y * 64, n0 = blockIdx.x * 64;
    if (m0 >= M) return;
    const int tid = threadIdx.x, tx = tid & 15, ty = tid >> 4;
    float acc[4][4];
#pragma unroll
    for (int i = 0; i < 4; ++i)
#pragma unroll
        for (int j = 0; j < 4; ++j) acc[i][j] = 0.f;
    const int ar = tid >> 2, ak = (tid & 3) * 4;
    const int arow = m0 + ar; const bool av = arow < M;
    const int srcrow = av ? (rowmap ? (rowmap[arow] >> rshift) : arow) : 0;
    const float* ap = A + (size_t)srcrow * lda + ak;
    const int bk = tid >> 4, bn = (tid & 15) * 4;
    const bool bv = (n0 + bn) < N;
    for (int k0 = 0; k0 < K; k0 += 16) {
        float4 a4 = av ? *(const float4*)(ap + k0) : make_float4(0.f, 0.f, 0.f, 0.f);
        float4 b4 = bv ? *(const float4*)(Bm + (size_t)(k0 + bk) * ldb + n0 + bn) : make_float4(0.f, 0.f, 0.f, 0.f);
        As[ak + 0][ar] = a4.x; As[ak + 1][ar] = a4.y; As[ak + 2][ar] = a4.z; As[ak + 3][ar] = a4.w;
        *(float4*)&Bs[bk][bn] = b4;
        __syncthreads();
#pragma unroll
        for (int kk = 0; kk < 16; ++kk) {
            float4 a = *(const float4*)&As[kk][ty * 4];
            float4 b = *(const float4*)&Bs[kk][tx * 4];
            float aa[4] = {a.x, a.y, a.z, a.w}, bb[4] = {b.x, b.y, b.z, b.w};
#pragma unroll
            for (int i = 0; i < 4; ++i)
#pragma unroll
                for (int j = 0; j < 4; ++j) acc[i][j] = fmaf(aa[i], bb[j], acc[i][j]);
        }
        __syncthreads();
    }
#pragma unroll
    for (int i = 0; i < 4; ++i) {
        const int row = m0 + ty * 4 + i;
        if (row >= M) continue;
        const int col = n0 + tx * 4;
        if (col >= N) continue;
        if (EPI == EPI_STORE) {
#pragma unroll
            for (int j = 0; j < 4; ++j) C[(size_t)row * ldc + col + j] = acc[i][j];
        } else if (EPI == EPI_RESID) {
#pragma unroll
            for (int j = 0; j < 4; ++j) C[(size_t)row * ldc + col + j] = aux1[(size_t)row * ldc + col + j] + acc[i][j];
        } else if (EPI == EPI_SWIGLU) {
#pragma unroll
            for (int j = 0; j < 4; j += 2) {
                float glu = acc[i][j] + aux1[col + j], lin = acc[i][j + 1] + aux1[col + j + 1];
                glu = fminf(glu, 7.0f); lin = fminf(fmaxf(lin, -7.0f), 7.0f);
                float sg = 1.0f / (1.0f + expf(-1.702f * glu));
                C[(size_t)row * ldc + (col + j) / 2] = glu * sg * (lin + 1.0f);
            }
        }
    }
}

__global__ void __launch_bounds__(256) nv_attn(const float* __restrict__ proj, const float* __restrict__ rel_bias, float* __restrict__ mix) {
    const int wid = blockIdx.x * 4 + (threadIdx.x >> 6), lane = threadIdx.x & 63;
    const int h = wid & 7, tok = wid >> 3, b = tok / S, pos = tok % S;
    const float q = proj[(size_t)tok * INW + C_AQ + h * 64 + lane];
    float outs[3], lses[3];
#pragma unroll
    for (int br = 0; br < 3; ++br) {
        const int dil = (br == 0) ? 1 : (br == 1 ? 4 : 16);
        float m = -3.0e38f, l = 0.f, o = 0.f;
        for (int j = -64; j <= 64; ++j) {
            const int kp = pos + j * dil;
            if (kp < 0 || kp >= S) continue;
            const size_t kr = (size_t)(b * S + kp) * INW;
            float d = wave_sum(q * proj[kr + C_AK + h * 64 + lane]);
            float logit = d * 0.125f + rel_bias[T5TAB[br * 129 + j + 64] * AH + h];
            float mn = fmaxf(m, logit);
            float sc = expf(m - mn), p = expf(logit - mn);
            l = l * sc + p; o = o * sc + p * proj[kr + C_AV + h * 64 + lane];
            m = mn;
        }
        outs[br] = o / l; lses[br] = m + logf(l);
    }
    float mm = fmaxf(lses[0], fmaxf(lses[1], lses[2]));
    float w0 = expf(lses[0] - mm), w1 = expf(lses[1] - mm), w2 = expf(lses[2] - mm);
    float ws = w0 + w1 + w2;
    mix[(size_t)tok * D + h * 64 + lane] = (w0 * outs[0] + w1 * outs[1] + w2 * outs[2]) / ws;
}

__global__ void __launch_bounds__(256) nv_la(const float* __restrict__ proj, const float* __restrict__ wgf, const float* __restrict__ bgf,
                                             const float* __restrict__ wgb, const float* __restrict__ bgb, float* __restrict__ ea) {
    const int tok = blockIdx.x, col = threadIdx.x;
#pragma unroll
    for (int dir = 0; dir < 2; ++dir) {
        const float* wg = dir ? wgb : wgf; const float* bg = dir ? bgb : bgf;
        float a = bg[col];
        for (int r = 0; r < 16; ++r) a += proj[(size_t)tok * INW + C_GZ + dir * 16 + r] * wg[r * 256 + col];
        float ls = fminf(a, 0.f) - log1pf(expf(-fabsf(a)));
        ea[((size_t)dir * T + tok) * 256 + col] = expf(ls * (1.0f / 16.0f));
    }
}

__global__ void __launch_bounds__(128) nv_gla(const float* __restrict__ proj, const float* __restrict__ ea, float* __restrict__ og) {
    const int e = threadIdx.x, bhd = blockIdx.x, dir = bhd & 1, h = (bhd >> 1) & 3, b = bhd >> 3;
    float st[64];
#pragma unroll
    for (int d = 0; d < 64; ++d) st[d] = 0.f;
    for (int i = 0; i < S; ++i) {
        const int pos = dir ? (S - 1 - i) : i;
        const size_t tok = (size_t)b * S + pos;
        const float* pr = proj + tok * INW;
        const float* ar = ea + ((size_t)dir * T + tok) * 256 + h * 64;
        const float v = pr[C_GV + h * 128 + e];
        float o = 0.f;
#pragma unroll
        for (int d = 0; d < 64; ++d) {
            st[d] = fmaf(ar[d], st[d], pr[C_GK + h * 64 + d] * v);
            o = fmaf(pr[C_GQ + h * 64 + d] * 0.125f, st[d], o);
        }
        og[((size_t)dir * T + tok) * 512 + h * 128 + e] = o;
    }
}

__global__ void __launch_bounds__(256) nv_gla_out(const float* __restrict__ proj, const float* __restrict__ og, const float* __restrict__ ng, float* __restrict__ mix) {
    const int wid = blockIdx.x * 4 + (threadIdx.x >> 6), lane = threadIdx.x & 63;
    const int h = wid & 3, tok = wid >> 2;
    float o0 = og[(size_t)tok * 512 + h * 128 + lane] + og[((size_t)T + tok) * 512 + h * 128 + lane];
    float o1 = og[(size_t)tok * 512 + h * 128 + 64 + lane] + og[((size_t)T + tok) * 512 + h * 128 + 64 + lane];
    float ss = wave_sum(o0 * o0 + o1 * o1);
    float r = rsqrtf(ss * (1.0f / 128.0f) + EPS);
    float g0 = proj[(size_t)tok * INW + C_GO + h * 128 + lane], g1 = proj[(size_t)tok * INW + C_GO + h * 128 + 64 + lane];
    mix[(size_t)tok * D + 512 + h * 128 + lane] = o0 * r * ng[h * 128 + lane] * (g0 / (1.0f + expf(-g0)));
    mix[(size_t)tok * D + 512 + h * 128 + 64 + lane] = o1 * r * ng[h * 128 + 64 + lane] * (g1 / (1.0f + expf(-g1)));
}

__global__ void __launch_bounds__(256) nv_route(const float* __restrict__ x1, const float* __restrict__ g2, const float* __restrict__ rw, const float* __restrict__ rb,
                                                float* __restrict__ xn2, int* __restrict__ topi, float* __restrict__ gate) {
    __shared__ float xs[4][1024];
    __shared__ float lg[4][32];
    const int w = threadIdx.x >> 6, lane = threadIdx.x & 63, tok = blockIdx.x * 4 + w;
    const float* xr = x1 + (size_t)tok * D;
    float v[16]; float ss = 0.f;
#pragma unroll
    for (int i = 0; i < 16; ++i) { v[i] = xr[lane + 64 * i]; ss += v[i] * v[i]; }
    ss = wave_sum(ss);
    const float r = rsqrtf(ss * (1.0f / D) + EPS);
#pragma unroll
    for (int i = 0; i < 16; ++i) { float y = v[i] * r * g2[lane + 64 * i]; xs[w][lane + 64 * i] = y; xn2[(size_t)tok * D + lane + 64 * i] = y; }
    __syncthreads();
    const int e = lane & 31, half = lane >> 5;
    float a = 0.f;
    for (int k = half * 512; k < half * 512 + 512; ++k) a = fmaf(xs[w][k], rw[k * 32 + e], a);
    a += __shfl_xor(a, 32);
    if (lane < 32) lg[w][lane] = a + rb[lane];
    __syncthreads();
    if (lane == 0) {
        float bv[4]; int bi[4];
        unsigned used = 0u;
#pragma unroll
        for (int k = 0; k < 4; ++k) {
            float best = -3.0e38f; int bidx = 0;
            for (int j = 0; j < 32; ++j) { float x = lg[w][j]; if (!((used >> j) & 1u) && x > best) { best = x; bidx = j; } }
            used |= 1u << bidx; bv[k] = best; bi[k] = bidx;
        }
        float e0 = 1.0f, e1 = expf(bv[1] - bv[0]), e2 = expf(bv[2] - bv[0]), e3 = expf(bv[3] - bv[0]);
        float s = e0 + e1 + e2 + e3;
        topi[tok * 4 + 0] = bi[0]; topi[tok * 4 + 1] = bi[1]; topi[tok * 4 + 2] = bi[2]; topi[tok * 4 + 3] = bi[3];
        gate[tok * 4 + 0] = e0 / s; gate[tok * 4 + 1] = e1 / s; gate[tok * 4 + 2] = e2 / s; gate[tok * 4 + 3] = e3 / s;
    }
}

__global__ void nv_lists(const int* __restrict__ topi, int* __restrict__ lists, int* __restrict__ counts) {
    const int e = threadIdx.x;
    int c = 0;
    for (int s = 0; s < T * 4; ++s) if (topi[s] == e) lists[e * T + c++] = s;
    counts[e] = c;
}

__global__ void __launch_bounds__(256) nv_moe2(const float* __restrict__ A, const int* __restrict__ slots, const int* __restrict__ Mptr,
                                               const float* __restrict__ Bm, float* __restrict__ x2, const float* __restrict__ b2, const float* __restrict__ gate) {
    __shared__ float As[16][68];
    __shared__ float Bs[16][64];
    const int M = *Mptr;
    const int m0 = blockIdx.y * 64, n0 = blockIdx.x * 64;
    if (m0 >= M) return;
    const int tid = threadIdx.x, tx = tid & 15, ty = tid >> 4;
    float acc[4][4];
#pragma unroll
    for (int i = 0; i < 4; ++i)
#pragma unroll
        for (int j = 0; j < 4; ++j) acc[i][j] = 0.f;
    const int ar = tid >> 2, ak = (tid & 3) * 4;
    const int arow = m0 + ar; const bool av = arow < M;
    const float* ap = A + (size_t)(av ? arow : 0) * DFF + ak;
    const int bk = tid >> 4, bn = (tid & 15) * 4;
    for (int k0 = 0; k0 < DFF; k0 += 16) {
        float4 a4 = av ? *(const float4*)(ap + k0) : make_float4(0.f, 0.f, 0.f, 0.f);
        float4 b4 = *(const float4*)(Bm + (size_t)(k0 + bk) * D + n0 + bn);
        As[ak + 0][ar] = a4.x; As[ak + 1][ar] = a4.y; As[ak + 2][ar] = a4.z; As[ak + 3][ar] = a4.w;
        *(float4*)&Bs[bk][bn] = b4;
        __syncthreads();
#pragma unroll
        for (int kk = 0; kk < 16; ++kk) {
            float4 a = *(const float4*)&As[kk][ty * 4];
            float4 b = *(const float4*)&Bs[kk][tx * 4];
            float aa[4] = {a.x, a.y, a.z, a.w}, bb[4] = {b.x, b.y, b.z, b.w};
#pragma unroll
            for (int i = 0; i < 4; ++i)
#pragma unroll
                for (int j = 0; j < 4; ++j) acc[i][j] = fmaf(aa[i], bb[j], acc[i][j]);
        }
        __syncthreads();
    }
#pragma unroll
    for (int i = 0; i < 4; ++i) {
        const int row = m0 + ty * 4 + i;
        if (row >= M) continue;
        const int col = n0 + tx * 4;
        const int slot = slots[row]; const int tok = slot >> 2; const float gt = gate[slot];
#pragma unroll
        for (int j = 0; j < 4; ++j) x2[(size_t)tok * D + col + j] += gt * (acc[i][j] + b2[col + j]);
    }
}


#include <hip/hip_cooperative_groups.h>
namespace cg = cooperative_groups;

typedef unsigned short u16;
typedef short bf16x8 __attribute__((ext_vector_type(8)));
typedef short s16x4 __attribute__((ext_vector_type(4)));
typedef float f32x4 __attribute__((ext_vector_type(4)));
typedef __bf16 bfv2 __attribute__((ext_vector_type(2)));
typedef float fv2 __attribute__((ext_vector_type(2)));
#define LDS_AS __attribute__((address_space(3)))

constexpr int LDS_BYTES = 72 * 1024;
constexpr int NSLOT = T * 4;

struct Params {
    const float *x, *g1, *w_in, *rel_bias, *wgf, *bgf, *wgb, *bgb, *gla_ng, *w_out, *g2, *rw, *rb, *w1, *b1, *w2, *b2, *gf;
    float* out;
    u16* xn;
    u16* proj;
    u16* abr;
    float* lse;
    float* dS;
    float* dec;
    u16* Sp;
    u16* mix;
    float* x1;
    u16* xn2;
    int* counts;
    int* lists;
    float* gate;
    u16* act;
    u16* y;
    unsigned* bar;
    int ph_lo, ph_hi;
};

__device__ __forceinline__ int tid_opaque() { int t = threadIdx.x; asm volatile("" : "+v"(t)); return t; }
__device__ __forceinline__ float bf2f(u16 v) { return __uint_as_float((unsigned)v << 16); }
__device__ __forceinline__ unsigned pack2(float a, float b) {
    fv2 v = {a, b};
    bfv2 r = __builtin_convertvector(v, bfv2);
    return __builtin_bit_cast(unsigned, r);
}
__device__ __forceinline__ u16 f2bf(float a) { return (u16)(pack2(a, 0.f) & 0xffffu); }
__device__ __forceinline__ float lo2f(unsigned u) { return __uint_as_float(u << 16); }
__device__ __forceinline__ float hi2f(unsigned u) { return __uint_as_float(u & 0xffff0000u); }
__device__ __forceinline__ int tile_off(int row, int chunk) { return row * 128 + ((chunk ^ (row & 7)) << 4); }
__device__ __forceinline__ bf16x8 lds_frag(const char* base, int row, int chunk) { return *(const bf16x8*)(base + tile_off(row, chunk)); }
__device__ __forceinline__ s16x4 tr_read(const char* p) {
    return __builtin_amdgcn_ds_read_tr16_b64_v4i16((LDS_AS s16x4*)(p));
}
__device__ __forceinline__ bf16x8 cat4(s16x4 a, s16x4 b) { bf16x8 r = {a[0], a[1], a[2], a[3], b[0], b[1], b[2], b[3]}; return r; }
__device__ __forceinline__ float logsig(float a) { return fminf(a, 0.f) - log1pf(expf(-fabsf(a))); }

__device__ void ph_norm1(const Params& p) {
    const int lane = threadIdx.x & 63, gw = blockIdx.x * 4 + (threadIdx.x >> 6), nw = gridDim.x * 4;
    if (blockIdx.x == 0 && threadIdx.x < 32) p.counts[threadIdx.x] = 0;
    for (int row = gw; row < T; row += nw) {
        const float4* xr = (const float4*)(p.x + (size_t)row * D);
        float4 v[4]; float ss = 0.f;
#pragma unroll
        for (int i = 0; i < 4; ++i) { v[i] = xr[lane + 64 * i]; ss += v[i].x * v[i].x + v[i].y * v[i].y + v[i].z * v[i].z + v[i].w * v[i].w; }
        ss = wave_sum(ss);
        const float r = rsqrtf(ss * (1.0f / D) + EPS);
#pragma unroll
        for (int i = 0; i < 4; ++i) {
            const float4 g = ((const float4*)p.g1)[lane + 64 * i];
            uint2 o; o.x = pack2(v[i].x * r * g.x, v[i].y * r * g.y); o.y = pack2(v[i].z * r * g.z, v[i].w * r * g.w);
            *(uint2*)(p.xn + (size_t)row * D + (lane + 64 * i) * 4) = o;
        }
    }
}

__device__ __forceinline__ void gemm_mainloop(char* lds, const u16* a0, const u16* a1, const u16* a2, const u16* a3,
                                              const float* bp, int ldb, bool bvalid, int nk, f32x4 (&acc)[4][4]) {
    const int t = tid_opaque(), l = t & 63, w = t >> 6;
    const int wm = w >> 1, wn = w & 1;
    const int ar = t >> 3, ac = t & 7;
    const int kg = l & 7, ng = w * 8 + (l >> 3);
    uint4 av[4]; float4 bv[8];
#pragma unroll
    for (int m = 0; m < 4; ++m)
#pragma unroll
        for (int n = 0; n < 4; ++n) acc[m][n] = (f32x4){0.f, 0.f, 0.f, 0.f};

    auto gload = [&](int kt) {
        av[0] = *(const uint4*)(a0 + kt * 64); av[1] = *(const uint4*)(a1 + kt * 64);
        av[2] = *(const uint4*)(a2 + kt * 64); av[3] = *(const uint4*)(a3 + kt * 64);
        const float* b = bp + (size_t)kt * 64 * ldb;
#pragma unroll
        for (int j = 0; j < 8; ++j) bv[j] = bvalid ? *(const float4*)(b + (size_t)j * ldb) : make_float4(0.f, 0.f, 0.f, 0.f);
    };
    auto lstore = [&](int buf) {
        char* As = lds + buf * 32768; char* Bs = As + 16384;
#pragma unroll
        for (int i = 0; i < 4; ++i) *(uint4*)(As + tile_off(ar + 32 * i, ac)) = av[i];
        {
            uint4 q;
            q.x = pack2(bv[0].x, bv[1].x); q.y = pack2(bv[2].x, bv[3].x); q.z = pack2(bv[4].x, bv[5].x); q.w = pack2(bv[6].x, bv[7].x);
            *(uint4*)(Bs + tile_off(4 * ng + 0, kg)) = q;
            q.x = pack2(bv[0].y, bv[1].y); q.y = pack2(bv[2].y, bv[3].y); q.z = pack2(bv[4].y, bv[5].y); q.w = pack2(bv[6].y, bv[7].y);
            *(uint4*)(Bs + tile_off(4 * ng + 1, kg)) = q;
            q.x = pack2(bv[0].z, bv[1].z); q.y = pack2(bv[2].z, bv[3].z); q.z = pack2(bv[4].z, bv[5].z); q.w = pack2(bv[6].z, bv[7].z);
            *(uint4*)(Bs + tile_off(4 * ng + 2, kg)) = q;
            q.x = pack2(bv[0].w, bv[1].w); q.y = pack2(bv[2].w, bv[3].w); q.z = pack2(bv[4].w, bv[5].w); q.w = pack2(bv[6].w, bv[7].w);
            *(uint4*)(Bs + tile_off(4 * ng + 3, kg)) = q;
        }
    };
    gload(0);
    lstore(0);
    __syncthreads();
    for (int kt = 0; kt < nk; ++kt) {
        const int cur = kt & 1;
        if (kt + 1 < nk) gload(kt + 1);
        const char* As = lds + cur * 32768; const char* Bs = As + 16384;
#pragma unroll
        for (int ks = 0; ks < 2; ++ks) {
            bf16x8 af[4], bf[4];
#pragma unroll
            for (int m = 0; m < 4; ++m) af[m] = lds_frag(As, wm * 64 + m * 16 + (l & 15), ks * 4 + (l >> 4));
#pragma unroll
            for (int n = 0; n < 4; ++n) bf[n] = lds_frag(Bs, wn * 64 + n * 16 + (l & 15), ks * 4 + (l >> 4));
#pragma unroll
            for (int m = 0; m < 4; ++m)
#pragma unroll
                for (int n = 0; n < 4; ++n) acc[m][n] = __builtin_amdgcn_mfma_f32_16x16x32_bf16(bf[n], af[m], acc[m][n], 0, 0, 0);
        }
        if (kt + 1 < nk) lstore(cur ^ 1);
        __syncthreads();
    }
}

__device__ void ph_proj(const Params& p, char* lds) {
    const int t = tid_opaque(), l = t & 63, w = t >> 6, wm = w >> 1, wn = w & 1;
    const int ar = t >> 3, ac = t & 7, kg = l & 7, ng = w * 8 + (l >> 3);
    constexpr int MT = T / 128, NT = (INW + 127) / 128;
    for (int tile = blockIdx.x; tile < MT * NT; tile += gridDim.x) {
        const int m0 = (tile % MT) * 128, n0 = (tile / MT) * 128;
        const u16* ab = p.xn + (size_t)(m0 + ar) * D + ac * 8;
        const bool bvalid = (n0 + 4 * ng) < INW;
        const float* bp = p.w_in + (size_t)(8 * kg) * INW + n0 + 4 * ng;
        f32x4 acc[4][4];
        gemm_mainloop(lds, ab, ab + 32 * D, ab + 64 * D, ab + 96 * D, bp, INW, bvalid, D / 64, acc);
#pragma unroll
        for (int m = 0; m < 4; ++m) {
            const int row = m0 + wm * 64 + m * 16 + (l & 15);
#pragma unroll
            for (int n = 0; n < 4; ++n) {
                const int col = n0 + wn * 64 + n * 16 + (l >> 4) * 4;
                if (col < INW) {
                    uint2 o; o.x = pack2(acc[m][n][0], acc[m][n][1]); o.y = pack2(acc[m][n][2], acc[m][n][3]);
                    *(uint2*)(p.proj + (size_t)row * INW + col) = o;
                }
            }
        }
    }
}

constexpr int AT_K = 0, AT_V = 24576, AT_Q = 24576 + 30720, AT_BIAS = AT_Q + 8192;
__device__ void attn_item(const Params& p, char* lds, int it) {
    const int t = tid_opaque(), l = t & 63, w = t >> 6, i16 = l & 15, g = l >> 4;
    const int idx = it & 63, br = (it >> 6) % 3, h = (it / 192) & 7, b = it / 1536;
    const int dsh = br * 2, L = S >> dsh, nbl = L >> 6;
    const int res = idx / nbl, qb = idx % nbl;
    char* Ks = lds + AT_K; char* Vs = lds + AT_V; char* Qs = lds + AT_Q; float* biasf = (float*)(lds + AT_BIAS);
    __syncthreads();
#pragma unroll
    for (int i = 0; i < 6; ++i) {
        const int j = t + 256 * i, row = j >> 3, c = j & 7;
        const int ki = 64 * (qb - 1) + row;
        uint4 kv = make_uint4(0u, 0u, 0u, 0u), vv = kv;
        if (ki >= 0 && ki < L) {
            const size_t base = (size_t)(b * S + res + (ki << dsh)) * INW + h * 64 + c * 8;
            kv = *(const uint4*)(p.proj + base + C_AK);
            vv = *(const uint4*)(p.proj + base + C_AV);
        }
        *(uint4*)(Ks + tile_off(row, c)) = kv;
        *(uint4*)(Vs + row * 160 + c * 16) = vv;
    }
#pragma unroll
    for (int i = 0; i < 2; ++i) {
        const int j = t + 256 * i, row = j >> 3, c = j & 7;
        const size_t base = (size_t)(b * S + res + ((64 * qb + row) << dsh)) * INW + C_AQ + h * 64 + c * 8;
        *(uint4*)(Qs + tile_off(row, c)) = *(const uint4*)(p.proj + base);
    }
    if (t < 129) biasf[t] = p.rel_bias[T5TAB[br * 129 + t] * AH + h];
    __syncthreads();

    const bf16x8 qf0 = lds_frag(Qs, 16 * w + i16, g), qf1 = lds_frag(Qs, 16 * w + i16, 4 + g);
    f32x4 sc[10];
#pragma unroll
    for (int i = 0; i < 10; ++i) {
        const int tt = min(w + i, 11);
        const bf16x8 k0 = lds_frag(Ks, 16 * tt + i16, g), k1 = lds_frag(Ks, 16 * tt + i16, 4 + g);
        f32x4 a = {0.f, 0.f, 0.f, 0.f};
        a = __builtin_amdgcn_mfma_f32_16x16x32_bf16(k0, qf0, a, 0, 0, 0);
        a = __builtin_amdgcn_mfma_f32_16x16x32_bf16(k1, qf1, a, 0, 0, 0);
        sc[i] = a;
    }
    const int sq = 16 * w + i16;
    float mx = -3.0e38f;
#pragma unroll
    for (int i = 0; i < 10; ++i) {
#pragma unroll
        for (int r = 0; r < 4; ++r) {
            const int tk = 16 * (w + i) + 4 * g + r;
            const int off = tk - 64 - sq;
            const int ki = 64 * (qb - 1) + tk;
            const bool valid = (w + i <= 11) && (off >= -64) && (off <= 64) && (ki >= 0) && (ki < L);
            const float lg = valid ? (sc[i][r] * 0.125f + biasf[valid ? off + 64 : 0]) : -1.0e30f;
            sc[i][r] = lg;
            mx = fmaxf(mx, lg);
        }
    }
    mx = fmaxf(mx, __shfl_xor(mx, 16)); mx = fmaxf(mx, __shfl_xor(mx, 32));
    float ls = 0.f;
#pragma unroll
    for (int i = 0; i < 10; ++i) {
#pragma unroll
        for (int r = 0; r < 4; ++r) { const float e = (sc[i][r] > -1.0e29f) ? __expf(sc[i][r] - mx) : 0.f; sc[i][r] = e; ls += e; }
    }
    ls += __shfl_xor(ls, 16); ls += __shfl_xor(ls, 32);

    f32x4 oa[4];
#pragma unroll
    for (int e = 0; e < 4; ++e) oa[e] = (f32x4){0.f, 0.f, 0.f, 0.f};
#pragma unroll
    for (int i2 = 0; i2 < 5; ++i2) {
        const int tta = min(w + 2 * i2, 11), ttb = min(w + 2 * i2 + 1, 11);
        uint4 pu;
        pu.x = pack2(sc[2 * i2][0], sc[2 * i2][1]); pu.y = pack2(sc[2 * i2][2], sc[2 * i2][3]);
        pu.z = pack2(sc[2 * i2 + 1][0], sc[2 * i2 + 1][1]); pu.w = pack2(sc[2 * i2 + 1][2], sc[2 * i2 + 1][3]);
        const bf16x8 pf = __builtin_bit_cast(bf16x8, pu);
#pragma unroll
        for (int et = 0; et < 4; ++et) {
            const s16x4 va = tr_read(Vs + (16 * tta + 4 * g + (i16 >> 2)) * 160 + (16 * et + 4 * (i16 & 3)) * 2);
            const s16x4 vb = tr_read(Vs + (16 * ttb + 4 * g + (i16 >> 2)) * 160 + (16 * et + 4 * (i16 & 3)) * 2);
            oa[et] = __builtin_amdgcn_mfma_f32_16x16x32_bf16(cat4(va, vb), pf, oa[et], 0, 0, 0);
        }
    }
    const float inv = 1.0f / ls;
    const size_t tok = (size_t)b * S + res + ((64 * qb + sq) << dsh);
#pragma unroll
    for (int et = 0; et < 4; ++et) {
        uint2 o; o.x = pack2(oa[et][0] * inv, oa[et][1] * inv); o.y = pack2(oa[et][2] * inv, oa[et][3] * inv);
        *(uint2*)(p.abr + ((size_t)br * T + tok) * 512 + h * 64 + 16 * et + 4 * g) = o;
    }
    if (g == 0) p.lse[((size_t)br * T + tok) * 8 + h] = mx + __logf(ls);
}

constexpr int GL_ZS = 0, GL_TOT = 8192, GL_T0 = 10240;
__device__ __forceinline__ void gla_prep(const Params& p, char* lds, int h, int t0, float (&bfv)[16], float (&bbv)[16], float& Gf, float& Gb) {
    const int t = tid_opaque(), d = t & 63, w = t >> 6;
    float* zs = (float*)(lds + GL_ZS); float* tot = (float*)(lds + GL_TOT);
    __syncthreads();
    {
        const uint4 zz = *(const uint4*)(p.proj + (size_t)(t0 + (t >> 2)) * INW + C_GZ + (t & 3) * 8);
        float* zd = zs + (t >> 2) * 32 + (t & 3) * 8;
        zd[0] = lo2f(zz.x); zd[1] = hi2f(zz.x); zd[2] = lo2f(zz.y); zd[3] = hi2f(zz.y);
        zd[4] = lo2f(zz.z); zd[5] = hi2f(zz.z); zd[6] = lo2f(zz.w); zd[7] = hi2f(zz.w);
    }
    float wf[16], wb[16];
#pragma unroll
    for (int r = 0; r < 16; ++r) { wf[r] = p.wgf[r * 256 + h * 64 + d]; wb[r] = p.wgb[r * 256 + h * 64 + d]; }
    const float biasf = p.bgf[h * 64 + d], biasb = p.bgb[h * 64 + d];
    __syncthreads();
#pragma unroll
    for (int i = 0; i < 16; ++i) {
        const float* zr = zs + (16 * w + i) * 32;
        float af = biasf, ab = biasb;
#pragma unroll
        for (int r = 0; r < 16; ++r) { af = fmaf(zr[r], wf[r], af); ab = fmaf(zr[16 + r], wb[r], ab); }
        bfv[i] = logsig(af) * (1.0f / 16.0f); bbv[i] = logsig(ab) * (1.0f / 16.0f);
    }
#pragma unroll
    for (int i = 1; i < 16; ++i) bfv[i] += bfv[i - 1];
#pragma unroll
    for (int i = 14; i >= 0; --i) bbv[i] += bbv[i + 1];
    tot[(0 * 4 + w) * 64 + d] = bfv[15];
    tot[(1 * 4 + w) * 64 + d] = bbv[0];
    __syncthreads();
    float offf = 0.f, offb = 0.f; Gf = 0.f; Gb = 0.f;
#pragma unroll
    for (int ww = 0; ww < 4; ++ww) {
        const float a = tot[(0 * 4 + ww) * 64 + d], c = tot[(1 * 4 + ww) * 64 + d];
        Gf += a; Gb += c;
        if (ww < w) offf += a;
        if (ww > w) offb += c;
    }
#pragma unroll
    for (int i = 0; i < 16; ++i) { bfv[i] += offf; bbv[i] += offb; }
}

constexpr int GD_KF = GL_T0, GD_KB = GD_KF + 64 * 160, GD_VT = GD_KB + 64 * 160;
__device__ void gla_ds_item(const Params& p, char* lds, int it) {
    const int t = tid_opaque(), l = t & 63, w = t >> 6, d = l, i16 = l & 15, g = l >> 4;
    const int n = it & 63, h = (it >> 6) & 3, b = it >> 8;
    const int t0 = b * S + n * 64;
    float bfv[16], bbv[16], Gf, Gb;
    gla_prep(p, lds, h, t0, bfv, bbv, Gf, Gb);
    char* KF = lds + GD_KF; char* KB = lds + GD_KB; char* VT = lds + GD_VT;
#pragma unroll
    for (int i = 0; i < 16; ++i) {
        const int s = 16 * w + i;
        const float kk = bf2f(p.proj[(size_t)(t0 + s) * INW + C_GK + h * 64 + d]);
        *(u16*)(KF + s * 160 + d * 2) = f2bf(kk * __expf(Gf - bfv[i]));
        *(u16*)(KB + s * 160 + d * 2) = f2bf(kk * __expf(Gb - bbv[i]));
    }
#pragma unroll
    for (int i = 0; i < 4; ++i) {
        const int j = t + 256 * i, row = j >> 4, c = j & 15;
        *(uint4*)(VT + row * 288 + c * 16) = *(const uint4*)(p.proj + (size_t)(t0 + row) * INW + C_GV + h * 128 + c * 8);
    }
    if (w == 0) { p.dec[((size_t)it * 2 + 0) * 64 + d] = __expf(Gf); p.dec[((size_t)it * 2 + 1) * 64 + d] = __expf(Gb); }
    __syncthreads();
#pragma unroll
    for (int dir = 0; dir < 2; ++dir) {
        const char* KX = dir ? KB : KF;
        f32x4 acc[2][4];
#pragma unroll
        for (int a = 0; a < 2; ++a)
#pragma unroll
            for (int c = 0; c < 4; ++c) acc[a][c] = (f32x4){0.f, 0.f, 0.f, 0.f};
#pragma unroll
        for (int ks = 0; ks < 2; ++ks) {
            const int r0 = ks * 32 + 8 * g + (i16 >> 2);
            bf16x8 af[2], bf[4];
#pragma unroll
            for (int a = 0; a < 2; ++a) {
                const int e0 = 16 * (2 * w + a) + 4 * (i16 & 3);
                af[a] = cat4(tr_read(VT + r0 * 288 + e0 * 2), tr_read(VT + (r0 + 4) * 288 + e0 * 2));
            }
#pragma unroll
            for (int c = 0; c < 4; ++c) {
                const int d0 = 16 * c + 4 * (i16 & 3);
                bf[c] = cat4(tr_read(KX + r0 * 160 + d0 * 2), tr_read(KX + (r0 + 4) * 160 + d0 * 2));
            }
#pragma unroll
            for (int a = 0; a < 2; ++a)
#pragma unroll
                for (int c = 0; c < 4; ++c) acc[a][c] = __builtin_amdgcn_mfma_f32_16x16x32_bf16(af[a], bf[c], acc[a][c], 0, 0, 0);
        }
        float* dst = p.dS + ((size_t)it * 2 + dir) * 128 * 64;
#pragma unroll
        for (int a = 0; a < 2; ++a)
#pragma unroll
            for (int c = 0; c < 4; ++c)
#pragma unroll
                for (int r = 0; r < 4; ++r) dst[(16 * (2 * w + a) + 4 * g + r) * 64 + 16 * c + i16] = acc[a][c][r];
    }
}

__device__ void gla_scan_block(const Params& p, int blk) {
    const int gid = blk * 256 + threadIdx.x;
    const int d = gid & 63, e = (gid >> 6) & 127, dir = (gid >> 13) & 1, bh = gid >> 14;
    float s = 0.f;
    for (int step = 0; step < 64; ++step) {
        const int n = dir ? (63 - step) : step;
        const size_t item = ((size_t)(bh * 64 + n)) * 2 + dir;
        p.Sp[(item * 128 + e) * 64 + d] = f2bf(s);
        s = fmaf(p.dec[item * 64 + d], s, p.dS[(item * 128 + e) * 64 + d]);
    }
}

__device__ void attn_combine_block(const Params& p, int blk) {
    const int gid = blk * 256 + threadIdx.x;
    const int tok = gid >> 6, c = gid & 63, h = c >> 3;
    const float l0 = p.lse[((size_t)0 * T + tok) * 8 + h], l1 = p.lse[((size_t)1 * T + tok) * 8 + h], l2 = p.lse[((size_t)2 * T + tok) * 8 + h];
    const float mm = fmaxf(l0, fmaxf(l1, l2));
    float w0 = __expf(l0 - mm), w1 = __expf(l1 - mm), w2 = __expf(l2 - mm);
    const float inv = 1.0f / (w0 + w1 + w2);
    w0 *= inv; w1 *= inv; w2 *= inv;
    const uint4 a0 = *(const uint4*)(p.abr + ((size_t)0 * T + tok) * 512 + c * 8);
    const uint4 a1 = *(const uint4*)(p.abr + ((size_t)1 * T + tok) * 512 + c * 8);
    const uint4 a2 = *(const uint4*)(p.abr + ((size_t)2 * T + tok) * 512 + c * 8);
    uint4 o;
    o.x = pack2(w0 * lo2f(a0.x) + w1 * lo2f(a1.x) + w2 * lo2f(a2.x), w0 * hi2f(a0.x) + w1 * hi2f(a1.x) + w2 * hi2f(a2.x));
    o.y = pack2(w0 * lo2f(a0.y) + w1 * lo2f(a1.y) + w2 * lo2f(a2.y), w0 * hi2f(a0.y) + w1 * hi2f(a1.y) + w2 * hi2f(a2.y));
    o.z = pack2(w0 * lo2f(a0.z) + w1 * lo2f(a1.z) + w2 * lo2f(a2.z), w0 * hi2f(a0.z) + w1 * hi2f(a1.z) + w2 * hi2f(a2.z));
    o.w = pack2(w0 * lo2f(a0.w) + w1 * lo2f(a1.w) + w2 * lo2f(a2.w), w0 * hi2f(a0.w) + w1 * hi2f(a1.w) + w2 * hi2f(a2.w));
    *(uint4*)(p.mix + (size_t)tok * D + c * 8) = o;
}

constexpr int GO_QF = GL_T0, GO_QB = GO_QF + 8192, GO_KF = GO_QB + 8192, GO_KB = GO_KF + 8192, GO_VT = GO_KB + 8192, GO_AM = GL_ZS;
__device__ void gla_out_item(const Params& p, char* lds, int it) {
    const int t = tid_opaque(), l = t & 63, w = t >> 6, d = l, i16 = l & 15, g = l >> 4;
    const int n = it & 63, h = (it >> 6) & 3, b = it >> 8;
    const int t0 = b * S + n * 64;
    float bfv[16], bbv[16], Gf, Gb;
    gla_prep(p, lds, h, t0, bfv, bbv, Gf, Gb);
    char* QF = lds + GO_QF; char* QB = lds + GO_QB; char* KF = lds + GO_KF; char* KB = lds + GO_KB; char* VT = lds + GO_VT; char* AM = lds + GO_AM;
#pragma unroll
    for (int i = 0; i < 16; ++i) {
        const int s = 16 * w + i;
        const size_t rb = (size_t)(t0 + s) * INW + h * 64 + d;
        const float qq = bf2f(p.proj[rb + C_GQ]) * 0.125f, kk = bf2f(p.proj[rb + C_GK]);
        const int o = tile_off(s, d >> 3) + (d & 7) * 2;
        const float ef = __expf(bfv[i]), eb = __expf(bbv[i]);
        *(u16*)(QF + o) = f2bf(qq * ef);
        *(u16*)(KF + o) = f2bf(kk / ef);
        *(u16*)(QB + o) = f2bf(qq * eb);
        *(u16*)(KB + o) = f2bf(kk / eb);
    }
#pragma unroll
    for (int i = 0; i < 4; ++i) {
        const int j = t + 256 * i, row = j >> 4, c = j & 15;
        *(uint4*)(VT + row * 288 + c * 16) = *(const uint4*)(p.proj + (size_t)(t0 + row) * INW + C_GV + h * 128 + c * 8);
    }
    __syncthreads();
    const int cq = 16 * w + i16;
    const bf16x8 qf0 = lds_frag(QF, cq, g), qf1 = lds_frag(QF, cq, 4 + g);
    const bf16x8 qb0 = lds_frag(QB, cq, g), qb1 = lds_frag(QB, cq, 4 + g);
#pragma unroll
    for (int st = 0; st < 4; ++st) {
        f32x4 af = {0.f, 0.f, 0.f, 0.f}, ab = {0.f, 0.f, 0.f, 0.f};
        af = __builtin_amdgcn_mfma_f32_16x16x32_bf16(lds_frag(KF, 16 * st + i16, g), qf0, af, 0, 0, 0);
        af = __builtin_amdgcn_mfma_f32_16x16x32_bf16(lds_frag(KF, 16 * st + i16, 4 + g), qf1, af, 0, 0, 0);
        ab = __builtin_amdgcn_mfma_f32_16x16x32_bf16(lds_frag(KB, 16 * st + i16, g), qb0, ab, 0, 0, 0);
        ab = __builtin_amdgcn_mfma_f32_16x16x32_bf16(lds_frag(KB, 16 * st + i16, 4 + g), qb1, ab, 0, 0, 0);
        float am[4];
#pragma unroll
        for (int r = 0; r < 4; ++r) {
            const int s = 16 * st + 4 * g + r;
            am[r] = (s <= cq ? af[r] : 0.f) + (s >= cq ? ab[r] : 0.f);
        }
        const int s0 = 16 * st + 4 * g;
        uint2 o; o.x = pack2(am[0], am[1]); o.y = pack2(am[2], am[3]);
        *(uint2*)(AM + tile_off(cq, s0 >> 3) + (s0 & 7) * 2) = o;
    }
    __syncthreads();
    f32x4 oc[8];
#pragma unroll
    for (int et = 0; et < 8; ++et) oc[et] = (f32x4){0.f, 0.f, 0.f, 0.f};
    const u16* SF = p.Sp + ((size_t)it * 2 + 0) * 128 * 64;
    const u16* SB = p.Sp + ((size_t)it * 2 + 1) * 128 * 64;
#pragma unroll
    for (int ks = 0; ks < 2; ++ks) {
        const bf16x8 amf = lds_frag(AM, cq, ks * 4 + g);
        const bf16x8 qff = ks ? qf1 : qf0, qbf = ks ? qb1 : qb0;
        const int r0 = ks * 32 + 8 * g + (i16 >> 2);
#pragma unroll
        for (int et = 0; et < 8; ++et) {
            const int e0 = 16 * et + 4 * (i16 & 3);
            const bf16x8 vf = cat4(tr_read(VT + r0 * 288 + e0 * 2), tr_read(VT + (r0 + 4) * 288 + e0 * 2));
            oc[et] = __builtin_amdgcn_mfma_f32_16x16x32_bf16(vf, amf, oc[et], 0, 0, 0);
            const bf16x8 sf = *(const bf16x8*)(SF + (16 * et + i16) * 64 + ks * 32 + 8 * g);
            oc[et] = __builtin_amdgcn_mfma_f32_16x16x32_bf16(sf, qff, oc[et], 0, 0, 0);
            const bf16x8 sb = *(const bf16x8*)(SB + (16 * et + i16) * 64 + ks * 32 + 8 * g);
            oc[et] = __builtin_amdgcn_mfma_f32_16x16x32_bf16(sb, qbf, oc[et], 0, 0, 0);
        }
    }
    float ss = 0.f;
#pragma unroll
    for (int et = 0; et < 8; ++et)
#pragma unroll
        for (int r = 0; r < 4; ++r) ss += oc[et][r] * oc[et][r];
    ss += __shfl_xor(ss, 16); ss += __shfl_xor(ss, 32);
    const float rstd = rsqrtf(ss * (1.0f / 128.0f) + EPS);
    const size_t tok = (size_t)t0 + cq;
#pragma unroll
    for (int et = 0; et < 8; ++et) {
        const int e = 16 * et + 4 * g;
        const uint2 gg = *(const uint2*)(p.proj + tok * INW + C_GO + h * 128 + e);
        const float4 ng = *(const float4*)(p.gla_ng + h * 128 + e);
        const float g0 = lo2f(gg.x), g1 = hi2f(gg.x), g2 = lo2f(gg.y), g3 = hi2f(gg.y);
        uint2 o;
        o.x = pack2(oc[et][0] * rstd * ng.x * (g0 / (1.0f + __expf(-g0))), oc[et][1] * rstd * ng.y * (g1 / (1.0f + __expf(-g1))));
        o.y = pack2(oc[et][2] * rstd * ng.z * (g2 / (1.0f + __expf(-g2))), oc[et][3] * rstd * ng.w * (g3 / (1.0f + __expf(-g3))));
        *(uint2*)(p.mix + tok * D + 512 + h * 128 + e) = o;
    }
}

__device__ void ph_outproj(const Params& p, char* lds) {
    const int t = tid_opaque(), l = t & 63, w = t >> 6, wm = w >> 1, wn = w & 1;
    const int ar = t >> 3, ac = t & 7, kg = l & 7, ng = w * 8 + (l >> 3);
    constexpr int MT = T / 128, NT = D / 128;
    for (int tile = blockIdx.x; tile < MT * NT; tile += gridDim.x) {
        const int m0 = (tile % MT) * 128, n0 = (tile / MT) * 128;
        const u16* ab = p.mix + (size_t)(m0 + ar) * D + ac * 8;
        const float* bp = p.w_out + (size_t)(8 * kg) * D + n0 + 4 * ng;
        f32x4 acc[4][4];
        gemm_mainloop(lds, ab, ab + 32 * D, ab + 64 * D, ab + 96 * D, bp, D, true, D / 64, acc);
#pragma unroll
        for (int m = 0; m < 4; ++m) {
            const int row = m0 + wm * 64 + m * 16 + (l & 15);
#pragma unroll
            for (int n = 0; n < 4; ++n) {
                const int col = n0 + wn * 64 + n * 16 + (l >> 4) * 4;
                const float4 xv = *(const float4*)(p.x + (size_t)row * D + col);
                float4 o; o.x = xv.x + acc[m][n][0]; o.y = xv.y + acc[m][n][1]; o.z = xv.z + acc[m][n][2]; o.w = xv.w + acc[m][n][3];
                *(float4*)(p.x1 + (size_t)row * D + col) = o;
            }
        }
    }
}

constexpr int RT_XS = 0, RT_PART = 32768, RT_LG = 32768 + 8192;
__device__ void ph_route(const Params& p, char* lds) {
    const int t = tid_opaque(), lane = t & 63, w = t >> 6;
    float* xs = (float*)(lds + RT_XS); float* part = (float*)(lds + RT_PART); float* lg = (float*)(lds + RT_LG);
    for (int it = blockIdx.x; it < T / 8; it += gridDim.x) {
        const int tok0 = it * 8;
        __syncthreads();
#pragma unroll
        for (int tt = 0; tt < 2; ++tt) {
            const int tl = 2 * w + tt, tok = tok0 + tl;
            const float4* xr = (const float4*)(p.x1 + (size_t)tok * D);
            float4 v[4]; float ss = 0.f;
#pragma unroll
            for (int i = 0; i < 4; ++i) { v[i] = xr[lane + 64 * i]; ss += v[i].x * v[i].x + v[i].y * v[i].y + v[i].z * v[i].z + v[i].w * v[i].w; }
            ss = wave_sum(ss);
            const float r = rsqrtf(ss * (1.0f / D) + EPS);
#pragma unroll
            for (int i = 0; i < 4; ++i) {
                const float4 gq = ((const float4*)p.g2)[lane + 64 * i];
                float4 yv; yv.x = v[i].x * r * gq.x; yv.y = v[i].y * r * gq.y; yv.z = v[i].z * r * gq.z; yv.w = v[i].w * r * gq.w;
                ((float4*)(xs + tl * 1024))[lane + 64 * i] = yv;
                uint2 o; o.x = pack2(yv.x, yv.y); o.y = pack2(yv.z, yv.w);
                *(uint2*)(p.xn2 + (size_t)tok * D + (lane + 64 * i) * 4) = o;
            }
        }
        __syncthreads();
        {
            const int e = t & 31, ksl = t >> 5;
            float a[8];
#pragma unroll
            for (int k = 0; k < 8; ++k) a[k] = 0.f;
            for (int k = ksl * 128; k < ksl * 128 + 128; ++k) {
                const float wv = p.rw[k * 32 + e];
#pragma unroll
                for (int tk = 0; tk < 8; ++tk) a[tk] = fmaf(xs[tk * 1024 + k], wv, a[tk]);
            }
#pragma unroll
            for (int tk = 0; tk < 8; ++tk) part[(ksl * 8 + tk) * 32 + e] = a[tk];
        }
        __syncthreads();
        {
            const int tk = t >> 5, e = t & 31;
            float sacc = 0.f;
#pragma unroll
            for (int ksl = 0; ksl < 8; ++ksl) sacc += part[(ksl * 8 + tk) * 32 + e];
            lg[tk * 32 + e] = sacc + p.rb[e];
        }
        __syncthreads();
        if (t < 8) {
            const int tok = tok0 + t;
            float bv[4]; int bi[4];
            unsigned used = 0u;
#pragma unroll
            for (int k = 0; k < 4; ++k) {
                float best = -3.0e38f; int bidx = 0;
                for (int j = 0; j < 32; ++j) { const float xv = lg[t * 32 + j]; if (!((used >> j) & 1u) && xv > best) { best = xv; bidx = j; } }
                used |= 1u << bidx; bv[k] = best; bi[k] = bidx;
            }
            const float e1 = expf(bv[1] - bv[0]), e2 = expf(bv[2] - bv[0]), e3 = expf(bv[3] - bv[0]);
            const float inv = 1.0f / (1.0f + e1 + e2 + e3);
            const float gs[4] = {inv, e1 * inv, e2 * inv, e3 * inv};
#pragma unroll
            for (int k = 0; k < 4; ++k) {
                const int slot = tok * 4 + k;
                const int pos = atomicAdd(&p.counts[bi[k]], 1);
                p.lists[bi[k] * T + pos] = slot;
                p.gate[slot] = gs[k];
            }
        }
    }
}

constexpr int MO_META = 65536;
__device__ __forceinline__ void moe_meta(const Params& p, int* meta) {
    __syncthreads();
    if (threadIdx.x == 0) {
        int mp = 0, rbse = 0;
        for (int e = 0; e < NE; ++e) {
            const int c = p.counts[e];
            meta[128 + e] = c; meta[160 + e] = mp; meta[200 + e] = rbse;
            mp += (c + 127) >> 7; rbse += c;
        }
        meta[160 + NE] = mp; meta[200 + NE] = rbse;
    }
    __syncthreads();
}

__device__ void ph_moe1(const Params& p, char* lds) {
    const int t = tid_opaque(), l = t & 63, w = t >> 6, wm = w >> 1, wn = w & 1;
    const int ar = t >> 3, ac = t & 7, kg = l & 7, ng = w * 8 + (l >> 3);
    int* meta = (int*)(lds + MO_META);
    moe_meta(p, meta);
    const int ntiles = meta[160 + NE] * 16;
    for (int tile = blockIdx.x; tile < ntiles; tile += gridDim.x) {
        const int gm = tile >> 4, nt = tile & 15;
        int e = 0;
        while (meta[160 + e + 1] <= gm) ++e;
        const int mi = gm - meta[160 + e], cnt = meta[128 + e], n0 = nt * 128;
        __syncthreads();
        if (t < 128) { const int i = mi * 128 + t; meta[t] = (i < cnt) ? p.lists[e * T + i] : -1; }
        __syncthreads();
        const int fallback = meta[0];
        const u16* ap[4];
#pragma unroll
        for (int i = 0; i < 4; ++i) { int sl = meta[ar + 32 * i]; if (sl < 0) sl = fallback; ap[i] = p.xn2 + (size_t)(sl >> 2) * D + ac * 8; }
        const float* bp = p.w1 + (size_t)e * D * (2 * DFF) + (size_t)(8 * kg) * (2 * DFF) + n0 + 4 * ng;
        f32x4 acc[4][4];
        gemm_mainloop(lds, ap[0], ap[1], ap[2], ap[3], bp, 2 * DFF, true, D / 64, acc);
        const float* b1e = p.b1 + (size_t)e * 2 * DFF;
        const int rowbase = meta[200 + e] + mi * 128;
#pragma unroll
        for (int m = 0; m < 4; ++m) {
            const int rl = wm * 64 + m * 16 + (l & 15);
            if (meta[rl] < 0) continue;
#pragma unroll
            for (int n = 0; n < 4; ++n) {
                const int col = n0 + wn * 64 + n * 16 + (l >> 4) * 4;
                const float4 bb = *(const float4*)(b1e + col);
                float g0 = fminf(acc[m][n][0] + bb.x, 7.0f), l0 = fminf(fmaxf(acc[m][n][1] + bb.y, -7.0f), 7.0f);
                float g1 = fminf(acc[m][n][2] + bb.z, 7.0f), l1 = fminf(fmaxf(acc[m][n][3] + bb.w, -7.0f), 7.0f);
                const float a0 = g0 / (1.0f + __expf(-1.702f * g0)) * (l0 + 1.0f);
                const float a1 = g1 / (1.0f + __expf(-1.702f * g1)) * (l1 + 1.0f);
                *(unsigned*)(p.act + (size_t)(rowbase + rl) * DFF + (col >> 1)) = pack2(a0, a1);
            }
        }
    }
}

__device__ void ph_moe2(const Params& p, char* lds) {
    const int t = tid_opaque(), l = t & 63, w = t >> 6, wm = w >> 1, wn = w & 1;
    const int ar = t >> 3, ac = t & 7, kg = l & 7, ng = w * 8 + (l >> 3);
    int* meta = (int*)(lds + MO_META);
    moe_meta(p, meta);
    const int ntiles = meta[160 + NE] * 8;
    for (int tile = blockIdx.x; tile < ntiles; tile += gridDim.x) {
        const int gm = tile >> 3, nt = tile & 7;
        int e = 0;
        while (meta[160 + e + 1] <= gm) ++e;
        const int mi = gm - meta[160 + e], cnt = meta[128 + e], n0 = nt * 128;
        __syncthreads();
        if (t < 128) { const int i = mi * 128 + t; meta[t] = (i < cnt) ? p.lists[e * T + i] : -1; }
        __syncthreads();
        const int rowbase = meta[200 + e] + mi * 128;
        const int nvalid = min(128, cnt - mi * 128);
        const u16* ap[4];
#pragma unroll
        for (int i = 0; i < 4; ++i) { const int r = min(ar + 32 * i, nvalid - 1); ap[i] = p.act + (size_t)(rowbase + r) * DFF + ac * 8; }
        const float* bp = p.w2 + (size_t)e * DFF * D + (size_t)(8 * kg) * D + n0 + 4 * ng;
        f32x4 acc[4][4];
        gemm_mainloop(lds, ap[0], ap[1], ap[2], ap[3], bp, D, true, DFF / 64, acc);
        const float* b2e = p.b2 + (size_t)e * D;
#pragma unroll
        for (int m = 0; m < 4; ++m) {
            const int rl = wm * 64 + m * 16 + (l & 15);
            const int slot = meta[rl];
            if (slot < 0) continue;
            const float gt = p.gate[slot];
#pragma unroll
            for (int n = 0; n < 4; ++n) {
                const int col = n0 + wn * 64 + n * 16 + (l >> 4) * 4;
                const float4 bb = *(const float4*)(b2e + col);
                uint2 o;
                o.x = pack2(gt * (acc[m][n][0] + bb.x), gt * (acc[m][n][1] + bb.y));
                o.y = pack2(gt * (acc[m][n][2] + bb.z), gt * (acc[m][n][3] + bb.w));
                *(uint2*)(p.y + (size_t)slot * D + col) = o;
            }
        }
    }
}

__device__ void ph_final(const Params& p) {
    const int lane = threadIdx.x & 63, gw = blockIdx.x * 4 + (threadIdx.x >> 6), nw = gridDim.x * 4;
    for (int tok = gw; tok < T; tok += nw) {
        float4 v[4]; float ss = 0.f;
#pragma unroll
        for (int i = 0; i < 4; ++i) {
            v[i] = ((const float4*)(p.x1 + (size_t)tok * D))[lane + 64 * i];
#pragma unroll
            for (int k = 0; k < 4; ++k) {
                const uint2 yy = *(const uint2*)(p.y + ((size_t)tok * 4 + k) * D + (lane + 64 * i) * 4);
                v[i].x += lo2f(yy.x); v[i].y += hi2f(yy.x); v[i].z += lo2f(yy.y); v[i].w += hi2f(yy.y);
            }
            ss += v[i].x * v[i].x + v[i].y * v[i].y + v[i].z * v[i].z + v[i].w * v[i].w;
        }
        ss = wave_sum(ss);
        const float r = rsqrtf(ss * (1.0f / D) + EPS);
#pragma unroll
        for (int i = 0; i < 4; ++i) {
            const float4 g = ((const float4*)p.gf)[lane + 64 * i];
            float4 o; o.x = v[i].x * r * g.x; o.y = v[i].y * r * g.y; o.z = v[i].z * r * g.z; o.w = v[i].w * r * g.w;
            ((float4*)(p.out + (size_t)tok * D))[lane + 64 * i] = o;
        }
    }
}


#define XB_TMO      128
#define XB_XCNT(j)  (256  + 64 * (j))
#define XB_XSUB(j)  (1280 + 64 * (j))
#define XB_XGEN(j)  (2304 + 64 * (j))
#define XB_TOP      3328
#define XB_TOPGEN   3392
#define XCD_BAR_WORDS 3456
#define XB_SPIN_CAP (1u << 22)
__device__ __forceinline__ unsigned xb_ld(unsigned* p)              { return __hip_atomic_load(p, __ATOMIC_RELAXED, __HIP_MEMORY_SCOPE_AGENT); }
__device__ __forceinline__ unsigned xb_add(unsigned* p, unsigned v) { return __hip_atomic_fetch_add(p, v, __ATOMIC_RELAXED, __HIP_MEMORY_SCOPE_AGENT); }
__device__ __forceinline__ unsigned xb_xcc_id() { return (unsigned)__builtin_amdgcn_s_getreg((3 << 11) | 20) & 0xFu; }
#define XB_SPIN(cond, bar) do { unsigned _sp = 0; while (cond) { __builtin_amdgcn_s_sleep(1); \
    if ((++_sp & 255u) == 0u) { if (xb_ld(&(bar)[XB_TMO])) break; if (_sp > XB_SPIN_CAP) { atomicAdd(&(bar)[XB_TMO], 1u); break; } } } } while (0)
struct XcdBarrier { unsigned* bar; unsigned x; volatile LDS_AS unsigned* st; };
__device__ __forceinline__ XcdBarrier xcd_barrier_post(unsigned* bar, volatile LDS_AS unsigned* st) {
    XcdBarrier b; b.bar = bar; b.x = xb_xcc_id(); b.st = st;
    if (threadIdx.x == 0) (void)xb_add(&bar[XB_XCNT(b.x)], 1u);
    return b;
}
__device__ __forceinline__ void xcd_barrier_complete(unsigned* bar, unsigned x, unsigned& nloc, unsigned& nx) {
    const unsigned G = gridDim.x * gridDim.y * gridDim.z;
    unsigned sum, cnt, mine, sp = 0u;
    for (;;) {
        sum = 0u; cnt = 0u; mine = 0u;
#pragma unroll
        for (unsigned j = 0; j < 16; ++j) { const unsigned c = xb_ld(&bar[XB_XCNT(j)]); sum += c; cnt += (c > 0u) ? 1u : 0u; mine = (j == x) ? c : mine; }
        if (sum == G) break;
        __builtin_amdgcn_s_sleep(1);
        if ((++sp & 255u) == 0u) { if (xb_ld(&bar[XB_TMO])) break; if (sp > XB_SPIN_CAP) { atomicAdd(&bar[XB_TMO], 1u); break; } }
    }
    nloc = mine > 0u ? mine : 1u; nx = cnt > 0u ? cnt : 1u;
}
__device__ __forceinline__ void xcd_barrier(const XcdBarrier& b) {
    asm volatile("s_waitcnt vmcnt(0)" ::: "memory");
    __syncthreads();
    if (threadIdx.x == 0) {
        unsigned* bar = b.bar;
        __builtin_amdgcn_s_waitcnt(0);
        unsigned nloc = b.st[0], nx = b.st[1];
        if (nloc == 0u) { xcd_barrier_complete(bar, b.x, nloc, nx); b.st[0] = nloc; b.st[1] = nx; }
        const unsigned old = xb_add(&bar[XB_XSUB(b.x)], 1u);
        const unsigned gen = old / nloc;
        if (old + 1u == (gen + 1u) * nloc) {
            __builtin_amdgcn_fence(__ATOMIC_RELEASE, "agent");
            asm volatile("s_waitcnt vmcnt(0)" ::: "memory");
            const unsigned og = xb_add(&bar[XB_TOP], 1u);
            const unsigned tg = og / nx;
            if (og + 1u == (tg + 1u) * nx) xb_add(&bar[XB_TOPGEN], 1u);
            else XB_SPIN(xb_ld(&bar[XB_TOPGEN]) == tg, bar);
            __builtin_amdgcn_fence(__ATOMIC_ACQUIRE, "agent");
            xb_add(&bar[XB_XGEN(b.x)], 1u);
            asm volatile("s_waitcnt vmcnt(0)" ::: "memory");
        } else {
            XB_SPIN(xb_ld(&bar[XB_XGEN(b.x)]) == gen, bar);
            __builtin_amdgcn_fence(__ATOMIC_ACQUIRE, "agent");
            asm volatile("s_waitcnt vmcnt(0)" ::: "memory");
        }
    }
    __syncthreads();
}

enum { PH_NORM1 = 0, PH_PROJ, PH_MIX1, PH_MIX2, PH_MIX3, PH_OUTPROJ, PH_ROUTE, PH_MOE1, PH_MOE2, PH_FINAL, PH_END };
constexpr int N_GLA_ITEMS = B * GH * 64, N_ATT_ITEMS = B * AH * 3 * 64;

__global__ void __launch_bounds__(256, 2) mega(Params p) {
    extern __shared__ __attribute__((aligned(16))) char lds[];
    cg::grid_group grid = cg::this_grid();
    volatile LDS_AS unsigned* xst = (volatile LDS_AS unsigned*)(lds + LDS_BYTES - 16);
    if (threadIdx.x == 0) { xst[0] = 0u; xst[1] = 0u; }
    __syncthreads();
    const XcdBarrier xb = xcd_barrier_post(p.bar, xst);
    for (int ph = p.ph_lo; ph < p.ph_hi; ++ph) {
        switch (ph) {
        case PH_NORM1: ph_norm1(p); break;
        case PH_PROJ: ph_proj(p, lds); break;
        case PH_MIX1:
            for (int it = blockIdx.x; it < N_GLA_ITEMS; it += gridDim.x) gla_ds_item(p, lds, it);
            for (int it = blockIdx.x; it < N_ATT_ITEMS; it += gridDim.x) attn_item(p, lds, it);
            break;
        case PH_MIX2:
            for (int it = blockIdx.x; it < 1024; it += gridDim.x) gla_scan_block(p, it);
            for (int it = blockIdx.x; it < T * 64 / 256; it += gridDim.x) attn_combine_block(p, it);
            break;
        case PH_MIX3:
            for (int it = blockIdx.x; it < N_GLA_ITEMS; it += gridDim.x) gla_out_item(p, lds, it);
            break;
        case PH_OUTPROJ: ph_outproj(p, lds); break;
        case PH_ROUTE: ph_route(p, lds); break;
        case PH_MOE1: ph_moe1(p, lds); break;
        case PH_MOE2: ph_moe2(p, lds); break;
        case PH_FINAL: ph_final(p); break;
        default: break;
        }
        if (ph + 1 < p.ph_hi) { if (ph == p.ph_lo) grid.sync(); else xcd_barrier(xb); }
    }
}

#ifndef STAGE
#define STAGE 6
#endif

__global__ void __launch_bounds__(256) cvt_bf16_f32(const u16* __restrict__ src, int lds_, float* __restrict__ dst, int ldd, int rows, int cols) {
    const size_t n = (size_t)rows * cols;
    for (size_t i = (size_t)blockIdx.x * 256 + threadIdx.x; i < n; i += (size_t)gridDim.x * 256) {
        const size_t r = i / cols, c = i % cols;
        dst[r * ldd + c] = bf2f(src[r * lds_ + c]);
    }
}

#include <cstdio>
extern "C" void kernel_launch(void* const* d_in, const int* in_sizes, int n_in, void* d_out, int out_size, void* d_ws, size_t ws_size, hipStream_t stream) {
    const float* x = (const float*)d_in[0];
    const float* norm1_g = (const float*)d_in[1];
    const float* w_in = (const float*)d_in[2];
    const float* rel_bias = (const float*)d_in[3];
    const float* wgf = (const float*)d_in[4];
    const float* bgf = (const float*)d_in[5];
    const float* wgb = (const float*)d_in[6];
    const float* bgb = (const float*)d_in[7];
    const float* gla_ng = (const float*)d_in[8];
    const float* w_out = (const float*)d_in[9];
    const float* norm2_g = (const float*)d_in[10];
    const float* router_w = (const float*)d_in[11];
    const float* router_b = (const float*)d_in[12];
    const float* w1 = (const float*)d_in[13];
    const float* b1 = (const float*)d_in[14];
    const float* w2 = (const float*)d_in[15];
    const float* b2 = (const float*)d_in[16];
    const float* final_g = (const float*)d_in[17];
    float* out = (float*)d_out;

    static int grid_blocks = 0;
    if (!grid_blocks) {
        int dev = 0, cus = 0, per_cu = 0;
        hipGetDevice(&dev);
        hipDeviceGetAttribute(&cus, hipDeviceAttributeMultiprocessorCount, dev);
        hipFuncSetAttribute((const void*)mega, hipFuncAttributeMaxDynamicSharedMemorySize, LDS_BYTES);
        hipOccupancyMaxActiveBlocksPerMultiprocessor(&per_cu, mega, 256, LDS_BYTES);
        if (per_cu > 2) per_cu = 2;
        if (per_cu < 1) per_cu = 1;
        grid_blocks = cus * per_cu;
    }

    char* ws = (char*)d_ws;
    size_t off = 0;
    auto take = [&](size_t bytes) { char* p = ws + off; off += (bytes + 255) & ~(size_t)255; return p; };
    Params p{};
    p.x = x; p.g1 = norm1_g; p.w_in = w_in; p.rel_bias = rel_bias; p.wgf = wgf; p.bgf = bgf; p.wgb = wgb; p.bgb = bgb; p.gla_ng = gla_ng;
    p.w_out = w_out; p.g2 = norm2_g; p.rw = router_w; p.rb = router_b; p.w1 = w1; p.b1 = b1; p.w2 = w2; p.b2 = b2; p.gf = final_g; p.out = out;
    p.xn = (u16*)take((size_t)T * D * 2);
    p.proj = (u16*)take((size_t)T * INW * 2);
    p.abr = (u16*)take((size_t)3 * T * 512 * 2);
    p.lse = (float*)take((size_t)3 * T * 8 * 4);
    p.dS = (float*)take((size_t)B * GH * 64 * 2 * 128 * 64 * 4);
    p.dec = (float*)take((size_t)B * GH * 64 * 2 * 64 * 4);
    p.Sp = (u16*)take((size_t)B * GH * 64 * 2 * 128 * 64 * 2);
    p.mix = (u16*)take((size_t)T * D * 2);
    p.x1 = (float*)take((size_t)T * D * 4);
    p.xn2 = (u16*)take((size_t)T * D * 2);
    p.counts = (int*)take(256);
    p.lists = (int*)take((size_t)NE * T * 4);
    p.gate = (float*)take((size_t)NSLOT * 4);
    p.bar = (unsigned*)take((size_t)XCD_BAR_WORDS * 4);
    const size_t off_shared = off;
    p.act = (u16*)take((size_t)NSLOT * DFF * 2);
    p.y = (u16*)take((size_t)NSLOT * D * 2);

    auto run_fast = [&](int lo, int hi) {
        (void)hipMemsetAsync(p.bar, 0, (size_t)XCD_BAR_WORDS * 4, stream);
        p.ph_lo = lo; p.ph_hi = hi;
        void* args[] = {&p};
        hipError_t e = hipLaunchCooperativeKernel((const void*)mega, dim3(grid_blocks), dim3(256), args, LDS_BYTES, stream);
        if (e != hipSuccess) fprintf(stderr, "cooperative launch failed: %s (grid %d)\n", hipGetErrorString(e), grid_blocks);
    };

#if STAGE >= 6
    run_fast(PH_NORM1, PH_END);
#else
    off = off_shared;
    float* n_xn = (float*)take((size_t)T * D * 4);
    float* n_x2 = (float*)take((size_t)T * D * 4);
    float* n_mix = (float*)take((size_t)T * D * 4);
    int* n_topi = (int*)take((size_t)T * 4 * 4);
    char* big = take((size_t)T * INW * 4 + (size_t)2 * T * 256 * 4 + (size_t)2 * T * 512 * 4);
    float* n_proj = (float*)big;
    float* n_ea = (float*)(big + (size_t)T * INW * 4);
    float* n_og = (float*)(big + (size_t)T * INW * 4 + (size_t)2 * T * 256 * 4);
    float* n_hact = (float*)big;
    float* n_x1 = p.x1;
    int* n_lists = p.lists; int* n_counts = p.counts; float* n_gate = p.gate;

#if STAGE == 1
    run_fast(PH_NORM1, PH_PROJ + 1);
#elif STAGE == 2
    run_fast(PH_NORM1, PH_MIX2 + 1);
#elif STAGE == 3
    run_fast(PH_NORM1, PH_MIX3 + 1);
#elif STAGE == 4
    run_fast(PH_NORM1, PH_OUTPROJ + 1);
#elif STAGE == 5
    run_fast(PH_NORM1, PH_ROUTE + 1);
#endif
#if STAGE <= 2
    cvt_bf16_f32<<<2048, 256, 0, stream>>>(p.proj, INW, n_proj, INW, T, INW);
#if STAGE == 1
    nv_attn<<<T * AH / 4, 256, 0, stream>>>(n_proj, rel_bias, n_mix);
#else
    cvt_bf16_f32<<<2048, 256, 0, stream>>>(p.mix, D, n_mix, D, T, 512);
#endif
    nv_la<<<T, 256, 0, stream>>>(n_proj, wgf, bgf, wgb, bgb, n_ea);
    nv_gla<<<B * GH * 2, 128, 0, stream>>>(n_proj, n_ea, n_og);
    nv_gla_out<<<T * GH / 4, 256, 0, stream>>>(n_proj, n_og, gla_ng, n_mix);
#endif
#if STAGE == 3
    cvt_bf16_f32<<<2048, 256, 0, stream>>>(p.mix, D, n_mix, D, T, D);
#endif
#if STAGE <= 3
    nv_gemm<EPI_RESID><<<dim3(D / 64, T / 64), 256, 0, stream>>>(n_mix, D, nullptr, 0, nullptr, T, w_out, D, D, D, n_x1, D, x, nullptr);
#endif
#if STAGE <= 4
    nv_route<<<T / 4, 256, 0, stream>>>(n_x1, norm2_g, router_w, router_b, n_xn, n_topi, n_gate);
    nv_lists<<<1, 32, 0, stream>>>(n_topi, n_lists, n_counts);
#endif
#if STAGE == 5
    cvt_bf16_f32<<<2048, 256, 0, stream>>>(p.xn2, D, n_xn, D, T, D);
#endif
    (void)hipMemcpyAsync(n_x2, n_x1, (size_t)T * D * 4, hipMemcpyDeviceToDevice, stream);
    for (int e = 0; e < NE; ++e) {
        nv_gemm<EPI_SWIGLU><<<dim3(2 * DFF / 64, T / 64), 256, 0, stream>>>(n_xn, D, n_lists + (size_t)e * T, 2, n_counts + e, 0,
                                                                          w1 + (size_t)e * D * 2 * DFF, 2 * DFF, 2 * DFF, D, n_hact, DFF, b1 + (size_t)e * 2 * DFF, nullptr);
        nv_moe2<<<dim3(D / 64, T / 64), 256, 0, stream>>>(n_hact, n_lists + (size_t)e * T, n_counts + e, w2 + (size_t)e * DFF * D, n_x2, b2 + (size_t)e * D, n_gate);
    }
    nv_rmsnorm<<<T / 4, 256, 0, stream>>>(n_x2, final_g, out, T);
#endif
}
```

```cpp
#define STAGE 6
#define REPMASK 0
#include <hip/hip_runtime.h>
#include <stdint.h>

namespace cfg {
constexpr int D = 1024, B = 4, S = 4096, T = B * S;
constexpr int AH = 8;
constexpr int GH = 4;
constexpr int INW = 3104;
constexpr int C_AQ = 0, C_AK = 512, C_AV = 1024, C_GQ = 1536, C_GK = 1792, C_GV = 2048, C_GO = 2560, C_GZ = 3072;
constexpr int NE = 32, DFF = 1024;
constexpr float EPS = 1e-5f;
}
using namespace cfg;

__device__ const unsigned char T5TAB[387] = {
11,11,11,11,11,11,11,11,11,11,11,11,11,11,11,10,10,10,10,10,10,10,10,10,10,10,10,10,10,10,10,10,10,10,10,10,10,10,9,9,9,9,9,9,9,9,9,9,9,9,8,8,8,8,8,8,8,7,6,5,4,3,2,1,0,17,18,19,20,21,22,23,24,24,24,24,24,24,24,25,25,25,25,25,25,25,25,25,25,25,25,26,26,26,26,26,26,26,26,26,26,26,26,26,26,26,26,26,26,26,26,26,26,26,27,27,27,27,27,27,27,27,27,27,27,27,27,27,27,
13,13,13,13,13,13,13,13,13,13,13,13,13,13,13,13,13,13,13,13,13,13,13,12,12,12,12,12,12,12,12,12,12,12,12,12,12,12,12,12,12,12,11,11,11,11,11,11,11,11,11,11,10,10,10,10,10,10,9,9,9,8,8,4,0,20,24,24,25,25,25,26,26,26,26,26,26,27,27,27,27,27,27,27,27,27,27,28,28,28,28,28,28,28,28,28,28,28,28,28,28,28,28,28,28,28,29,29,29,29,29,29,29,29,29,29,29,29,29,29,29,29,29,29,29,29,29,29,29,
15,15,15,15,15,15,15,15,15,15,15,15,15,15,15,15,15,15,15,15,15,15,15,15,15,15,15,15,15,15,14,14,14,14,14,14,14,14,14,14,14,14,14,14,14,13,13,13,13,13,13,13,13,13,12,12,12,12,12,11,11,10,10,9,0,25,26,26,27,27,28,28,28,28,28,29,29,29,29,29,29,29,29,29,30,30,30,30,30,30,30,30,30,30,30,30,30,30,30,31,31,31,31,31,31,31,31,31,31,31,31,31,31,31,31,31,31,31,31,31,31,31,31,31,31,31,31,31,31};

__device__ __forceinline__ float wave_sum(float v) {
#pragma unroll
    for (int o = 32; o > 0; o >>= 1) v += __shfl_xor(v, o);
    return v;
}


#include <hip/hip_cooperative_groups.h>
namespace cg = cooperative_groups;

typedef unsigned short u16;
typedef short bf16x8 __attribute__((ext_vector_type(8)));
typedef short s16x4 __attribute__((ext_vector_type(4)));
typedef float f32x4 __attribute__((ext_vector_type(4)));
typedef unsigned u32x4 __attribute__((ext_vector_type(4)));
typedef __bf16 bfv2 __attribute__((ext_vector_type(2)));
typedef float fv2 __attribute__((ext_vector_type(2)));
#define LDS_AS __attribute__((address_space(3)))

constexpr int LDS_BYTES = 160 * 1024;
constexpr int HALF_LDS = 80 * 1024;
constexpr int NSLOT = T * 4;
constexpr int PJW = 3072;
#ifndef REPMASK
#define REPMASK 0
#endif

struct Params {
    const float *x, *g1, *w_in, *rel_bias, *wgf, *bgf, *wgb, *bgb, *gla_ng, *w_out, *g2, *rw, *rb, *w1, *b1, *w2, *b2, *gf;
    float* out;
    u16* winT;
    u16* wzT;
    u16* woT;
    u16* w1T;
    u16* w2T;
    u16* xn;
    u16* proj;
    float* zbuf;
    u16* abr;
    float* lse;
    float* dS;
    float* dec;
    u16* Sp;
    u16* mix;
    float* x1;
    u16* xn2;
    int* counts;
    int* lists;
    float* gate;
    u16* act;
    u16* y;
    unsigned* bar;
    int ph_lo, ph_hi;
};

__device__ __forceinline__ int tid_opaque() { int t = threadIdx.x; asm volatile("" : "+v"(t)); return t; }
__device__ __forceinline__ float bf2f(u16 v) { return __uint_as_float((unsigned)v << 16); }
__device__ __forceinline__ unsigned pack2(float a, float b) {
    fv2 v = {a, b};
    bfv2 r = __builtin_convertvector(v, bfv2);
    return __builtin_bit_cast(unsigned, r);
}
__device__ __forceinline__ u16 f2bf(float a) { return (u16)(pack2(a, 0.f) & 0xffffu); }
__device__ __forceinline__ float lo2f(unsigned u) { return __uint_as_float(u << 16); }
__device__ __forceinline__ float hi2f(unsigned u) { return __uint_as_float(u & 0xffff0000u); }
__device__ __forceinline__ int tile_off(int row, int chunk) { return row * 128 + ((chunk ^ (row & 7)) << 4); }
__device__ __forceinline__ bf16x8 lds_frag(const char* base, int row, int chunk) { return *(const bf16x8*)(base + tile_off(row, chunk)); }
__device__ __forceinline__ s16x4 tr_read(const char* p) {
    return __builtin_amdgcn_ds_read_tr16_b64_v4i16((LDS_AS s16x4*)(p));
}
__device__ __forceinline__ bf16x8 cat4(s16x4 a, s16x4 b) { bf16x8 r = {a[0], a[1], a[2], a[3], b[0], b[1], b[2], b[3]}; return r; }
__device__ __forceinline__ float logsig(float a) { return fminf(a, 0.f) - log1pf(expf(-fabsf(a))); }

__device__ __forceinline__ void cvt_tile(const float* __restrict__ src, int ldsrc, u16* __restrict__ dst, int k0, int n0, int t) {
    const int l = t & 63, w = t >> 6, kg = l & 7, ng = w * 8 + (l >> 3);
    const float* s = src + (size_t)(k0 + 8 * kg) * ldsrc + n0 + 4 * ng;
    float4 bv[8];
#pragma unroll
    for (int j = 0; j < 8; ++j) bv[j] = *(const float4*)(s + (size_t)j * ldsrc);
    u16* d = dst + (size_t)(n0 + 4 * ng) * 1024 + k0 + 8 * kg;
    uint4 q;
    q.x = pack2(bv[0].x, bv[1].x); q.y = pack2(bv[2].x, bv[3].x); q.z = pack2(bv[4].x, bv[5].x); q.w = pack2(bv[6].x, bv[7].x);
    *(uint4*)(d) = q;
    q.x = pack2(bv[0].y, bv[1].y); q.y = pack2(bv[2].y, bv[3].y); q.z = pack2(bv[4].y, bv[5].y); q.w = pack2(bv[6].y, bv[7].y);
    *(uint4*)(d + 1024) = q;
    q.x = pack2(bv[0].z, bv[1].z); q.y = pack2(bv[2].z, bv[3].z); q.z = pack2(bv[4].z, bv[5].z); q.w = pack2(bv[6].z, bv[7].z);
    *(uint4*)(d + 2048) = q;
    q.x = pack2(bv[0].w, bv[1].w); q.y = pack2(bv[2].w, bv[3].w); q.z = pack2(bv[4].w, bv[5].w); q.w = pack2(bv[6].w, bv[7].w);
    *(uint4*)(d + 3072) = q;
}
struct CvtRegs { f32x4 bv[8]; };
__device__ __forceinline__ void cvt_load(const float* __restrict__ src, int ldsrc, int k0, int n0, int t, CvtRegs& R) {
    const int l = t & 63, w = t >> 6, kg = l & 7, ng = w * 8 + (l >> 3);
    const float* s = src + (size_t)(k0 + 8 * kg) * ldsrc + n0 + 4 * ng;
#pragma unroll
    for (int j = 0; j < 8; ++j) R.bv[j] = *(const f32x4*)(s + (size_t)j * ldsrc);
}
__device__ __forceinline__ void cvt_store(u16* __restrict__ dst, int k0, int n0, int t, const CvtRegs& R) {
    const int l = t & 63, w = t >> 6, kg = l & 7, ng = w * 8 + (l >> 3);
    u16* d = dst + (size_t)(n0 + 4 * ng) * 1024 + k0 + 8 * kg;
#pragma unroll
    for (int c = 0; c < 4; ++c) {
        u32x4 q;
        q.x = pack2(R.bv[0][c], R.bv[1][c]); q.y = pack2(R.bv[2][c], R.bv[3][c]); q.z = pack2(R.bv[4][c], R.bv[5][c]); q.w = pack2(R.bv[6][c], R.bv[7][c]);
        *(u32x4*)(d + c * 1024) = q;
    }
}
__device__ __forceinline__ void w1_load(const Params& p, int i, int t, CvtRegs& R) { const int e = i >> 8, j = i & 255; cvt_load(p.w1 + (size_t)e * D * 2 * DFF, 2 * DFF, (j >> 4) * 64, (j & 15) * 128, t, R); }
__device__ __forceinline__ void w1_store(const Params& p, int i, int t, const CvtRegs& R) { const int e = i >> 8, j = i & 255; cvt_store(p.w1T + (size_t)e * 2 * DFF * D, (j >> 4) * 64, (j & 15) * 128, t, R); }
constexpr int CV_WIN = 384, CV_WZ = 1, CV_WO = 128, CV_W1 = NE * 256, CV_W2 = NE * 128;
constexpr int CV_TOTAL = CV_WIN + CV_WZ + CV_WO + CV_W1 + CV_W2;
constexpr int W2_LATE = 4096;
#ifndef NCONV
#define NCONV 102
#endif
__device__ void ph_prologue(const Params& p) {
    const int tid = tid_opaque();
    if (blockIdx.x == 0 && tid < 32) p.counts[tid] = 0;
    {
        const int lane = tid & 63, gw = blockIdx.x * 8 + (tid >> 6), nw = gridDim.x * 8;
        for (int row = gw; row < T; row += nw) {
            const float4* xr = (const float4*)(p.x + (size_t)row * D);
            float4 v[4]; float ss = 0.f;
#pragma unroll
            for (int i = 0; i < 4; ++i) { v[i] = xr[lane + 64 * i]; ss += v[i].x * v[i].x + v[i].y * v[i].y + v[i].z * v[i].z + v[i].w * v[i].w; }
            ss = wave_sum(ss);
            const float r = rsqrtf(ss * (1.0f / D) + EPS);
#pragma unroll
            for (int i = 0; i < 4; ++i) {
                const float4 g = ((const float4*)p.g1)[lane + 64 * i];
                uint2 o; o.x = pack2(v[i].x * r * g.x, v[i].y * r * g.y); o.y = pack2(v[i].z * r * g.z, v[i].w * r * g.w);
                *(uint2*)(p.xn + (size_t)row * D + (lane + 64 * i) * 4) = o;
            }
        }
    }
    const int t = tid & 255, vb = blockIdx.x * 2 + (tid >> 8), nvb = gridDim.x * 2;
    for (int it = vb; it < CV_TOTAL; it += nvb) {
        int i = it;
        if (i < CV_WIN) { cvt_tile(p.w_in, INW, p.winT, (i / 24) * 64, (i % 24) * 128, t); continue; }
        i -= CV_WIN;
        if (i < CV_WZ) {
            for (int c = t; c < 32 * 128; c += 256) {
                const int n = c >> 7, k8 = (c & 127) * 8;
                const float* s = p.w_in + (size_t)k8 * INW + PJW + n;
                uint4 q;
                q.x = pack2(s[0], s[INW]); q.y = pack2(s[2 * INW], s[3 * INW]); q.z = pack2(s[4 * INW], s[5 * INW]); q.w = pack2(s[6 * INW], s[7 * INW]);
                *(uint4*)(p.wzT + (size_t)n * 1024 + k8) = q;
            }
            continue;
        }
        i -= CV_WZ;
        if (i < CV_WO) { cvt_tile(p.w_out, D, p.woT, (i >> 3) * 64, (i & 7) * 128, t); continue; }
        i -= CV_WO;
        if (i < CV_W1) continue;
        i -= CV_W1;
        if (i >= W2_LATE) { const int e = i >> 7, j = i & 127; cvt_tile(p.w2 + (size_t)e * DFF * D, D, p.w2T + (size_t)e * D * DFF, (j >> 3) * 64, (j & 7) * 128, t); }
    }
}

namespace pg {
constexpr int BM = 256, BK = 64, HALF = 128, HTB = HALF * BK * 2, KD = 1024;
__host__ __device__ __forceinline__ int lds_byte(int r, int c) { const int st = (r >> 4) * 2 + (c >> 5), rr = r & 15, cc = c & 31, ob = rr * 64 + cc * 2; return st * 1024 + (ob ^ (((ob >> 9) & 1) << 5)); }
__host__ __device__ __forceinline__ void stage_rc(int b, int& R, int& C) { const int st = b / 1024, sb = b % 1024, swz = sb ^ (((sb >> 9) & 1) << 5); R = (st >> 1) * 16 + swz / 64; C = (st & 1) * 32 + (swz % 64) / 2; }
__host__ __device__ __forceinline__ int perm32(int rho) { const int n = rho >> 4, i = rho & 15; return 8 * (i >> 2) + 4 * n + (i & 3); }

struct Unit { int pn, row0, nvalid, e; };

template <class Epi, class Sched>
__device__ __forceinline__ void gemm_phase(LDS_AS unsigned char* lds, const Sched& S, const Epi& E) {
    const int tid = tid_opaque(), wid = __builtin_amdgcn_readfirstlane(tid >> 6), lane = tid & 63, wr = wid >> 2, wc = wid & 3, fr = lane & 15, fq = lane >> 4;
    constexpr int nt = KD / BK;
    int R0, C0; stage_rc(tid * 16, R0, C0);
    unsigned voffB[2];
#pragma unroll
    for (int i = 0; i < 2; ++i) { const int R = R0 + 64 * i; const int Rb = Epi::PERM ? ((R & ~31) + perm32(R & 31)) : R; voffB[i] = (unsigned)(Rb * KD + C0) * 2u; }
    const size_t kstep = (size_t)(BK * 2);
    const size_t hstep = (size_t)HALF * KD * 2;
    const unsigned ldsw = (unsigned)wid * 1024u;
    const int aoff = lds_byte(wr * 64 + fr, fq * 8), boff = lds_byte(wc * 32 + fr, fq * 8);
#define PG_SA(b, h) (((b) * 2 + (h)) * HTB)
#define PG_SB(b, h) ((4 + (b) * 2 + (h)) * HTB)
#define PG_STAGE_B(bufoff, gbase) do { _Pragma("unroll") for (int _i = 0; _i < 2; ++_i) \
        __builtin_amdgcn_global_load_lds((const unsigned*)((const char*)(gbase) + voffB[_i]), (LDS_AS unsigned*)(lds + (bufoff) + ldsw + _i * 8192), 16, 0, 0); } while (0)
#define PG_STAGE_A(bufoff, o0, o1) do { \
        __builtin_amdgcn_global_load_lds((const unsigned*)(Abase + (o0)), (LDS_AS unsigned*)(lds + (bufoff) + ldsw), 16, 0, 0); \
        __builtin_amdgcn_global_load_lds((const unsigned*)(Abase + (o1)), (LDS_AS unsigned*)(lds + (bufoff) + ldsw + 8192), 16, 0, 0); } while (0)
#define PG_LDA(dst, b, h) do { _Pragma("unroll") for (int m = 0; m < 4; ++m) _Pragma("unroll") for (int k = 0; k < 2; ++k) dst[m][k] = *(const LDS_AS bf16x8*)(lds + PG_SA(b, h) + aoff + m * 2048 + k * 1024); } while (0)
#define PG_LDB(dst, b, h) do { _Pragma("unroll") for (int n = 0; n < 2; ++n) _Pragma("unroll") for (int k = 0; k < 2; ++k) dst[n][k] = *(const LDS_AS bf16x8*)(lds + PG_SB(b, h) + boff + n * 2048 + k * 1024); } while (0)
#define PG_MMA(ai, bj, At, Bt) do { __builtin_amdgcn_s_setprio(1); _Pragma("unroll") for (int m = 0; m < 4; ++m) _Pragma("unroll") for (int n = 0; n < 2; ++n) _Pragma("unroll") for (int k = 0; k < 2; ++k) \
        acc[ai][bj][m][n] = __builtin_amdgcn_mfma_f32_16x16x32_bf16(Bt[n][k], At[m][k], acc[ai][bj][m][n], 0, 0, 0); __builtin_amdgcn_s_setprio(0); } while (0)
#define PG_WAIT_V(n) asm volatile("s_waitcnt vmcnt(" #n ")" ::: "memory")
#define PG_WAIT_L(n) asm volatile("s_waitcnt lgkmcnt(" #n ")" ::: "memory")
#define PG_BAR __builtin_amdgcn_s_barrier()
#define PG_SCHED __builtin_amdgcn_sched_barrier(0)
    Unit cur, nxt; int ui = 0;
    if (!S.next(0, cur)) return;
    f32x4 acc[2][2][4][2];
    E.init(acc, cur, wr, wc, fr, fq);
    bf16x8 At[4][2], B0[2][2], B1[2][2];
    const char* Abase = (const char*)S.A;
    unsigned c00 = S.rowoff(cur, R0) + C0 * 2u, c01 = S.rowoff(cur, R0 + 64) + C0 * 2u, c10 = S.rowoff(cur, R0 + 128) + C0 * 2u, c11 = S.rowoff(cur, R0 + 192) + C0 * 2u;
    unsigned n00, n01, n10, n11;
    const char* cB = S.bbase(cur);
    PG_STAGE_B(PG_SB(0, 0), cB); PG_STAGE_A(PG_SA(0, 0), c00, c01); PG_STAGE_B(PG_SB(0, 1), cB + hstep); PG_STAGE_A(PG_SA(0, 1), c10, c11);
    if (wr == 1) PG_BAR;
    PG_WAIT_V(4); PG_BAR;
    PG_STAGE_B(PG_SB(1, 0), cB + kstep); PG_STAGE_A(PG_SA(1, 0), c00 + 128u, c01 + 128u); PG_STAGE_B(PG_SB(1, 1), cB + hstep + kstep);
    PG_WAIT_V(6); PG_BAR;
    for (;;) {
        const bool has_next = S.next(ui + 1, nxt);
        const char* nB = has_next ? S.bbase(nxt) : cB;
        if (has_next) { n00 = S.rowoff(nxt, R0) + C0 * 2u; n01 = S.rowoff(nxt, R0 + 64) + C0 * 2u; n10 = S.rowoff(nxt, R0 + 128) + C0 * 2u; n11 = S.rowoff(nxt, R0 + 192) + C0 * 2u; }
        else { n00 = c00; n01 = c01; n10 = c10; n11 = c11; }
        for (int t = 0; t < nt; t += 2) {
            const bool last = (t == nt - 2);
            const unsigned k1 = (unsigned)(t + 1) * 128u, k2 = last ? 0u : (unsigned)(t + 2) * 128u, k3 = k2 + 128u;
            const unsigned a2_00 = (last ? n00 : c00) + k2, a2_01 = (last ? n01 : c01) + k2, a2_10 = (last ? n10 : c10) + k2, a2_11 = (last ? n11 : c11) + k2;
            const unsigned a3_00 = (last ? n00 : c00) + k3, a3_01 = (last ? n01 : c01) + k3;
            const char* b2 = last ? nB : cB + (size_t)(t + 2) * kstep;
            const char* b3 = b2 + kstep;
            PG_LDB(B0, 0, 0); PG_SCHED; PG_LDA(At, 0, 0); PG_STAGE_A(PG_SA(1, 1), c10 + k1, c11 + k1);
            PG_WAIT_L(8); PG_BAR; PG_WAIT_L(0); PG_MMA(0, 0, At, B0); PG_BAR; PG_SCHED;
            PG_LDB(B1, 0, 1); PG_STAGE_B(PG_SB(0, 0), b2);
            PG_BAR; PG_WAIT_L(0); PG_MMA(0, 1, At, B1); PG_BAR;
            PG_LDA(At, 0, 1); PG_STAGE_A(PG_SA(0, 0), a2_00, a2_01);
            PG_BAR; PG_WAIT_L(0); PG_MMA(1, 0, At, B0); PG_BAR; PG_SCHED;
            PG_STAGE_B(PG_SB(0, 1), b2 + hstep);
            PG_WAIT_V(6); PG_BAR; PG_MMA(1, 1, At, B1); PG_BAR;
            PG_LDB(B0, 1, 0); PG_SCHED; PG_LDA(At, 1, 0); PG_STAGE_A(PG_SA(0, 1), a2_10, a2_11);
            PG_WAIT_L(8); PG_BAR; PG_WAIT_L(0); PG_MMA(0, 0, At, B0); PG_BAR; PG_SCHED;
            PG_LDB(B1, 1, 1); PG_STAGE_B(PG_SB(1, 0), b3);
            PG_BAR; PG_WAIT_L(0); PG_MMA(0, 1, At, B1); PG_BAR;
            PG_LDA(At, 1, 1); PG_STAGE_A(PG_SA(1, 0), a3_00, a3_01);
            PG_BAR; PG_WAIT_L(0); PG_MMA(1, 0, At, B0); PG_BAR; PG_SCHED;
            PG_STAGE_B(PG_SB(1, 1), b3 + hstep);
            PG_WAIT_V(6); PG_BAR; PG_MMA(1, 1, At, B1); PG_BAR;
        }
        E(acc, cur, wr, wc, fr, fq);
        if (!has_next) break;
        E.init(acc, nxt, wr, wc, fr, fq);
        cur = nxt; cB = nB; c00 = n00; c01 = n01; c10 = n10; c11 = n11; ++ui;
    }
    PG_WAIT_V(0);
    if (wr == 0) PG_BAR;
    PG_BAR;
#undef PG_SA
#undef PG_SB
#undef PG_STAGE_A
#undef PG_STAGE_B
#undef PG_LDA
#undef PG_LDB
#undef PG_MMA
#undef PG_WAIT_V
#undef PG_WAIT_L
#undef PG_BAR
#undef PG_SCHED
}

struct DenseSched {
    const u16* A; const u16* Bt; int nM, nN, nwg, G, c;
    __device__ void init(const u16* A_, const u16* Bt_, int M, int N, int G_, int c_) { A = A_; Bt = Bt_; nM = M / BM; nN = N / BM; nwg = nM * nN; G = G_; c = c_; }
    __device__ __forceinline__ bool next(int i, Unit& u) const {
        const int L = i * G + c; if (L >= nwg) return false;
        int wgid = L; { const int q = nwg / 8, r = nwg % 8, xcd = wgid % 8, off = wgid / 8; wgid = (xcd < r ? xcd * (q + 1) : r * (q + 1) + (xcd - r) * q) + off; }
        const int nig = 8 * nN, gid = wgid / nig, fm = gid * 8, gsz = (nM - fm) < 8 ? (nM - fm) : 8;
        u.row0 = (fm + ((wgid % nig) % gsz)) * BM; u.pn = (wgid % nig) / gsz; u.nvalid = BM; u.e = 0; return true;
    }
    __device__ __forceinline__ unsigned rowoff(const Unit& u, int r) const { return (unsigned)(u.row0 + r) * (unsigned)(KD * 2); }
    __device__ __forceinline__ const char* bbase(const Unit& u) const { return (const char*)Bt + (size_t)u.pn * BM * KD * 2; }
};

struct MoeSched {
    const u16* A; const u16* Bt; const int* lists; const LDS_AS int* meta; int NT, nunits, G, c; bool gather;
    __device__ __forceinline__ bool next(int i, Unit& u) const {
        const int L = i * G + c; if (L >= nunits) return false;
        int wgid = L; { const int q = nunits / 8, r = nunits % 8, xcd = wgid % 8, off = wgid / 8; wgid = (xcd < r ? xcd * (q + 1) : r * (q + 1) + (xcd - r) * q) + off; }
        const int gm = wgid / NT; u.pn = wgid % NT;
        int e = 0;
        while (meta[32 + e + 1] <= gm) ++e;
        const int mi = gm - meta[32 + e];
        u.e = e; u.row0 = meta[72 + e] + mi * BM; u.nvalid = min(BM, meta[e] - mi * BM);
        return true;
    }
    __device__ __forceinline__ unsigned rowoff(const Unit& u, int r) const {
        const int rr = min(r, u.nvalid - 1);
        if (gather) { const int slot = lists[u.e * T + (u.row0 - meta[72 + u.e]) + rr]; return (unsigned)(slot >> 2) * (unsigned)(KD * 2); }
        return (unsigned)(u.row0 + rr) * (unsigned)(KD * 2);
    }
    __device__ __forceinline__ const char* bbase(const Unit& u) const { return (const char*)Bt + ((size_t)u.e * NT + u.pn) * BM * KD * 2; }
};

struct EpiProj {
    static constexpr bool PERM = true;
    u16* O;
    __device__ __forceinline__ void init(f32x4 (&acc)[2][2][4][2], const Unit&, int, int, int, int) const {
#pragma unroll
        for (int a = 0; a < 2; ++a)
#pragma unroll
            for (int b = 0; b < 2; ++b)
#pragma unroll
                for (int m = 0; m < 4; ++m)
#pragma unroll
                    for (int n = 0; n < 2; ++n) acc[a][b][m][n] = (f32x4){0.f, 0.f, 0.f, 0.f};
    }
    __device__ __forceinline__ void operator()(const f32x4 (&acc)[2][2][4][2], const Unit& u, int wr, int wc, int fr, int fq) const {
        const int row0 = u.row0 + wr * 64 + fr, col0 = u.pn * BM + wc * 32 + 8 * fq;
#pragma unroll
        for (int ai = 0; ai < 2; ++ai)
#pragma unroll
            for (int m = 0; m < 4; ++m) { u16* rowp = O + (size_t)(row0 + ai * HALF + m * 16) * PJW + col0;
#pragma unroll
                for (int bj = 0; bj < 2; ++bj) { const f32x4 v0 = acc[ai][bj][m][0], v1 = acc[ai][bj][m][1];
                    u32x4 w; w.x = pack2(v0[0], v0[1]); w.y = pack2(v0[2], v0[3]); w.z = pack2(v1[0], v1[1]); w.w = pack2(v1[2], v1[3]);
                    *(u32x4*)(rowp + bj * HALF) = w; } }
    }
};
struct EpiOut {
    static constexpr bool PERM = false;
    const float* X; float* C;
    __device__ __forceinline__ void init(f32x4 (&acc)[2][2][4][2], const Unit& u, int wr, int wc, int fr, int fq) const {
        const int row0 = u.row0 + wr * 64 + fr, col0 = u.pn * BM + wc * 32 + 4 * fq;
#pragma unroll
        for (int ai = 0; ai < 2; ++ai)
#pragma unroll
            for (int m = 0; m < 4; ++m) { const size_t ro = (size_t)(row0 + ai * HALF + m * 16) * D + col0;
#pragma unroll
                for (int bj = 0; bj < 2; ++bj)
#pragma unroll
                    for (int n = 0; n < 2; ++n) acc[ai][bj][m][n] = *(const f32x4*)(X + ro + bj * HALF + n * 16); }
    }
    __device__ __forceinline__ void operator()(const f32x4 (&acc)[2][2][4][2], const Unit& u, int wr, int wc, int fr, int fq) const {
        const int row0 = u.row0 + wr * 64 + fr, col0 = u.pn * BM + wc * 32 + 4 * fq;
#pragma unroll
        for (int ai = 0; ai < 2; ++ai)
#pragma unroll
            for (int m = 0; m < 4; ++m) { const size_t ro = (size_t)(row0 + ai * HALF + m * 16) * D + col0;
#pragma unroll
                for (int bj = 0; bj < 2; ++bj)
#pragma unroll
                    for (int n = 0; n < 2; ++n) *(f32x4*)(C + ro + bj * HALF + n * 16) = acc[ai][bj][m][n]; }
    }
};
struct EpiMoe1 {
    static constexpr bool PERM = true;
    const float* b1; u16* act;
    __device__ __forceinline__ void init(f32x4 (&acc)[2][2][4][2], const Unit&, int, int, int, int) const {
#pragma unroll
        for (int a = 0; a < 2; ++a)
#pragma unroll
            for (int b = 0; b < 2; ++b)
#pragma unroll
                for (int m = 0; m < 4; ++m)
#pragma unroll
                    for (int n = 0; n < 2; ++n) acc[a][b][m][n] = (f32x4){0.f, 0.f, 0.f, 0.f};
    }
    __device__ __forceinline__ void operator()(const f32x4 (&acc)[2][2][4][2], const Unit& u, int wr, int wc, int fr, int fq) const {
        const int r0 = wr * 64 + fr, col0 = u.pn * BM + wc * 32 + 8 * fq;
        const float* be = b1 + (size_t)u.e * 2 * DFF + col0;
        f32x4 bv[2][2];
#pragma unroll
        for (int bj = 0; bj < 2; ++bj)
#pragma unroll
            for (int n = 0; n < 2; ++n) bv[bj][n] = *(const f32x4*)(be + bj * HALF + 4 * n);
#pragma unroll
        for (int ai = 0; ai < 2; ++ai)
#pragma unroll
            for (int m = 0; m < 4; ++m) {
                const int r = r0 + ai * HALF + m * 16;
                if (r < u.nvalid) {
                    u16* rowp = act + (size_t)(u.row0 + r) * DFF + (col0 >> 1);
#pragma unroll
                    for (int bj = 0; bj < 2; ++bj) {
                        const f32x4 v0 = acc[ai][bj][m][0] + bv[bj][0], v1 = acc[ai][bj][m][1] + bv[bj][1];
                        const float g0 = fminf(v0[0], 7.0f), l0 = fminf(fmaxf(v0[1], -7.0f), 7.0f);
                        const float g1 = fminf(v0[2], 7.0f), l1 = fminf(fmaxf(v0[3], -7.0f), 7.0f);
                        const float g2 = fminf(v1[0], 7.0f), l2 = fminf(fmaxf(v1[1], -7.0f), 7.0f);
                        const float g3 = fminf(v1[2], 7.0f), l3 = fminf(fmaxf(v1[3], -7.0f), 7.0f);
                        uint2 o;
                        o.x = pack2(g0 * __builtin_amdgcn_rcpf(1.0f + __expf(-1.702f * g0)) * (l0 + 1.0f), g1 * __builtin_amdgcn_rcpf(1.0f + __expf(-1.702f * g1)) * (l1 + 1.0f));
                        o.y = pack2(g2 * __builtin_amdgcn_rcpf(1.0f + __expf(-1.702f * g2)) * (l2 + 1.0f), g3 * __builtin_amdgcn_rcpf(1.0f + __expf(-1.702f * g3)) * (l3 + 1.0f));
                        *(uint2*)(rowp + bj * (HALF / 2)) = o;
                    }
                }
            }
    }
};
struct EpiMoe2 {
    static constexpr bool PERM = true;
    const float* b2; const float* gate; const int* lists; const LDS_AS int* meta; u16* y;
    __device__ __forceinline__ void init(f32x4 (&acc)[2][2][4][2], const Unit&, int, int, int, int) const {
#pragma unroll
        for (int a = 0; a < 2; ++a)
#pragma unroll
            for (int b = 0; b < 2; ++b)
#pragma unroll
                for (int m = 0; m < 4; ++m)
#pragma unroll
                    for (int n = 0; n < 2; ++n) acc[a][b][m][n] = (f32x4){0.f, 0.f, 0.f, 0.f};
    }
    __device__ __forceinline__ void operator()(const f32x4 (&acc)[2][2][4][2], const Unit& u, int wr, int wc, int fr, int fq) const {
        const int r0 = wr * 64 + fr, col0 = u.pn * BM + wc * 32 + 8 * fq;
        const float* be = b2 + (size_t)u.e * D + col0;
        const int* le = lists + (size_t)u.e * T + (u.row0 - meta[72 + u.e]);
        f32x4 bv[2][2];
#pragma unroll
        for (int bj = 0; bj < 2; ++bj)
#pragma unroll
            for (int n = 0; n < 2; ++n) bv[bj][n] = *(const f32x4*)(be + bj * HALF + 4 * n);
        int slot[8]; float gt[8];
#pragma unroll
        for (int q = 0; q < 8; ++q) slot[q] = le[min(r0 + (q >> 2) * HALF + (q & 3) * 16, u.nvalid - 1)];
        __builtin_amdgcn_sched_barrier(0);
#pragma unroll
        for (int q = 0; q < 8; ++q) gt[q] = gate[slot[q]];
        __builtin_amdgcn_sched_barrier(0);
#pragma unroll
        for (int ai = 0; ai < 2; ++ai)
#pragma unroll
            for (int m = 0; m < 4; ++m) {
                const int r = r0 + ai * HALF + m * 16;
                if (r < u.nvalid) {
                    const float g1 = gt[ai * 4 + m];
                    u16* rowp = y + (size_t)slot[ai * 4 + m] * D + col0;
#pragma unroll
                    for (int bj = 0; bj < 2; ++bj) {
                        const f32x4 v0 = (acc[ai][bj][m][0] + bv[bj][0]) * g1, v1 = (acc[ai][bj][m][1] + bv[bj][1]) * g1;
                        u32x4 w; w.x = pack2(v0[0], v0[1]); w.y = pack2(v0[2], v0[3]); w.z = pack2(v1[0], v1[1]); w.w = pack2(v1[2], v1[3]);
                        *(u32x4*)(rowp + bj * HALF) = w;
                    }
                }
            }
    }
};
}

constexpr int AT_K = 0, AT_V = 208 * 128, AT_Q = AT_V + 208 * 160, AT_BIAS = AT_Q + 8192;
struct AttnRegs { u32x4 kv[6], vv[6], qv[2]; float tb[3]; };
__device__ __forceinline__ void attn_load(const Params& p, int t, int it, AttnRegs& R) {
    const int idx = it & 63, br = (it >> 6) % 3, h = (it / 192) & 7, b = it / 1536;
    const int dsh = br * 2, L = S >> dsh, nbl = L >> 6;
    const int res = idx / nbl, qb = idx % nbl;
#pragma unroll
    for (int i = 0; i < 6; ++i) {
        const int j = t + 256 * i, row = j >> 3, c = j & 7;
        const int ki = 64 * (qb - 1) + row;
        const bool ok = (ki >= 0 && ki < L);
        const size_t base = (size_t)(b * S + res + ((ok ? ki : 0) << dsh)) * PJW + h * 64 + c * 8;
        const u32x4 kx = *(const u32x4*)(p.proj + base + C_AK), vx = *(const u32x4*)(p.proj + base + C_AV);
        const u32x4 zz = {0u, 0u, 0u, 0u};
        R.kv[i] = ok ? kx : zz; R.vv[i] = ok ? vx : zz;
    }
#pragma unroll
    for (int i = 0; i < 2; ++i) {
        const int j = t + 256 * i, row = j >> 3, c = j & 7;
        const size_t base = (size_t)(b * S + res + ((64 * qb + row) << dsh)) * PJW + C_AQ + h * 64 + c * 8;
        R.qv[i] = *(const u32x4*)(p.proj + base);
    }
#pragma unroll
    for (int i = 0; i < 3; ++i) {
        const int en = t + 256 * i, c = en / 176, x = en - c * 176, y = x - c - 16;
        const bool ok = (en < 704) && (y >= 0) && (y <= 128);
        const float bvl = p.rel_bias[T5TAB[br * 129 + (ok ? y : 0)] * AH + h];
        R.tb[i] = ok ? bvl * 1.44269504f : -1.0e30f;
    }
}
__device__ void attn_item(const Params& p, char* lds, int t, int it, int nit, AttnRegs& R) {
    const int l = t & 63, w = t >> 6, i16 = l & 15, g = l >> 4;
    const int idx = it & 63, br = (it >> 6) % 3, h = (it / 192) & 7, b = it / 1536;
    const int dsh = br * 2, L = S >> dsh, nbl = L >> 6;
    const int res = idx / nbl, qb = idx % nbl;
    char* Ks = lds + AT_K; char* Vs = lds + AT_V; char* Qs = lds + AT_Q; float* biasf = (float*)(lds + AT_BIAS);
    __syncthreads();
#pragma unroll
    for (int i = 0; i < 6; ++i) {
        const int j = t + 256 * i, row = j >> 3, c = j & 7;
        *(u32x4*)(Ks + tile_off(row, c)) = R.kv[i];
        *(u32x4*)(Vs + row * 160 + c * 16) = R.vv[i];
    }
    { u32x4 zz = {0u, 0u, 0u, 0u}; asm volatile("" : "+v"(zz));
      if (t < 160) *(u32x4*)(Vs + 192 * 160 + t * 16) = zz; else if (t < 224) { *(u32x4*)(Ks + 192 * 128 + (t - 160) * 16) = zz; *(u32x4*)(Ks + 192 * 128 + (t - 96) * 16) = zz; } }
#pragma unroll
    for (int i = 0; i < 2; ++i) { const int j = t + 256 * i; *(u32x4*)(Qs + tile_off(j >> 3, j & 7)) = R.qv[i]; }
#pragma unroll
    for (int i = 0; i < 3; ++i) { const int en = t + 256 * i; if (en < 704) biasf[en] = R.tb[i]; }
    __syncthreads();
    if (nit >= 0) attn_load(p, t, nit, R);

    const bf16x8 qf0 = lds_frag(Qs, 16 * w + i16, g), qf1 = lds_frag(Qs, 16 * w + i16, 4 + g);
    const char* Kw = Ks + 16 * w * 128;
    f32x4 sc[10];
#pragma unroll
    for (int i = 0; i < 10; ++i) {
        const bf16x8 k0 = lds_frag(Kw, 16 * i + i16, g), k1 = lds_frag(Kw, 16 * i + i16, 4 + g);
        f32x4 a = {0.f, 0.f, 0.f, 0.f};
        a = __builtin_amdgcn_mfma_f32_16x16x32_bf16(k0, qf0, a, 0, 0, 0);
        a = __builtin_amdgcn_mfma_f32_16x16x32_bf16(k1, qf1, a, 0, 0, 0);
        sc[i] = a;
    }
    const int sq = 16 * w + i16;
    const float* tabc = biasf + (i16 & 3) * 176 + 4 * g - 4 * (i16 >> 2) + 16;
    float mx = -3.0e38f;
#pragma unroll
    for (int i = 0; i < 10; ++i) {
        const f32x4 b4 = *(const f32x4*)(tabc + 16 * i);
#pragma unroll
        for (int r = 0; r < 4; ++r) sc[i][r] = fmaf(sc[i][r], 0.125f * 1.44269504f, b4[r]);
    }
    if (qb == 0 || qb == nbl - 1) {
        const int lo = (qb == 0) ? 64 : 0, hi = (qb == nbl - 1) ? 128 : 192;
#pragma unroll
        for (int i = 0; i < 10; ++i)
#pragma unroll
            for (int r = 0; r < 4; ++r) { const int tk = 16 * (w + i) + 4 * g + r; sc[i][r] = (tk >= lo && tk < hi) ? sc[i][r] : -1.0e30f; }
    }
#pragma unroll
    for (int i = 0; i < 10; ++i) mx = fmaxf(mx, fmaxf(fmaxf(sc[i][0], sc[i][1]), fmaxf(sc[i][2], sc[i][3])));
    mx = fmaxf(mx, __shfl_xor(mx, 16)); mx = fmaxf(mx, __shfl_xor(mx, 32));
    float ls = 0.f;
#pragma unroll
    for (int i = 0; i < 10; ++i) {
#pragma unroll
        for (int r = 0; r < 4; ++r) { const float e = __builtin_amdgcn_exp2f(sc[i][r] - mx); sc[i][r] = e; ls += e; }
    }
    ls += __shfl_xor(ls, 16); ls += __shfl_xor(ls, 32);

    f32x4 oa[4];
#pragma unroll
    for (int e = 0; e < 4; ++e) oa[e] = (f32x4){0.f, 0.f, 0.f, 0.f};
    const char* Vw = Vs + (16 * w + 4 * g + (i16 >> 2)) * 160 + 4 * (i16 & 3) * 2;
#pragma unroll
    for (int i2 = 0; i2 < 5; ++i2) {
        uint4 pu;
        pu.x = pack2(sc[2 * i2][0], sc[2 * i2][1]); pu.y = pack2(sc[2 * i2][2], sc[2 * i2][3]);
        pu.z = pack2(sc[2 * i2 + 1][0], sc[2 * i2 + 1][1]); pu.w = pack2(sc[2 * i2 + 1][2], sc[2 * i2 + 1][3]);
        const bf16x8 pf = __builtin_bit_cast(bf16x8, pu);
#pragma unroll
        for (int et = 0; et < 4; ++et) {
            const s16x4 va = tr_read(Vw + (32 * i2) * 160 + et * 32);
            const s16x4 vb = tr_read(Vw + (32 * i2 + 16) * 160 + et * 32);
            oa[et] = __builtin_amdgcn_mfma_f32_16x16x32_bf16(cat4(va, vb), pf, oa[et], 0, 0, 0);
        }
    }
    const float inv = 1.0f / ls;
    const size_t tok = (size_t)b * S + res + ((64 * qb + sq) << dsh);
#pragma unroll
    for (int et = 0; et < 4; ++et) {
        uint2 o; o.x = pack2(oa[et][0] * inv, oa[et][1] * inv); o.y = pack2(oa[et][2] * inv, oa[et][3] * inv);
        *(uint2*)(p.abr + ((size_t)br * T + tok) * 512 + h * 64 + 16 * et + 4 * g) = o;
    }
    if (g == 0) p.lse[((size_t)br * T + tok) * 8 + h] = (mx + __log2f(ls)) * 0.69314718f;
}

constexpr int GL_ZS = 0, GL_TOT = 8192, GL_GG = 10240, GL_BF = 10752, GL_BS = 68, GL_BB = GL_BF + 64 * GL_BS * 4, GL_R2 = GL_BB + 64 * GL_BS * 4;
__device__ __forceinline__ float logsig_fast(float a) { return fminf(a, 0.f) - __logf(1.0f + __expf(-fabsf(a))); }
__device__ __forceinline__ void gla_prep(const Params& p, char* lds, int t, int h) {
    const int d = t & 63, w = t >> 6;
    float* zs = (float*)(lds + GL_ZS); float* tot = (float*)(lds + GL_TOT); float* GG = (float*)(lds + GL_GG);
    float* BF = (float*)(lds + GL_BF); float* BB = (float*)(lds + GL_BB);
    float wf[16], wb[16];
#pragma unroll
    for (int r = 0; r < 16; ++r) { wf[r] = p.wgf[r * 256 + h * 64 + d]; wb[r] = p.wgb[r * 256 + h * 64 + d]; }
    const float biasf = p.bgf[h * 64 + d], biasb = p.bgb[h * 64 + d];
    __syncthreads();
    float bfv[16], bbv[16];
#pragma unroll
    for (int i = 0; i < 16; ++i) {
        const float4* zr = (const float4*)(zs + (16 * w + i) * 32);
        float af = biasf, ab = biasb;
#pragma unroll
        for (int r4 = 0; r4 < 4; ++r4) {
            const float4 zf = zr[r4], zb = zr[4 + r4];
            af = fmaf(zf.x, wf[4 * r4], af); af = fmaf(zf.y, wf[4 * r4 + 1], af); af = fmaf(zf.z, wf[4 * r4 + 2], af); af = fmaf(zf.w, wf[4 * r4 + 3], af);
            ab = fmaf(zb.x, wb[4 * r4], ab); ab = fmaf(zb.y, wb[4 * r4 + 1], ab); ab = fmaf(zb.z, wb[4 * r4 + 2], ab); ab = fmaf(zb.w, wb[4 * r4 + 3], ab);
        }
        bfv[i] = logsig_fast(af) * (1.0f / 16.0f); bbv[i] = logsig_fast(ab) * (1.0f / 16.0f);
    }
#pragma unroll
    for (int i = 1; i < 16; ++i) bfv[i] += bfv[i - 1];
#pragma unroll
    for (int i = 14; i >= 0; --i) bbv[i] += bbv[i + 1];
    tot[(0 * 4 + w) * 64 + d] = bfv[15];
    tot[(1 * 4 + w) * 64 + d] = bbv[0];
    __syncthreads();
    float offf = 0.f, offb = 0.f, Gf = 0.f, Gb = 0.f;
#pragma unroll
    for (int ww = 0; ww < 4; ++ww) {
        const float a = tot[(0 * 4 + ww) * 64 + d], c = tot[(1 * 4 + ww) * 64 + d];
        Gf += a; Gb += c;
        if (ww < w) offf += a;
        if (ww > w) offb += c;
    }
#pragma unroll
    for (int i = 0; i < 16; ++i) { BF[(16 * w + i) * GL_BS + d] = bfv[i] + offf; BB[(16 * w + i) * GL_BS + d] = bbv[i] + offb; }
    if (w == 0) { GG[d] = Gf; GG[64 + d] = Gb; }
    __syncthreads();
}
__device__ __forceinline__ void unpack8(const uint4 u, float (&f)[8]) {
    f[0] = lo2f(u.x); f[1] = hi2f(u.x); f[2] = lo2f(u.y); f[3] = hi2f(u.y); f[4] = lo2f(u.z); f[5] = hi2f(u.z); f[6] = lo2f(u.w); f[7] = hi2f(u.w);
}
__device__ __forceinline__ uint4 pack8(const float (&f)[8]) { uint4 u; u.x = pack2(f[0], f[1]); u.y = pack2(f[2], f[3]); u.z = pack2(f[4], f[5]); u.w = pack2(f[6], f[7]); return u; }

constexpr int GD_KF = GL_R2, GD_KB = GD_KF + 64 * 160, GD_VT = GL_BF;
__device__ void gla_ds_item(const Params& p, char* lds, int t, int it) {
    const int l = t & 63, w = t >> 6, i16 = l & 15, g = l >> 4;
    const int n = it & 63, h = (it >> 6) & 3, b = it >> 8;
    const int t0 = b * S + n * 64;
    float* zs = (float*)(lds + GL_ZS);
    const int sr = t >> 2, sc = t & 3;
    const u16* kp = p.proj + (size_t)(t0 + sr) * PJW + C_GK + h * 64 + sc * 16;
    const uint4 kr0 = *(const uint4*)(kp), kr1 = *(const uint4*)(kp + 8);
    u32x4 vr[4];
#pragma unroll
    for (int i = 0; i < 4; ++i) { const int j = t + 256 * i; vr[i] = *(const u32x4*)(p.proj + (size_t)(t0 + (j >> 4)) * PJW + C_GV + h * 128 + (j & 15) * 8); }
    const float4* zsrc = (const float4*)(p.zbuf + (size_t)t0 * 32);
    const float4 zv0 = zsrc[t], zv1 = zsrc[t + 256];
    __syncthreads();
    ((float4*)zs)[t] = zv0; ((float4*)zs)[t + 256] = zv1;
    gla_prep(p, lds, t, h);
    const float* BF = (const float*)(lds + GL_BF); const float* BB = (const float*)(lds + GL_BB); const float* GG = (const float*)(lds + GL_GG);
    char* KF = lds + GD_KF; char* KB = lds + GD_KB; char* VT = lds + GD_VT;
    {
        float kk[16];
        { float tmp[8]; unpack8(kr0, tmp);
#pragma unroll
          for (int j = 0; j < 8; ++j) kk[j] = tmp[j];
          unpack8(kr1, tmp);
#pragma unroll
          for (int j = 0; j < 8; ++j) kk[8 + j] = tmp[j]; }
        float of[16], ob[16];
#pragma unroll
        for (int q = 0; q < 4; ++q) {
            const float4 bf4 = *(const float4*)(BF + sr * GL_BS + sc * 16 + 4 * q), bb4 = *(const float4*)(BB + sr * GL_BS + sc * 16 + 4 * q);
            const float4 gf4 = *(const float4*)(GG + sc * 16 + 4 * q), gb4 = *(const float4*)(GG + 64 + sc * 16 + 4 * q);
            of[4 * q + 0] = kk[4 * q + 0] * __expf(gf4.x - bf4.x); of[4 * q + 1] = kk[4 * q + 1] * __expf(gf4.y - bf4.y);
            of[4 * q + 2] = kk[4 * q + 2] * __expf(gf4.z - bf4.z); of[4 * q + 3] = kk[4 * q + 3] * __expf(gf4.w - bf4.w);
            ob[4 * q + 0] = kk[4 * q + 0] * __expf(gb4.x - bb4.x); ob[4 * q + 1] = kk[4 * q + 1] * __expf(gb4.y - bb4.y);
            ob[4 * q + 2] = kk[4 * q + 2] * __expf(gb4.z - bb4.z); ob[4 * q + 3] = kk[4 * q + 3] * __expf(gb4.w - bb4.w);
        }
        uint4 u;
        u.x = pack2(of[0], of[1]); u.y = pack2(of[2], of[3]); u.z = pack2(of[4], of[5]); u.w = pack2(of[6], of[7]);
        *(uint4*)(KF + sr * 160 + sc * 32) = u;
        u.x = pack2(of[8], of[9]); u.y = pack2(of[10], of[11]); u.z = pack2(of[12], of[13]); u.w = pack2(of[14], of[15]);
        *(uint4*)(KF + sr * 160 + sc * 32 + 16) = u;
        u.x = pack2(ob[0], ob[1]); u.y = pack2(ob[2], ob[3]); u.z = pack2(ob[4], ob[5]); u.w = pack2(ob[6], ob[7]);
        *(uint4*)(KB + sr * 160 + sc * 32) = u;
        u.x = pack2(ob[8], ob[9]); u.y = pack2(ob[10], ob[11]); u.z = pack2(ob[12], ob[13]); u.w = pack2(ob[14], ob[15]);
        *(uint4*)(KB + sr * 160 + sc * 32 + 16) = u;
        if (t < 64) { p.dec[((size_t)it * 2 + 0) * 64 + t] = __expf(GG[t]); p.dec[((size_t)it * 2 + 1) * 64 + t] = __expf(GG[64 + t]); }
    }
    __syncthreads();
#pragma unroll
    for (int i = 0; i < 4; ++i) { const int j = t + 256 * i; *(u32x4*)(VT + (j >> 4) * 288 + (j & 15) * 16) = vr[i]; }
    __syncthreads();
#pragma unroll
    for (int dir = 0; dir < 2; ++dir) {
        const char* KX = dir ? KB : KF;
        f32x4 acc[2][4];
#pragma unroll
        for (int a = 0; a < 2; ++a)
#pragma unroll
            for (int c = 0; c < 4; ++c) acc[a][c] = (f32x4){0.f, 0.f, 0.f, 0.f};
#pragma unroll
        for (int ks = 0; ks < 2; ++ks) {
            const int r0 = ks * 32 + 8 * g + (i16 >> 2);
            bf16x8 vf[2], kf[4];
#pragma unroll
            for (int a = 0; a < 2; ++a) {
                const int e0 = 16 * (2 * w + a) + 4 * (i16 & 3);
                vf[a] = cat4(tr_read(VT + r0 * 288 + e0 * 2), tr_read(VT + (r0 + 4) * 288 + e0 * 2));
            }
#pragma unroll
            for (int c = 0; c < 4; ++c) {
                const int d0 = 16 * c + 4 * (i16 & 3);
                kf[c] = cat4(tr_read(KX + r0 * 160 + d0 * 2), tr_read(KX + (r0 + 4) * 160 + d0 * 2));
            }
#pragma unroll
            for (int a = 0; a < 2; ++a)
#pragma unroll
                for (int c = 0; c < 4; ++c) acc[a][c] = __builtin_amdgcn_mfma_f32_16x16x32_bf16(kf[c], vf[a], acc[a][c], 0, 0, 0);
        }
        float* dst = p.dS + ((size_t)it * 2 + dir) * 128 * 64;
#pragma unroll
        for (int a = 0; a < 2; ++a)
#pragma unroll
            for (int c = 0; c < 4; ++c) *(f32x4*)(dst + (16 * (2 * w + a) + i16) * 64 + 16 * c + 4 * g) = acc[a][c];
    }
}

__device__ void gla_scan_thread2(const Params& p, int gid) {
    const int d = gid & 63, e = (gid >> 6) & 127, dir = (gid >> 13) & 1, bh0 = gid >> 14, bh1 = bh0 + 8;
    float s0 = 0.f, s1 = 0.f;
#pragma unroll 8
    for (int step = 0; step < 64; ++step) {
        const int n = dir ? (63 - step) : step;
        const size_t i0 = ((size_t)(bh0 * 64 + n)) * 2 + dir, i1 = ((size_t)(bh1 * 64 + n)) * 2 + dir;
        const float dc0 = p.dec[i0 * 64 + d], ds0 = p.dS[(i0 * 128 + e) * 64 + d];
        const float dc1 = p.dec[i1 * 64 + d], ds1 = p.dS[(i1 * 128 + e) * 64 + d];
        p.Sp[(i0 * 128 + e) * 64 + d] = f2bf(s0);
        p.Sp[(i1 * 128 + e) * 64 + d] = f2bf(s1);
        s0 = fmaf(dc0, s0, ds0); s1 = fmaf(dc1, s1, ds1);
    }
}

__device__ void attn_combine_thread(const Params& p, int gid) {
    const int tok = gid >> 6, c = gid & 63, h = c >> 3;
    const float l0 = p.lse[((size_t)0 * T + tok) * 8 + h], l1 = p.lse[((size_t)1 * T + tok) * 8 + h], l2 = p.lse[((size_t)2 * T + tok) * 8 + h];
    const float mm = fmaxf(l0, fmaxf(l1, l2));
    float w0 = __expf(l0 - mm), w1 = __expf(l1 - mm), w2 = __expf(l2 - mm);
    const float inv = 1.0f / (w0 + w1 + w2);
    w0 *= inv; w1 *= inv; w2 *= inv;
    const uint4 a0 = *(const uint4*)(p.abr + ((size_t)0 * T + tok) * 512 + c * 8);
    const uint4 a1 = *(const uint4*)(p.abr + ((size_t)1 * T + tok) * 512 + c * 8);
    const uint4 a2 = *(const uint4*)(p.abr + ((size_t)2 * T + tok) * 512 + c * 8);
    uint4 o;
    o.x = pack2(w0 * lo2f(a0.x) + w1 * lo2f(a1.x) + w2 * lo2f(a2.x), w0 * hi2f(a0.x) + w1 * hi2f(a1.x) + w2 * hi2f(a2.x));
    o.y = pack2(w0 * lo2f(a0.y) + w1 * lo2f(a1.y) + w2 * lo2f(a2.y), w0 * hi2f(a0.y) + w1 * hi2f(a1.y) + w2 * hi2f(a2.y));
    o.z = pack2(w0 * lo2f(a0.z) + w1 * lo2f(a1.z) + w2 * lo2f(a2.z), w0 * hi2f(a0.z) + w1 * hi2f(a1.z) + w2 * hi2f(a2.z));
    o.w = pack2(w0 * lo2f(a0.w) + w1 * lo2f(a1.w) + w2 * lo2f(a2.w), w0 * hi2f(a0.w) + w1 * hi2f(a1.w) + w2 * hi2f(a2.w));
    *(uint4*)(p.mix + (size_t)tok * D + c * 8) = o;
}

constexpr int GO_QF = GL_R2, GO_QB = GO_QF + 8192, GO_KF = GO_QB + 8192, GO_KB = GO_KF + 8192, GO_VT = GL_R2, GO_AM = GL_ZS, GO_SF = GL_BF, GO_SB = GL_BF + 16384;
__device__ void gla_out_item(const Params& p, char* lds, int t, int it) {
    const int l = t & 63, w = t >> 6, i16 = l & 15, g = l >> 4;
    const int n = it & 63, h = (it >> 6) & 3, b = it >> 8;
    const int t0 = b * S + n * 64;
    float* zs = (float*)(lds + GL_ZS);
    const int sr = t >> 2, sc = t & 3;
    const float4* zsrc = (const float4*)(p.zbuf + (size_t)t0 * 32);
    const float4 zv0 = zsrc[t], zv1 = zsrc[t + 256];
    const u16* qp = p.proj + (size_t)(t0 + sr) * PJW + C_GQ + h * 64 + sc * 16;
    const u16* kp = p.proj + (size_t)(t0 + sr) * PJW + C_GK + h * 64 + sc * 16;
    const uint4 qr0 = *(const uint4*)(qp), qr1 = *(const uint4*)(qp + 8), kr0 = *(const uint4*)(kp), kr1 = *(const uint4*)(kp + 8);
    u32x4 vr[4], sv[8];
#pragma unroll
    for (int i = 0; i < 4; ++i) { const int j = t + 256 * i; vr[i] = *(const u32x4*)(p.proj + (size_t)(t0 + (j >> 4)) * PJW + C_GV + h * 128 + (j & 15) * 8); }
    const u16* SPG = p.Sp + (size_t)it * 2 * 128 * 64;
    __syncthreads();
    ((float4*)zs)[t] = zv0; ((float4*)zs)[t + 256] = zv1;
    gla_prep(p, lds, t, h);
#pragma unroll
    for (int i = 0; i < 8; ++i) { const int j = t + 256 * i; sv[i] = *(const u32x4*)(SPG + (size_t)j * 8); }
    const float* BF = (const float*)(lds + GL_BF); const float* BB = (const float*)(lds + GL_BB);
    char* QF = lds + GO_QF; char* QB = lds + GO_QB; char* KF = lds + GO_KF; char* KB = lds + GO_KB; char* VT = lds + GO_VT; char* AM = lds + GO_AM;
    char* SF = lds + GO_SF; char* SB = lds + GO_SB;
    {
        float qq[16], kk[16];
        { float tmp[8];
          unpack8(qr0, tmp);
#pragma unroll
          for (int j = 0; j < 8; ++j) qq[j] = tmp[j] * 0.125f;
          unpack8(qr1, tmp);
#pragma unroll
          for (int j = 0; j < 8; ++j) qq[8 + j] = tmp[j] * 0.125f;
          unpack8(kr0, tmp);
#pragma unroll
          for (int j = 0; j < 8; ++j) kk[j] = tmp[j];
          unpack8(kr1, tmp);
#pragma unroll
          for (int j = 0; j < 8; ++j) kk[8 + j] = tmp[j]; }
        float ef[16], eb[16];
#pragma unroll
        for (int q = 0; q < 4; ++q) {
            const float4 bf4 = *(const float4*)(BF + sr * GL_BS + sc * 16 + 4 * q), bb4 = *(const float4*)(BB + sr * GL_BS + sc * 16 + 4 * q);
            ef[4 * q + 0] = __expf(bf4.x); ef[4 * q + 1] = __expf(bf4.y); ef[4 * q + 2] = __expf(bf4.z); ef[4 * q + 3] = __expf(bf4.w);
            eb[4 * q + 0] = __expf(bb4.x); eb[4 * q + 1] = __expf(bb4.y); eb[4 * q + 2] = __expf(bb4.z); eb[4 * q + 3] = __expf(bb4.w);
        }
        float o8[8];
#pragma unroll
        for (int hh = 0; hh < 2; ++hh) {
            const int off = tile_off(sr, 2 * sc + hh);
#pragma unroll
            for (int j = 0; j < 8; ++j) o8[j] = qq[8 * hh + j] * ef[8 * hh + j];
            *(uint4*)(QF + off) = pack8(o8);
#pragma unroll
            for (int j = 0; j < 8; ++j) o8[j] = kk[8 * hh + j] / ef[8 * hh + j];
            *(uint4*)(KF + off) = pack8(o8);
#pragma unroll
            for (int j = 0; j < 8; ++j) o8[j] = qq[8 * hh + j] * eb[8 * hh + j];
            *(uint4*)(QB + off) = pack8(o8);
#pragma unroll
            for (int j = 0; j < 8; ++j) o8[j] = kk[8 * hh + j] / eb[8 * hh + j];
            *(uint4*)(KB + off) = pack8(o8);
        }
    }
    __syncthreads();
#pragma unroll
    for (int i = 0; i < 8; ++i) { const int j = t + 256 * i; *(u32x4*)((j >> 10 ? SB : SF) + tile_off((j >> 3) & 127, j & 7)) = sv[i]; }
    const int cq = 16 * w + i16;
    const bf16x8 qf0 = lds_frag(QF, cq, g), qf1 = lds_frag(QF, cq, 4 + g);
    const bf16x8 qb0 = lds_frag(QB, cq, g), qb1 = lds_frag(QB, cq, 4 + g);
    uint2 amo[4];
#pragma unroll
    for (int st = 0; st < 4; ++st) {
        f32x4 af = {0.f, 0.f, 0.f, 0.f}, ab = {0.f, 0.f, 0.f, 0.f};
        af = __builtin_amdgcn_mfma_f32_16x16x32_bf16(lds_frag(KF, 16 * st + i16, g), qf0, af, 0, 0, 0);
        af = __builtin_amdgcn_mfma_f32_16x16x32_bf16(lds_frag(KF, 16 * st + i16, 4 + g), qf1, af, 0, 0, 0);
        ab = __builtin_amdgcn_mfma_f32_16x16x32_bf16(lds_frag(KB, 16 * st + i16, g), qb0, ab, 0, 0, 0);
        ab = __builtin_amdgcn_mfma_f32_16x16x32_bf16(lds_frag(KB, 16 * st + i16, 4 + g), qb1, ab, 0, 0, 0);
        float am[4];
#pragma unroll
        for (int r = 0; r < 4; ++r) {
            const int s = 16 * st + 4 * g + r;
            am[r] = (s <= cq ? af[r] : 0.f) + (s >= cq ? ab[r] : 0.f);
        }
        amo[st].x = pack2(am[0], am[1]); amo[st].y = pack2(am[2], am[3]);
    }
#pragma unroll
    for (int st = 0; st < 4; ++st) { const int s0 = 16 * st + 4 * g; *(uint2*)(AM + tile_off(cq, s0 >> 3) + (s0 & 7) * 2) = amo[st]; }
    __syncthreads();
#pragma unroll
    for (int i = 0; i < 4; ++i) { const int j = t + 256 * i; *(u32x4*)(VT + (j >> 4) * 288 + (j & 15) * 16) = vr[i]; }
    __syncthreads();
    f32x4 oc[8];
#pragma unroll
    for (int et = 0; et < 8; ++et) oc[et] = (f32x4){0.f, 0.f, 0.f, 0.f};
#pragma unroll
    for (int ks = 0; ks < 2; ++ks) {
        const bf16x8 amf = lds_frag(AM, cq, ks * 4 + g);
        const bf16x8 qff = ks ? qf1 : qf0, qbf = ks ? qb1 : qb0;
        const int r0 = ks * 32 + 8 * g + (i16 >> 2);
#pragma unroll
        for (int et = 0; et < 8; ++et) {
            const int e0 = 16 * et + 4 * (i16 & 3);
            const bf16x8 vf = cat4(tr_read(VT + r0 * 288 + e0 * 2), tr_read(VT + (r0 + 4) * 288 + e0 * 2));
            oc[et] = __builtin_amdgcn_mfma_f32_16x16x32_bf16(vf, amf, oc[et], 0, 0, 0);
            oc[et] = __builtin_amdgcn_mfma_f32_16x16x32_bf16(lds_frag(SF, 16 * et + i16, ks * 4 + g), qff, oc[et], 0, 0, 0);
            oc[et] = __builtin_amdgcn_mfma_f32_16x16x32_bf16(lds_frag(SB, 16 * et + i16, ks * 4 + g), qbf, oc[et], 0, 0, 0);
        }
    }
    float ss = 0.f;
#pragma unroll
    for (int et = 0; et < 8; ++et)
#pragma unroll
        for (int r = 0; r < 4; ++r) ss += oc[et][r] * oc[et][r];
    ss += __shfl_xor(ss, 16); ss += __shfl_xor(ss, 32);
    const float rstd = rsqrtf(ss * (1.0f / 128.0f) + EPS);
    const size_t tok = (size_t)t0 + cq;
#pragma unroll
    for (int et = 0; et < 8; ++et) {
        const int e = 16 * et + 4 * g;
        const uint2 gg = *(const uint2*)(p.proj + tok * PJW + C_GO + h * 128 + e);
        const float4 ng = *(const float4*)(p.gla_ng + h * 128 + e);
        const float g0 = lo2f(gg.x), g1 = hi2f(gg.x), g2 = lo2f(gg.y), g3 = hi2f(gg.y);
        uint2 o;
        o.x = pack2(oc[et][0] * rstd * ng.x * (g0 / (1.0f + __expf(-g0))), oc[et][1] * rstd * ng.y * (g1 / (1.0f + __expf(-g1))));
        o.y = pack2(oc[et][2] * rstd * ng.z * (g2 / (1.0f + __expf(-g2))), oc[et][3] * rstd * ng.w * (g3 / (1.0f + __expf(-g3))));
        *(uint2*)(p.mix + tok * D + 512 + h * 128 + e) = o;
    }
}

constexpr int RT_RS = 1028;
constexpr int RT_XS = 0, RT_PART = 16 * RT_RS * 4, RT_PE = RT_PART + 4 * 16 * 32 * 4 + 512, RT_RANK = RT_PE + 1024, RT_HIST = RT_RANK + 1024, RT_BASE = RT_HIST + 128;
__device__ void ph_route(const Params& p, char* ldsall) {
    const int tid = tid_opaque(), t = tid & 255, half = tid >> 8, lane = t & 63, w = t >> 6;
    char* lds = ldsall + half * HALF_LDS;
    const int vb = blockIdx.x * 2 + half, nvb = gridDim.x * 2;
    float* xs = (float*)(lds + RT_XS); float* part = (float*)(lds + RT_PART);
    int* pe = (int*)(lds + RT_PE); int* rank = (int*)(lds + RT_RANK); int* hist = (int*)(lds + RT_HIST); int* base = (int*)(lds + RT_BASE);
    const int ngr = (T / 16 + nvb - 1) / nvb;
    for (int gl = 0; gl < ngr; ++gl) {
        const int gi = vb + gl * nvb;
        const bool live = gi < T / 16;
        const int tok0 = (live ? gi : 0) * 16;
        __syncthreads();
#pragma unroll
        for (int th = 0; th < 2; ++th) {
            f32x4 v[2][4];
#pragma unroll
            for (int tt = 0; tt < 2; ++tt) {
                const f32x4* xr = (const f32x4*)(p.x1 + (size_t)(tok0 + 4 * w + 2 * th + tt) * D);
#pragma unroll
                for (int i = 0; i < 4; ++i) v[tt][i] = xr[lane + 64 * i];
            }
#pragma unroll
            for (int tt = 0; tt < 2; ++tt) {
                const int tl = 4 * w + 2 * th + tt, tok = tok0 + tl;
                float ss = 0.f;
#pragma unroll
                for (int i = 0; i < 4; ++i) ss += v[tt][i][0] * v[tt][i][0] + v[tt][i][1] * v[tt][i][1] + v[tt][i][2] * v[tt][i][2] + v[tt][i][3] * v[tt][i][3];
                ss = wave_sum(ss);
                const float r = rsqrtf(ss * (1.0f / D) + EPS);
#pragma unroll
                for (int i = 0; i < 4; ++i) {
                    const f32x4 gq = ((const f32x4*)p.g2)[lane + 64 * i];
                    const f32x4 yv = v[tt][i] * r * gq;
                    *(f32x4*)(xs + tl * RT_RS + (lane + 64 * i) * 4) = yv;
                    if (live) { uint2 o; o.x = pack2(yv[0], yv[1]); o.y = pack2(yv[2], yv[3]); *(uint2*)(p.xn2 + (size_t)tok * D + (lane + 64 * i) * 4) = o; }
                }
            }
        }
        __syncthreads();
        {
            const int i16 = lane & 15, kq = lane >> 4;
            const float* xa = xs + i16 * RT_RS + 256 * w + 64 * kq;
            const float* rwp = p.rw + (size_t)(256 * w + 64 * kq) * 32 + i16;
            f32x4 a0 = {0.f, 0.f, 0.f, 0.f}, a1 = {0.f, 0.f, 0.f, 0.f};
            f32x4 bqA[8];
#define RT_LOADB(dst, b) do { _Pragma("unroll") for (int q = 0; q < 8; ++q) { \
                dst[q][0] = rwp[(size_t)((b) * 16 + 2 * q) * 32]; dst[q][1] = rwp[(size_t)((b) * 16 + 2 * q) * 32 + 16]; \
                dst[q][2] = rwp[(size_t)((b) * 16 + 2 * q + 1) * 32]; dst[q][3] = rwp[(size_t)((b) * 16 + 2 * q + 1) * 32 + 16]; } } while (0)
#define RT_MMA(src, b) do { _Pragma("unroll") for (int s4 = 0; s4 < 4; ++s4) { const float4 av = *(const float4*)(xa + 16 * (b) + 4 * s4); \
                a0 = __builtin_amdgcn_mfma_f32_16x16x4f32(av.x, src[2 * s4][0], a0, 0, 0, 0); a1 = __builtin_amdgcn_mfma_f32_16x16x4f32(av.x, src[2 * s4][1], a1, 0, 0, 0); \
                a0 = __builtin_amdgcn_mfma_f32_16x16x4f32(av.y, src[2 * s4][2], a0, 0, 0, 0); a1 = __builtin_amdgcn_mfma_f32_16x16x4f32(av.y, src[2 * s4][3], a1, 0, 0, 0); \
                a0 = __builtin_amdgcn_mfma_f32_16x16x4f32(av.z, src[2 * s4 + 1][0], a0, 0, 0, 0); a1 = __builtin_amdgcn_mfma_f32_16x16x4f32(av.z, src[2 * s4 + 1][1], a1, 0, 0, 0); \
                a0 = __builtin_amdgcn_mfma_f32_16x16x4f32(av.w, src[2 * s4 + 1][2], a0, 0, 0, 0); a1 = __builtin_amdgcn_mfma_f32_16x16x4f32(av.w, src[2 * s4 + 1][3], a1, 0, 0, 0); } } while (0)
#pragma unroll
            for (int b = 0; b < 4; ++b) {
                RT_LOADB(bqA, b);
                __builtin_amdgcn_sched_barrier(0);
                RT_MMA(bqA, b);
                __builtin_amdgcn_sched_barrier(0);
            }
#undef RT_LOADB
#undef RT_MMA
#pragma unroll
            for (int r = 0; r < 4; ++r) { part[(w * 16 + 4 * kq + r) * 32 + i16] = a0[r]; part[(w * 16 + 4 * kq + r) * 32 + 16 + i16] = a1[r]; }
        }
        __syncthreads();
#pragma unroll
        for (int ro = 0; ro < 2; ++ro) {
            const int tk = 4 * w + 2 * ro + (lane >> 5), e = lane & 31;
            float v = p.rb[e] + ((part[(0 * 16 + tk) * 32 + e] + part[(1 * 16 + tk) * 32 + e]) + (part[(2 * 16 + tk) * 32 + e] + part[(3 * 16 + tk) * 32 + e]));
            int rk = 0;
#pragma unroll
            for (int j = 0; j < 64; ++j) {
                const float bj = __builtin_bit_cast(float, __builtin_amdgcn_readlane(__builtin_bit_cast(int, v), j));
                if ((j >> 5) == (lane >> 5)) rk += (bj > v || (bj == v && (j & 31) < e)) ? 1 : 0;
            }
            float* selv = part + 2048 + (w * 2 + (lane >> 5)) * 8;
            if (rk < 4) { selv[rk] = v; selv[4 + rk] = __builtin_bit_cast(float, e); }
            __builtin_amdgcn_s_waitcnt(0xc07f);
            __builtin_amdgcn_wave_barrier();
            const float b0 = selv[0], b1 = selv[1], b2 = selv[2], b3 = selv[3];
            const float e1 = expf(b1 - b0), e2 = expf(b2 - b0), e3 = expf(b3 - b0);
            const float inv = 1.0f / (1.0f + e1 + e2 + e3);
            if (e < 4) {
                const int sel = __builtin_bit_cast(int, selv[4 + e]);
                const float gs = (e == 0) ? inv : (e == 1) ? e1 * inv : (e == 2) ? e2 * inv : e3 * inv;
                pe[gl * 64 + tk * 4 + e] = live ? (sel & 31) : -1;
                if (live) p.gate[(size_t)(tok0 + tk) * 4 + e] = gs;
            }
            __builtin_amdgcn_wave_barrier();
        }
    }
    __syncthreads();
    if (t < 32) hist[t] = 0;
    __syncthreads();
    for (int i = t; i < ngr * 64; i += 256) { const int e = pe[i]; if (e >= 0) rank[i] = atomicAdd(&hist[e], 1); }
    __syncthreads();
    if (t < 32) { const int c = hist[t]; base[t] = c ? atomicAdd(&p.counts[t], c) : 0; }
    __syncthreads();
    for (int i = t; i < ngr * 64; i += 256) {
        const int e = pe[i];
        if (e >= 0) { const int gl = i >> 6, gi = vb + gl * nvb; const int slot = (gi * 16 + ((i >> 2) & 15)) * 4 + (i & 3); p.lists[e * T + base[e] + rank[i]] = slot; }
    }
}

__device__ void ph_final(const Params& p) {
    const int tid = tid_opaque(), lane = tid & 63, gw = blockIdx.x * 8 + (tid >> 6), nw = gridDim.x * 8;
    for (int tok = gw; tok < T; tok += nw) {
        float v[2][8]; float ss = 0.f;
#pragma unroll
        for (int i = 0; i < 2; ++i) {
            const int c = lane * 8 + 512 * i;
            const float4 xa = *(const float4*)(p.x1 + (size_t)tok * D + c), xb = *(const float4*)(p.x1 + (size_t)tok * D + c + 4);
            v[i][0] = xa.x; v[i][1] = xa.y; v[i][2] = xa.z; v[i][3] = xa.w; v[i][4] = xb.x; v[i][5] = xb.y; v[i][6] = xb.z; v[i][7] = xb.w;
#pragma unroll
            for (int k = 0; k < 4; ++k) {
                const uint4 yy = *(const uint4*)(p.y + ((size_t)tok * 4 + k) * D + c);
                v[i][0] += lo2f(yy.x); v[i][1] += hi2f(yy.x); v[i][2] += lo2f(yy.y); v[i][3] += hi2f(yy.y);
                v[i][4] += lo2f(yy.z); v[i][5] += hi2f(yy.z); v[i][6] += lo2f(yy.w); v[i][7] += hi2f(yy.w);
            }
#pragma unroll
            for (int j = 0; j < 8; ++j) ss += v[i][j] * v[i][j];
        }
        ss = wave_sum(ss);
        const float r = rsqrtf(ss * (1.0f / D) + EPS);
#pragma unroll
        for (int i = 0; i < 2; ++i) {
            const int c = lane * 8 + 512 * i;
            const float4 ga = *(const float4*)(p.gf + c), gb = *(const float4*)(p.gf + c + 4);
            float4 oa, ob;
            oa.x = v[i][0] * r * ga.x; oa.y = v[i][1] * r * ga.y; oa.z = v[i][2] * r * ga.z; oa.w = v[i][3] * r * ga.w;
            ob.x = v[i][4] * r * gb.x; ob.y = v[i][5] * r * gb.y; ob.z = v[i][6] * r * gb.z; ob.w = v[i][7] * r * gb.w;
            *(float4*)(p.out + (size_t)tok * D + c) = oa; *(float4*)(p.out + (size_t)tok * D + c + 4) = ob;
        }
    }
}

#define XB_TMO      128
#define XB_XCNT(j)  (256  + 64 * (j))
#define XB_XSUB(j)  (1280 + 64 * (j))
#define XB_XGEN(j)  (2304 + 64 * (j))
#define XB_TOP      3328
#define XB_TOPGEN   3392
#define XCD_BAR_WORDS 3456
#define XB_SPIN_CAP (1u << 22)
__device__ __forceinline__ unsigned xb_ld(unsigned* p)              { return __hip_atomic_load(p, __ATOMIC_RELAXED, __HIP_MEMORY_SCOPE_AGENT); }
__device__ __forceinline__ unsigned xb_add(unsigned* p, unsigned v) { return __hip_atomic_fetch_add(p, v, __ATOMIC_RELAXED, __HIP_MEMORY_SCOPE_AGENT); }
__device__ __forceinline__ unsigned xb_xcc_id() { return (unsigned)__builtin_amdgcn_s_getreg((3 << 11) | 20) & 0xFu; }
#define XB_SPIN(cond, bar) do { unsigned _sp = 0; while (cond) { __builtin_amdgcn_s_sleep(1); \
    if ((++_sp & 255u) == 0u) { if (xb_ld(&(bar)[XB_TMO])) break; if (_sp > XB_SPIN_CAP) { atomicAdd(&(bar)[XB_TMO], 1u); break; } } } } while (0)
struct XcdBarrier { unsigned* bar; unsigned x; volatile LDS_AS unsigned* st; };
__device__ __forceinline__ XcdBarrier xcd_barrier_post(unsigned* bar, volatile LDS_AS unsigned* st) {
    XcdBarrier b; b.bar = bar; b.x = xb_xcc_id(); b.st = st;
    if (threadIdx.x == 0) (void)xb_add(&bar[XB_XCNT(b.x)], 1u);
    return b;
}
__device__ __forceinline__ void xcd_barrier_complete(unsigned* bar, unsigned x, unsigned& nloc, unsigned& nx) {
    const unsigned G = gridDim.x * gridDim.y * gridDim.z;
    unsigned sum, cnt, mine, sp = 0u;
    for (;;) {
        sum = 0u; cnt = 0u; mine = 0u;
#pragma unroll
        for (unsigned j = 0; j < 16; ++j) { const unsigned c = xb_ld(&bar[XB_XCNT(j)]); sum += c; cnt += (c > 0u) ? 1u : 0u; mine = (j == x) ? c : mine; }
        if (sum == G) break;
        __builtin_amdgcn_s_sleep(1);
        if ((++sp & 255u) == 0u) { if (xb_ld(&bar[XB_TMO])) break; if (sp > XB_SPIN_CAP) { atomicAdd(&bar[XB_TMO], 1u); break; } }
    }
    nloc = mine > 0u ? mine : 1u; nx = cnt > 0u ? cnt : 1u;
}
__device__ __forceinline__ void xcd_barrier(const XcdBarrier& b) {
    asm volatile("s_waitcnt vmcnt(0)" ::: "memory");
    __syncthreads();
    if (threadIdx.x == 0) {
        unsigned* bar = b.bar;
        __builtin_amdgcn_s_waitcnt(0);
        unsigned nloc = b.st[0], nx = b.st[1];
        if (nloc == 0u) { xcd_barrier_complete(bar, b.x, nloc, nx); b.st[0] = nloc; b.st[1] = nx; }
        const unsigned old = xb_add(&bar[XB_XSUB(b.x)], 1u);
        const unsigned gen = old / nloc;
        if (old + 1u == (gen + 1u) * nloc) {
            __builtin_amdgcn_fence(__ATOMIC_RELEASE, "agent");
            asm volatile("s_waitcnt vmcnt(0)" ::: "memory");
            const unsigned og = xb_add(&bar[XB_TOP], 1u);
            const unsigned tg = og / nx;
            if (og + 1u == (tg + 1u) * nx) xb_add(&bar[XB_TOPGEN], 1u);
            else XB_SPIN(xb_ld(&bar[XB_TOPGEN]) == tg, bar);
            __builtin_amdgcn_fence(__ATOMIC_ACQUIRE, "agent");
            xb_add(&bar[XB_XGEN(b.x)], 1u);
            asm volatile("s_waitcnt vmcnt(0)" ::: "memory");
        } else {
            XB_SPIN(xb_ld(&bar[XB_XGEN(b.x)]) == gen, bar);
            __builtin_amdgcn_fence(__ATOMIC_ACQUIRE, "agent");
            asm volatile("s_waitcnt vmcnt(0)" ::: "memory");
        }
    }
    __syncthreads();
}


#if defined(FLUSHMASK)
__device__ void ph_flush(const Params& p) {
    const int tid = tid_opaque();
    const float4* src = (const float4*)p.w1;
    float acc = 0.f;
    for (size_t i = (size_t)blockIdx.x * 512 + tid; i < (size_t)NE * D * 2 * DFF / 4; i += (size_t)gridDim.x * 512) { const float4 v = src[i]; acc += v.x + v.y + v.z + v.w; }
    if (acc == 123.456f) p.out[0] = acc;
}
#endif
enum { PH_PRO = 0, PH_PROJ, PH_MIX1, PH_MIX2, PH_MIX3, PH_OUTPROJ, PH_ROUTE, PH_MOE1, PH_MOE2, PH_FINAL, PH_END };
constexpr int N_GLA_ITEMS = B * GH * 64, N_ATT_ITEMS = B * AH * 3 * 64;
constexpr int MO_META = 128 * 1024;

__device__ __forceinline__ void moe_meta(const Params& p, int* meta) {
    __syncthreads();
    if (threadIdx.x == 0) {
        int mp = 0, rbse = 0;
        for (int e = 0; e < NE; ++e) {
            const int c = p.counts[e];
            meta[e] = c; meta[32 + e] = mp; meta[72 + e] = rbse;
            mp += (c + 255) >> 8; rbse += c;
        }
        meta[32 + NE] = mp; meta[72 + NE] = rbse;
    }
    __syncthreads();
}

typedef const __attribute__((address_space(4))) Params* KParams;
#if defined(__HIP_DEVICE_COMPILE__)
#define PHASE_PARAMS() KParams _kq = kp; asm volatile("" : "+s"(_kq)); const Params p = *_kq
#define KP_INIT() KParams kp = (KParams)__builtin_amdgcn_kernarg_segment_ptr(); const int ph_lo = kp->ph_lo, ph_hi = kp->ph_hi; unsigned* const barw = kp->bar
#else
#define PHASE_PARAMS() const Params p = p_unused
#define KP_INIT() const int ph_lo = p_unused.ph_lo, ph_hi = p_unused.ph_hi; unsigned* const barw = p_unused.bar
#endif
__global__ void __launch_bounds__(512, 2) mega(Params p_unused) {
    extern __shared__ __attribute__((aligned(16))) char lds[];
    KP_INIT();
    cg::grid_group grid = cg::this_grid();
    volatile LDS_AS unsigned* xst = (volatile LDS_AS unsigned*)(lds + LDS_BYTES - 16);
    if (threadIdx.x == 0) { xst[0] = 0u; xst[1] = 0u; }
    __syncthreads();
    const XcdBarrier xb = xcd_barrier_post(barw, xst);
    if (ph_hi > PH_END) grid.sync();
    for (int ph = ph_lo; ph < ph_hi; ++ph) {
      const int nrep = ((REPMASK >> ph) & 1) ? 2 : 1;
      for (int rep = 0; rep < nrep; ++rep) {
        if (rep) xcd_barrier(xb);
#if defined(ROUTE2)
        if (rep && ph == PH_ROUTE) { PHASE_PARAMS(); if (blockIdx.x == 0 && threadIdx.x < 32) p.counts[threadIdx.x] = 0; xcd_barrier(xb); }
#endif
#if defined(FLUSHMASK)
        if (rep && ((FLUSHMASK >> ph) & 1)) { PHASE_PARAMS(); ph_flush(p); xcd_barrier(xb); }
#if defined(FLUSHONLY)
        if (rep && ((FLUSHMASK >> ph) & 1)) continue;
#endif
#endif
        switch (ph) {
        case PH_PRO: { PHASE_PARAMS(); ph_prologue(p); } break;
        case PH_PROJ: {
            PHASE_PARAMS();
            const int G = gridDim.x, ng = G - NCONV;
            if ((int)blockIdx.x < ng) {
                pg::DenseSched S; S.init(p.xn, p.winT, T, PJW, ng, blockIdx.x);
                pg::EpiProj E{p.proj};
                pg::gemm_phase((LDS_AS unsigned char*)lds, S, E);
            } else {
                const int tid = tid_opaque(), t = tid & 255, st = NCONV * 2;
                const int l = t & 63, w = t >> 6, kg = l & 7, ngq = w * 8 + (l >> 3);
#define CV_DECL(X) f32x4 X##0 = {0.f, 0.f, 0.f, 0.f}, X##1 = X##0, X##2 = X##0, X##3 = X##0, X##4 = X##0, X##5 = X##0, X##6 = X##0, X##7 = X##0
#define CV_LOAD(X, i_) do { const int e_ = (i_) >> 8, j_ = (i_) & 255; const float* s_ = p.w1 + (size_t)e_ * D * 2 * DFF + (size_t)((j_ >> 4) * 64 + 8 * kg) * (2 * DFF) + (j_ & 15) * 128 + 4 * ngq; \
        X##0 = *(const f32x4*)(s_); X##1 = *(const f32x4*)(s_ + 2 * DFF); X##2 = *(const f32x4*)(s_ + 2 * 2 * DFF); X##3 = *(const f32x4*)(s_ + 3 * 2 * DFF); \
        X##4 = *(const f32x4*)(s_ + 4 * 2 * DFF); X##5 = *(const f32x4*)(s_ + 5 * 2 * DFF); X##6 = *(const f32x4*)(s_ + 6 * 2 * DFF); X##7 = *(const f32x4*)(s_ + 7 * 2 * DFF); } while (0)
#define CV_STORE(X, i_) do { const int e_ = (i_) >> 8, j_ = (i_) & 255; u16* d_ = p.w1T + (size_t)e_ * 2 * DFF * D + (size_t)((j_ & 15) * 128 + 4 * ngq) * 1024 + (j_ >> 4) * 64 + 8 * kg; \
        _Pragma("unroll") for (int c_ = 0; c_ < 4; ++c_) { u32x4 q_; q_.x = pack2(X##0[c_], X##1[c_]); q_.y = pack2(X##2[c_], X##3[c_]); q_.z = pack2(X##4[c_], X##5[c_]); q_.w = pack2(X##6[c_], X##7[c_]); \
            *(u32x4*)(d_ + c_ * 1024) = q_; } } while (0)
                CV_DECL(ra); CV_DECL(rb);
                const int hid = ((int)blockIdx.x - ng) * 2 + (tid >> 8), per = (CV_W1 + st - 1) / st;
                const int i0 = min(hid * per, CV_W1 - 1), ilast = min(i0 + per, CV_W1) - 1;
                const int npair = (per + 1) / 2;
                CV_LOAD(ra, i0);
                for (int k = 0; k < npair; ++k) {
                    const int ia = min(i0 + 2 * k, ilast), ib = min(ia + 1, ilast), ic = min(ib + 1, ilast);
                    CV_LOAD(rb, ib);
                    CV_STORE(ra, ia);
                    CV_LOAD(ra, ic);
                    CV_STORE(rb, ib);
                }
#undef CV_DECL
#undef CV_LOAD
#undef CV_STORE
            }
            {
                const int tid2 = tid_opaque(), lane = tid2 & 63, i16 = lane & 15, g = lane >> 4;
                for (int task = (G - 1 - (int)blockIdx.x) * 8 + (tid2 >> 6); task < T / 16; task += G * 8) {
                    f32x4 z0 = {0.f, 0.f, 0.f, 0.f}, z1 = {0.f, 0.f, 0.f, 0.f};
                    const u16* ar = p.xn + (size_t)(task * 16 + i16) * D + 8 * g;
                    const u16* w0 = p.wzT + (size_t)i16 * D + 8 * g;
                    const u16* w1 = w0 + 16 * D;
#pragma unroll 8
                    for (int ks = 0; ks < 32; ++ks) {
                        const bf16x8 a = *(const bf16x8*)(ar + ks * 32);
                        z0 = __builtin_amdgcn_mfma_f32_16x16x32_bf16(a, *(const bf16x8*)(w0 + ks * 32), z0, 0, 0, 0);
                        z1 = __builtin_amdgcn_mfma_f32_16x16x32_bf16(a, *(const bf16x8*)(w1 + ks * 32), z1, 0, 0, 0);
                    }
#pragma unroll
                    for (int r = 0; r < 4; ++r) {
                        const size_t row = (size_t)task * 16 + 4 * g + r;
                        p.zbuf[row * 32 + i16] = z0[r]; p.zbuf[row * 32 + 16 + i16] = z1[r];
                    }
                }
            }
        } break;
        case PH_MIX1: {
            PHASE_PARAMS();
            const int tid = tid_opaque(), t = tid & 255, half = tid >> 8;
            char* hl = lds + half * HALF_LDS;
#ifndef MIX1_SKIP_GLA_ON_REP
            for (int it0 = blockIdx.x * 2; it0 < N_GLA_ITEMS; it0 += gridDim.x * 2) gla_ds_item(p, hl, t, min(it0 + half, N_GLA_ITEMS - 1));
#else
            if (!rep) for (int it0 = blockIdx.x * 2; it0 < N_GLA_ITEMS; it0 += gridDim.x * 2) gla_ds_item(p, hl, t, min(it0 + half, N_GLA_ITEMS - 1));
#endif
            {
                AttnRegs AR;
                attn_load(p, t, min((int)blockIdx.x * 2 + half, N_ATT_ITEMS - 1), AR);
                for (int it0 = blockIdx.x * 2; it0 < N_ATT_ITEMS; it0 += gridDim.x * 2) {
                    const int nx0 = it0 + gridDim.x * 2;
                    attn_item(p, hl, t, min(it0 + half, N_ATT_ITEMS - 1), nx0 < N_ATT_ITEMS ? min(nx0 + half, N_ATT_ITEMS - 1) : -1, AR);
                }
            }
        } break;
        case PH_MIX2: {
            PHASE_PARAMS();
            const int tid = tid_opaque();
            for (int gid = blockIdx.x * 512 + tid; gid < (1 << 17); gid += gridDim.x * 512) gla_scan_thread2(p, gid);
            for (int gid = blockIdx.x * 512 + tid; gid < T * 64; gid += gridDim.x * 512) attn_combine_thread(p, gid);
        } break;
        case PH_MIX3: {
            PHASE_PARAMS();
            const int tid = tid_opaque(), t = tid & 255, half = tid >> 8;
            char* hl = lds + half * HALF_LDS;
            for (int it0 = blockIdx.x * 2; it0 < N_GLA_ITEMS; it0 += gridDim.x * 2) gla_out_item(p, hl, t, min(it0 + half, N_GLA_ITEMS - 1));
        } break;
        case PH_OUTPROJ: {
            PHASE_PARAMS();
            pg::DenseSched S; S.init(p.mix, p.woT, T, D, gridDim.x, blockIdx.x);
            pg::EpiOut E{p.x, p.x1};
            pg::gemm_phase((LDS_AS unsigned char*)lds, S, E);
        } break;
        case PH_ROUTE: { PHASE_PARAMS(); ph_route(p, lds); } break;
        case PH_MOE1: {
            PHASE_PARAMS();
            int* meta = (int*)(lds + MO_META);
            moe_meta(p, meta);
            pg::MoeSched S{p.xn2, p.w1T, p.lists, (const LDS_AS int*)meta, 8, meta[32 + NE] * 8, (int)gridDim.x, (int)blockIdx.x, true};
            pg::EpiMoe1 E{p.b1, p.act};
            pg::gemm_phase((LDS_AS unsigned char*)lds, S, E);
            {
                const int G = gridDim.x, nun = S.nunits, r = nun % G, nshort = r ? G - r : G, sidx = r ? (int)blockIdx.x - r : (int)blockIdx.x;
                if (sidx >= 0) {
                    const int tid = tid_opaque(), t = tid & 255, hv = tid >> 8;
                    const int per = (W2_LATE + nshort * 2 - 1) / (nshort * 2), ib = (sidx * 2 + hv) * per;
                    for (int i = ib; i < min(ib + per, W2_LATE); ++i) { const int e = i >> 7, j = i & 127; cvt_tile(p.w2 + (size_t)e * DFF * D, D, p.w2T + (size_t)e * D * DFF, (j >> 3) * 64, (j & 7) * 128, t); }
                }
            }
        } break;
        case PH_MOE2: {
            PHASE_PARAMS();
            int* meta = (int*)(lds + MO_META);
            moe_meta(p, meta);
            pg::MoeSched S{p.act, p.w2T, p.lists, (const LDS_AS int*)meta, 4, meta[32 + NE] * 4, (int)gridDim.x, (int)blockIdx.x, false};
            pg::EpiMoe2 E{p.b2, p.gate, p.lists, (const LDS_AS int*)meta, p.y};
            pg::gemm_phase((LDS_AS unsigned char*)lds, S, E);
        } break;
        case PH_FINAL: { PHASE_PARAMS(); ph_final(p); } break;
        default: break;
        }
      }
#ifdef EXTRA_BAR
        if (ph == PH_MIX2) { for (int q = 0; q < EXTRA_BAR; ++q) xcd_barrier(xb); }
#endif
        if (ph + 1 < ph_hi) xcd_barrier(xb);
    }
}


#include <cstdio>
extern "C" void kernel_launch(void* const* d_in, const int* in_sizes, int n_in, void* d_out, int out_size, void* d_ws, size_t ws_size, hipStream_t stream) {
    const float* x = (const float*)d_in[0];
    const float* norm1_g = (const float*)d_in[1];
    const float* w_in = (const float*)d_in[2];
    const float* rel_bias = (const float*)d_in[3];
    const float* wgf = (const float*)d_in[4];
    const float* bgf = (const float*)d_in[5];
    const float* wgb = (const float*)d_in[6];
    const float* bgb = (const float*)d_in[7];
    const float* gla_ng = (const float*)d_in[8];
    const float* w_out = (const float*)d_in[9];
    const float* norm2_g = (const float*)d_in[10];
    const float* router_w = (const float*)d_in[11];
    const float* router_b = (const float*)d_in[12];
    const float* w1 = (const float*)d_in[13];
    const float* b1 = (const float*)d_in[14];
    const float* w2 = (const float*)d_in[15];
    const float* b2 = (const float*)d_in[16];
    const float* final_g = (const float*)d_in[17];
    float* out = (float*)d_out;

    static int grid_blocks = 0;
    if (!grid_blocks) {
        int dev = 0, cus = 0, per_cu = 0;
        hipGetDevice(&dev);
        hipDeviceGetAttribute(&cus, hipDeviceAttributeMultiprocessorCount, dev);
        hipFuncSetAttribute((const void*)mega, hipFuncAttributeMaxDynamicSharedMemorySize, LDS_BYTES);
        hipOccupancyMaxActiveBlocksPerMultiprocessor(&per_cu, mega, 512, LDS_BYTES);
        if (per_cu > 1) per_cu = 1;
        if (per_cu < 1) per_cu = 1;
        grid_blocks = cus * per_cu;
    }

    char* ws = (char*)d_ws;
    size_t off = 0;
    auto take = [&](size_t bytes) { char* p = ws + off; off += (bytes + 255) & ~(size_t)255; return p; };
    Params p{};
    p.x = x; p.g1 = norm1_g; p.w_in = w_in; p.rel_bias = rel_bias; p.wgf = wgf; p.bgf = bgf; p.wgb = wgb; p.bgb = bgb; p.gla_ng = gla_ng;
    p.w_out = w_out; p.g2 = norm2_g; p.rw = router_w; p.rb = router_b; p.w1 = w1; p.b1 = b1; p.w2 = w2; p.b2 = b2; p.gf = final_g; p.out = out;
    p.winT = (u16*)take((size_t)PJW * D * 2);
    p.wzT = (u16*)take((size_t)32 * D * 2);
    p.woT = (u16*)take((size_t)D * D * 2);
    p.w1T = (u16*)take((size_t)NE * 2 * DFF * D * 2);
    p.w2T = (u16*)take((size_t)NE * D * DFF * 2);
    p.zbuf = (float*)take((size_t)T * 32 * 4);
    p.lse = (float*)take((size_t)3 * T * 8 * 4);
    p.dec = (float*)take((size_t)B * GH * 64 * 2 * 64 * 4);
    p.x1 = (float*)take((size_t)T * D * 4);
    p.counts = (int*)take(256);
    p.lists = (int*)take((size_t)NE * T * 4);
    p.gate = (float*)take((size_t)NSLOT * 4);
    p.bar = (unsigned*)take((size_t)XCD_BAR_WORDS * 4);
    p.xn = (u16*)take((size_t)T * D * 2); p.xn2 = p.xn;
    { char* ra = take((size_t)T * PJW * 2 + (size_t)3 * T * 512 * 2);
      p.proj = (u16*)ra; p.abr = (u16*)(ra + (size_t)T * PJW * 2); p.act = (u16*)ra; }
    { char* rb = take((size_t)B * GH * 64 * 2 * 128 * 64 * 4 + (size_t)B * GH * 64 * 2 * 128 * 64 * 2 + (size_t)T * D * 2);
      p.dS = (float*)rb; p.Sp = (u16*)(rb + (size_t)B * GH * 64 * 2 * 128 * 64 * 4); p.mix = (u16*)(rb + (size_t)B * GH * 64 * 2 * 128 * 64 * 4 + (size_t)B * GH * 64 * 2 * 128 * 64 * 2); p.y = (u16*)rb; }

    auto run_fast = [&](int lo, int hi) {
        (void)hipMemsetAsync(p.bar, 0, (size_t)XCD_BAR_WORDS * 4, stream);
        p.ph_lo = lo; p.ph_hi = hi;
        void* args[] = {&p};
        hipError_t e = hipLaunchCooperativeKernel((const void*)mega, dim3(grid_blocks), dim3(512), args, LDS_BYTES, stream);
        if (e != hipSuccess) fprintf(stderr, "cooperative launch failed: %s (grid %d)\n", hipGetErrorString(e), grid_blocks);
    };

    run_fast(PH_PRO, PH_END);

}
```

```cpp
#define STAGE 6
#define REPMASK 0
#include <hip/hip_runtime.h>
#include <stdint.h>

namespace cfg {
constexpr int D = 1024, B = 4, S = 4096, T = B * S;
constexpr int AH = 8;
constexpr int GH = 4;
constexpr int INW = 3104;
constexpr int C_AQ = 0, C_AK = 512, C_AV = 1024, C_GQ = 1536, C_GK = 1792, C_GV = 2048, C_GO = 2560, C_GZ = 3072;
constexpr int NE = 32, DFF = 1024;
constexpr float EPS = 1e-5f;
}
using namespace cfg;

__device__ const unsigned char T5TAB[387] = {
11,11,11,11,11,11,11,11,11,11,11,11,11,11,11,10,10,10,10,10,10,10,10,10,10,10,10,10,10,10,10,10,10,10,10,10,10,10,9,9,9,9,9,9,9,9,9,9,9,9,8,8,8,8,8,8,8,7,6,5,4,3,2,1,0,17,18,19,20,21,22,23,24,24,24,24,24,24,24,25,25,25,25,25,25,25,25,25,25,25,25,26,26,26,26,26,26,26,26,26,26,26,26,26,26,26,26,26,26,26,26,26,26,26,27,27,27,27,27,27,27,27,27,27,27,27,27,27,27,
13,13,13,13,13,13,13,13,13,13,13,13,13,13,13,13,13,13,13,13,13,13,13,12,12,12,12,12,12,12,12,12,12,12,12,12,12,12,12,12,12,12,11,11,11,11,11,11,11,11,11,11,10,10,10,10,10,10,9,9,9,8,8,4,0,20,24,24,25,25,25,26,26,26,26,26,26,27,27,27,27,27,27,27,27,27,27,28,28,28,28,28,28,28,28,28,28,28,28,28,28,28,28,28,28,28,29,29,29,29,29,29,29,29,29,29,29,29,29,29,29,29,29,29,29,29,29,29,29,
15,15,15,15,15,15,15,15,15,15,15,15,15,15,15,15,15,15,15,15,15,15,15,15,15,15,15,15,15,15,14,14,14,14,14,14,14,14,14,14,14,14,14,14,14,13,13,13,13,13,13,13,13,13,12,12,12,12,12,11,11,10,10,9,0,25,26,26,27,27,28,28,28,28,28,29,29,29,29,29,29,29,29,29,30,30,30,30,30,30,30,30,30,30,30,30,30,30,30,31,31,31,31,31,31,31,31,31,31,31,31,31,31,31,31,31,31,31,31,31,31,31,31,31,31,31,31,31,31};

template <int MASK> __device__ __forceinline__ float swz_xor(float v) { return __builtin_bit_cast(float, __builtin_amdgcn_ds_swizzle(__builtin_bit_cast(int, v), (MASK << 10) | 0x1F)); }
__device__ __forceinline__ float half_sum(float v) {
    const auto r = __builtin_amdgcn_permlane32_swap(__builtin_bit_cast(unsigned, v), __builtin_bit_cast(unsigned, v), false, false);
    return __builtin_bit_cast(float, (unsigned)r[0]) + __builtin_bit_cast(float, (unsigned)r[1]);
}
__device__ __forceinline__ float half_max(float v) {
    const auto r = __builtin_amdgcn_permlane32_swap(__builtin_bit_cast(unsigned, v), __builtin_bit_cast(unsigned, v), false, false);
    return fmaxf(__builtin_bit_cast(float, (unsigned)r[0]), __builtin_bit_cast(float, (unsigned)r[1]));
}
__device__ __forceinline__ float wave_sum(float v) {
    v += swz_xor<1>(v); v += swz_xor<2>(v); v += swz_xor<4>(v); v += swz_xor<8>(v); v += swz_xor<16>(v);
    return half_sum(v);
}
__global__ void __launch_bounds__(256) nv_rmsnorm(const float* __restrict__ x, const float* __restrict__ g, float* __restrict__ y, int rows) {
    int row = blockIdx.x * 4 + (threadIdx.x >> 6), lane = threadIdx.x & 63;
    if (row >= rows) return;
    const float* xr = x + (size_t)row * D;
    float v[16]; float ss = 0.f;
#pragma unroll
    for (int i = 0; i < 16; ++i) { v[i] = xr[lane + 64 * i]; ss += v[i] * v[i]; }
    ss = wave_sum(ss);
    float r = rsqrtf(ss * (1.0f / D) + EPS);
#pragma unroll
    for (int i = 0; i < 16; ++i) y[(size_t)row * D + lane + 64 * i] = v[i] * r * g[lane + 64 * i];
}

enum { EPI_STORE = 0, EPI_RESID = 1, EPI_SWIGLU = 2 };
template <int EPI>
__global__ void __launch_bounds__(256) nv_gemm(const float* __restrict__ A, int lda, const int* __restrict__ rowmap, int rshift,
                                               const int* __restrict__ Mptr, int Mfix,
                                               const float* __restrict__ Bm, int ldb, int N, int K,
                                               float* __restrict__ C, int ldc,
                                               const float* __restrict__ aux1, const float* __restrict__ aux2) {
    __shared__ float As[16][68];
    __shared__ float Bs[16][64];
    const int M = Mptr ? *Mptr : Mfix;
    const int m0 = blockIdx.y * 64, n0 = blockIdx.x * 64;
    if (m0 >= M) return;
    const int tid = threadIdx.x, tx = tid & 15, ty = tid >> 4;
    float acc[4][4];
#pragma unroll
    for (int i = 0; i < 4; ++i)
#pragma unroll
        for (int j = 0; j < 4; ++j) acc[i][j] = 0.f;
    const int ar = tid >> 2, ak = (tid & 3) * 4;
    const int arow = m0 + ar; const bool av = arow < M;
    const int srcrow = av ? (rowmap ? (rowmap[arow] >> rshift) : arow) : 0;
    const float* ap = A + (size_t)srcrow * lda + ak;
    const int bk = tid >> 4, bn = (tid & 15) * 4;
    const bool bv = (n0 + bn) < N;
    for (int k0 = 0; k0 < K; k0 += 16) {
        float4 a4 = av ? *(const float4*)(ap + k0) : make_float4(0.f, 0.f, 0.f, 0.f);
        float4 b4 = bv ? *(const float4*)(Bm + (size_t)(k0 + bk) * ldb + n0 + bn) : make_float4(0.f, 0.f, 0.f, 0.f);
        As[ak + 0][ar] = a4.x; As[ak + 1][ar] = a4.y; As[ak + 2][ar] = a4.z; As[ak + 3][ar] = a4.w;
        *(float4*)&Bs[bk][bn] = b4;
        __syncthreads();
#pragma unroll
        for (int kk = 0; kk < 16; ++kk) {
            float4 a = *(const float4*)&As[kk][ty * 4];
            float4 b = *(const float4*)&Bs[kk][tx * 4];
            float aa[4] = {a.x, a.y, a.z, a.w}, bb[4] = {b.x, b.y, b.z, b.w};
#pragma unroll
            for (int i = 0; i < 4; ++i)
#pragma unroll
                for (int j = 0; j < 4; ++j) acc[i][j] = fmaf(aa[i], bb[j], acc[i][j]);
        }
        __syncthreads();
    }
#pragma unroll
    for (int i = 0; i < 4; ++i) {
        const int row = m0 + ty * 4 + i;
        if (row >= M) continue;
        const int col = n0 + tx * 4;
        if (col >= N) continue;
        if (EPI == EPI_STORE) {
#pragma unroll
            for (int j = 0; j < 4; ++j) C[(size_t)row * ldc + col + j] = acc[i][j];
        } else if (EPI == EPI_RESID) {
#pragma unroll
            for (int j = 0; j < 4; ++j) C[(size_t)row * ldc + col + j] = aux1[(size_t)row * ldc + col + j] + acc[i][j];
        } else if (EPI == EPI_SWIGLU) {
#pragma unroll
            for (int j = 0; j < 4; j += 2) {
                float glu = acc[i][j] + aux1[col + j], lin = acc[i][j + 1] + aux1[col + j + 1];
                glu = fminf(glu, 7.0f); lin = fminf(fmaxf(lin, -7.0f), 7.0f);
                float sg = 1.0f / (1.0f + expf(-1.702f * glu));
                C[(size_t)row * ldc + (col + j) / 2] = glu * sg * (lin + 1.0f);
            }
        }
    }
}

__global__ void __launch_bounds__(256) nv_attn(const float* __restrict__ proj, const float* __restrict__ rel_bias, float* __restrict__ mix) {
    const int wid = blockIdx.x * 4 + (threadIdx.x >> 6), lane = threadIdx.x & 63;
    const int h = wid & 7, tok = wid >> 3, b = tok / S, pos = tok % S;
    const float q = proj[(size_t)tok * INW + C_AQ + h * 64 + lane];
    float outs[3], lses[3];
#pragma unroll
    for (int br = 0; br < 3; ++br) {
        const int dil = (br == 0) ? 1 : (br == 1 ? 4 : 16);
        float m = -3.0e38f, l = 0.f, o = 0.f;
        for (int j = -64; j <= 64; ++j) {
            const int kp = pos + j * dil;
            if (kp < 0 || kp >= S) continue;
            const size_t kr = (size_t)(b * S + kp) * INW;
            float d = wave_sum(q * proj[kr + C_AK + h * 64 + lane]);
            float logit = d * 0.125f + rel_bias[T5TAB[br * 129 + j + 64] * AH + h];
            float mn = fmaxf(m, logit);
            float sc = expf(m - mn), p = expf(logit - mn);
            l = l * sc + p; o = o * sc + p * proj[kr + C_AV + h * 64 + lane];
            m = mn;
        }
        outs[br] = o / l; lses[br] = m + logf(l);
    }
    float mm = fmaxf(lses[0], fmaxf(lses[1], lses[2]));
    float w0 = expf(lses[0] - mm), w1 = expf(lses[1] - mm), w2 = expf(lses[2] - mm);
    float ws = w0 + w1 + w2;
    mix[(size_t)tok * D + h * 64 + lane] = (w0 * outs[0] + w1 * outs[1] + w2 * outs[2]) / ws;
}

__global__ void __launch_bounds__(256) nv_la(const float* __restrict__ proj, const float* __restrict__ wgf, const float* __restrict__ bgf,
                                             const float* __restrict__ wgb, const float* __restrict__ bgb, float* __restrict__ ea) {
    const int tok = blockIdx.x, col = threadIdx.x;
#pragma unroll
    for (int dir = 0; dir < 2; ++dir) {
        const float* wg = dir ? wgb : wgf; const float* bg = dir ? bgb : bgf;
        float a = bg[col];
        for (int r = 0; r < 16; ++r) a += proj[(size_t)tok * INW + C_GZ + dir * 16 + r] * wg[r * 256 + col];
        float ls = fminf(a, 0.f) - log1pf(expf(-fabsf(a)));
        ea[((size_t)dir * T + tok) * 256 + col] = expf(ls * (1.0f / 16.0f));
    }
}

__global__ void __launch_bounds__(128) nv_gla(const float* __restrict__ proj, const float* __restrict__ ea, float* __restrict__ og) {
    const int e = threadIdx.x, bhd = blockIdx.x, dir = bhd & 1, h = (bhd >> 1) & 3, b = bhd >> 3;
    float st[64];
#pragma unroll
    for (int d = 0; d < 64; ++d) st[d] = 0.f;
    for (int i = 0; i < S; ++i) {
        const int pos = dir ? (S - 1 - i) : i;
        const size_t tok = (size_t)b * S + pos;
        const float* pr = proj + tok * INW;
        const float* ar = ea + ((size_t)dir * T + tok) * 256 + h * 64;
        const float v = pr[C_GV + h * 128 + e];
        float o = 0.f;
#pragma unroll
        for (int d = 0; d < 64; ++d) {
            st[d] = fmaf(ar[d], st[d], pr[C_GK + h * 64 + d] * v);
            o = fmaf(pr[C_GQ + h * 64 + d] * 0.125f, st[d], o);
        }
        og[((size_t)dir * T + tok) * 512 + h * 128 + e] = o;
    }
}

__global__ void __launch_bounds__(256) nv_gla_out(const float* __restrict__ proj, const float* __restrict__ og, const float* __restrict__ ng, float* __restrict__ mix) {
    const int wid = blockIdx.x * 4 + (threadIdx.x >> 6), lane = threadIdx.x & 63;
    const int h = wid & 3, tok = wid >> 2;
    float o0 = og[(size_t)tok * 512 + h * 128 + lane] + og[((size_t)T + tok) * 512 + h * 128 + lane];
    float o1 = og[(size_t)tok * 512 + h * 128 + 64 + lane] + og[((size_t)T + tok) * 512 + h * 128 + 64 + lane];
    float ss = wave_sum(o0 * o0 + o1 * o1);
    float r = rsqrtf(ss * (1.0f / 128.0f) + EPS);
    float g0 = proj[(size_t)tok * INW + C_GO + h * 128 + lane], g1 = proj[(size_t)tok * INW + C_GO + h * 128 + 64 + lane];
    mix[(size_t)tok * D + 512 + h * 128 + lane] = o0 * r * ng[h * 128 + lane] * (g0 / (1.0f + expf(-g0)));
    mix[(size_t)tok * D + 512 + h * 128 + 64 + lane] = o1 * r * ng[h * 128 + 64 + lane] * (g1 / (1.0f + expf(-g1)));
}

__global__ void __launch_bounds__(256) nv_route(const float* __restrict__ x1, const float* __restrict__ g2, const float* __restrict__ rw, const float* __restrict__ rb,
                                                float* __restrict__ xn2, int* __restrict__ topi, float* __restrict__ gate) {
    __shared__ float xs[4][1024];
    __shared__ float lg[4][32];
    const int w = threadIdx.x >> 6, lane = threadIdx.x & 63, tok = blockIdx.x * 4 + w;
    const float* xr = x1 + (size_t)tok * D;
    float v[16]; float ss = 0.f;
#pragma unroll
    for (int i = 0; i < 16; ++i) { v[i] = xr[lane + 64 * i]; ss += v[i] * v[i]; }
    ss = wave_sum(ss);
    const float r = rsqrtf(ss * (1.0f / D) + EPS);
#pragma unroll
    for (int i = 0; i < 16; ++i) { float y = v[i] * r * g2[lane + 64 * i]; xs[w][lane + 64 * i] = y; xn2[(size_t)tok * D + lane + 64 * i] = y; }
    __syncthreads();
    const int e = lane & 31, half = lane >> 5;
    float a = 0.f;
    for (int k = half * 512; k < half * 512 + 512; ++k) a = fmaf(xs[w][k], rw[k * 32 + e], a);
    a += __shfl_xor(a, 32);
    if (lane < 32) lg[w][lane] = a + rb[lane];
    __syncthreads();
    if (lane == 0) {
        float bv[4]; int bi[4];
        unsigned used = 0u;
#pragma unroll
        for (int k = 0; k < 4; ++k) {
            float best = -3.0e38f; int bidx = 0;
            for (int j = 0; j < 32; ++j) { float x = lg[w][j]; if (!((used >> j) & 1u) && x > best) { best = x; bidx = j; } }
            used |= 1u << bidx; bv[k] = best; bi[k] = bidx;
        }
        float e0 = 1.0f, e1 = expf(bv[1] - bv[0]), e2 = expf(bv[2] - bv[0]), e3 = expf(bv[3] - bv[0]);
        float s = e0 + e1 + e2 + e3;
        topi[tok * 4 + 0] = bi[0]; topi[tok * 4 + 1] = bi[1]; topi[tok * 4 + 2] = bi[2]; topi[tok * 4 + 3] = bi[3];
        gate[tok * 4 + 0] = e0 / s; gate[tok * 4 + 1] = e1 / s; gate[tok * 4 + 2] = e2 / s; gate[tok * 4 + 3] = e3 / s;
    }
}

__global__ void nv_lists(const int* __restrict__ topi, int* __restrict__ lists, int* __restrict__ counts) {
    const int e = threadIdx.x;
    int c = 0;
    for (int s = 0; s < T * 4; ++s) if (topi[s] == e) lists[e * T + c++] = s;
    counts[e] = c;
}

__global__ void __launch_bounds__(256) nv_moe2(const float* __restrict__ A, const int* __restrict__ slots, const int* __restrict__ Mptr,
                                               const float* __restrict__ Bm, float* __restrict__ x2, const float* __restrict__ b2, const float* __restrict__ gate) {
    __shared__ float As[16][68];
    __shared__ float Bs[16][64];
    const int M = *Mptr;
    const int m0 = blockIdx.y * 64, n0 = blockIdx.x * 64;
    if (m0 >= M) return;
    const int tid = threadIdx.x, tx = tid & 15, ty = tid >> 4;
    float acc[4][4];
#pragma unroll
    for (int i = 0; i < 4; ++i)
#pragma unroll
        for (int j = 0; j < 4; ++j) acc[i][j] = 0.f;
    const int ar = tid >> 2, ak = (tid & 3) * 4;
    const int arow = m0 + ar; const bool av = arow < M;
    const float* ap = A + (size_t)(av ? arow : 0) * DFF + ak;
    const int bk = tid >> 4, bn = (tid & 15) * 4;
    for (int k0 = 0; k0 < DFF; k0 += 16) {
        float4 a4 = av ? *(const float4*)(ap + k0) : make_float4(0.f, 0.f, 0.f, 0.f);
        float4 b4 = *(const float4*)(Bm + (size_t)(k0 + bk) * D + n0 + bn);
        As[ak + 0][ar] = a4.x; As[ak + 1][ar] = a4.y; As[ak + 2][ar] = a4.z; As[ak + 3][ar] = a4.w;
        *(float4*)&Bs[bk][bn] = b4;
        __syncthreads();
#pragma unroll
        for (int kk = 0; kk < 16; ++kk) {
            float4 a = *(const float4*)&As[kk][ty * 4];
            float4 b = *(const float4*)&Bs[kk][tx * 4];
            float aa[4] = {a.x, a.y, a.z, a.w}, bb[4] = {b.x, b.y, b.z, b.w};
#pragma unroll
            for (int i = 0; i < 4; ++i)
#pragma unroll
                for (int j = 0; j < 4; ++j) acc[i][j] = fmaf(aa[i], bb[j], acc[i][j]);
        }
        __syncthreads();
    }
#pragma unroll
    for (int i = 0; i < 4; ++i) {
        const int row = m0 + ty * 4 + i;
        if (row >= M) continue;
        const int col = n0 + tx * 4;
        const int slot = slots[row]; const int tok = slot >> 2; const float gt = gate[slot];
#pragma unroll
        for (int j = 0; j < 4; ++j) x2[(size_t)tok * D + col + j] += gt * (acc[i][j] + b2[col + j]);
    }
}


#include <hip/hip_cooperative_groups.h>
namespace cg = cooperative_groups;

typedef unsigned short u16;
typedef short bf16x8 __attribute__((ext_vector_type(8)));
typedef short s16x4 __attribute__((ext_vector_type(4)));
typedef float f32x4 __attribute__((ext_vector_type(4)));
typedef unsigned u32x4 __attribute__((ext_vector_type(4)));
typedef __bf16 bfv2 __attribute__((ext_vector_type(2)));
typedef float fv2 __attribute__((ext_vector_type(2)));
#define LDS_AS __attribute__((address_space(3)))

constexpr int LDS_BYTES = 160 * 1024;
constexpr int HALF_LDS = 80 * 1024;
constexpr int NSLOT = T * 4;
constexpr int PJW = 3072;
#ifndef REPMASK
#define REPMASK 0
#endif

struct Params {
    const float *x, *g1, *w_in, *rel_bias, *wgf, *bgf, *wgb, *bgb, *gla_ng, *w_out, *g2, *rw, *rb, *w1, *b1, *w2, *b2, *gf;
    float* out;
    u16* winT;
    u16* wzT;
    u16* woT;
    u16* w1T;
    u16* w2T;
    u16* xn;
    u16* proj;
    float* zbuf;
    u16* abr;
    float* lse;
    float* dS;
    float* dec;
    u16* Sp;
    u16* mix;
    float* x1;
    u16* xn2;
    int* counts;
    int* lists;
    float* gate;
    u16* act;
    u16* y;
    unsigned char* xn28;
    unsigned char* w1T8;
    unsigned char* act8;
    unsigned char* w2T8;
    unsigned* bar;
    int ph_lo, ph_hi;
};

__device__ __forceinline__ int tid_opaque() { int t = threadIdx.x; asm volatile("" : "+v"(t)); return t; }
__device__ __forceinline__ float bf2f(u16 v) { return __uint_as_float((unsigned)v << 16); }
__device__ __forceinline__ unsigned pack2(float a, float b) {
    fv2 v = {a, b};
    bfv2 r = __builtin_convertvector(v, bfv2);
    return __builtin_bit_cast(unsigned, r);
}
__device__ __forceinline__ u16 f2bf(float a) { return (u16)(pack2(a, 0.f) & 0xffffu); }
__device__ __forceinline__ float lo2f(unsigned u) { return __uint_as_float(u << 16); }
__device__ __forceinline__ float hi2f(unsigned u) { return __uint_as_float(u & 0xffff0000u); }
__device__ __forceinline__ int tile_off(int row, int chunk) { return row * 128 + ((chunk ^ (row & 7)) << 4); }
__device__ __forceinline__ bf16x8 lds_frag(const char* base, int row, int chunk) { return *(const bf16x8*)(base + tile_off(row, chunk)); }
__device__ __forceinline__ s16x4 tr_read(const char* p) {
    return __builtin_amdgcn_ds_read_tr16_b64_v4i16((LDS_AS s16x4*)(p));
}
__device__ __forceinline__ bf16x8 cat4(s16x4 a, s16x4 b) { bf16x8 r = {a[0], a[1], a[2], a[3], b[0], b[1], b[2], b[3]}; return r; }
__device__ __forceinline__ float logsig(float a) { return fminf(a, 0.f) - log1pf(expf(-fabsf(a))); }

__device__ __forceinline__ void cvt_tile(const float* __restrict__ src, int ldsrc, u16* __restrict__ dst, int k0, int n0, int t) {
    const int l = t & 63, w = t >> 6, kg = l & 7, ng = w * 8 + (l >> 3);
    const float* s = src + (size_t)(k0 + 8 * kg) * ldsrc + n0 + 4 * ng;
    float4 bv[8];
#pragma unroll
    for (int j = 0; j < 8; ++j) bv[j] = *(const float4*)(s + (size_t)j * ldsrc);
    u16* d = dst + (size_t)(n0 + 4 * ng) * 1024 + k0 + 8 * kg;
    uint4 q;
    q.x = pack2(bv[0].x, bv[1].x); q.y = pack2(bv[2].x, bv[3].x); q.z = pack2(bv[4].x, bv[5].x); q.w = pack2(bv[6].x, bv[7].x);
    *(uint4*)(d) = q;
    q.x = pack2(bv[0].y, bv[1].y); q.y = pack2(bv[2].y, bv[3].y); q.z = pack2(bv[4].y, bv[5].y); q.w = pack2(bv[6].y, bv[7].y);
    *(uint4*)(d + 1024) = q;
    q.x = pack2(bv[0].z, bv[1].z); q.y = pack2(bv[2].z, bv[3].z); q.z = pack2(bv[4].z, bv[5].z); q.w = pack2(bv[6].z, bv[7].z);
    *(uint4*)(d + 2048) = q;
    q.x = pack2(bv[0].w, bv[1].w); q.y = pack2(bv[2].w, bv[3].w); q.z = pack2(bv[4].w, bv[5].w); q.w = pack2(bv[6].w, bv[7].w);
    *(uint4*)(d + 3072) = q;
}
struct CvtRegs { f32x4 bv[8]; };
__device__ __forceinline__ void cvt_load(const float* __restrict__ src, int ldsrc, int k0, int n0, int t, CvtRegs& R) {
    const int l = t & 63, w = t >> 6, kg = l & 7, ng = w * 8 + (l >> 3);
    const float* s = src + (size_t)(k0 + 8 * kg) * ldsrc + n0 + 4 * ng;
#pragma unroll
    for (int j = 0; j < 8; ++j) R.bv[j] = *(const f32x4*)(s + (size_t)j * ldsrc);
}
__device__ __forceinline__ void cvt_store(u16* __restrict__ dst, int k0, int n0, int t, const CvtRegs& R) {
    const int l = t & 63, w = t >> 6, kg = l & 7, ng = w * 8 + (l >> 3);
    u16* d = dst + (size_t)(n0 + 4 * ng) * 1024 + k0 + 8 * kg;
#pragma unroll
    for (int c = 0; c < 4; ++c) {
        u32x4 q;
        q.x = pack2(R.bv[0][c], R.bv[1][c]); q.y = pack2(R.bv[2][c], R.bv[3][c]); q.z = pack2(R.bv[4][c], R.bv[5][c]); q.w = pack2(R.bv[6][c], R.bv[7][c]);
        *(u32x4*)(d + c * 1024) = q;
    }
}
__device__ __forceinline__ void w1_load(const Params& p, int i, int t, CvtRegs& R) { const int e = i >> 8, j = i & 255; cvt_load(p.w1 + (size_t)e * D * 2 * DFF, 2 * DFF, (j >> 4) * 64, (j & 15) * 128, t, R); }
__device__ __forceinline__ void w1_store(const Params& p, int i, int t, const CvtRegs& R) { const int e = i >> 8, j = i & 255; cvt_store(p.w1T + (size_t)e * 2 * DFF * D, (j >> 4) * 64, (j & 15) * 128, t, R); }
constexpr int CV_WIN = 384, CV_WZ = 1, CV_WO = 128, CV_W1 = NE * 256, CV_W2 = NE * 128;
constexpr int CV_TOTAL = CV_WIN + CV_WZ + CV_WO + CV_W1 + CV_W2;
constexpr int W2_LATE = 4096;
__device__ __forceinline__ void cvt_tile8(const float* __restrict__ src, int ldsrc, unsigned char* __restrict__ dst, int k0, int n0, int t) {
    const int l = t & 63, w = t >> 6, kg = l & 7, ng = w * 8 + (l >> 3);
    const float* s = src + (size_t)(k0 + 8 * kg) * ldsrc + n0 + 4 * ng;
    f32x4 bv[8];
#pragma unroll
    for (int j = 0; j < 8; ++j) bv[j] = *(const f32x4*)(s + (size_t)j * ldsrc) * 32.0f;
    unsigned char* d = dst + (size_t)(n0 + 4 * ng) * 1024 + k0 + 8 * kg;
#pragma unroll
    for (int c = 0; c < 4; ++c) {
        int lo = __builtin_amdgcn_cvt_pk_fp8_f32(bv[0][c], bv[1][c], 0, false); lo = __builtin_amdgcn_cvt_pk_fp8_f32(bv[2][c], bv[3][c], lo, true);
        int hi = __builtin_amdgcn_cvt_pk_fp8_f32(bv[4][c], bv[5][c], 0, false); hi = __builtin_amdgcn_cvt_pk_fp8_f32(bv[6][c], bv[7][c], hi, true);
        uint2 q; q.x = (unsigned)lo; q.y = (unsigned)hi;
        *(uint2*)(d + c * 1024) = q;
    }
}
#ifndef NCONV
#define NCONV 102
#endif
__device__ void ph_prologue(const Params& p) {
    const int tid = tid_opaque();
    if (blockIdx.x == 0 && tid < 32) p.counts[tid] = 0;
    {
        const int lane = tid & 63, gw = blockIdx.x * 8 + (tid >> 6), nw = gridDim.x * 8;
        for (int row = gw; row < T; row += nw) {
            const float4* xr = (const float4*)(p.x + (size_t)row * D);
            float4 v[4]; float ss = 0.f;
#pragma unroll
            for (int i = 0; i < 4; ++i) { v[i] = xr[lane + 64 * i]; ss += v[i].x * v[i].x + v[i].y * v[i].y + v[i].z * v[i].z + v[i].w * v[i].w; }
            ss = wave_sum(ss);
            const float r = rsqrtf(ss * (1.0f / D) + EPS);
#pragma unroll
            for (int i = 0; i < 4; ++i) {
                const float4 g = ((const float4*)p.g1)[lane + 64 * i];
                uint2 o; o.x = pack2(v[i].x * r * g.x, v[i].y * r * g.y); o.y = pack2(v[i].z * r * g.z, v[i].w * r * g.w);
                *(uint2*)(p.xn + (size_t)row * D + (lane + 64 * i) * 4) = o;
            }
        }
    }
    const int t = tid & 255, vb = blockIdx.x * 2 + (tid >> 8), nvb = gridDim.x * 2;
    for (int it = vb; it < CV_TOTAL; it += nvb) {
        int i = it;
        if (i < CV_WIN) { cvt_tile(p.w_in, INW, p.winT, (i / 24) * 64, (i % 24) * 128, t); continue; }
        i -= CV_WIN;
        if (i < CV_WZ) {
            for (int c = t; c < 32 * 128; c += 256) {
                const int n = c >> 7, k8 = (c & 127) * 8;
                const float* s = p.w_in + (size_t)k8 * INW + PJW + n;
                uint4 q;
                q.x = pack2(s[0], s[INW]); q.y = pack2(s[2 * INW], s[3 * INW]); q.z = pack2(s[4 * INW], s[5 * INW]); q.w = pack2(s[6 * INW], s[7 * INW]);
                *(uint4*)(p.wzT + (size_t)n * 1024 + k8) = q;
            }
            continue;
        }
        i -= CV_WZ;
        if (i < CV_WO) { cvt_tile(p.w_out, D, p.woT, (i >> 3) * 64, (i & 7) * 128, t); continue; }
        i -= CV_WO;
        if (i < CV_W1) continue;
        i -= CV_W1;
        if (i >= W2_LATE) { const int e = i >> 7, j = i & 127; cvt_tile(p.w2 + (size_t)e * DFF * D, D, p.w2T + (size_t)e * D * DFF, (j >> 3) * 64, (j & 7) * 128, t); }
    }
}

namespace pg {
constexpr int BM = 256, BK = 64, HALF = 128, HTB = HALF * BK * 2, KD = 1024;
__host__ __device__ __forceinline__ int lds_byte(int r, int c) { const int st = (r >> 4) * 2 + (c >> 5), rr = r & 15, cc = c & 31, ob = rr * 64 + cc * 2; return st * 1024 + (ob ^ (((ob >> 9) & 1) << 5)); }
__host__ __device__ __forceinline__ void stage_rc(int b, int& R, int& C) { const int st = b / 1024, sb = b % 1024, swz = sb ^ (((sb >> 9) & 1) << 5); R = (st >> 1) * 16 + swz / 64; C = (st & 1) * 32 + (swz % 64) / 2; }
__host__ __device__ __forceinline__ int perm32(int rho) { const int n = rho >> 4, i = rho & 15; return 8 * (i >> 2) + 4 * n + (i & 3); }

struct Unit { int pn, row0, nvalid, e, ord; };

typedef int v8i32 __attribute__((ext_vector_type(8)));
template <class Epi, class Sched, bool FP8 = false>
__device__ __forceinline__ void gemm_phase(LDS_AS unsigned char* lds, const Sched& S, const Epi& E) {
    const int tid = tid_opaque(), wid = __builtin_amdgcn_readfirstlane(tid >> 6), lane = tid & 63, wr = wid >> 2, wc = wid & 3, fr = lane & 15, fq = lane >> 4;
    constexpr int ROWB = FP8 ? KD : KD * 2;
    constexpr int nt = FP8 ? KD / 128 : KD / BK;
    int R0, C0; stage_rc(tid * 16, R0, C0);
    unsigned voffB[2];
#pragma unroll
    for (int i = 0; i < 2; ++i) { const int R = R0 + 64 * i; const int Rb = Epi::PERM ? ((R & ~31) + perm32(R & 31)) : R; voffB[i] = (unsigned)(Rb * ROWB + C0 * 2); }
    const size_t kstep = (size_t)(BK * 2);
    const size_t hstep = (size_t)HALF * ROWB;
    const unsigned ldsw = (unsigned)wid * 1024u;
    const int aoff = lds_byte(wr * 64 + fr, fq * 8), boff = lds_byte(wc * 32 + fr, fq * 8);
    const int aoff8a = lds_byte(wr * 64 + fr, fq * 16), boff8a = lds_byte(wc * 32 + fr, fq * 16);
#define PG_SA(b, h) (((b) * 2 + (h)) * HTB)
#define PG_SB(b, h) ((4 + (b) * 2 + (h)) * HTB)
#define PG_STAGE_B(bufoff, gbase) do { _Pragma("unroll") for (int _i = 0; _i < 2; ++_i) \
        __builtin_amdgcn_global_load_lds((const unsigned*)((const char*)(gbase) + voffB[_i]), (LDS_AS unsigned*)(lds + (bufoff) + ldsw + _i * 8192), 16, 0, 0); } while (0)
#define PG_STAGE_A(bufoff, o0, o1) do { \
        __builtin_amdgcn_global_load_lds((const unsigned*)(Abase + (o0)), (LDS_AS unsigned*)(lds + (bufoff) + ldsw), 16, 0, 0); \
        __builtin_amdgcn_global_load_lds((const unsigned*)(Abase + (o1)), (LDS_AS unsigned*)(lds + (bufoff) + ldsw + 8192), 16, 0, 0); } while (0)
#define PG_LDA16(dst, b, h) do { _Pragma("unroll") for (int m = 0; m < 4; ++m) _Pragma("unroll") for (int k = 0; k < 2; ++k) dst[m][k] = *(const LDS_AS bf16x8*)(lds + PG_SA(b, h) + aoff + m * 2048 + k * 1024); } while (0)
#define PG_LDB16(dst, b, h) do { _Pragma("unroll") for (int n = 0; n < 2; ++n) _Pragma("unroll") for (int k = 0; k < 2; ++k) dst[n][k] = *(const LDS_AS bf16x8*)(lds + PG_SB(b, h) + boff + n * 2048 + k * 1024); } while (0)
#define PG_RD16(off) __builtin_bit_cast(u32x4, *(const LDS_AS bf16x8*)(lds + (off)))
#define PG_LDA8(dst, b, h) do { _Pragma("unroll") for (int m = 0; m < 4; ++m) dst##8[m] = __builtin_bit_cast(v8i32, __builtin_shufflevector(PG_RD16(PG_SA(b, h) + aoff8a + m * 2048), PG_RD16(PG_SA(b, h) + aoff8a + 16 + m * 2048), 0, 1, 2, 3, 4, 5, 6, 7)); } while (0)
#define PG_LDB8(dst, b, h) do { _Pragma("unroll") for (int n = 0; n < 2; ++n) dst##8[n] = __builtin_bit_cast(v8i32, __builtin_shufflevector(PG_RD16(PG_SB(b, h) + boff8a + n * 2048), PG_RD16(PG_SB(b, h) + boff8a + 16 + n * 2048), 0, 1, 2, 3, 4, 5, 6, 7)); } while (0)
#define PG_LDA(dst, b, h) do { if constexpr (FP8) PG_LDA8(dst, b, h); else PG_LDA16(dst, b, h); } while (0)
#define PG_LDB(dst, b, h) do { if constexpr (FP8) PG_LDB8(dst, b, h); else PG_LDB16(dst, b, h); } while (0)
#define PG_MMA(ai, bj, At, Bt) do { __builtin_amdgcn_s_setprio(1); _Pragma("unroll") for (int m = 0; m < 4; ++m) _Pragma("unroll") for (int n = 0; n < 2; ++n) { \
        if constexpr (FP8) asm volatile("v_mfma_scale_f32_16x16x128_f8f6f4 %0, %1, %2, %0, %3, %4 op_sel_hi:[0,0,0]" : "+v"(acc[ai][bj][m][n]) : "v"(Bt##8[n]), "v"(At##8[m]), "v"(sclA), "v"(sclA)); \
        else { _Pragma("unroll") for (int k = 0; k < 2; ++k) acc[ai][bj][m][n] = __builtin_amdgcn_mfma_f32_16x16x32_bf16(Bt[n][k], At[m][k], acc[ai][bj][m][n], 0, 0, 0); } } \
        __builtin_amdgcn_s_setprio(0); } while (0)
#define PG_WAIT_V(n) asm volatile("s_waitcnt vmcnt(" #n ")" ::: "memory")
#define PG_WAIT_L(n) asm volatile("s_waitcnt lgkmcnt(" #n ")" ::: "memory")
#define PG_BAR __builtin_amdgcn_s_barrier()
#define PG_SCHED __builtin_amdgcn_sched_barrier(0)
    Unit cur, nxt; int ui = 0;
    if (!S.next(0, cur)) return;
    f32x4 acc[2][2][4][2];
    E.init(acc, cur, wr, wc, fr, fq);
    bf16x8 At[4][2], B0[2][2], B1[2][2];
    v8i32 At8[4], B08[2], B18[2];
    int sclA = 0x7F7F7F7F;
    asm volatile("" : "+v"(sclA));
    const char* Abase = (const char*)S.A;
    unsigned c00 = S.rowoff(cur, R0) + C0 * 2u, c01 = S.rowoff(cur, R0 + 64) + C0 * 2u, c10 = S.rowoff(cur, R0 + 128) + C0 * 2u, c11 = S.rowoff(cur, R0 + 192) + C0 * 2u;
    const char* cB = S.bbase(cur);
    PG_STAGE_B(PG_SB(0, 0), cB); PG_STAGE_A(PG_SA(0, 0), c00, c01); PG_STAGE_B(PG_SB(0, 1), cB + hstep); PG_STAGE_A(PG_SA(0, 1), c10, c11);
    if (wr == 1) PG_BAR;
    PG_WAIT_V(4); PG_BAR;
    PG_STAGE_B(PG_SB(1, 0), cB + kstep); PG_STAGE_A(PG_SA(1, 0), c00 + 128u, c01 + 128u); PG_STAGE_B(PG_SB(1, 1), cB + hstep + kstep);
    PG_WAIT_V(6); PG_BAR;
    for (;;) {
        const bool has_next = S.next(ui + 1, nxt);
        const char* nB = has_next ? S.bbase(nxt) : cB;
        unsigned dnx = 0u;
        if constexpr (Sched::LINEAR) { if (has_next) dnx = S.rowoff(nxt, 0) - S.rowoff(cur, 0); }

#pragma unroll 1
        for (int t = 0; t < nt; t += 2) {
            const bool last = (t == nt - 2);
            const unsigned k1 = (unsigned)(t + 1) * 128u, k2 = last ? 0u : (unsigned)(t + 2) * 128u, k3 = k2 + 128u;
            unsigned a2_00, a2_01, a2_10, a2_11, a3_00, a3_01;
            if constexpr (Sched::LINEAR) { const unsigned dl = last ? dnx : 0u; a2_00 = c00 + dl + k2; a2_01 = c01 + dl + k2; a2_10 = c10 + dl + k2; a2_11 = c11 + dl + k2; a3_00 = c00 + dl + k3; a3_01 = c01 + dl + k3; }
            else {
                a2_00 = c00; a2_01 = c01; a2_10 = c10; a2_11 = c11;
                if (last && has_next) { a2_00 = S.rowoff(nxt, R0) + C0 * 2u; a2_01 = S.rowoff(nxt, R0 + 64) + C0 * 2u; a2_10 = S.rowoff(nxt, R0 + 128) + C0 * 2u; a2_11 = S.rowoff(nxt, R0 + 192) + C0 * 2u; }
                a3_00 = a2_00 + k3; a3_01 = a2_01 + k3; a2_00 += k2; a2_01 += k2; a2_10 += k2; a2_11 += k2;
            }
            const char* b2 = last ? nB : cB + (size_t)(t + 2) * kstep;
            const char* b3 = b2 + kstep;
            PG_LDB(B0, 0, 0); PG_SCHED; PG_LDA(At, 0, 0); PG_STAGE_A(PG_SA(1, 1), c10 + k1, c11 + k1);
            PG_WAIT_L(8); PG_BAR; PG_WAIT_L(0); PG_MMA(0, 0, At, B0); PG_BAR; PG_SCHED;
            PG_LDB(B1, 0, 1); PG_STAGE_B(PG_SB(0, 0), b2);
            PG_BAR; PG_WAIT_L(0); PG_MMA(0, 1, At, B1); PG_BAR;
            PG_LDA(At, 0, 1); PG_STAGE_A(PG_SA(0, 0), a2_00, a2_01);
            PG_BAR; PG_WAIT_L(0); PG_MMA(1, 0, At, B0); PG_BAR; PG_SCHED;
            PG_STAGE_B(PG_SB(0, 1), b2 + hstep);
            PG_WAIT_V(6); PG_BAR; PG_MMA(1, 1, At, B1); PG_BAR;
            PG_LDB(B0, 1, 0); PG_SCHED; PG_LDA(At, 1, 0); PG_STAGE_A(PG_SA(0, 1), a2_10, a2_11);
            PG_WAIT_L(8); PG_BAR; PG_WAIT_L(0); PG_MMA(0, 0, At, B0); PG_BAR; PG_SCHED;
            PG_LDB(B1, 1, 1); PG_STAGE_B(PG_SB(1, 0), b3);
            PG_BAR; PG_WAIT_L(0); PG_MMA(0, 1, At, B1); PG_BAR;
            PG_LDA(At, 1, 1); PG_STAGE_A(PG_SA(1, 0), a3_00, a3_01);
            PG_BAR; PG_WAIT_L(0); PG_MMA(1, 0, At, B0); PG_BAR; PG_SCHED;
            PG_STAGE_B(PG_SB(1, 1), b3 + hstep);
            PG_WAIT_V(6); PG_BAR; PG_MMA(1, 1, At, B1); PG_BAR;
        }
        E(acc, cur, wr, wc, fr, fq);
        if (!has_next) break;
        E.init(acc, nxt, wr, wc, fr, fq);
        if constexpr (Sched::LINEAR) { c00 += dnx; c01 += dnx; c10 += dnx; c11 += dnx; }
        else { c00 = S.rowoff(nxt, R0) + C0 * 2u; c01 = S.rowoff(nxt, R0 + 64) + C0 * 2u; c10 = S.rowoff(nxt, R0 + 128) + C0 * 2u; c11 = S.rowoff(nxt, R0 + 192) + C0 * 2u; }
        cur = nxt; cB = nB; ++ui;
    }
    PG_WAIT_V(0);
    if (wr == 0) PG_BAR;
    PG_BAR;
#undef PG_SA
#undef PG_SB
#undef PG_STAGE_A
#undef PG_STAGE_B
#undef PG_LDA
#undef PG_LDB
#undef PG_LDA8
#undef PG_LDB8
#undef PG_LDA16
#undef PG_LDB16
#undef PG_RD16
#undef PG_MMA
#undef PG_WAIT_V
#undef PG_WAIT_L
#undef PG_BAR
#undef PG_SCHED
}

struct DenseSched {
    static constexpr bool LINEAR = true;
    const u16* A; const u16* Bt; int nM, nN, nwg, G, c;
    __device__ void init(const u16* A_, const u16* Bt_, int M, int N, int G_, int c_) { A = A_; Bt = Bt_; nM = M / BM; nN = N / BM; nwg = nM * nN; G = G_; c = c_; }
    __device__ __forceinline__ bool next(int i, Unit& u) const {
        const int L = i * G + c; if (L >= nwg) return false;
        int wgid = L; { const int q = nwg / 8, r = nwg % 8, xcd = wgid % 8, off = wgid / 8; wgid = (xcd < r ? xcd * (q + 1) : r * (q + 1) + (xcd - r) * q) + off; }
        const int nig = 8 * nN, gid = wgid / nig, fm = gid * 8, gsz = (nM - fm) < 8 ? (nM - fm) : 8;
        u.row0 = (fm + ((wgid % nig) % gsz)) * BM; u.pn = (wgid % nig) / gsz; u.nvalid = BM; u.e = 0; u.ord = i; return true;
    }
    __device__ __forceinline__ unsigned rowoff(const Unit& u, int r) const { return (unsigned)(u.row0 + r) * (unsigned)(KD * 2); }
    __device__ __forceinline__ const char* bbase(const Unit& u) const { return (const char*)Bt + (size_t)u.pn * BM * KD * 2; }
};

template <bool GATHER> struct MoeSchedT {
    static constexpr bool LINEAR = !GATHER;
    const u16* A; const u16* Bt; const int* lists; const LDS_AS int* meta; int NT, nunits, G, c; int rowb; const LDS_AS unsigned* rowtab;
    __device__ __forceinline__ bool next(int i, Unit& u) const {
        const int L = i * G + c; if (L >= nunits) return false;
        int wgid = L; { const int q = nunits / 8, r = nunits % 8, xcd = wgid % 8, off = wgid / 8; wgid = (xcd < r ? xcd * (q + 1) : r * (q + 1) + (xcd - r) * q) + off; }
        const int gm = wgid / NT; u.pn = wgid % NT;
        int e = 0;
        while (meta[32 + e + 1] <= gm) ++e;
        const int mi = gm - meta[32 + e];
        u.e = e; u.row0 = meta[72 + e] + mi * BM; u.nvalid = min(BM, meta[e] - mi * BM); u.ord = i;
        return true;
    }
    __device__ __forceinline__ unsigned rowoff(const Unit& u, int r) const {
        if constexpr (GATHER) return rowtab[u.ord * BM + r];
        else return (unsigned)(u.row0 + r) * (unsigned)rowb;
    }
    __device__ __forceinline__ const char* bbase(const Unit& u) const { return (const char*)Bt + ((size_t)u.e * NT + u.pn) * BM * (size_t)rowb; }
};

struct EpiProj {
    static constexpr int SCALE_A = 0x7F7F7F7F, SCALE_B = 0x7F7F7F7F;
    static constexpr bool PERM = true;
    u16* O;
    __device__ __forceinline__ void init(f32x4 (&acc)[2][2][4][2], const Unit&, int, int, int, int) const {
#pragma unroll
        for (int a = 0; a < 2; ++a)
#pragma unroll
            for (int b = 0; b < 2; ++b)
#pragma unroll
                for (int m = 0; m < 4; ++m)
#pragma unroll
                    for (int n = 0; n < 2; ++n) acc[a][b][m][n] = (f32x4){0.f, 0.f, 0.f, 0.f};
    }
    __device__ __forceinline__ void operator()(const f32x4 (&acc)[2][2][4][2], const Unit& u, int wr, int wc, int fr, int fq) const {
        const int row0 = u.row0 + wr * 64 + fr, col0 = u.pn * BM + wc * 32 + 8 * fq;
#pragma unroll
        for (int ai = 0; ai < 2; ++ai)
#pragma unroll
            for (int m = 0; m < 4; ++m) { u16* rowp = O + (size_t)(row0 + ai * HALF + m * 16) * PJW + col0;
#pragma unroll
                for (int bj = 0; bj < 2; ++bj) { const f32x4 v0 = acc[ai][bj][m][0], v1 = acc[ai][bj][m][1];
                    u32x4 w; w.x = pack2(v0[0], v0[1]); w.y = pack2(v0[2], v0[3]); w.z = pack2(v1[0], v1[1]); w.w = pack2(v1[2], v1[3]);
                    *(u32x4*)(rowp + bj * HALF) = w; } }
    }
};
struct EpiOut {
    static constexpr int SCALE_A = 0x7F7F7F7F, SCALE_B = 0x7F7F7F7F;
    static constexpr bool PERM = false;
    const float* X; float* C;
    __device__ __forceinline__ void init(f32x4 (&acc)[2][2][4][2], const Unit& u, int wr, int wc, int fr, int fq) const {
        const int row0 = u.row0 + wr * 64 + fr, col0 = u.pn * BM + wc * 32 + 4 * fq;
#pragma unroll
        for (int ai = 0; ai < 2; ++ai)
#pragma unroll
            for (int m = 0; m < 4; ++m) { const size_t ro = (size_t)(row0 + ai * HALF + m * 16) * D + col0;
#pragma unroll
                for (int bj = 0; bj < 2; ++bj)
#pragma unroll
                    for (int n = 0; n < 2; ++n) acc[ai][bj][m][n] = *(const f32x4*)(X + ro + bj * HALF + n * 16); }
    }
    __device__ __forceinline__ void operator()(const f32x4 (&acc)[2][2][4][2], const Unit& u, int wr, int wc, int fr, int fq) const {
        const int row0 = u.row0 + wr * 64 + fr, col0 = u.pn * BM + wc * 32 + 4 * fq;
#pragma unroll
        for (int ai = 0; ai < 2; ++ai)
#pragma unroll
            for (int m = 0; m < 4; ++m) { const size_t ro = (size_t)(row0 + ai * HALF + m * 16) * D + col0;
#pragma unroll
                for (int bj = 0; bj < 2; ++bj)
#pragma unroll
                    for (int n = 0; n < 2; ++n) *(f32x4*)(C + ro + bj * HALF + n * 16) = acc[ai][bj][m][n]; }
    }
};
struct EpiMoe1 {
    static constexpr int SCALE_A = 0x7F7F7F7F, SCALE_B = 0x7F7F7F7F;
    static constexpr bool PERM = true;
    const float* b1; unsigned char* act8;
    __device__ __forceinline__ void init(f32x4 (&acc)[2][2][4][2], const Unit&, int, int, int, int) const {
#pragma unroll
        for (int a = 0; a < 2; ++a)
#pragma unroll
            for (int b = 0; b < 2; ++b)
#pragma unroll
                for (int m = 0; m < 4; ++m)
#pragma unroll
                    for (int n = 0; n < 2; ++n) acc[a][b][m][n] = (f32x4){0.f, 0.f, 0.f, 0.f};
    }
    __device__ __forceinline__ void operator()(const f32x4 (&acc)[2][2][4][2], const Unit& u, int wr, int wc, int fr, int fq) const {
        const int r0 = wr * 64 + fr, col0 = u.pn * BM + wc * 32 + 8 * fq;
        const float* be = b1 + (size_t)u.e * 2 * DFF + col0;
        f32x4 bv[2][2];
#pragma unroll
        for (int bj = 0; bj < 2; ++bj)
#pragma unroll
            for (int n = 0; n < 2; ++n) bv[bj][n] = *(const f32x4*)(be + bj * HALF + 4 * n);
#pragma unroll
        for (int ai = 0; ai < 2; ++ai)
#pragma unroll
            for (int m = 0; m < 4; ++m) {
                const int r = r0 + ai * HALF + m * 16;
                if (r < u.nvalid) {
                    unsigned char* rowp = act8 + (size_t)(u.row0 + r) * DFF + (col0 >> 1);
#pragma unroll
                    for (int bj = 0; bj < 2; ++bj) {
                        const f32x4 v0 = acc[ai][bj][m][0] * 0.03125f + bv[bj][0], v1 = acc[ai][bj][m][1] * 0.03125f + bv[bj][1];
                        const float g0 = fminf(v0[0], 7.0f), l0 = fminf(fmaxf(v0[1], -7.0f), 7.0f);
                        const float g1 = fminf(v0[2], 7.0f), l1 = fminf(fmaxf(v0[3], -7.0f), 7.0f);
                        const float g2 = fminf(v1[0], 7.0f), l2 = fminf(fmaxf(v1[1], -7.0f), 7.0f);
                        const float g3 = fminf(v1[2], 7.0f), l3 = fminf(fmaxf(v1[3], -7.0f), 7.0f);
                        const float a0 = g0 * __builtin_amdgcn_rcpf(1.0f + __expf(-1.702f * g0)) * (l0 + 1.0f), a1 = g1 * __builtin_amdgcn_rcpf(1.0f + __expf(-1.702f * g1)) * (l1 + 1.0f);
                        const float a2 = g2 * __builtin_amdgcn_rcpf(1.0f + __expf(-1.702f * g2)) * (l2 + 1.0f), a3 = g3 * __builtin_amdgcn_rcpf(1.0f + __expf(-1.702f * g3)) * (l3 + 1.0f);
                        int pk = __builtin_amdgcn_cvt_pk_fp8_f32(a0, a1, 0, false);
                        pk = __builtin_amdgcn_cvt_pk_fp8_f32(a2, a3, pk, true);
                        *(int*)(rowp + bj * (HALF / 2)) = pk;
                    }
                }
            }
    }
};
struct EpiMoe2 {
    static constexpr bool PERM = true;
    static constexpr int SCALE_A = 0x7F7F7F7F, SCALE_B = 0x7A7A7A7A;
    const float* b2; const float* gate; const int* lists; const LDS_AS int* meta; u16* y;
    __device__ __forceinline__ void init(f32x4 (&acc)[2][2][4][2], const Unit&, int, int, int, int) const {
#pragma unroll
        for (int a = 0; a < 2; ++a)
#pragma unroll
            for (int b = 0; b < 2; ++b)
#pragma unroll
                for (int m = 0; m < 4; ++m)
#pragma unroll
                    for (int n = 0; n < 2; ++n) acc[a][b][m][n] = (f32x4){0.f, 0.f, 0.f, 0.f};
    }
    __device__ __forceinline__ void operator()(const f32x4 (&acc)[2][2][4][2], const Unit& u, int wr, int wc, int fr, int fq) const {
        const int r0 = wr * 64 + fr, col0 = u.pn * BM + wc * 32 + 8 * fq;
        const float* be = b2 + (size_t)u.e * D + col0;
        const int* le = lists + (size_t)u.e * T + (u.row0 - meta[72 + u.e]);
        f32x4 bv[2][2];
#pragma unroll
        for (int bj = 0; bj < 2; ++bj)
#pragma unroll
            for (int n = 0; n < 2; ++n) bv[bj][n] = *(const f32x4*)(be + bj * HALF + 4 * n);
        int slot[8]; float gt[8];
#pragma unroll
        for (int q = 0; q < 8; ++q) slot[q] = le[min(r0 + (q >> 2) * HALF + (q & 3) * 16, u.nvalid - 1)];
        __builtin_amdgcn_sched_barrier(0);
#pragma unroll
        for (int q = 0; q < 8; ++q) gt[q] = gate[slot[q]];
        __builtin_amdgcn_sched_barrier(0);
#pragma unroll
        for (int ai = 0; ai < 2; ++ai)
#pragma unroll
            for (int m = 0; m < 4; ++m) {
                const int r = r0 + ai * HALF + m * 16;
                if (r < u.nvalid) {
                    const float g1 = gt[ai * 4 + m];
                    u16* rowp = y + (size_t)slot[ai * 4 + m] * D + col0;
#pragma unroll
                    for (int bj = 0; bj < 2; ++bj) {
                        const f32x4 v0 = (acc[ai][bj][m][0] * 0.03125f + bv[bj][0]) * g1, v1 = (acc[ai][bj][m][1] * 0.03125f + bv[bj][1]) * g1;
                        u32x4 w; w.x = pack2(v0[0], v0[1]); w.y = pack2(v0[2], v0[3]); w.z = pack2(v1[0], v1[1]); w.w = pack2(v1[2], v1[3]);
                        *(u32x4*)(rowp + bj * HALF) = w;
                    }
                }
            }
    }
};
}

constexpr int AT_K = 0, AT_V = 208 * 128, AT_Q = AT_V + 208 * 160, AT_BIAS = AT_Q + 8192;
struct AttnRegs { u32x4 kv[6], vv[6], qv[2]; float tb[3]; };
__device__ __forceinline__ void attn_load(const Params& p, int t, int it, AttnRegs& R) {
    const int idx = it & 63, br = (it >> 6) % 3, h = (it / 192) & 7, b = it / 1536;
    const int dsh = br * 2, L = S >> dsh, nbl = L >> 6;
    const int res = idx / nbl, qb = idx % nbl;
#pragma unroll
    for (int i = 0; i < 6; ++i) {
        const int j = t + 256 * i, row = j >> 3, c = j & 7;
        const int ki = 64 * (qb - 1) + row;
        const bool ok = (ki >= 0 && ki < L);
        const size_t base = (size_t)(b * S + res + ((ok ? ki : 0) << dsh)) * PJW + h * 64 + c * 8;
        const u32x4 kx = *(const u32x4*)(p.proj + base + C_AK), vx = *(const u32x4*)(p.proj + base + C_AV);
        const u32x4 zz = {0u, 0u, 0u, 0u};
        R.kv[i] = ok ? kx : zz; R.vv[i] = ok ? vx : zz;
    }
#pragma unroll
    for (int i = 0; i < 2; ++i) {
        const int j = t + 256 * i, row = j >> 3, c = j & 7;
        const size_t base = (size_t)(b * S + res + ((64 * qb + row) << dsh)) * PJW + C_AQ + h * 64 + c * 8;
        R.qv[i] = *(const u32x4*)(p.proj + base);
    }
#pragma unroll
    for (int i = 0; i < 3; ++i) {
        const int en = t + 256 * i, c = en / 176, x = en - c * 176, y = x - c - 16;
        const bool ok = (en < 704) && (y >= 0) && (y <= 128);
        const float bvl = p.rel_bias[T5TAB[br * 129 + (ok ? y : 0)] * AH + h];
        R.tb[i] = ok ? bvl * 1.44269504f : -1.0e30f;
    }
}
__device__ void attn_item(const Params& p, char* lds, int t, int it, int nit, AttnRegs& R) {
    const int l = t & 63, w = t >> 6, i16 = l & 15, g = l >> 4;
    const int idx = it & 63, br = (it >> 6) % 3, h = (it / 192) & 7, b = it / 1536;
    const int dsh = br * 2, L = S >> dsh, nbl = L >> 6;
    const int res = idx / nbl, qb = idx % nbl;
    char* Ks = lds + AT_K; char* Vs = lds + AT_V; char* Qs = lds + AT_Q; float* biasf = (float*)(lds + AT_BIAS);
    __syncthreads();
#pragma unroll
    for (int i = 0; i < 6; ++i) {
        const int j = t + 256 * i, row = j >> 3, c = j & 7;
        *(u32x4*)(Ks + tile_off(row, c)) = R.kv[i];
        *(u32x4*)(Vs + row * 160 + c * 16) = R.vv[i];
    }
    { u32x4 zz = {0u, 0u, 0u, 0u}; asm volatile("" : "+v"(zz));
      if (t < 160) *(u32x4*)(Vs + 192 * 160 + t * 16) = zz; else if (t < 224) { *(u32x4*)(Ks + 192 * 128 + (t - 160) * 16) = zz; *(u32x4*)(Ks + 192 * 128 + (t - 96) * 16) = zz; } }
#pragma unroll
    for (int i = 0; i < 2; ++i) { const int j = t + 256 * i; *(u32x4*)(Qs + tile_off(j >> 3, j & 7)) = R.qv[i]; }
#pragma unroll
    for (int i = 0; i < 3; ++i) { const int en = t + 256 * i; if (en < 704) biasf[en] = R.tb[i]; }
    __syncthreads();
    if (nit >= 0) attn_load(p, t, nit, R);

    const bf16x8 qf0 = lds_frag(Qs, 16 * w + i16, g), qf1 = lds_frag(Qs, 16 * w + i16, 4 + g);
    const char* Kw = Ks + 16 * w * 128;
    f32x4 sc[10];
#pragma unroll
    for (int i = 0; i < 10; ++i) {
        const bf16x8 k0 = lds_frag(Kw, 16 * i + i16, g), k1 = lds_frag(Kw, 16 * i + i16, 4 + g);
        f32x4 a = {0.f, 0.f, 0.f, 0.f};
        a = __builtin_amdgcn_mfma_f32_16x16x32_bf16(k0, qf0, a, 0, 0, 0);
        a = __builtin_amdgcn_mfma_f32_16x16x32_bf16(k1, qf1, a, 0, 0, 0);
        sc[i] = a;
    }
    const int sq = 16 * w + i16;
    const float* tabc = biasf + (i16 & 3) * 176 + 4 * g - 4 * (i16 >> 2) + 16;
    float mx = -3.0e38f;
#pragma unroll
    for (int i = 0; i < 10; ++i) {
        const f32x4 b4 = *(const f32x4*)(tabc + 16 * i);
#pragma unroll
        for (int r = 0; r < 4; ++r) sc[i][r] = fmaf(sc[i][r], 0.125f * 1.44269504f, b4[r]);
    }
    if (qb == 0 || qb == nbl - 1) {
        const int lo = (qb == 0) ? 64 : 0, hi = (qb == nbl - 1) ? 128 : 192;
#pragma unroll
        for (int i = 0; i < 10; ++i)
#pragma unroll
            for (int r = 0; r < 4; ++r) { const int tk = 16 * (w + i) + 4 * g + r; sc[i][r] = (tk >= lo && tk < hi) ? sc[i][r] : -1.0e30f; }
    }
#pragma unroll
    for (int i = 0; i < 10; ++i) mx = fmaxf(mx, fmaxf(fmaxf(sc[i][0], sc[i][1]), fmaxf(sc[i][2], sc[i][3])));
    mx = fmaxf(mx, swz_xor<16>(mx)); mx = half_max(mx);
    float ls = 0.f;
#pragma unroll
    for (int i = 0; i < 10; ++i) {
#pragma unroll
        for (int r = 0; r < 4; ++r) { const float e = __builtin_amdgcn_exp2f(sc[i][r] - mx); sc[i][r] = e; ls += e; }
    }
    ls += swz_xor<16>(ls); ls = half_sum(ls);

    f32x4 oa[4];
#pragma unroll
    for (int e = 0; e < 4; ++e) oa[e] = (f32x4){0.f, 0.f, 0.f, 0.f};
    const char* Vw = Vs + (16 * w + 4 * g + (i16 >> 2)) * 160 + 4 * (i16 & 3) * 2;
#pragma unroll
    for (int i2 = 0; i2 < 5; ++i2) {
        uint4 pu;
        pu.x = pack2(sc[2 * i2][0], sc[2 * i2][1]); pu.y = pack2(sc[2 * i2][2], sc[2 * i2][3]);
        pu.z = pack2(sc[2 * i2 + 1][0], sc[2 * i2 + 1][1]); pu.w = pack2(sc[2 * i2 + 1][2], sc[2 * i2 + 1][3]);
        const bf16x8 pf = __builtin_bit_cast(bf16x8, pu);
#pragma unroll
        for (int et = 0; et < 4; ++et) {
            const s16x4 va = tr_read(Vw + (32 * i2) * 160 + et * 32);
            const s16x4 vb = tr_read(Vw + (32 * i2 + 16) * 160 + et * 32);
            oa[et] = __builtin_amdgcn_mfma_f32_16x16x32_bf16(cat4(va, vb), pf, oa[et], 0, 0, 0);
        }
    }
    const float inv = 1.0f / ls;
    const size_t tok = (size_t)b * S + res + ((64 * qb + sq) << dsh);
#pragma unroll
    for (int et = 0; et < 4; ++et) {
        uint2 o; o.x = pack2(oa[et][0] * inv, oa[et][1] * inv); o.y = pack2(oa[et][2] * inv, oa[et][3] * inv);
        *(uint2*)(p.abr + ((size_t)br * T + tok) * 512 + h * 64 + 16 * et + 4 * g) = o;
    }
    if (g == 0) p.lse[((size_t)br * T + tok) * 8 + h] = (mx + __log2f(ls)) * 0.69314718f;
}

constexpr int GL_ZS = 0, GL_TOT = 8192, GL_GG = 10240, GL_BF = 10752, GL_BS = 68, GL_BB = GL_BF + 64 * GL_BS * 4, GL_R2 = GL_BB + 64 * GL_BS * 4;
__device__ __forceinline__ float logsig_fast(float a) { return fminf(a, 0.f) - __logf(1.0f + __expf(-fabsf(a))); }
__device__ __forceinline__ void gla_prep(const Params& p, char* lds, int t, int h) {
    const int d = t & 63, w = t >> 6;
    float* zs = (float*)(lds + GL_ZS); float* tot = (float*)(lds + GL_TOT); float* GG = (float*)(lds + GL_GG);
    float* BF = (float*)(lds + GL_BF); float* BB = (float*)(lds + GL_BB);
    float wf[16], wb[16];
#pragma unroll
    for (int r = 0; r < 16; ++r) { wf[r] = p.wgf[r * 256 + h * 64 + d]; wb[r] = p.wgb[r * 256 + h * 64 + d]; }
    const float biasf = p.bgf[h * 64 + d], biasb = p.bgb[h * 64 + d];
    __syncthreads();
    float bfv[16], bbv[16];
#pragma unroll
    for (int i = 0; i < 16; ++i) {
        const float4* zr = (const float4*)(zs + (16 * w + i) * 32);
        float af = biasf, ab = biasb;
#pragma unroll
        for (int r4 = 0; r4 < 4; ++r4) {
            const float4 zf = zr[r4], zb = zr[4 + r4];
            af = fmaf(zf.x, wf[4 * r4], af); af = fmaf(zf.y, wf[4 * r4 + 1], af); af = fmaf(zf.z, wf[4 * r4 + 2], af); af = fmaf(zf.w, wf[4 * r4 + 3], af);
            ab = fmaf(zb.x, wb[4 * r4], ab); ab = fmaf(zb.y, wb[4 * r4 + 1], ab); ab = fmaf(zb.z, wb[4 * r4 + 2], ab); ab = fmaf(zb.w, wb[4 * r4 + 3], ab);
        }
        bfv[i] = logsig_fast(af) * (1.0f / 16.0f); bbv[i] = logsig_fast(ab) * (1.0f / 16.0f);
    }
#pragma unroll
    for (int i = 1; i < 16; ++i) bfv[i] += bfv[i - 1];
#pragma unroll
    for (int i = 14; i >= 0; --i) bbv[i] += bbv[i + 1];
    tot[(0 * 4 + w) * 64 + d] = bfv[15];
    tot[(1 * 4 + w) * 64 + d] = bbv[0];
    __syncthreads();
    float offf = 0.f, offb = 0.f, Gf = 0.f, Gb = 0.f;
#pragma unroll
    for (int ww = 0; ww < 4; ++ww) {
        const float a = tot[(0 * 4 + ww) * 64 + d], c = tot[(1 * 4 + ww) * 64 + d];
        Gf += a; Gb += c;
        if (ww < w) offf += a;
        if (ww > w) offb += c;
    }
#pragma unroll
    for (int i = 0; i < 16; ++i) { BF[(16 * w + i) * GL_BS + d] = bfv[i] + offf; BB[(16 * w + i) * GL_BS + d] = bbv[i] + offb; }
    if (w == 0) { GG[d] = Gf; GG[64 + d] = Gb; }
    __syncthreads();
}
__device__ __forceinline__ void unpack8(const uint4 u, float (&f)[8]) {
    f[0] = lo2f(u.x); f[1] = hi2f(u.x); f[2] = lo2f(u.y); f[3] = hi2f(u.y); f[4] = lo2f(u.z); f[5] = hi2f(u.z); f[6] = lo2f(u.w); f[7] = hi2f(u.w);
}
__device__ __forceinline__ uint4 pack8(const float (&f)[8]) { uint4 u; u.x = pack2(f[0], f[1]); u.y = pack2(f[2], f[3]); u.z = pack2(f[4], f[5]); u.w = pack2(f[6], f[7]); return u; }

constexpr int GD_KF = GL_R2, GD_KB = GD_KF + 64 * 160, GD_VT = GL_BF;
__device__ void gla_ds_item(const Params& p, char* lds, int t, int it) {
    const int l = t & 63, w = t >> 6, i16 = l & 15, g = l >> 4;
    const int n = it & 63, h = (it >> 6) & 3, b = it >> 8;
    const int t0 = b * S + n * 64;
    float* zs = (float*)(lds + GL_ZS);
    const int sr = t >> 2, sc = t & 3;
    const u16* kp = p.proj + (size_t)(t0 + sr) * PJW + C_GK + h * 64 + sc * 16;
    const uint4 kr0 = *(const uint4*)(kp), kr1 = *(const uint4*)(kp + 8);
    u32x4 vr[4];
#pragma unroll
    for (int i = 0; i < 4; ++i) { const int j = t + 256 * i; vr[i] = *(const u32x4*)(p.proj + (size_t)(t0 + (j >> 4)) * PJW + C_GV + h * 128 + (j & 15) * 8); }
    const float4* zsrc = (const float4*)(p.zbuf + (size_t)t0 * 32);
    const float4 zv0 = zsrc[t], zv1 = zsrc[t + 256];
    __syncthreads();
    ((float4*)zs)[t] = zv0; ((float4*)zs)[t + 256] = zv1;
    gla_prep(p, lds, t, h);
    const float* BF = (const float*)(lds + GL_BF); const float* BB = (const float*)(lds + GL_BB); const float* GG = (const float*)(lds + GL_GG);
    char* KF = lds + GD_KF; char* KB = lds + GD_KB; char* VT = lds + GD_VT;
    {
        float kk[16];
        { float tmp[8]; unpack8(kr0, tmp);
#pragma unroll
          for (int j = 0; j < 8; ++j) kk[j] = tmp[j];
          unpack8(kr1, tmp);
#pragma unroll
          for (int j = 0; j < 8; ++j) kk[8 + j] = tmp[j]; }
        float of[16], ob[16];
#pragma unroll
        for (int q = 0; q < 4; ++q) {
            const float4 bf4 = *(const float4*)(BF + sr * GL_BS + sc * 16 + 4 * q), bb4 = *(const float4*)(BB + sr * GL_BS + sc * 16 + 4 * q);
            const float4 gf4 = *(const float4*)(GG + sc * 16 + 4 * q), gb4 = *(const float4*)(GG + 64 + sc * 16 + 4 * q);
            of[4 * q + 0] = kk[4 * q + 0] * __expf(gf4.x - bf4.x); of[4 * q + 1] = kk[4 * q + 1] * __expf(gf4.y - bf4.y);
            of[4 * q + 2] = kk[4 * q + 2] * __expf(gf4.z - bf4.z); of[4 * q + 3] = kk[4 * q + 3] * __expf(gf4.w - bf4.w);
            ob[4 * q + 0] = kk[4 * q + 0] * __expf(gb4.x - bb4.x); ob[4 * q + 1] = kk[4 * q + 1] * __expf(gb4.y - bb4.y);
            ob[4 * q + 2] = kk[4 * q + 2] * __expf(gb4.z - bb4.z); ob[4 * q + 3] = kk[4 * q + 3] * __expf(gb4.w - bb4.w);
        }
        uint4 u;
        u.x = pack2(of[0], of[1]); u.y = pack2(of[2], of[3]); u.z = pack2(of[4], of[5]); u.w = pack2(of[6], of[7]);
        *(uint4*)(KF + sr * 160 + sc * 32) = u;
        u.x = pack2(of[8], of[9]); u.y = pack2(of[10], of[11]); u.z = pack2(of[12], of[13]); u.w = pack2(of[14], of[15]);
        *(uint4*)(KF + sr * 160 + sc * 32 + 16) = u;
        u.x = pack2(ob[0], ob[1]); u.y = pack2(ob[2], ob[3]); u.z = pack2(ob[4], ob[5]); u.w = pack2(ob[6], ob[7]);
        *(uint4*)(KB + sr * 160 + sc * 32) = u;
        u.x = pack2(ob[8], ob[9]); u.y = pack2(ob[10], ob[11]); u.z = pack2(ob[12], ob[13]); u.w = pack2(ob[14], ob[15]);
        *(uint4*)(KB + sr * 160 + sc * 32 + 16) = u;
        if (t < 64) { p.dec[((size_t)it * 2 + 0) * 64 + t] = __expf(GG[t]); p.dec[((size_t)it * 2 + 1) * 64 + t] = __expf(GG[64 + t]); }
    }
    __syncthreads();
#pragma unroll
    for (int i = 0; i < 4; ++i) { const int j = t + 256 * i; *(u32x4*)(VT + (j >> 4) * 288 + (j & 15) * 16) = vr[i]; }
    __syncthreads();
#pragma unroll
    for (int dir = 0; dir < 2; ++dir) {
        const char* KX = dir ? KB : KF;
        f32x4 acc[2][4];
#pragma unroll
        for (int a = 0; a < 2; ++a)
#pragma unroll
            for (int c = 0; c < 4; ++c) acc[a][c] = (f32x4){0.f, 0.f, 0.f, 0.f};
#pragma unroll
        for (int ks = 0; ks < 2; ++ks) {
            const int r0 = ks * 32 + 8 * g + (i16 >> 2);
            bf16x8 vf[2], kf[4];
#pragma unroll
            for (int a = 0; a < 2; ++a) {
                const int e0 = 16 * (2 * w + a) + 4 * (i16 & 3);
                vf[a] = cat4(tr_read(VT + r0 * 288 + e0 * 2), tr_read(VT + (r0 + 4) * 288 + e0 * 2));
            }
#pragma unroll
            for (int c = 0; c < 4; ++c) {
                const int d0 = 16 * c + 4 * (i16 & 3);
                kf[c] = cat4(tr_read(KX + r0 * 160 + d0 * 2), tr_read(KX + (r0 + 4) * 160 + d0 * 2));
            }
#pragma unroll
            for (int a = 0; a < 2; ++a)
#pragma unroll
                for (int c = 0; c < 4; ++c) acc[a][c] = __builtin_amdgcn_mfma_f32_16x16x32_bf16(kf[c], vf[a], acc[a][c], 0, 0, 0);
        }
        float* dst = p.dS + ((size_t)it * 2 + dir) * 128 * 64;
#pragma unroll
        for (int a = 0; a < 2; ++a)
#pragma unroll
            for (int c = 0; c < 4; ++c) *(f32x4*)(dst + (16 * (2 * w + a) + i16) * 64 + 16 * c + 4 * g) = acc[a][c];
    }
}

__device__ void gla_scan_thread2(const Params& p, int gid) {
    const int d = gid & 63, e = (gid >> 6) & 127, dir = (gid >> 13) & 1, bh0 = gid >> 14, bh1 = bh0 + 8;
    float s0 = 0.f, s1 = 0.f;
#pragma unroll 8
    for (int step = 0; step < 64; ++step) {
        const int n = dir ? (63 - step) : step;
        const size_t i0 = ((size_t)(bh0 * 64 + n)) * 2 + dir, i1 = ((size_t)(bh1 * 64 + n)) * 2 + dir;
        const float dc0 = p.dec[i0 * 64 + d], ds0 = p.dS[(i0 * 128 + e) * 64 + d];
        const float dc1 = p.dec[i1 * 64 + d], ds1 = p.dS[(i1 * 128 + e) * 64 + d];
        p.Sp[(i0 * 128 + e) * 64 + d] = f2bf(s0);
        p.Sp[(i1 * 128 + e) * 64 + d] = f2bf(s1);
        s0 = fmaf(dc0, s0, ds0); s1 = fmaf(dc1, s1, ds1);
    }
}

__device__ void attn_combine_thread(const Params& p, int gid) {
    const int tok = gid >> 6, c = gid & 63, h = c >> 3;
    const float l0 = p.lse[((size_t)0 * T + tok) * 8 + h], l1 = p.lse[((size_t)1 * T + tok) * 8 + h], l2 = p.lse[((size_t)2 * T + tok) * 8 + h];
    const float mm = fmaxf(l0, fmaxf(l1, l2));
    float w0 = __expf(l0 - mm), w1 = __expf(l1 - mm), w2 = __expf(l2 - mm);
    const float inv = 1.0f / (w0 + w1 + w2);
    w0 *= inv; w1 *= inv; w2 *= inv;
    const uint4 a0 = *(const uint4*)(p.abr + ((size_t)0 * T + tok) * 512 + c * 8);
    const uint4 a1 = *(const uint4*)(p.abr + ((size_t)1 * T + tok) * 512 + c * 8);
    const uint4 a2 = *(const uint4*)(p.abr + ((size_t)2 * T + tok) * 512 + c * 8);
    uint4 o;
    o.x = pack2(w0 * lo2f(a0.x) + w1 * lo2f(a1.x) + w2 * lo2f(a2.x), w0 * hi2f(a0.x) + w1 * hi2f(a1.x) + w2 * hi2f(a2.x));
    o.y = pack2(w0 * lo2f(a0.y) + w1 * lo2f(a1.y) + w2 * lo2f(a2.y), w0 * hi2f(a0.y) + w1 * hi2f(a1.y) + w2 * hi2f(a2.y));
    o.z = pack2(w0 * lo2f(a0.z) + w1 * lo2f(a1.z) + w2 * lo2f(a2.z), w0 * hi2f(a0.z) + w1 * hi2f(a1.z) + w2 * hi2f(a2.z));
    o.w = pack2(w0 * lo2f(a0.w) + w1 * lo2f(a1.w) + w2 * lo2f(a2.w), w0 * hi2f(a0.w) + w1 * hi2f(a1.w) + w2 * hi2f(a2.w));
    *(uint4*)(p.mix + (size_t)tok * D + c * 8) = o;
}

constexpr int GO_QF = GL_R2, GO_QB = GO_QF + 8192, GO_KF = GO_QB + 8192, GO_KB = GO_KF + 8192, GO_VT = GL_R2, GO_AM = GL_ZS, GO_SF = GL_BF, GO_SB = GL_BF + 16384;
__device__ void gla_out_item(const Params& p, char* lds, int t, int it) {
    const int l = t & 63, w = t >> 6, i16 = l & 15, g = l >> 4;
    const int n = it & 63, h = (it >> 6) & 3, b = it >> 8;
    const int t0 = b * S + n * 64;
    float* zs = (float*)(lds + GL_ZS);
    const int sr = t >> 2, sc = t & 3;
    const float4* zsrc = (const float4*)(p.zbuf + (size_t)t0 * 32);
    const float4 zv0 = zsrc[t], zv1 = zsrc[t + 256];
    const u16* qp = p.proj + (size_t)(t0 + sr) * PJW + C_GQ + h * 64 + sc * 16;
    const u16* kp = p.proj + (size_t)(t0 + sr) * PJW + C_GK + h * 64 + sc * 16;
    const uint4 qr0 = *(const uint4*)(qp), qr1 = *(const uint4*)(qp + 8), kr0 = *(const uint4*)(kp), kr1 = *(const uint4*)(kp + 8);
    u32x4 vr[4], sv[8];
#pragma unroll
    for (int i = 0; i < 4; ++i) { const int j = t + 256 * i; vr[i] = *(const u32x4*)(p.proj + (size_t)(t0 + (j >> 4)) * PJW + C_GV + h * 128 + (j & 15) * 8); }
    const u16* SPG = p.Sp + (size_t)it * 2 * 128 * 64;
    __syncthreads();
    ((float4*)zs)[t] = zv0; ((float4*)zs)[t + 256] = zv1;
    gla_prep(p, lds, t, h);
#pragma unroll
    for (int i = 0; i < 8; ++i) { const int j = t + 256 * i; sv[i] = *(const u32x4*)(SPG + (size_t)j * 8); }
    const float* BF = (const float*)(lds + GL_BF); const float* BB = (const float*)(lds + GL_BB);
    char* QF = lds + GO_QF; char* QB = lds + GO_QB; char* KF = lds + GO_KF; char* KB = lds + GO_KB; char* VT = lds + GO_VT; char* AM = lds + GO_AM;
    char* SF = lds + GO_SF; char* SB = lds + GO_SB;
    {
        float qq[16], kk[16];
        { float tmp[8];
          unpack8(qr0, tmp);
#pragma unroll
          for (int j = 0; j < 8; ++j) qq[j] = tmp[j] * 0.125f;
          unpack8(qr1, tmp);
#pragma unroll
          for (int j = 0; j < 8; ++j) qq[8 + j] = tmp[j] * 0.125f;
          unpack8(kr0, tmp);
#pragma unroll
          for (int j = 0; j < 8; ++j) kk[j] = tmp[j];
          unpack8(kr1, tmp);
#pragma unroll
          for (int j = 0; j < 8; ++j) kk[8 + j] = tmp[j]; }
        float ef[16], eb[16];
#pragma unroll
        for (int q = 0; q < 4; ++q) {
            const float4 bf4 = *(const float4*)(BF + sr * GL_BS + sc * 16 + 4 * q), bb4 = *(const float4*)(BB + sr * GL_BS + sc * 16 + 4 * q);
            ef[4 * q + 0] = __expf(bf4.x); ef[4 * q + 1] = __expf(bf4.y); ef[4 * q + 2] = __expf(bf4.z); ef[4 * q + 3] = __expf(bf4.w);
            eb[4 * q + 0] = __expf(bb4.x); eb[4 * q + 1] = __expf(bb4.y); eb[4 * q + 2] = __expf(bb4.z); eb[4 * q + 3] = __expf(bb4.w);
        }
        float o8[8];
#pragma unroll
        for (int hh = 0; hh < 2; ++hh) {
            const int off = tile_off(sr, 2 * sc + hh);
#pragma unroll
            for (int j = 0; j < 8; ++j) o8[j] = qq[8 * hh + j] * ef[8 * hh + j];
            *(uint4*)(QF + off) = pack8(o8);
#pragma unroll
            for (int j = 0; j < 8; ++j) o8[j] = kk[8 * hh + j] / ef[8 * hh + j];
            *(uint4*)(KF + off) = pack8(o8);
#pragma unroll
            for (int j = 0; j < 8; ++j) o8[j] = qq[8 * hh + j] * eb[8 * hh + j];
            *(uint4*)(QB + off) = pack8(o8);
#pragma unroll
            for (int j = 0; j < 8; ++j) o8[j] = kk[8 * hh + j] / eb[8 * hh + j];
            *(uint4*)(KB + off) = pack8(o8);
        }
    }
    __syncthreads();
#pragma unroll
    for (int i = 0; i < 8; ++i) { const int j = t + 256 * i; *(u32x4*)((j >> 10 ? SB : SF) + tile_off((j >> 3) & 127, j & 7)) = sv[i]; }
    const int cq = 16 * w + i16;
    const bf16x8 qf0 = lds_frag(QF, cq, g), qf1 = lds_frag(QF, cq, 4 + g);
    const bf16x8 qb0 = lds_frag(QB, cq, g), qb1 = lds_frag(QB, cq, 4 + g);
    uint2 amo[4];
#pragma unroll
    for (int st = 0; st < 4; ++st) {
        f32x4 af = {0.f, 0.f, 0.f, 0.f}, ab = {0.f, 0.f, 0.f, 0.f};
        af = __builtin_amdgcn_mfma_f32_16x16x32_bf16(lds_frag(KF, 16 * st + i16, g), qf0, af, 0, 0, 0);
        af = __builtin_amdgcn_mfma_f32_16x16x32_bf16(lds_frag(KF, 16 * st + i16, 4 + g), qf1, af, 0, 0, 0);
        ab = __builtin_amdgcn_mfma_f32_16x16x32_bf16(lds_frag(KB, 16 * st + i16, g), qb0, ab, 0, 0, 0);
        ab = __builtin_amdgcn_mfma_f32_16x16x32_bf16(lds_frag(KB, 16 * st + i16, 4 + g), qb1, ab, 0, 0, 0);
        float am[4];
#pragma unroll
        for (int r = 0; r < 4; ++r) {
            const int s = 16 * st + 4 * g + r;
            am[r] = (s <= cq ? af[r] : 0.f) + (s >= cq ? ab[r] : 0.f);
        }
        amo[st].x = pack2(am[0], am[1]); amo[st].y = pack2(am[2], am[3]);
    }
#pragma unroll
    for (int st = 0; st < 4; ++st) { const int s0 = 16 * st + 4 * g; *(uint2*)(AM + tile_off(cq, s0 >> 3) + (s0 & 7) * 2) = amo[st]; }
    __syncthreads();
#pragma unroll
    for (int i = 0; i < 4; ++i) { const int j = t + 256 * i; *(u32x4*)(VT + (j >> 4) * 288 + (j & 15) * 16) = vr[i]; }
    __syncthreads();
    f32x4 oc[8];
#pragma unroll
    for (int et = 0; et < 8; ++et) oc[et] = (f32x4){0.f, 0.f, 0.f, 0.f};
#pragma unroll
    for (int ks = 0; ks < 2; ++ks) {
        const bf16x8 amf = lds_frag(AM, cq, ks * 4 + g);
        const bf16x8 qff = ks ? qf1 : qf0, qbf = ks ? qb1 : qb0;
        const int r0 = ks * 32 + 8 * g + (i16 >> 2);
#pragma unroll
        for (int et = 0; et < 8; ++et) {
            const int e0 = 16 * et + 4 * (i16 & 3);
            const bf16x8 vf = cat4(tr_read(VT + r0 * 288 + e0 * 2), tr_read(VT + (r0 + 4) * 288 + e0 * 2));
            oc[et] = __builtin_amdgcn_mfma_f32_16x16x32_bf16(vf, amf, oc[et], 0, 0, 0);
            oc[et] = __builtin_amdgcn_mfma_f32_16x16x32_bf16(lds_frag(SF, 16 * et + i16, ks * 4 + g), qff, oc[et], 0, 0, 0);
            oc[et] = __builtin_amdgcn_mfma_f32_16x16x32_bf16(lds_frag(SB, 16 * et + i16, ks * 4 + g), qbf, oc[et], 0, 0, 0);
        }
    }
    float ss = 0.f;
#pragma unroll
    for (int et = 0; et < 8; ++et)
#pragma unroll
        for (int r = 0; r < 4; ++r) ss += oc[et][r] * oc[et][r];
    ss += swz_xor<16>(ss); ss = half_sum(ss);
    const float rstd = rsqrtf(ss * (1.0f / 128.0f) + EPS);
    const size_t tok = (size_t)t0 + cq;
#pragma unroll
    for (int et = 0; et < 8; ++et) {
        const int e = 16 * et + 4 * g;
        const uint2 gg = *(const uint2*)(p.proj + tok * PJW + C_GO + h * 128 + e);
        const float4 ng = *(const float4*)(p.gla_ng + h * 128 + e);
        const float g0 = lo2f(gg.x), g1 = hi2f(gg.x), g2 = lo2f(gg.y), g3 = hi2f(gg.y);
        uint2 o;
        o.x = pack2(oc[et][0] * rstd * ng.x * (g0 / (1.0f + __expf(-g0))), oc[et][1] * rstd * ng.y * (g1 / (1.0f + __expf(-g1))));
        o.y = pack2(oc[et][2] * rstd * ng.z * (g2 / (1.0f + __expf(-g2))), oc[et][3] * rstd * ng.w * (g3 / (1.0f + __expf(-g3))));
        *(uint2*)(p.mix + tok * D + 512 + h * 128 + e) = o;
    }
}

constexpr int RT_RS = 1028;
constexpr int RT_XS = 0, RT_PART = 16 * RT_RS * 4, RT_PE = RT_PART + 4 * 16 * 32 * 4 + 512, RT_RANK = RT_PE + 1024, RT_HIST = RT_RANK + 1024, RT_BASE = RT_HIST + 128;
__device__ void ph_route(const Params& p, char* ldsall) {
    const int tid = tid_opaque(), t = tid & 255, half = tid >> 8, lane = t & 63, w = t >> 6;
    char* lds = ldsall + half * HALF_LDS;
    const int vb = blockIdx.x * 2 + half, nvb = gridDim.x * 2;
    float* xs = (float*)(lds + RT_XS); float* part = (float*)(lds + RT_PART);
    int* pe = (int*)(lds + RT_PE); int* rank = (int*)(lds + RT_RANK); int* hist = (int*)(lds + RT_HIST); int* base = (int*)(lds + RT_BASE);
    const int ngr = (T / 16 + nvb - 1) / nvb;
    for (int gl = 0; gl < ngr; ++gl) {
        const int gi = vb + gl * nvb;
        const bool live = gi < T / 16;
        const int tok0 = (live ? gi : 0) * 16;
        __syncthreads();
#pragma unroll
        for (int th = 0; th < 2; ++th) {
            f32x4 v[2][4];
#pragma unroll
            for (int tt = 0; tt < 2; ++tt) {
                const f32x4* xr = (const f32x4*)(p.x1 + (size_t)(tok0 + 4 * w + 2 * th + tt) * D);
#pragma unroll
                for (int i = 0; i < 4; ++i) v[tt][i] = xr[lane + 64 * i];
            }
#pragma unroll
            for (int tt = 0; tt < 2; ++tt) {
                const int tl = 4 * w + 2 * th + tt, tok = tok0 + tl;
                float ss = 0.f;
#pragma unroll
                for (int i = 0; i < 4; ++i) ss += v[tt][i][0] * v[tt][i][0] + v[tt][i][1] * v[tt][i][1] + v[tt][i][2] * v[tt][i][2] + v[tt][i][3] * v[tt][i][3];
                ss = wave_sum(ss);
                const float r = rsqrtf(ss * (1.0f / D) + EPS);
#pragma unroll
                for (int i = 0; i < 4; ++i) {
                    const f32x4 gq = ((const f32x4*)p.g2)[lane + 64 * i];
                    const f32x4 yv = v[tt][i] * r * gq;
                    *(f32x4*)(xs + tl * RT_RS + (lane + 64 * i) * 4) = yv;
                    if (live) { int pk = __builtin_amdgcn_cvt_pk_fp8_f32(yv[0], yv[1], 0, false); pk = __builtin_amdgcn_cvt_pk_fp8_f32(yv[2], yv[3], pk, true); *(int*)(p.xn28 + (size_t)tok * D + (lane + 64 * i) * 4) = pk; }
                }
            }
        }
        __syncthreads();
        {
            const int i16 = lane & 15, kq = lane >> 4;
            const float* xa = xs + i16 * RT_RS + 256 * w + 64 * kq;
            const float* rwp = p.rw + (size_t)(256 * w + 64 * kq) * 32 + i16;
            f32x4 a0 = {0.f, 0.f, 0.f, 0.f}, a1 = {0.f, 0.f, 0.f, 0.f};
            f32x4 bqA[8];
#define RT_LOADB(dst, b) do { _Pragma("unroll") for (int q = 0; q < 8; ++q) { \
                dst[q][0] = rwp[(size_t)((b) * 16 + 2 * q) * 32]; dst[q][1] = rwp[(size_t)((b) * 16 + 2 * q) * 32 + 16]; \
                dst[q][2] = rwp[(size_t)((b) * 16 + 2 * q + 1) * 32]; dst[q][3] = rwp[(size_t)((b) * 16 + 2 * q + 1) * 32 + 16]; } } while (0)
#define RT_MMA(src, b) do { _Pragma("unroll") for (int s4 = 0; s4 < 4; ++s4) { const float4 av = *(const float4*)(xa + 16 * (b) + 4 * s4); \
                a0 = __builtin_amdgcn_mfma_f32_16x16x4f32(av.x, src[2 * s4][0], a0, 0, 0, 0); a1 = __builtin_amdgcn_mfma_f32_16x16x4f32(av.x, src[2 * s4][1], a1, 0, 0, 0); \
                a0 = __builtin_amdgcn_mfma_f32_16x16x4f32(av.y, src[2 * s4][2], a0, 0, 0, 0); a1 = __builtin_amdgcn_mfma_f32_16x16x4f32(av.y, src[2 * s4][3], a1, 0, 0, 0); \
                a0 = __builtin_amdgcn_mfma_f32_16x16x4f32(av.z, src[2 * s4 + 1][0], a0, 0, 0, 0); a1 = __builtin_amdgcn_mfma_f32_16x16x4f32(av.z, src[2 * s4 + 1][1], a1, 0, 0, 0); \
                a0 = __builtin_amdgcn_mfma_f32_16x16x4f32(av.w, src[2 * s4 + 1][2], a0, 0, 0, 0); a1 = __builtin_amdgcn_mfma_f32_16x16x4f32(av.w, src[2 * s4 + 1][3], a1, 0, 0, 0); } } while (0)
#pragma unroll
            for (int b = 0; b < 4; ++b) {
                RT_LOADB(bqA, b);
                __builtin_amdgcn_sched_barrier(0);
                RT_MMA(bqA, b);
                __builtin_amdgcn_sched_barrier(0);
            }
#undef RT_LOADB
#undef RT_MMA
#pragma unroll
            for (int r = 0; r < 4; ++r) { part[(w * 16 + 4 * kq + r) * 32 + i16] = a0[r]; part[(w * 16 + 4 * kq + r) * 32 + 16 + i16] = a1[r]; }
        }
        __syncthreads();
#pragma unroll
        for (int ro = 0; ro < 2; ++ro) {
            const int tk = 4 * w + 2 * ro + (lane >> 5), e = lane & 31;
            float v = p.rb[e] + ((part[(0 * 16 + tk) * 32 + e] + part[(1 * 16 + tk) * 32 + e]) + (part[(2 * 16 + tk) * 32 + e] + part[(3 * 16 + tk) * 32 + e]));
            int rk = 0;
#pragma unroll
            for (int j = 0; j < 64; ++j) {
                const float bj = __builtin_bit_cast(float, __builtin_amdgcn_readlane(__builtin_bit_cast(int, v), j));
                if ((j >> 5) == (lane >> 5)) rk += (bj > v || (bj == v && (j & 31) < e)) ? 1 : 0;
            }
            float* selv = part + 2048 + (w * 2 + (lane >> 5)) * 8;
            if (rk < 4) { selv[rk] = v; selv[4 + rk] = __builtin_bit_cast(float, e); }
            __builtin_amdgcn_s_waitcnt(0xc07f);
            __builtin_amdgcn_wave_barrier();
            const float b0 = selv[0], b1 = selv[1], b2 = selv[2], b3 = selv[3];
            const float e1 = expf(b1 - b0), e2 = expf(b2 - b0), e3 = expf(b3 - b0);
            const float inv = 1.0f / (1.0f + e1 + e2 + e3);
            if (e < 4) {
                const int sel = __builtin_bit_cast(int, selv[4 + e]);
                const float gs = (e == 0) ? inv : (e == 1) ? e1 * inv : (e == 2) ? e2 * inv : e3 * inv;
                pe[gl * 64 + tk * 4 + e] = live ? (sel & 31) : -1;
                if (live) p.gate[(size_t)(tok0 + tk) * 4 + e] = gs;
            }
            __builtin_amdgcn_wave_barrier();
        }
    }
    __syncthreads();
    if (t < 32) hist[t] = 0;
    __syncthreads();
    for (int i = t; i < ngr * 64; i += 256) { const int e = pe[i]; if (e >= 0) rank[i] = atomicAdd(&hist[e], 1); }
    __syncthreads();
    if (t < 32) { const int c = hist[t]; base[t] = c ? atomicAdd(&p.counts[t], c) : 0; }
    __syncthreads();
    for (int i = t; i < ngr * 64; i += 256) {
        const int e = pe[i];
        if (e >= 0) { const int gl = i >> 6, gi = vb + gl * nvb; const int slot = (gi * 16 + ((i >> 2) & 15)) * 4 + (i & 3); p.lists[e * T + base[e] + rank[i]] = slot; }
    }
}

__device__ void ph_final(const Params& p) {
    const int tid = tid_opaque(), lane = tid & 63, gw = blockIdx.x * 8 + (tid >> 6), nw = gridDim.x * 8;
    for (int tok = gw; tok < T; tok += nw) {
        float v[2][8]; float ss = 0.f;
#pragma unroll
        for (int i = 0; i < 2; ++i) {
            const int c = lane * 8 + 512 * i;
            const float4 xa = *(const float4*)(p.x1 + (size_t)tok * D + c), xb = *(const float4*)(p.x1 + (size_t)tok * D + c + 4);
            v[i][0] = xa.x; v[i][1] = xa.y; v[i][2] = xa.z; v[i][3] = xa.w; v[i][4] = xb.x; v[i][5] = xb.y; v[i][6] = xb.z; v[i][7] = xb.w;
#pragma unroll
            for (int k = 0; k < 4; ++k) {
                const uint4 yy = *(const uint4*)(p.y + ((size_t)tok * 4 + k) * D + c);
                v[i][0] += lo2f(yy.x); v[i][1] += hi2f(yy.x); v[i][2] += lo2f(yy.y); v[i][3] += hi2f(yy.y);
                v[i][4] += lo2f(yy.z); v[i][5] += hi2f(yy.z); v[i][6] += lo2f(yy.w); v[i][7] += hi2f(yy.w);
            }
#pragma unroll
            for (int j = 0; j < 8; ++j) ss += v[i][j] * v[i][j];
        }
        ss = wave_sum(ss);
        const float r = rsqrtf(ss * (1.0f / D) + EPS);
#pragma unroll
        for (int i = 0; i < 2; ++i) {
            const int c = lane * 8 + 512 * i;
            const float4 ga = *(const float4*)(p.gf + c), gb = *(const float4*)(p.gf + c + 4);
            float4 oa, ob;
            oa.x = v[i][0] * r * ga.x; oa.y = v[i][1] * r * ga.y; oa.z = v[i][2] * r * ga.z; oa.w = v[i][3] * r * ga.w;
            ob.x = v[i][4] * r * gb.x; ob.y = v[i][5] * r * gb.y; ob.z = v[i][6] * r * gb.z; ob.w = v[i][7] * r * gb.w;
            *(float4*)(p.out + (size_t)tok * D + c) = oa; *(float4*)(p.out + (size_t)tok * D + c + 4) = ob;
        }
    }
}

#define XB_TMO      128
#define XB_XCNT(j)  (256  + 64 * (j))
#define XB_XSUB(j)  (1280 + 64 * (j))
#define XB_XGEN(j)  (2304 + 64 * (j))
#define XB_TOP      3328
#define XB_TOPGEN   3392
#define XCD_BAR_WORDS 3456
#define XB_SPIN_CAP (1u << 22)
__device__ __forceinline__ unsigned xb_ld(unsigned* p)              { return __hip_atomic_load(p, __ATOMIC_RELAXED, __HIP_MEMORY_SCOPE_AGENT); }
__device__ __forceinline__ unsigned xb_add(unsigned* p, unsigned v) { return __hip_atomic_fetch_add(p, v, __ATOMIC_RELAXED, __HIP_MEMORY_SCOPE_AGENT); }
__device__ __forceinline__ unsigned xb_xcc_id() { return (unsigned)__builtin_amdgcn_s_getreg((3 << 11) | 20) & 0xFu; }
#define XB_SPIN(cond, bar) do { unsigned _sp = 0; while (cond) { __builtin_amdgcn_s_sleep(1); \
    if ((++_sp & 255u) == 0u) { if (xb_ld(&(bar)[XB_TMO])) break; if (_sp > XB_SPIN_CAP) { atomicAdd(&(bar)[XB_TMO], 1u); break; } } } } while (0)
struct XcdBarrier { unsigned* bar; unsigned x; volatile LDS_AS unsigned* st; };
__device__ __forceinline__ XcdBarrier xcd_barrier_post(unsigned* bar, volatile LDS_AS unsigned* st) {
    XcdBarrier b; b.bar = bar; b.x = xb_xcc_id(); b.st = st;
    if (threadIdx.x == 0) (void)xb_add(&bar[XB_XCNT(b.x)], 1u);
    return b;
}
__device__ __forceinline__ void xcd_barrier_complete(unsigned* bar, unsigned x, unsigned& nloc, unsigned& nx) {
    const unsigned G = gridDim.x * gridDim.y * gridDim.z;
    unsigned sum, cnt, mine, sp = 0u;
    for (;;) {
        sum = 0u; cnt = 0u; mine = 0u;
#pragma unroll
        for (unsigned j = 0; j < 16; ++j) { const unsigned c = xb_ld(&bar[XB_XCNT(j)]); sum += c; cnt += (c > 0u) ? 1u : 0u; mine = (j == x) ? c : mine; }
        if (sum == G) break;
        __builtin_amdgcn_s_sleep(1);
        if ((++sp & 255u) == 0u) { if (xb_ld(&bar[XB_TMO])) break; if (sp > XB_SPIN_CAP) { atomicAdd(&bar[XB_TMO], 1u); break; } }
    }
    nloc = mine > 0u ? mine : 1u; nx = cnt > 0u ? cnt : 1u;
}
__device__ __forceinline__ void xcd_barrier(const XcdBarrier& b) {
    asm volatile("s_waitcnt vmcnt(0)" ::: "memory");
    __syncthreads();
    if (threadIdx.x == 0) {
        unsigned* bar = b.bar;
        __builtin_amdgcn_s_waitcnt(0);
        unsigned nloc = b.st[0], nx = b.st[1];
        if (nloc == 0u) { xcd_barrier_complete(bar, b.x, nloc, nx); b.st[0] = nloc; b.st[1] = nx; }
        const unsigned old = xb_add(&bar[XB_XSUB(b.x)], 1u);
        const unsigned gen = old / nloc;
        if (old + 1u == (gen + 1u) * nloc) {
            __builtin_amdgcn_fence(__ATOMIC_RELEASE, "agent");
            asm volatile("s_waitcnt vmcnt(0)" ::: "memory");
            const unsigned og = xb_add(&bar[XB_TOP], 1u);
            const unsigned tg = og / nx;
            if (og + 1u == (tg + 1u) * nx) xb_add(&bar[XB_TOPGEN], 1u);
            else XB_SPIN(xb_ld(&bar[XB_TOPGEN]) == tg, bar);
            __builtin_amdgcn_fence(__ATOMIC_ACQUIRE, "agent");
            xb_add(&bar[XB_XGEN(b.x)], 1u);
            asm volatile("s_waitcnt vmcnt(0)" ::: "memory");
        } else {
            XB_SPIN(xb_ld(&bar[XB_XGEN(b.x)]) == gen, bar);
            __builtin_amdgcn_fence(__ATOMIC_ACQUIRE, "agent");
            asm volatile("s_waitcnt vmcnt(0)" ::: "memory");
        }
    }
    __syncthreads();
}


#if defined(FLUSHMASK)
__device__ void ph_flush(const Params& p) {
    const int tid = tid_opaque();
    const float4* src = (const float4*)p.w1;
    float acc = 0.f;
    for (size_t i = (size_t)blockIdx.x * 512 + tid; i < (size_t)NE * D * 2 * DFF / 4; i += (size_t)gridDim.x * 512) { const float4 v = src[i]; acc += v.x + v.y + v.z + v.w; }
    if (acc == 123.456f) p.out[0] = acc;
}
#endif
enum { PH_PRO = 0, PH_PROJ, PH_MIX1, PH_MIX2, PH_MIX3, PH_OUTPROJ, PH_ROUTE, PH_MOE1, PH_MOE2, PH_FINAL, PH_END };
constexpr int N_GLA_ITEMS = B * GH * 64, N_ATT_ITEMS = B * AH * 3 * 64;
constexpr int MO_META = LDS_BYTES - 1024;

__device__ __forceinline__ void moe_meta(const Params& p, int* meta) {
    __syncthreads();
    if (threadIdx.x == 0) {
        int mp = 0, rbse = 0;
        for (int e = 0; e < NE; ++e) {
            const int c = p.counts[e];
            meta[e] = c; meta[32 + e] = mp; meta[72 + e] = rbse;
            mp += (c + 255) >> 8; rbse += c;
        }
        meta[32 + NE] = mp; meta[72 + NE] = rbse;
    }
    __syncthreads();
}

constexpr int MO_TABA = 128 * 1024, MO_MAXU = 12;
template <class SchedT>
__device__ __forceinline__ void moe_tables(const Params& p, char* lds, const SchedT& S) {
    unsigned* tabA = (unsigned*)(lds + MO_TABA);
    const int tid = tid_opaque(), r = tid & 255;
    for (int i = tid >> 8; i < MO_MAXU; i += 2) {
        pg::Unit u;
        if (!S.next(i, u)) break;
        const int slot = p.lists[u.e * T + (u.row0 - S.meta[72 + u.e]) + min(r, u.nvalid - 1)];
        tabA[i * 256 + r] = (unsigned)(slot >> 2) * (unsigned)S.rowb;
    }
    __syncthreads();
}

typedef const __attribute__((address_space(4))) Params* KParams;
#if defined(__HIP_DEVICE_COMPILE__)
#define PHASE_PARAMS() KParams _kq = kp; asm volatile("" : "+s"(_kq)); const Params p = *_kq
#define KP_INIT() KParams kp = (KParams)__builtin_amdgcn_kernarg_segment_ptr(); const int ph_lo = kp->ph_lo, ph_hi = kp->ph_hi; unsigned* const barw = kp->bar
#else
#define PHASE_PARAMS() const Params p = p_unused
#define KP_INIT() const int ph_lo = p_unused.ph_lo, ph_hi = p_unused.ph_hi; unsigned* const barw = p_unused.bar
#endif
__global__ void __launch_bounds__(512, 2) mega(Params p_unused) {
    extern __shared__ __attribute__((aligned(16))) char lds[];
    KP_INIT();
    cg::grid_group grid = cg::this_grid();
    volatile LDS_AS unsigned* xst = (volatile LDS_AS unsigned*)(lds + LDS_BYTES - 16);
    if (threadIdx.x == 0) { xst[0] = 0u; xst[1] = 0u; }
    __syncthreads();
    const XcdBarrier xb = xcd_barrier_post(barw, xst);
    if (ph_hi > PH_END) grid.sync();
    for (int ph = ph_lo; ph < ph_hi; ++ph) {
      const int nrep = ((REPMASK >> ph) & 1) ? 2 : 1;
      for (int rep = 0; rep < nrep; ++rep) {
        if (rep) xcd_barrier(xb);
#if defined(ROUTE2)
        if (rep && ph == PH_ROUTE) { PHASE_PARAMS(); if (blockIdx.x == 0 && threadIdx.x < 32) p.counts[threadIdx.x] = 0; xcd_barrier(xb); }
#endif
#if defined(FLUSHMASK)
        if (rep && ((FLUSHMASK >> ph) & 1)) { PHASE_PARAMS(); ph_flush(p); xcd_barrier(xb); }
#if defined(FLUSHONLY)
        if (rep && ((FLUSHMASK >> ph) & 1)) continue;
#endif
#endif
        switch (ph) {
        case PH_PRO: { PHASE_PARAMS(); ph_prologue(p); } break;
        case PH_PROJ: {
            PHASE_PARAMS();
            const int G = gridDim.x, ng = G - NCONV;
            if ((int)blockIdx.x < ng) {
                pg::DenseSched S; S.init(p.xn, p.winT, T, PJW, ng, blockIdx.x);
                pg::EpiProj E{p.proj};
                pg::gemm_phase((LDS_AS unsigned char*)lds, S, E);
            } else {
                const int tid = tid_opaque(), t = tid & 255, st = NCONV * 2;
                const int l = t & 63, w = t >> 6, kg = l & 7, ngq = w * 8 + (l >> 3);
#define CV_DECL(X) f32x4 X##0 = {0.f, 0.f, 0.f, 0.f}, X##1 = X##0, X##2 = X##0, X##3 = X##0, X##4 = X##0, X##5 = X##0, X##6 = X##0, X##7 = X##0
#define CV_LOAD(X, i_) do { const int e_ = (i_) >> 8, j_ = (i_) & 255; const float* s_ = p.w1 + (size_t)e_ * D * 2 * DFF + (size_t)((j_ >> 4) * 64 + 8 * kg) * (2 * DFF) + (j_ & 15) * 128 + 4 * ngq; \
        X##0 = *(const f32x4*)(s_); X##1 = *(const f32x4*)(s_ + 2 * DFF); X##2 = *(const f32x4*)(s_ + 2 * 2 * DFF); X##3 = *(const f32x4*)(s_ + 3 * 2 * DFF); \
        X##4 = *(const f32x4*)(s_ + 4 * 2 * DFF); X##5 = *(const f32x4*)(s_ + 5 * 2 * DFF); X##6 = *(const f32x4*)(s_ + 6 * 2 * DFF); X##7 = *(const f32x4*)(s_ + 7 * 2 * DFF); } while (0)
#define CV_STORE(X, i_) do { const int e_ = (i_) >> 8, j_ = (i_) & 255; unsigned char* d_ = p.w1T8 + (size_t)e_ * 2 * DFF * D + (size_t)((j_ & 15) * 128 + 4 * ngq) * 1024 + (j_ >> 4) * 64 + 8 * kg; \
        _Pragma("unroll") for (int c_ = 0; c_ < 4; ++c_) { \
            int lo_ = __builtin_amdgcn_cvt_pk_fp8_f32(X##0[c_] * 32.0f, X##1[c_] * 32.0f, 0, false); lo_ = __builtin_amdgcn_cvt_pk_fp8_f32(X##2[c_] * 32.0f, X##3[c_] * 32.0f, lo_, true); \
            int hi_ = __builtin_amdgcn_cvt_pk_fp8_f32(X##4[c_] * 32.0f, X##5[c_] * 32.0f, 0, false); hi_ = __builtin_amdgcn_cvt_pk_fp8_f32(X##6[c_] * 32.0f, X##7[c_] * 32.0f, hi_, true); \
            uint2 q_; q_.x = (unsigned)lo_; q_.y = (unsigned)hi_; *(uint2*)(d_ + c_ * 1024) = q_; } } while (0)
                CV_DECL(ra); CV_DECL(rb);
                const int hid = ((int)blockIdx.x - ng) * 2 + (tid >> 8), per = (CV_W1 + st - 1) / st;
                const int i0 = min(hid * per, CV_W1 - 1), ilast = min(i0 + per, CV_W1) - 1;
                const int npair = (per + 1) / 2;
                CV_LOAD(ra, i0);
                for (int k = 0; k < npair; ++k) {
                    const int ia = min(i0 + 2 * k, ilast), ib = min(ia + 1, ilast), ic = min(ib + 1, ilast);
                    CV_LOAD(rb, ib);
                    CV_STORE(ra, ia);
                    CV_LOAD(ra, ic);
                    CV_STORE(rb, ib);
                }
#undef CV_DECL
#undef CV_LOAD
#undef CV_STORE
            }
            {
                const int tid2 = tid_opaque(), lane = tid2 & 63, i16 = lane & 15, g = lane >> 4;
                for (int task = (G - 1 - (int)blockIdx.x) * 8 + (tid2 >> 6); task < T / 16; task += G * 8) {
                    f32x4 z0 = {0.f, 0.f, 0.f, 0.f}, z1 = {0.f, 0.f, 0.f, 0.f};
                    const u16* ar = p.xn + (size_t)(task * 16 + i16) * D + 8 * g;
                    const u16* w0 = p.wzT + (size_t)i16 * D + 8 * g;
                    const u16* w1 = w0 + 16 * D;
#pragma unroll 8
                    for (int ks = 0; ks < 32; ++ks) {
                        const bf16x8 a = *(const bf16x8*)(ar + ks * 32);
                        z0 = __builtin_amdgcn_mfma_f32_16x16x32_bf16(a, *(const bf16x8*)(w0 + ks * 32), z0, 0, 0, 0);
                        z1 = __builtin_amdgcn_mfma_f32_16x16x32_bf16(a, *(const bf16x8*)(w1 + ks * 32), z1, 0, 0, 0);
                    }
#pragma unroll
                    for (int r = 0; r < 4; ++r) {
                        const size_t row = (size_t)task * 16 + 4 * g + r;
                        p.zbuf[row * 32 + i16] = z0[r]; p.zbuf[row * 32 + 16 + i16] = z1[r];
                    }
                }
            }
        } break;
        case PH_MIX1: {
            PHASE_PARAMS();
            const int tid = tid_opaque(), t = tid & 255, half = tid >> 8;
            char* hl = lds + half * HALF_LDS;
#ifndef MIX1_SKIP_GLA_ON_REP
            for (int it0 = blockIdx.x * 2; it0 < N_GLA_ITEMS; it0 += gridDim.x * 2) gla_ds_item(p, hl, t, min(it0 + half, N_GLA_ITEMS - 1));
#else
            if (!rep) for (int it0 = blockIdx.x * 2; it0 < N_GLA_ITEMS; it0 += gridDim.x * 2) gla_ds_item(p, hl, t, min(it0 + half, N_GLA_ITEMS - 1));
#endif
            {
                AttnRegs AR;
                attn_load(p, t, min((int)blockIdx.x * 2 + half, N_ATT_ITEMS - 1), AR);
                for (int it0 = blockIdx.x * 2; it0 < N_ATT_ITEMS; it0 += gridDim.x * 2) {
                    const int nx0 = it0 + gridDim.x * 2;
                    attn_item(p, hl, t, min(it0 + half, N_ATT_ITEMS - 1), nx0 < N_ATT_ITEMS ? min(nx0 + half, N_ATT_ITEMS - 1) : -1, AR);
                }
            }
        } break;
        case PH_MIX2: {
            PHASE_PARAMS();
            const int tid = tid_opaque();
            for (int gid = blockIdx.x * 512 + tid; gid < (1 << 17); gid += gridDim.x * 512) gla_scan_thread2(p, gid);
            for (int gid = blockIdx.x * 512 + tid; gid < T * 64; gid += gridDim.x * 512) attn_combine_thread(p, gid);
        } break;
        case PH_MIX3: {
            PHASE_PARAMS();
            const int tid = tid_opaque(), t = tid & 255, half = tid >> 8;
            char* hl = lds + half * HALF_LDS;
            for (int it0 = blockIdx.x * 2; it0 < N_GLA_ITEMS; it0 += gridDim.x * 2) gla_out_item(p, hl, t, min(it0 + half, N_GLA_ITEMS - 1));
        } break;
        case PH_OUTPROJ: {
            PHASE_PARAMS();
            pg::DenseSched S; S.init(p.mix, p.woT, T, D, gridDim.x, blockIdx.x);
            pg::EpiOut E{p.x, p.x1};
            pg::gemm_phase((LDS_AS unsigned char*)lds, S, E);
        } break;
        case PH_ROUTE: { PHASE_PARAMS(); ph_route(p, lds); } break;
        case PH_MOE1: {
            PHASE_PARAMS();
            int* meta = (int*)(lds + MO_META);
            moe_meta(p, meta);
            pg::MoeSchedT<true> S{(const u16*)p.xn28, (const u16*)p.w1T8, p.lists, (const LDS_AS int*)meta, 8, meta[32 + NE] * 8, (int)gridDim.x, (int)blockIdx.x, 1024, (const LDS_AS unsigned*)(lds + MO_TABA)};
            moe_tables(p, lds, S);
            pg::EpiMoe1 E{p.b1, p.act8};
            pg::gemm_phase<pg::EpiMoe1, pg::MoeSchedT<true>, true>((LDS_AS unsigned char*)lds, S, E);
            {
                const int G = gridDim.x, nun = S.nunits, r = nun % G, nshort = r ? G - r : G, sidx = r ? (int)blockIdx.x - r : (int)blockIdx.x;
                if (sidx >= 0) {
                    const int tid = tid_opaque(), t = tid & 255, hv = tid >> 8;
                    const int per = (W2_LATE + nshort * 2 - 1) / (nshort * 2), ib = (sidx * 2 + hv) * per;
                    for (int i = ib; i < min(ib + per, W2_LATE); ++i) { const int e = i >> 7, j = i & 127; cvt_tile8(p.w2 + (size_t)e * DFF * D, D, p.w2T8 + (size_t)e * D * DFF, (j >> 3) * 64, (j & 7) * 128, t); }
                }
            }
        } break;
        case PH_MOE2: {
            PHASE_PARAMS();
            int* meta = (int*)(lds + MO_META);
            moe_meta(p, meta);
            pg::MoeSchedT<false> S{(const u16*)p.act8, (const u16*)p.w2T8, p.lists, (const LDS_AS int*)meta, 4, meta[32 + NE] * 4, (int)gridDim.x, (int)blockIdx.x, 1024, nullptr};
            pg::EpiMoe2 E{p.b2, p.gate, p.lists, (const LDS_AS int*)meta, p.y};
            pg::gemm_phase<pg::EpiMoe2, pg::MoeSchedT<false>, true>((LDS_AS unsigned char*)lds, S, E);
        } break;
        case PH_FINAL: { PHASE_PARAMS(); ph_final(p); } break;
        default: break;
        }
      }
#ifdef EXTRA_BAR
        if (ph == PH_MIX2) { for (int q = 0; q < EXTRA_BAR; ++q) xcd_barrier(xb); }
#endif
        if (ph + 1 < ph_hi) xcd_barrier(xb);
    }
}

#ifndef STAGE
#define STAGE 6
#endif

__global__ void __launch_bounds__(256) cvt_bf16_f32(const u16* __restrict__ src, int lds_, float* __restrict__ dst, int ldd, int rows, int cols) {
    const size_t n = (size_t)rows * cols;
    for (size_t i = (size_t)blockIdx.x * 256 + threadIdx.x; i < n; i += (size_t)gridDim.x * 256) {
        const size_t r = i / cols, c = i % cols;
        dst[r * ldd + c] = bf2f(src[r * lds_ + c]);
    }
}

#include <cstdio>
extern "C" void kernel_launch(void* const* d_in, const int* in_sizes, int n_in, void* d_out, int out_size, void* d_ws, size_t ws_size, hipStream_t stream) {
    const float* x = (const float*)d_in[0];
    const float* norm1_g = (const float*)d_in[1];
    const float* w_in = (const float*)d_in[2];
    const float* rel_bias = (const float*)d_in[3];
    const float* wgf = (const float*)d_in[4];
    const float* bgf = (const float*)d_in[5];
    const float* wgb = (const float*)d_in[6];
    const float* bgb = (const float*)d_in[7];
    const float* gla_ng = (const float*)d_in[8];
    const float* w_out = (const float*)d_in[9];
    const float* norm2_g = (const float*)d_in[10];
    const float* router_w = (const float*)d_in[11];
    const float* router_b = (const float*)d_in[12];
    const float* w1 = (const float*)d_in[13];
    const float* b1 = (const float*)d_in[14];
    const float* w2 = (const float*)d_in[15];
    const float* b2 = (const float*)d_in[16];
    const float* final_g = (const float*)d_in[17];
    float* out = (float*)d_out;

    static int grid_blocks = 0;
    if (!grid_blocks) {
        int dev = 0, cus = 0, per_cu = 0;
        hipGetDevice(&dev);
        hipDeviceGetAttribute(&cus, hipDeviceAttributeMultiprocessorCount, dev);
        hipFuncSetAttribute((const void*)mega, hipFuncAttributeMaxDynamicSharedMemorySize, LDS_BYTES);
        hipOccupancyMaxActiveBlocksPerMultiprocessor(&per_cu, mega, 512, LDS_BYTES);
        if (per_cu > 1) per_cu = 1;
        if (per_cu < 1) per_cu = 1;
        grid_blocks = cus * per_cu;
    }

    char* ws = (char*)d_ws;
    size_t off = 0;
    auto take = [&](size_t bytes) { char* p = ws + off; off += (bytes + 255) & ~(size_t)255; return p; };
    Params p{};
    p.x = x; p.g1 = norm1_g; p.w_in = w_in; p.rel_bias = rel_bias; p.wgf = wgf; p.bgf = bgf; p.wgb = wgb; p.bgb = bgb; p.gla_ng = gla_ng;
    p.w_out = w_out; p.g2 = norm2_g; p.rw = router_w; p.rb = router_b; p.w1 = w1; p.b1 = b1; p.w2 = w2; p.b2 = b2; p.gf = final_g; p.out = out;
    p.winT = (u16*)take((size_t)PJW * D * 2);
    p.wzT = (u16*)take((size_t)32 * D * 2);
    p.woT = (u16*)take((size_t)D * D * 2);
    p.w1T = (u16*)take((size_t)NE * 2 * DFF * D * 2); p.w1T8 = (unsigned char*)p.w1T;
    p.w2T = (u16*)take((size_t)NE * D * DFF * 2); p.w2T8 = (unsigned char*)p.w2T;
    p.zbuf = (float*)take((size_t)T * 32 * 4);
    p.lse = (float*)take((size_t)3 * T * 8 * 4);
    p.dec = (float*)take((size_t)B * GH * 64 * 2 * 64 * 4);
    p.x1 = (float*)take((size_t)T * D * 4);
    p.counts = (int*)take(256);
    p.lists = (int*)take((size_t)NE * T * 4);
    p.gate = (float*)take((size_t)NSLOT * 4);
    p.bar = (unsigned*)take((size_t)XCD_BAR_WORDS * 4);
    p.xn = (u16*)take((size_t)T * D * 2); p.xn2 = p.xn; p.xn28 = (unsigned char*)p.xn;
    { char* ra = take((size_t)T * PJW * 2 + (size_t)3 * T * 512 * 2);
      p.proj = (u16*)ra; p.abr = (u16*)(ra + (size_t)T * PJW * 2); p.act = (u16*)ra; p.act8 = (unsigned char*)ra; }
    { char* rb = take((size_t)B * GH * 64 * 2 * 128 * 64 * 4 + (size_t)B * GH * 64 * 2 * 128 * 64 * 2 + (size_t)T * D * 2);
      p.dS = (float*)rb; p.Sp = (u16*)(rb + (size_t)B * GH * 64 * 2 * 128 * 64 * 4); p.mix = (u16*)(rb + (size_t)B * GH * 64 * 2 * 128 * 64 * 4 + (size_t)B * GH * 64 * 2 * 128 * 64 * 2); p.y = (u16*)rb; }
    const size_t off_shared = off;

    auto run_fast = [&](int lo, int hi) {
        (void)hipMemsetAsync(p.bar, 0, (size_t)XCD_BAR_WORDS * 4, stream);
        p.ph_lo = lo; p.ph_hi = hi;
        void* args[] = {&p};
        hipError_t e = hipLaunchCooperativeKernel((const void*)mega, dim3(grid_blocks), dim3(512), args, LDS_BYTES, stream);
        if (e != hipSuccess) fprintf(stderr, "cooperative launch failed: %s (grid %d)\n", hipGetErrorString(e), grid_blocks);
    };

#if STAGE >= 6
    run_fast(PH_PRO, PH_END);
#else
    off = off_shared;
    float* n_xn = (float*)take((size_t)T * D * 4);
    float* n_x2 = (float*)take((size_t)T * D * 4);
    float* n_mix = (float*)take((size_t)T * D * 4);
    int* n_topi = (int*)take((size_t)T * 4 * 4);
    float* n_hact = (float*)take((size_t)T * DFF * 4);
    float* n_x1 = p.x1;
    int* n_lists = p.lists; int* n_counts = p.counts; float* n_gate = p.gate;
#if STAGE == 3
    run_fast(PH_PRO, PH_MIX3 + 1);
#elif STAGE == 4
    run_fast(PH_PRO, PH_OUTPROJ + 1);
#elif STAGE == 5
    run_fast(PH_PRO, PH_ROUTE + 1);
#else
#error "hybrid STAGE must be 3, 4 or 5"
#endif
#if STAGE == 3
    cvt_bf16_f32<<<2048, 256, 0, stream>>>(p.mix, D, n_mix, D, T, D);
#endif
#if STAGE <= 3
    nv_gemm<EPI_RESID><<<dim3(D / 64, T / 64), 256, 0, stream>>>(n_mix, D, nullptr, 0, nullptr, T, w_out, D, D, D, n_x1, D, x, nullptr);
#endif
#if STAGE <= 4
    nv_route<<<T / 4, 256, 0, stream>>>(n_x1, norm2_g, router_w, router_b, n_xn, n_topi, n_gate);
    nv_lists<<<1, 32, 0, stream>>>(n_topi, n_lists, n_counts);
#endif
#if STAGE == 5
    cvt_bf16_f32<<<2048, 256, 0, stream>>>(p.xn2, D, n_xn, D, T, D);
#endif
    (void)hipMemcpyAsync(n_x2, n_x1, (size_t)T * D * 4, hipMemcpyDeviceToDevice, stream);
    for (int e = 0; e < NE; ++e) {
        nv_gemm<EPI_SWIGLU><<<dim3(2 * DFF / 64, T / 64), 256, 0, stream>>>(n_xn, D, n_lists + (size_t)e * T, 2, n_counts + e, 0,
                                                                          w1 + (size_t)e * D * 2 * DFF, 2 * DFF, 2 * DFF, D, n_hact, DFF, b1 + (size_t)e * 2 * DFF, nullptr);
        nv_moe2<<<dim3(D / 64, T / 64), 256, 0, stream>>>(n_hact, n_lists + (size_t)e * T, n_counts + e, w2 + (size_t)e * DFF * D, n_x2, b2 + (size_t)e * D, n_gate);
    }
    nv_rmsnorm<<<T / 4, 256, 0, stream>>>(n_x2, final_g, out, T);
#endif
}
```

```cpp
#define STAGE 6
#define REPMASK 0
#include <hip/hip_runtime.h>
#include <stdint.h>

namespace cfg {
constexpr int D = 1024, B = 4, S = 4096, T = B * S;
constexpr int AH = 8;
constexpr int GH = 4;
constexpr int INW = 3104;
constexpr int C_AQ = 0, C_AK = 512, C_AV = 1024, C_GQ = 1536, C_GK = 1792, C_GV = 2048, C_GO = 2560, C_GZ = 3072;
constexpr int NE = 32, DFF = 1024;
constexpr float EPS = 1e-5f;
}
using namespace cfg;

__device__ const unsigned char T5TAB[387] = {
11,11,11,11,11,11,11,11,11,11,11,11,11,11,11,10,10,10,10,10,10,10,10,10,10,10,10,10,10,10,10,10,10,10,10,10,10,10,9,9,9,9,9,9,9,9,9,9,9,9,8,8,8,8,8,8,8,7,6,5,4,3,2,1,0,17,18,19,20,21,22,23,24,24,24,24,24,24,24,25,25,25,25,25,25,25,25,25,25,25,25,26,26,26,26,26,26,26,26,26,26,26,26,26,26,26,26,26,26,26,26,26,26,26,27,27,27,27,27,27,27,27,27,27,27,27,27,27,27,
13,13,13,13,13,13,13,13,13,13,13,13,13,13,13,13,13,13,13,13,13,13,13,12,12,12,12,12,12,12,12,12,12,12,12,12,12,12,12,12,12,12,11,11,11,11,11,11,11,11,11,11,10,10,10,10,10,10,9,9,9,8,8,4,0,20,24,24,25,25,25,26,26,26,26,26,26,27,27,27,27,27,27,27,27,27,27,28,28,28,28,28,28,28,28,28,28,28,28,28,28,28,28,28,28,28,29,29,29,29,29,29,29,29,29,29,29,29,29,29,29,29,29,29,29,29,29,29,29,
15,15,15,15,15,15,15,15,15,15,15,15,15,15,15,15,15,15,15,15,15,15,15,15,15,15,15,15,15,15,14,14,14,14,14,14,14,14,14,14,14,14,14,14,14,13,13,13,13,13,13,13,13,13,12,12,12,12,12,11,11,10,10,9,0,25,26,26,27,27,28,28,28,28,28,29,29,29,29,29,29,29,29,29,30,30,30,30,30,30,30,30,30,30,30,30,30,30,30,31,31,31,31,31,31,31,31,31,31,31,31,31,31,31,31,31,31,31,31,31,31,31,31,31,31,31,31,31,31};

template <int MASK> __device__ __forceinline__ float swz_xor(float v) { return __builtin_bit_cast(float, __builtin_amdgcn_ds_swizzle(__builtin_bit_cast(int, v), (MASK << 10) | 0x1F)); }
__device__ __forceinline__ float half_sum(float v) {
    const auto r = __builtin_amdgcn_permlane32_swap(__builtin_bit_cast(unsigned, v), __builtin_bit_cast(unsigned, v), false, false);
    return __builtin_bit_cast(float, (unsigned)r[0]) + __builtin_bit_cast(float, (unsigned)r[1]);
}
__device__ __forceinline__ float half_max(float v) {
    const auto r = __builtin_amdgcn_permlane32_swap(__builtin_bit_cast(unsigned, v), __builtin_bit_cast(unsigned, v), false, false);
    return fmaxf(__builtin_bit_cast(float, (unsigned)r[0]), __builtin_bit_cast(float, (unsigned)r[1]));
}
__device__ __forceinline__ float wave_sum(float v) {
    v += swz_xor<1>(v); v += swz_xor<2>(v); v += swz_xor<4>(v); v += swz_xor<8>(v); v += swz_xor<16>(v);
    return half_sum(v);
}

#include <hip/hip_cooperative_groups.h>
namespace cg = cooperative_groups;

typedef unsigned short u16;
typedef short bf16x8 __attribute__((ext_vector_type(8)));
typedef short s16x4 __attribute__((ext_vector_type(4)));
typedef float f32x4 __attribute__((ext_vector_type(4)));
typedef unsigned u32x4 __attribute__((ext_vector_type(4)));
typedef __bf16 bfv2 __attribute__((ext_vector_type(2)));
typedef float fv2 __attribute__((ext_vector_type(2)));
#define LDS_AS __attribute__((address_space(3)))

constexpr int LDS_BYTES = 160 * 1024;
constexpr int HALF_LDS = 80 * 1024;
constexpr int NSLOT = T * 4;
constexpr int PJW = 3072;
#ifndef REPMASK
#define REPMASK 0
#endif

struct Params {
    const float *x, *g1, *w_in, *rel_bias, *wgf, *bgf, *wgb, *bgb, *gla_ng, *w_out, *g2, *rw, *rb, *w1, *b1, *w2, *b2, *gf;
    float* out;
    u16* winT;
    u16* wzT;
    u16* woT;
    u16* w1T;
    u16* w2T;
    u16* xn;
    u16* proj;
    float* zbuf;
    u16* abr;
    float* lse;
    float* dS;
    float* dec;
    u16* Sp;
    u16* mix;
    float* x1;
    u16* xn2;
    int* counts;
    int* lists;
    float* gate;
    u16* act;
    u16* y;
    unsigned char* xn28;
    unsigned char* w1T8;
    unsigned char* act8;
    unsigned char* w2T8;
    unsigned* bar;
    int ph_lo, ph_hi;
};

__device__ __forceinline__ int tid_opaque() { int t = threadIdx.x; asm volatile("" : "+v"(t)); return t; }
__device__ __forceinline__ float bf2f(u16 v) { return __uint_as_float((unsigned)v << 16); }
__device__ __forceinline__ unsigned pack2(float a, float b) {
    fv2 v = {a, b};
    bfv2 r = __builtin_convertvector(v, bfv2);
    return __builtin_bit_cast(unsigned, r);
}
__device__ __forceinline__ u16 f2bf(float a) { return (u16)(pack2(a, 0.f) & 0xffffu); }
__device__ __forceinline__ float lo2f(unsigned u) { return __uint_as_float(u << 16); }
__device__ __forceinline__ float hi2f(unsigned u) { return __uint_as_float(u & 0xffff0000u); }
__device__ __forceinline__ int tile_off(int row, int chunk) { return row * 128 + ((chunk ^ (row & 7)) << 4); }
__device__ __forceinline__ bf16x8 lds_frag(const char* base, int row, int chunk) { return *(const bf16x8*)(base + tile_off(row, chunk)); }
__device__ __forceinline__ s16x4 tr_read(const char* p) {
    return __builtin_amdgcn_ds_read_tr16_b64_v4i16((LDS_AS s16x4*)(p));
}
__device__ __forceinline__ bf16x8 cat4(s16x4 a, s16x4 b) { bf16x8 r = {a[0], a[1], a[2], a[3], b[0], b[1], b[2], b[3]}; return r; }
__device__ __forceinline__ float logsig(float a) { return fminf(a, 0.f) - log1pf(expf(-fabsf(a))); }

__device__ __forceinline__ void cvt_tile8(const float* __restrict__ src, int ldsrc, unsigned char* __restrict__ dst, int k0, int n0, int t) {
    const int l = t & 63, w = t >> 6, kg = l & 7, ng = w * 8 + (l >> 3);
    const float* s = src + (size_t)(k0 + 8 * kg) * ldsrc + n0 + 4 * ng;
    f32x4 bv[8];
#pragma unroll
    for (int j = 0; j < 8; ++j) bv[j] = *(const f32x4*)(s + (size_t)j * ldsrc) * 32.0f;
    unsigned char* d = dst + (size_t)(n0 + 4 * ng) * 1024 + k0 + 8 * kg;
#pragma unroll
    for (int c = 0; c < 4; ++c) {
        int lo = __builtin_amdgcn_cvt_pk_fp8_f32(bv[0][c], bv[1][c], 0, false); lo = __builtin_amdgcn_cvt_pk_fp8_f32(bv[2][c], bv[3][c], lo, true);
        int hi = __builtin_amdgcn_cvt_pk_fp8_f32(bv[4][c], bv[5][c], 0, false); hi = __builtin_amdgcn_cvt_pk_fp8_f32(bv[6][c], bv[7][c], hi, true);
        uint2 q; q.x = (unsigned)lo; q.y = (unsigned)hi;
        *(uint2*)(d + c * 1024) = q;
    }
}
__device__ __forceinline__ void cvt_tile(const float* __restrict__ src, int ldsrc, u16* __restrict__ dst, int k0, int n0, int t) {
    const int l = t & 63, w = t >> 6, kg = l & 7, ng = w * 8 + (l >> 3);
    const float* s = src + (size_t)(k0 + 8 * kg) * ldsrc + n0 + 4 * ng;
    float4 bv[8];
#pragma unroll
    for (int j = 0; j < 8; ++j) bv[j] = *(const float4*)(s + (size_t)j * ldsrc);
    u16* d = dst + (size_t)(n0 + 4 * ng) * 1024 + k0 + 8 * kg;
    uint4 q;
    q.x = pack2(bv[0].x, bv[1].x); q.y = pack2(bv[2].x, bv[3].x); q.z = pack2(bv[4].x, bv[5].x); q.w = pack2(bv[6].x, bv[7].x);
    *(uint4*)(d) = q;
    q.x = pack2(bv[0].y, bv[1].y); q.y = pack2(bv[2].y, bv[3].y); q.z = pack2(bv[4].y, bv[5].y); q.w = pack2(bv[6].y, bv[7].y);
    *(uint4*)(d + 1024) = q;
    q.x = pack2(bv[0].z, bv[1].z); q.y = pack2(bv[2].z, bv[3].z); q.z = pack2(bv[4].z, bv[5].z); q.w = pack2(bv[6].z, bv[7].z);
    *(uint4*)(d + 2048) = q;
    q.x = pack2(bv[0].w, bv[1].w); q.y = pack2(bv[2].w, bv[3].w); q.z = pack2(bv[4].w, bv[5].w); q.w = pack2(bv[6].w, bv[7].w);
    *(uint4*)(d + 3072) = q;
}
struct CvtRegs { f32x4 bv[8]; };
__device__ __forceinline__ void cvt_load(const float* __restrict__ src, int ldsrc, int k0, int n0, int t, CvtRegs& R) {
    const int l = t & 63, w = t >> 6, kg = l & 7, ng = w * 8 + (l >> 3);
    const float* s = src + (size_t)(k0 + 8 * kg) * ldsrc + n0 + 4 * ng;
#pragma unroll
    for (int j = 0; j < 8; ++j) R.bv[j] = *(const f32x4*)(s + (size_t)j * ldsrc);
}
__device__ __forceinline__ void cvt_store(u16* __restrict__ dst, int k0, int n0, int t, const CvtRegs& R) {
    const int l = t & 63, w = t >> 6, kg = l & 7, ng = w * 8 + (l >> 3);
    u16* d = dst + (size_t)(n0 + 4 * ng) * 1024 + k0 + 8 * kg;
#pragma unroll
    for (int c = 0; c < 4; ++c) {
        u32x4 q;
        q.x = pack2(R.bv[0][c], R.bv[1][c]); q.y = pack2(R.bv[2][c], R.bv[3][c]); q.z = pack2(R.bv[4][c], R.bv[5][c]); q.w = pack2(R.bv[6][c], R.bv[7][c]);
        *(u32x4*)(d + c * 1024) = q;
    }
}
__device__ __forceinline__ void w1_load(const Params& p, int i, int t, CvtRegs& R) { const int e = i >> 8, j = i & 255; cvt_load(p.w1 + (size_t)e * D * 2 * DFF, 2 * DFF, (j >> 4) * 64, (j & 15) * 128, t, R); }
__device__ __forceinline__ void w1_store(const Params& p, int i, int t, const CvtRegs& R) { const int e = i >> 8, j = i & 255; cvt_store(p.w1T + (size_t)e * 2 * DFF * D, (j >> 4) * 64, (j & 15) * 128, t, R); }
constexpr int CV_WIN = 384, CV_WZ = 1, CV_WO = 128, CV_W1 = NE * 256, CV_W2 = NE * 128;
constexpr int CV_TOTAL = CV_WIN + CV_WZ + CV_WO + CV_W1 + CV_W2;
constexpr int W2_LATE = 3072;
#ifndef NCONV
#define NCONV 102
#endif
#ifndef W1_CONV
#define W1_CONV 8192
#endif
__device__ void ph_prologue(const Params& p) {
    const int tid = tid_opaque();
    if (blockIdx.x == 0 && tid < 32) p.counts[tid] = 0;
    {
        const int lane = tid & 63, gw = blockIdx.x * 8 + (tid >> 6), nw = gridDim.x * 8;
        for (int row = gw; row < T; row += nw) {
            const float4* xr = (const float4*)(p.x + (size_t)row * D);
            float4 v[4]; float ss = 0.f;
#pragma unroll
            for (int i = 0; i < 4; ++i) { v[i] = xr[lane + 64 * i]; ss += v[i].x * v[i].x + v[i].y * v[i].y + v[i].z * v[i].z + v[i].w * v[i].w; }
            ss = wave_sum(ss);
            const float r = rsqrtf(ss * (1.0f / D) + EPS);
#pragma unroll
            for (int i = 0; i < 4; ++i) {
                const float4 g = ((const float4*)p.g1)[lane + 64 * i];
                uint2 o; o.x = pack2(v[i].x * r * g.x, v[i].y * r * g.y); o.y = pack2(v[i].z * r * g.z, v[i].w * r * g.w);
                *(uint2*)(p.xn + (size_t)row * D + (lane + 64 * i) * 4) = o;
            }
        }
    }
    const int t = tid & 255, vb = blockIdx.x * 2 + (tid >> 8), nvb = gridDim.x * 2;
    for (int it = vb; it < CV_TOTAL; it += nvb) {
        int i = it;
        if (i < CV_WIN) { cvt_tile(p.w_in, INW, p.winT, (i / 24) * 64, (i % 24) * 128, t); continue; }
        i -= CV_WIN;
        if (i < CV_WZ) {
            for (int c = t; c < 32 * 128; c += 256) {
                const int n = c >> 7, k8 = (c & 127) * 8;
                const float* s = p.w_in + (size_t)k8 * INW + PJW + n;
                uint4 q;
                q.x = pack2(s[0], s[INW]); q.y = pack2(s[2 * INW], s[3 * INW]); q.z = pack2(s[4 * INW], s[5 * INW]); q.w = pack2(s[6 * INW], s[7 * INW]);
                *(uint4*)(p.wzT + (size_t)n * 1024 + k8) = q;
            }
            continue;
        }
        i -= CV_WZ;
        if (i < CV_WO) { cvt_tile(p.w_out, D, p.woT, (i >> 3) * 64, (i & 7) * 128, t); continue; }
        i -= CV_WO;
        if (i < CV_W1) { if (i >= W1_CONV) { const int e = i >> 8, j = i & 255; cvt_tile8(p.w1 + (size_t)e * D * 2 * DFF, 2 * DFF, p.w1T8 + (size_t)e * 2 * DFF * D, (j >> 4) * 64, (j & 15) * 128, t); } continue; }
        i -= CV_W1;
        if (i >= W2_LATE) { const int e = i >> 7, j = i & 127; cvt_tile8(p.w2 + (size_t)e * DFF * D, D, p.w2T8 + (size_t)e * D * DFF, (j >> 3) * 64, (j & 7) * 128, t); }
    }
}

namespace pg {
constexpr int BM = 256, BK = 64, HALF = 128, HTB = HALF * BK * 2, KD = 1024;
__host__ __device__ __forceinline__ int lds_byte(int r, int c) { const int st = (r >> 4) * 2 + (c >> 5), rr = r & 15, cc = c & 31, ob = rr * 64 + cc * 2; return st * 1024 + (ob ^ (((ob >> 9) & 1) << 5)); }
__host__ __device__ __forceinline__ void stage_rc(int b, int& R, int& C) { const int st = b / 1024, sb = b % 1024, swz = sb ^ (((sb >> 9) & 1) << 5); R = (st >> 1) * 16 + swz / 64; C = (st & 1) * 32 + (swz % 64) / 2; }
__host__ __device__ __forceinline__ int perm32(int rho) { const int n = rho >> 4, i = rho & 15; return 8 * (i >> 2) + 4 * n + (i & 3); }

struct Unit { int pn, row0, nvalid, e, ord; };

typedef int v8i32 __attribute__((ext_vector_type(8)));
template <class Epi, class Sched, bool FP8 = false>
__device__ __forceinline__ void gemm_phase(LDS_AS unsigned char* lds, const Sched& S, const Epi& E) {
    const int tid = tid_opaque(), wid = __builtin_amdgcn_readfirstlane(tid >> 6), lane = tid & 63, wr = wid >> 2, wc = wid & 3, fr = lane & 15, fq = lane >> 4;
    constexpr int ROWB = FP8 ? KD : KD * 2;
    constexpr int nt = FP8 ? KD / 128 : KD / BK;
    int R0, C0; stage_rc(tid * 16, R0, C0);
    unsigned voffB[2];
#pragma unroll
    for (int i = 0; i < 2; ++i) { const int R = R0 + 64 * i; const int Rb = Epi::PERM ? ((R & ~31) + perm32(R & 31)) : R; voffB[i] = (unsigned)(Rb * ROWB + C0 * 2); }
    const size_t kstep = (size_t)(BK * 2);
    const size_t hstep = (size_t)HALF * ROWB;
    const unsigned ldsw = (unsigned)wid * 1024u;
    const int aoff = lds_byte(wr * 64 + fr, fq * 8), boff = lds_byte(wc * 32 + fr, fq * 8);
    const int aoff8a = lds_byte(wr * 64 + fr, fq * 16), boff8a = lds_byte(wc * 32 + fr, fq * 16);
#define PG_SA(b, h) (((b) * 2 + (h)) * HTB)
#define PG_SB(b, h) ((4 + (b) * 2 + (h)) * HTB)
#define PG_STAGE_B(bufoff, gbase) do { _Pragma("unroll") for (int _i = 0; _i < 2; ++_i) \
        __builtin_amdgcn_global_load_lds((const unsigned*)((const char*)(gbase) + voffB[_i]), (LDS_AS unsigned*)(lds + (bufoff) + ldsw + _i * 8192), 16, 0, 0); } while (0)
#define PG_STAGE_A(bufoff, o0, o1) do { \
        __builtin_amdgcn_global_load_lds((const unsigned*)(Abase + (o0)), (LDS_AS unsigned*)(lds + (bufoff) + ldsw), 16, 0, 0); \
        __builtin_amdgcn_global_load_lds((const unsigned*)(Abase + (o1)), (LDS_AS unsigned*)(lds + (bufoff) + ldsw + 8192), 16, 0, 0); } while (0)
#define PG_LDA16(dst, b, h) do { _Pragma("unroll") for (int m = 0; m < 4; ++m) _Pragma("unroll") for (int k = 0; k < 2; ++k) dst[m][k] = *(const LDS_AS bf16x8*)(lds + PG_SA(b, h) + aoff + m * 2048 + k * 1024); } while (0)
#define PG_LDB16(dst, b, h) do { _Pragma("unroll") for (int n = 0; n < 2; ++n) _Pragma("unroll") for (int k = 0; k < 2; ++k) dst[n][k] = *(const LDS_AS bf16x8*)(lds + PG_SB(b, h) + boff + n * 2048 + k * 1024); } while (0)
#define PG_RD16(off) __builtin_bit_cast(u32x4, *(const LDS_AS bf16x8*)(lds + (off)))
#define PG_LDA8(dst, b, h) do { _Pragma("unroll") for (int m = 0; m < 4; ++m) dst##8[m] = __builtin_bit_cast(v8i32, __builtin_shufflevector(PG_RD16(PG_SA(b, h) + aoff8a + m * 2048), PG_RD16(PG_SA(b, h) + aoff8a + 16 + m * 2048), 0, 1, 2, 3, 4, 5, 6, 7)); } while (0)
#define PG_LDB8(dst, b, h) do { _Pragma("unroll") for (int n = 0; n < 2; ++n) dst##8[n] = __builtin_bit_cast(v8i32, __builtin_shufflevector(PG_RD16(PG_SB(b, h) + boff8a + n * 2048), PG_RD16(PG_SB(b, h) + boff8a + 16 + n * 2048), 0, 1, 2, 3, 4, 5, 6, 7)); } while (0)
#define PG_LDA(dst, b, h) do { if constexpr (FP8) PG_LDA8(dst, b, h); else PG_LDA16(dst, b, h); } while (0)
#define PG_LDB(dst, b, h) do { if constexpr (FP8) PG_LDB8(dst, b, h); else PG_LDB16(dst, b, h); } while (0)
#define PG_MMA(ai, bj, At, Bt) do { __builtin_amdgcn_s_setprio(1); _Pragma("unroll") for (int m = 0; m < 4; ++m) _Pragma("unroll") for (int n = 0; n < 2; ++n) { \
        if constexpr (FP8) asm volatile("v_mfma_scale_f32_16x16x128_f8f6f4 %0, %1, %2, %0, %3, %4 op_sel_hi:[0,0,0]" : "+v"(acc[ai][bj][m][n]) : "v"(Bt##8[n]), "v"(At##8[m]), "v"(sclA), "v"(sclA)); \
        else { _Pragma("unroll") for (int k = 0; k < 2; ++k) acc[ai][bj][m][n] = __builtin_amdgcn_mfma_f32_16x16x32_bf16(Bt[n][k], At[m][k], acc[ai][bj][m][n], 0, 0, 0); } } \
        __builtin_amdgcn_s_setprio(0); } while (0)
#define PG_WAIT_V(n) asm volatile("s_waitcnt vmcnt(" #n ")" ::: "memory")
#define PG_WAIT_L(n) asm volatile("s_waitcnt lgkmcnt(" #n ")" ::: "memory")
#define PG_BAR __builtin_amdgcn_s_barrier()
#define PG_SCHED __builtin_amdgcn_sched_barrier(0)
    Unit cur, nxt; int ui = 0;
    if (!S.next(0, cur)) return;
    f32x4 acc[2][2][4][2];
    E.init(acc, cur, wr, wc, fr, fq);
    bf16x8 At[4][2], B0[2][2], B1[2][2];
    v8i32 At8[4], B08[2], B18[2];
    int sclA = 0x7F7F7F7F;
    asm volatile("" : "+v"(sclA));
    const char* Abase = (const char*)S.A;
    unsigned c00 = S.rowoff(cur, R0) + C0 * 2u, c01 = S.rowoff(cur, R0 + 64) + C0 * 2u, c10 = S.rowoff(cur, R0 + 128) + C0 * 2u, c11 = S.rowoff(cur, R0 + 192) + C0 * 2u;
    const char* cB = S.bbase(cur);
    PG_STAGE_B(PG_SB(0, 0), cB); PG_STAGE_A(PG_SA(0, 0), c00, c01); PG_STAGE_B(PG_SB(0, 1), cB + hstep); PG_STAGE_A(PG_SA(0, 1), c10, c11);
    if (wr == 1) PG_BAR;
    PG_WAIT_V(4); PG_BAR;
    PG_STAGE_B(PG_SB(1, 0), cB + kstep); PG_STAGE_A(PG_SA(1, 0), c00 + 128u, c01 + 128u); PG_STAGE_B(PG_SB(1, 1), cB + hstep + kstep);
    PG_WAIT_V(6); PG_BAR;
    for (;;) {
        const bool has_next = S.next(ui + 1, nxt);
        const char* nB = has_next ? S.bbase(nxt) : cB;
        unsigned dnx = 0u;
        if constexpr (Sched::LINEAR) { if (has_next) dnx = S.rowoff(nxt, 0) - S.rowoff(cur, 0); }

#pragma unroll 1
        for (int t = 0; t < nt; t += 2) {
            const bool last = (t == nt - 2);
            const unsigned k1 = (unsigned)(t + 1) * 128u, k2 = last ? 0u : (unsigned)(t + 2) * 128u, k3 = k2 + 128u;
            unsigned a2_00, a2_01, a2_10, a2_11, a3_00, a3_01;
            if constexpr (Sched::LINEAR) { const unsigned dl = last ? dnx : 0u; a2_00 = c00 + dl + k2; a2_01 = c01 + dl + k2; a2_10 = c10 + dl + k2; a2_11 = c11 + dl + k2; a3_00 = c00 + dl + k3; a3_01 = c01 + dl + k3; }
            else {
                a2_00 = c00; a2_01 = c01; a2_10 = c10; a2_11 = c11;
                if (last && has_next) { a2_00 = S.rowoff(nxt, R0) + C0 * 2u; a2_01 = S.rowoff(nxt, R0 + 64) + C0 * 2u; a2_10 = S.rowoff(nxt, R0 + 128) + C0 * 2u; a2_11 = S.rowoff(nxt, R0 + 192) + C0 * 2u; }
                a3_00 = a2_00 + k3; a3_01 = a2_01 + k3; a2_00 += k2; a2_01 += k2; a2_10 += k2; a2_11 += k2;
            }
            const char* b2 = last ? nB : cB + (size_t)(t + 2) * kstep;
            const char* b3 = b2 + kstep;
            PG_LDB(B0, 0, 0); PG_SCHED; PG_LDA(At, 0, 0); PG_STAGE_A(PG_SA(1, 1), c10 + k1, c11 + k1);
            PG_WAIT_L(8); PG_BAR; PG_WAIT_L(0); PG_MMA(0, 0, At, B0); PG_BAR; PG_SCHED;
            PG_LDB(B1, 0, 1); PG_STAGE_B(PG_SB(0, 0), b2);
            PG_BAR; PG_WAIT_L(0); PG_MMA(0, 1, At, B1); PG_BAR;
            PG_LDA(At, 0, 1); PG_STAGE_A(PG_SA(0, 0), a2_00, a2_01);
            PG_BAR; PG_WAIT_L(0); PG_MMA(1, 0, At, B0); PG_BAR; PG_SCHED;
            PG_STAGE_B(PG_SB(0, 1), b2 + hstep);
            PG_WAIT_V(6); PG_BAR; PG_MMA(1, 1, At, B1); PG_BAR;
            PG_LDB(B0, 1, 0); PG_SCHED; PG_LDA(At, 1, 0); PG_STAGE_A(PG_SA(0, 1), a2_10, a2_11);
            PG_WAIT_L(8); PG_BAR; PG_WAIT_L(0); PG_MMA(0, 0, At, B0); PG_BAR; PG_SCHED;
            PG_LDB(B1, 1, 1); PG_STAGE_B(PG_SB(1, 0), b3);
            PG_BAR; PG_WAIT_L(0); PG_MMA(0, 1, At, B1); PG_BAR;
            PG_LDA(At, 1, 1); PG_STAGE_A(PG_SA(1, 0), a3_00, a3_01);
            PG_BAR; PG_WAIT_L(0); PG_MMA(1, 0, At, B0); PG_BAR; PG_SCHED;
            PG_STAGE_B(PG_SB(1, 1), b3 + hstep);
            PG_WAIT_V(6); PG_BAR; PG_MMA(1, 1, At, B1); PG_BAR;
        }
        E(acc, cur, wr, wc, fr, fq);
        if (!has_next) break;
        E.init(acc, nxt, wr, wc, fr, fq);
        if constexpr (Sched::LINEAR) { c00 += dnx; c01 += dnx; c10 += dnx; c11 += dnx; }
        else { c00 = S.rowoff(nxt, R0) + C0 * 2u; c01 = S.rowoff(nxt, R0 + 64) + C0 * 2u; c10 = S.rowoff(nxt, R0 + 128) + C0 * 2u; c11 = S.rowoff(nxt, R0 + 192) + C0 * 2u; }
        cur = nxt; cB = nB; ++ui;
    }
    PG_WAIT_V(0);
    if (wr == 0) PG_BAR;
    PG_BAR;
#undef PG_SA
#undef PG_SB
#undef PG_STAGE_A
#undef PG_STAGE_B
#undef PG_LDA
#undef PG_LDB
#undef PG_LDA8
#undef PG_LDB8
#undef PG_LDA16
#undef PG_LDB16
#undef PG_RD16
#undef PG_MMA
#undef PG_WAIT_V
#undef PG_WAIT_L
#undef PG_BAR
#undef PG_SCHED
}

struct DenseSched {
    static constexpr bool LINEAR = true;
    const u16* A; const u16* Bt; int nM, nN, nwg, G, c;
    __device__ void init(const u16* A_, const u16* Bt_, int M, int N, int G_, int c_) { A = A_; Bt = Bt_; nM = M / BM; nN = N / BM; nwg = nM * nN; G = G_; c = c_; }
    __device__ __forceinline__ bool next(int i, Unit& u) const {
        const int L = i * G + c; if (L >= nwg) return false;
        int wgid = L; { const int q = nwg / 8, r = nwg % 8, xcd = wgid % 8, off = wgid / 8; wgid = (xcd < r ? xcd * (q + 1) : r * (q + 1) + (xcd - r) * q) + off; }
        const int nig = 8 * nN, gid = wgid / nig, fm = gid * 8, gsz = (nM - fm) < 8 ? (nM - fm) : 8;
        u.row0 = (fm + ((wgid % nig) % gsz)) * BM; u.pn = (wgid % nig) / gsz; u.nvalid = BM; u.e = 0; u.ord = i; return true;
    }
    __device__ __forceinline__ unsigned rowoff(const Unit& u, int r) const { return (unsigned)(u.row0 + r) * (unsigned)(KD * 2); }
    __device__ __forceinline__ const char* bbase(const Unit& u) const { return (const char*)Bt + (size_t)u.pn * BM * KD * 2; }
};

template <bool GATHER> struct MoeSchedT {
    static constexpr bool LINEAR = !GATHER;
    const u16* A; const u16* Bt; const int* lists; const LDS_AS int* meta; int NT, nunits, G, c; int rowb; const LDS_AS unsigned* rowtab;
    __device__ __forceinline__ bool next(int i, Unit& u) const {
        const int L = i * G + c; if (L >= nunits) return false;
        int wgid = L; { const int q = nunits / 8, r = nunits % 8, xcd = wgid % 8, off = wgid / 8; wgid = (xcd < r ? xcd * (q + 1) : r * (q + 1) + (xcd - r) * q) + off; }
        const int gm = wgid / NT; u.pn = wgid % NT;
        int e = 0;
        while (meta[32 + e + 1] <= gm) ++e;
        const int mi = gm - meta[32 + e];
        u.e = e; u.row0 = meta[72 + e] + mi * BM; u.nvalid = min(BM, meta[e] - mi * BM); u.ord = i;
        return true;
    }
    __device__ __forceinline__ unsigned rowoff(const Unit& u, int r) const {
        if constexpr (GATHER) return rowtab[u.ord * BM + r];
        else return (unsigned)(u.row0 + r) * (unsigned)rowb;
    }
    __device__ __forceinline__ const char* bbase(const Unit& u) const { return (const char*)Bt + ((size_t)u.e * NT + u.pn) * BM * (size_t)rowb; }
};

struct EpiProj {
    static constexpr int SCALE_A = 0x7F7F7F7F, SCALE_B = 0x7F7F7F7F;
    static constexpr bool PERM = true;
    u16* O;
    __device__ __forceinline__ void init(f32x4 (&acc)[2][2][4][2], const Unit&, int, int, int, int) const {
#pragma unroll
        for (int a = 0; a < 2; ++a)
#pragma unroll
            for (int b = 0; b < 2; ++b)
#pragma unroll
                for (int m = 0; m < 4; ++m)
#pragma unroll
                    for (int n = 0; n < 2; ++n) acc[a][b][m][n] = (f32x4){0.f, 0.f, 0.f, 0.f};
    }
    __device__ __forceinline__ void operator()(const f32x4 (&acc)[2][2][4][2], const Unit& u, int wr, int wc, int fr, int fq) const {
        const int row0 = u.row0 + wr * 64 + fr, col0 = u.pn * BM + wc * 32 + 8 * fq;
#pragma unroll
        for (int ai = 0; ai < 2; ++ai)
#pragma unroll
            for (int m = 0; m < 4; ++m) { u16* rowp = O + (size_t)(row0 + ai * HALF + m * 16) * PJW + col0;
#pragma unroll
                for (int bj = 0; bj < 2; ++bj) { const f32x4 v0 = acc[ai][bj][m][0], v1 = acc[ai][bj][m][1];
                    u32x4 w; w.x = pack2(v0[0], v0[1]); w.y = pack2(v0[2], v0[3]); w.z = pack2(v1[0], v1[1]); w.w = pack2(v1[2], v1[3]);
                    *(u32x4*)(rowp + bj * HALF) = w; } }
    }
};
struct EpiOut {
    static constexpr int SCALE_A = 0x7F7F7F7F, SCALE_B = 0x7F7F7F7F;
    static constexpr bool PERM = false;
    const float* X; float* C;
    __device__ __forceinline__ void init(f32x4 (&acc)[2][2][4][2], const Unit& u, int wr, int wc, int fr, int fq) const {
        const int row0 = u.row0 + wr * 64 + fr, col0 = u.pn * BM + wc * 32 + 4 * fq;
#pragma unroll
        for (int ai = 0; ai < 2; ++ai)
#pragma unroll
            for (int m = 0; m < 4; ++m) { const size_t ro = (size_t)(row0 + ai * HALF + m * 16) * D + col0;
#pragma unroll
                for (int bj = 0; bj < 2; ++bj)
#pragma unroll
                    for (int n = 0; n < 2; ++n) acc[ai][bj][m][n] = *(const f32x4*)(X + ro + bj * HALF + n * 16); }
    }
    __device__ __forceinline__ void operator()(const f32x4 (&acc)[2][2][4][2], const Unit& u, int wr, int wc, int fr, int fq) const {
        const int row0 = u.row0 + wr * 64 + fr, col0 = u.pn * BM + wc * 32 + 4 * fq;
#pragma unroll
        for (int ai = 0; ai < 2; ++ai)
#pragma unroll
            for (int m = 0; m < 4; ++m) { const size_t ro = (size_t)(row0 + ai * HALF + m * 16) * D + col0;
#pragma unroll
                for (int bj = 0; bj < 2; ++bj)
#pragma unroll
                    for (int n = 0; n < 2; ++n) *(f32x4*)(C + ro + bj * HALF + n * 16) = acc[ai][bj][m][n]; }
    }
};
struct EpiMoe1 {
    static constexpr int SCALE_A = 0x7F7F7F7F, SCALE_B = 0x7F7F7F7F;
    static constexpr bool PERM = true;
    const float* b1; unsigned char* act8;
    __device__ __forceinline__ void init(f32x4 (&acc)[2][2][4][2], const Unit&, int, int, int, int) const {
#pragma unroll
        for (int a = 0; a < 2; ++a)
#pragma unroll
            for (int b = 0; b < 2; ++b)
#pragma unroll
                for (int m = 0; m < 4; ++m)
#pragma unroll
                    for (int n = 0; n < 2; ++n) acc[a][b][m][n] = (f32x4){0.f, 0.f, 0.f, 0.f};
    }
    __device__ __forceinline__ void operator()(const f32x4 (&acc)[2][2][4][2], const Unit& u, int wr, int wc, int fr, int fq) const {
        const int r0 = wr * 64 + fr, col0 = u.pn * BM + wc * 32 + 8 * fq;
        const float* be = b1 + (size_t)u.e * 2 * DFF + col0;
        f32x4 bv[2][2];
#pragma unroll
        for (int bj = 0; bj < 2; ++bj)
#pragma unroll
            for (int n = 0; n < 2; ++n) bv[bj][n] = *(const f32x4*)(be + bj * HALF + 4 * n);
#pragma unroll
        for (int ai = 0; ai < 2; ++ai)
#pragma unroll
            for (int m = 0; m < 4; ++m) {
                const int r = r0 + ai * HALF + m * 16;
                if (r < u.nvalid) {
                    unsigned char* rowp = act8 + (size_t)(u.row0 + r) * DFF + (col0 >> 1);
#pragma unroll
                    for (int bj = 0; bj < 2; ++bj) {
                        const f32x4 v0 = acc[ai][bj][m][0] * 0.03125f + bv[bj][0], v1 = acc[ai][bj][m][1] * 0.03125f + bv[bj][1];
                        const float g0 = fminf(v0[0], 7.0f), l0 = fminf(fmaxf(v0[1], -7.0f), 7.0f);
                        const float g1 = fminf(v0[2], 7.0f), l1 = fminf(fmaxf(v0[3], -7.0f), 7.0f);
                        const float g2 = fminf(v1[0], 7.0f), l2 = fminf(fmaxf(v1[1], -7.0f), 7.0f);
                        const float g3 = fminf(v1[2], 7.0f), l3 = fminf(fmaxf(v1[3], -7.0f), 7.0f);
                        const float a0 = g0 * __builtin_amdgcn_rcpf(1.0f + __expf(-1.702f * g0)) * (l0 + 1.0f), a1 = g1 * __builtin_amdgcn_rcpf(1.0f + __expf(-1.702f * g1)) * (l1 + 1.0f);
                        const float a2 = g2 * __builtin_amdgcn_rcpf(1.0f + __expf(-1.702f * g2)) * (l2 + 1.0f), a3 = g3 * __builtin_amdgcn_rcpf(1.0f + __expf(-1.702f * g3)) * (l3 + 1.0f);
                        int pk = __builtin_amdgcn_cvt_pk_fp8_f32(a0, a1, 0, false);
                        pk = __builtin_amdgcn_cvt_pk_fp8_f32(a2, a3, pk, true);
                        *(int*)(rowp + bj * (HALF / 2)) = pk;
                    }
                }
            }
    }
};
struct EpiMoe2 {
    static constexpr bool PERM = true;
    static constexpr int SCALE_A = 0x7F7F7F7F, SCALE_B = 0x7A7A7A7A;
    const float* b2; const float* gate; const int* lists; const LDS_AS int* meta; u16* y;
    __device__ __forceinline__ void init(f32x4 (&acc)[2][2][4][2], const Unit&, int, int, int, int) const {
#pragma unroll
        for (int a = 0; a < 2; ++a)
#pragma unroll
            for (int b = 0; b < 2; ++b)
#pragma unroll
                for (int m = 0; m < 4; ++m)
#pragma unroll
                    for (int n = 0; n < 2; ++n) acc[a][b][m][n] = (f32x4){0.f, 0.f, 0.f, 0.f};
    }
    __device__ __forceinline__ void operator()(const f32x4 (&acc)[2][2][4][2], const Unit& u, int wr, int wc, int fr, int fq) const {
        const int r0 = wr * 64 + fr, col0 = u.pn * BM + wc * 32 + 8 * fq;
        const float* be = b2 + (size_t)u.e * D + col0;
        const int* le = lists + (size_t)u.e * T + (u.row0 - meta[72 + u.e]);
        f32x4 bv[2][2];
#pragma unroll
        for (int bj = 0; bj < 2; ++bj)
#pragma unroll
            for (int n = 0; n < 2; ++n) bv[bj][n] = *(const f32x4*)(be + bj * HALF + 4 * n);
        int slot[8]; float gt[8];
#pragma unroll
        for (int q = 0; q < 8; ++q) slot[q] = le[min(r0 + (q >> 2) * HALF + (q & 3) * 16, u.nvalid - 1)];
        __builtin_amdgcn_sched_barrier(0);
#pragma unroll
        for (int q = 0; q < 8; ++q) gt[q] = gate[slot[q]];
        __builtin_amdgcn_sched_barrier(0);
#pragma unroll
        for (int ai = 0; ai < 2; ++ai)
#pragma unroll
            for (int m = 0; m < 4; ++m) {
                const int r = r0 + ai * HALF + m * 16;
                if (r < u.nvalid) {
                    const float g1 = gt[ai * 4 + m];
                    u16* rowp = y + (size_t)slot[ai * 4 + m] * D + col0;
#pragma unroll
                    for (int bj = 0; bj < 2; ++bj) {
                        const f32x4 v0 = (acc[ai][bj][m][0] * 0.03125f + bv[bj][0]) * g1, v1 = (acc[ai][bj][m][1] * 0.03125f + bv[bj][1]) * g1;
                        u32x4 w; w.x = pack2(v0[0], v0[1]); w.y = pack2(v0[2], v0[3]); w.z = pack2(v1[0], v1[1]); w.w = pack2(v1[2], v1[3]);
                        *(u32x4*)(rowp + bj * HALF) = w;
                    }
                }
            }
    }
};
}

constexpr int AT_K = 0, AT_V = 208 * 128, AT_Q = AT_V + 208 * 160, AT_BIAS = AT_Q + 8192;
struct AttnRegs { u32x4 kv[6], vv[6], qv[2]; float tb[3]; };
__device__ __forceinline__ void attn_load(const Params& p, int t, int it, AttnRegs& R) {
    const int idx = it & 63, br = (it >> 6) % 3, h = (it / 192) & 7, b = it / 1536;
    const int dsh = br * 2, L = S >> dsh, nbl = L >> 6;
    const int res = idx / nbl, qb = idx % nbl;
#pragma unroll
    for (int i = 0; i < 6; ++i) {
        const int j = t + 256 * i, row = j >> 3, c = j & 7;
        const int ki = 64 * (qb - 1) + row;
        const bool ok = (ki >= 0 && ki < L);
        const size_t base = (size_t)(b * S + res + ((ok ? ki : 0) << dsh)) * PJW + h * 64 + c * 8;
        const u32x4 kx = *(const u32x4*)(p.proj + base + C_AK), vx = *(const u32x4*)(p.proj + base + C_AV);
        const u32x4 zz = {0u, 0u, 0u, 0u};
        R.kv[i] = ok ? kx : zz; R.vv[i] = ok ? vx : zz;
    }
#pragma unroll
    for (int i = 0; i < 2; ++i) {
        const int j = t + 256 * i, row = j >> 3, c = j & 7;
        const size_t base = (size_t)(b * S + res + ((64 * qb + row) << dsh)) * PJW + C_AQ + h * 64 + c * 8;
        R.qv[i] = *(const u32x4*)(p.proj + base);
    }
#pragma unroll
    for (int i = 0; i < 3; ++i) {
        const int en = t + 256 * i, c = en / 176, x = en - c * 176, y = x - c - 16;
        const bool ok = (en < 704) && (y >= 0) && (y <= 128);
        const float bvl = p.rel_bias[T5TAB[br * 129 + (ok ? y : 0)] * AH + h];
        R.tb[i] = ok ? bvl * 1.44269504f : -1.0e30f;
    }
}
__device__ void attn_item(const Params& p, char* lds, int t, int it, int nit, AttnRegs& R) {
    const int l = t & 63, w = t >> 6, i16 = l & 15, g = l >> 4;
    const int idx = it & 63, br = (it >> 6) % 3, h = (it / 192) & 7, b = it / 1536;
    const int dsh = br * 2, L = S >> dsh, nbl = L >> 6;
    const int res = idx / nbl, qb = idx % nbl;
    char* Ks = lds + AT_K; char* Vs = lds + AT_V; char* Qs = lds + AT_Q; float* biasf = (float*)(lds + AT_BIAS);
    __syncthreads();
#pragma unroll
    for (int i = 0; i < 6; ++i) {
        const int j = t + 256 * i, row = j >> 3, c = j & 7;
        *(u32x4*)(Ks + tile_off(row, c)) = R.kv[i];
        *(u32x4*)(Vs + row * 160 + c * 16) = R.vv[i];
    }
    { u32x4 zz = {0u, 0u, 0u, 0u}; asm volatile("" : "+v"(zz));
      if (t < 160) *(u32x4*)(Vs + 192 * 160 + t * 16) = zz; else if (t < 224) { *(u32x4*)(Ks + 192 * 128 + (t - 160) * 16) = zz; *(u32x4*)(Ks + 192 * 128 + (t - 96) * 16) = zz; } }
#pragma unroll
    for (int i = 0; i < 2; ++i) { const int j = t + 256 * i; *(u32x4*)(Qs + tile_off(j >> 3, j & 7)) = R.qv[i]; }
#pragma unroll
    for (int i = 0; i < 3; ++i) { const int en = t + 256 * i; if (en < 704) biasf[en] = R.tb[i]; }
    __syncthreads();
    if (nit >= 0) attn_load(p, t, nit, R);

    const bf16x8 qf0 = lds_frag(Qs, 16 * w + i16, g), qf1 = lds_frag(Qs, 16 * w + i16, 4 + g);
    const char* Kw = Ks + 16 * w * 128;
    f32x4 sc[10];
#pragma unroll
    for (int i = 0; i < 10; ++i) {
        const bf16x8 k0 = lds_frag(Kw, 16 * i + i16, g), k1 = lds_frag(Kw, 16 * i + i16, 4 + g);
        f32x4 a = {0.f, 0.f, 0.f, 0.f};
        a = __builtin_amdgcn_mfma_f32_16x16x32_bf16(k0, qf0, a, 0, 0, 0);
        a = __builtin_amdgcn_mfma_f32_16x16x32_bf16(k1, qf1, a, 0, 0, 0);
        sc[i] = a;
    }
    const int sq = 16 * w + i16;
    const float* tabc = biasf + (i16 & 3) * 176 + 4 * g - 4 * (i16 >> 2) + 16;
    float mx = -3.0e38f;
#pragma unroll
    for (int i = 0; i < 10; ++i) {
        const f32x4 b4 = *(const f32x4*)(tabc + 16 * i);
#pragma unroll
        for (int r = 0; r < 4; ++r) sc[i][r] = fmaf(sc[i][r], 0.125f * 1.44269504f, b4[r]);
    }
    if (qb == 0 || qb == nbl - 1) {
        const int lo = (qb == 0) ? 64 : 0, hi = (qb == nbl - 1) ? 128 : 192;
#pragma unroll
        for (int i = 0; i < 10; ++i)
#pragma unroll
            for (int r = 0; r < 4; ++r) { const int tk = 16 * (w + i) + 4 * g + r; sc[i][r] = (tk >= lo && tk < hi) ? sc[i][r] : -1.0e30f; }
    }
#pragma unroll
    for (int i = 0; i < 10; ++i) mx = fmaxf(mx, fmaxf(fmaxf(sc[i][0], sc[i][1]), fmaxf(sc[i][2], sc[i][3])));
    mx = fmaxf(mx, swz_xor<16>(mx)); mx = half_max(mx);
    float ls = 0.f;
#pragma unroll
    for (int i = 0; i < 10; ++i) {
#pragma unroll
        for (int r = 0; r < 4; ++r) { const float e = __builtin_amdgcn_exp2f(sc[i][r] - mx); sc[i][r] = e; ls += e; }
    }
    ls += swz_xor<16>(ls); ls = half_sum(ls);

    f32x4 oa[4];
#pragma unroll
    for (int e = 0; e < 4; ++e) oa[e] = (f32x4){0.f, 0.f, 0.f, 0.f};
    const char* Vw = Vs + (16 * w + 4 * g + (i16 >> 2)) * 160 + 4 * (i16 & 3) * 2;
#pragma unroll
    for (int i2 = 0; i2 < 5; ++i2) {
        uint4 pu;
        pu.x = pack2(sc[2 * i2][0], sc[2 * i2][1]); pu.y = pack2(sc[2 * i2][2], sc[2 * i2][3]);
        pu.z = pack2(sc[2 * i2 + 1][0], sc[2 * i2 + 1][1]); pu.w = pack2(sc[2 * i2 + 1][2], sc[2 * i2 + 1][3]);
        const bf16x8 pf = __builtin_bit_cast(bf16x8, pu);
#pragma unroll
        for (int et = 0; et < 4; ++et) {
            const s16x4 va = tr_read(Vw + (32 * i2) * 160 + et * 32);
            const s16x4 vb = tr_read(Vw + (32 * i2 + 16) * 160 + et * 32);
            oa[et] = __builtin_amdgcn_mfma_f32_16x16x32_bf16(cat4(va, vb), pf, oa[et], 0, 0, 0);
        }
    }
    const float inv = 1.0f / ls;
    const size_t tok = (size_t)b * S + res + ((64 * qb + sq) << dsh);
#pragma unroll
    for (int et = 0; et < 4; ++et) {
        uint2 o; o.x = pack2(oa[et][0] * inv, oa[et][1] * inv); o.y = pack2(oa[et][2] * inv, oa[et][3] * inv);
        *(uint2*)(p.abr + ((size_t)br * T + tok) * 512 + h * 64 + 16 * et + 4 * g) = o;
    }
    if (g == 0) p.lse[((size_t)br * T + tok) * 8 + h] = (mx + __log2f(ls)) * 0.69314718f;
}

constexpr int GL_ZS = 0, GL_TOT = 8192, GL_GG = 10240, GL_BF = 10752, GL_BS = 68, GL_BB = GL_BF + 64 * GL_BS * 4, GL_R2 = GL_BB + 64 * GL_BS * 4;
__device__ __forceinline__ float logsig_fast(float a) { return fminf(a, 0.f) - __logf(1.0f + __expf(-fabsf(a))); }
__device__ __forceinline__ void gla_prep(const Params& p, char* lds, int t, int h) {
    const int d = t & 63, w = t >> 6;
    float* zs = (float*)(lds + GL_ZS); float* tot = (float*)(lds + GL_TOT); float* GG = (float*)(lds + GL_GG);
    float* BF = (float*)(lds + GL_BF); float* BB = (float*)(lds + GL_BB);
    float wf[16], wb[16];
#pragma unroll
    for (int r = 0; r < 16; ++r) { wf[r] = p.wgf[r * 256 + h * 64 + d]; wb[r] = p.wgb[r * 256 + h * 64 + d]; }
    const float biasf = p.bgf[h * 64 + d], biasb = p.bgb[h * 64 + d];
    __syncthreads();
    float bfv[16], bbv[16];
#pragma unroll
    for (int i = 0; i < 16; ++i) {
        const float4* zr = (const float4*)(zs + (16 * w + i) * 32);
        float af = biasf, ab = biasb;
#pragma unroll
        for (int r4 = 0; r4 < 4; ++r4) {
            const float4 zf = zr[r4], zb = zr[4 + r4];
            af = fmaf(zf.x, wf[4 * r4], af); af = fmaf(zf.y, wf[4 * r4 + 1], af); af = fmaf(zf.z, wf[4 * r4 + 2], af); af = fmaf(zf.w, wf[4 * r4 + 3], af);
            ab = fmaf(zb.x, wb[4 * r4], ab); ab = fmaf(zb.y, wb[4 * r4 + 1], ab); ab = fmaf(zb.z, wb[4 * r4 + 2], ab); ab = fmaf(zb.w, wb[4 * r4 + 3], ab);
        }
        bfv[i] = logsig_fast(af) * (1.0f / 16.0f); bbv[i] = logsig_fast(ab) * (1.0f / 16.0f);
    }
#pragma unroll
    for (int i = 1; i < 16; ++i) bfv[i] += bfv[i - 1];
#pragma unroll
    for (int i = 14; i >= 0; --i) bbv[i] += bbv[i + 1];
    tot[(0 * 4 + w) * 64 + d] = bfv[15];
    tot[(1 * 4 + w) * 64 + d] = bbv[0];
    __syncthreads();
    float offf = 0.f, offb = 0.f, Gf = 0.f, Gb = 0.f;
#pragma unroll
    for (int ww = 0; ww < 4; ++ww) {
        const float a = tot[(0 * 4 + ww) * 64 + d], c = tot[(1 * 4 + ww) * 64 + d];
        Gf += a; Gb += c;
        if (ww < w) offf += a;
        if (ww > w) offb += c;
    }
#pragma unroll
    for (int i = 0; i < 16; ++i) { BF[(16 * w + i) * GL_BS + d] = bfv[i] + offf; BB[(16 * w + i) * GL_BS + d] = bbv[i] + offb; }
    if (w == 0) { GG[d] = Gf; GG[64 + d] = Gb; }
    __syncthreads();
}
__device__ __forceinline__ void unpack8(const uint4 u, float (&f)[8]) {
    f[0] = lo2f(u.x); f[1] = hi2f(u.x); f[2] = lo2f(u.y); f[3] = hi2f(u.y); f[4] = lo2f(u.z); f[5] = hi2f(u.z); f[6] = lo2f(u.w); f[7] = hi2f(u.w);
}
__device__ __forceinline__ uint4 pack8(const float (&f)[8]) { uint4 u; u.x = pack2(f[0], f[1]); u.y = pack2(f[2], f[3]); u.z = pack2(f[4], f[5]); u.w = pack2(f[6], f[7]); return u; }

constexpr int GD_KF = GL_R2, GD_KB = GD_KF + 64 * 160, GD_VT = GL_BF;
__device__ void gla_ds_item(const Params& p, char* lds, int t, int it) {
    const int l = t & 63, w = t >> 6, i16 = l & 15, g = l >> 4;
    const int n = it & 63, h = (it >> 6) & 3, b = it >> 8;
    const int t0 = b * S + n * 64;
    float* zs = (float*)(lds + GL_ZS);
    const int sr = t >> 2, sc = t & 3;
    const u16* kp = p.proj + (size_t)(t0 + sr) * PJW + C_GK + h * 64 + sc * 16;
    const uint4 kr0 = *(const uint4*)(kp), kr1 = *(const uint4*)(kp + 8);
    u32x4 vr[4];
#pragma unroll
    for (int i = 0; i < 4; ++i) { const int j = t + 256 * i; vr[i] = *(const u32x4*)(p.proj + (size_t)(t0 + (j >> 4)) * PJW + C_GV + h * 128 + (j & 15) * 8); }
    const float4* zsrc = (const float4*)(p.zbuf + (size_t)t0 * 32);
    const float4 zv0 = zsrc[t], zv1 = zsrc[t + 256];
    __syncthreads();
    ((float4*)zs)[t] = zv0; ((float4*)zs)[t + 256] = zv1;
    gla_prep(p, lds, t, h);
    const float* BF = (const float*)(lds + GL_BF); const float* BB = (const float*)(lds + GL_BB); const float* GG = (const float*)(lds + GL_GG);
    char* KF = lds + GD_KF; char* KB = lds + GD_KB; char* VT = lds + GD_VT;
    {
        float kk[16];
        { float tmp[8]; unpack8(kr0, tmp);
#pragma unroll
          for (int j = 0; j < 8; ++j) kk[j] = tmp[j];
          unpack8(kr1, tmp);
#pragma unroll
          for (int j = 0; j < 8; ++j) kk[8 + j] = tmp[j]; }
        float of[16], ob[16];
#pragma unroll
        for (int q = 0; q < 4; ++q) {
            const float4 bf4 = *(const float4*)(BF + sr * GL_BS + sc * 16 + 4 * q), bb4 = *(const float4*)(BB + sr * GL_BS + sc * 16 + 4 * q);
            const float4 gf4 = *(const float4*)(GG + sc * 16 + 4 * q), gb4 = *(const float4*)(GG + 64 + sc * 16 + 4 * q);
            of[4 * q + 0] = kk[4 * q + 0] * __expf(gf4.x - bf4.x); of[4 * q + 1] = kk[4 * q + 1] * __expf(gf4.y - bf4.y);
            of[4 * q + 2] = kk[4 * q + 2] * __expf(gf4.z - bf4.z); of[4 * q + 3] = kk[4 * q + 3] * __expf(gf4.w - bf4.w);
            ob[4 * q + 0] = kk[4 * q + 0] * __expf(gb4.x - bb4.x); ob[4 * q + 1] = kk[4 * q + 1] * __expf(gb4.y - bb4.y);
            ob[4 * q + 2] = kk[4 * q + 2] * __expf(gb4.z - bb4.z); ob[4 * q + 3] = kk[4 * q + 3] * __expf(gb4.w - bb4.w);
        }
        uint4 u;
        u.x = pack2(of[0], of[1]); u.y = pack2(of[2], of[3]); u.z = pack2(of[4], of[5]); u.w = pack2(of[6], of[7]);
        *(uint4*)(KF + sr * 160 + sc * 32) = u;
        u.x = pack2(of[8], of[9]); u.y = pack2(of[10], of[11]); u.z = pack2(of[12], of[13]); u.w = pack2(of[14], of[15]);
        *(uint4*)(KF + sr * 160 + sc * 32 + 16) = u;
        u.x = pack2(ob[0], ob[1]); u.y = pack2(ob[2], ob[3]); u.z = pack2(ob[4], ob[5]); u.w = pack2(ob[6], ob[7]);
        *(uint4*)(KB + sr * 160 + sc * 32) = u;
        u.x = pack2(ob[8], ob[9]); u.y = pack2(ob[10], ob[11]); u.z = pack2(ob[12], ob[13]); u.w = pack2(ob[14], ob[15]);
        *(uint4*)(KB + sr * 160 + sc * 32 + 16) = u;
        if (t < 64) { p.dec[((size_t)it * 2 + 0) * 64 + t] = __expf(GG[t]); p.dec[((size_t)it * 2 + 1) * 64 + t] = __expf(GG[64 + t]); }
    }
    __syncthreads();
#pragma unroll
    for (int i = 0; i < 4; ++i) { const int j = t + 256 * i; *(u32x4*)(VT + (j >> 4) * 288 + (j & 15) * 16) = vr[i]; }
    __syncthreads();
#pragma unroll
    for (int dir = 0; dir < 2; ++dir) {
        const char* KX = dir ? KB : KF;
        f32x4 acc[2][4];
#pragma unroll
        for (int a = 0; a < 2; ++a)
#pragma unroll
            for (int c = 0; c < 4; ++c) acc[a][c] = (f32x4){0.f, 0.f, 0.f, 0.f};
#pragma unroll
        for (int ks = 0; ks < 2; ++ks) {
            const int r0 = ks * 32 + 8 * g + (i16 >> 2);
            bf16x8 vf[2], kf[4];
#pragma unroll
            for (int a = 0; a < 2; ++a) {
                const int e0 = 16 * (2 * w + a) + 4 * (i16 & 3);
                vf[a] = cat4(tr_read(VT + r0 * 288 + e0 * 2), tr_read(VT + (r0 + 4) * 288 + e0 * 2));
            }
#pragma unroll
            for (int c = 0; c < 4; ++c) {
                const int d0 = 16 * c + 4 * (i16 & 3);
                kf[c] = cat4(tr_read(KX + r0 * 160 + d0 * 2), tr_read(KX + (r0 + 4) * 160 + d0 * 2));
            }
#pragma unroll
            for (int a = 0; a < 2; ++a)
#pragma unroll
                for (int c = 0; c < 4; ++c) acc[a][c] = __builtin_amdgcn_mfma_f32_16x16x32_bf16(kf[c], vf[a], acc[a][c], 0, 0, 0);
        }
        float* dst = p.dS + ((size_t)it * 2 + dir) * 128 * 64;
#pragma unroll
        for (int a = 0; a < 2; ++a)
#pragma unroll
            for (int c = 0; c < 4; ++c) *(f32x4*)(dst + (16 * (2 * w + a) + i16) * 64 + 16 * c + 4 * g) = acc[a][c];
    }
}

__device__ void gla_scan_thread2(const Params& p, int gid) {
    const int d = gid & 63, e = (gid >> 6) & 127, dir = (gid >> 13) & 1, bh0 = gid >> 14, bh1 = bh0 + 8;
    float s0 = 0.f, s1 = 0.f;
#pragma unroll 8
    for (int step = 0; step < 64; ++step) {
        const int n = dir ? (63 - step) : step;
        const size_t i0 = ((size_t)(bh0 * 64 + n)) * 2 + dir, i1 = ((size_t)(bh1 * 64 + n)) * 2 + dir;
        const float dc0 = p.dec[i0 * 64 + d], ds0 = p.dS[(i0 * 128 + e) * 64 + d];
        const float dc1 = p.dec[i1 * 64 + d], ds1 = p.dS[(i1 * 128 + e) * 64 + d];
        p.Sp[(i0 * 128 + e) * 64 + d] = f2bf(s0);
        p.Sp[(i1 * 128 + e) * 64 + d] = f2bf(s1);
        s0 = fmaf(dc0, s0, ds0); s1 = fmaf(dc1, s1, ds1);
    }
}

__device__ void attn_combine_thread(const Params& p, int gid) {
    const int tok = gid >> 6, c = gid & 63, h = c >> 3;
    const float l0 = p.lse[((size_t)0 * T + tok) * 8 + h], l1 = p.lse[((size_t)1 * T + tok) * 8 + h], l2 = p.lse[((size_t)2 * T + tok) * 8 + h];
    const float mm = fmaxf(l0, fmaxf(l1, l2));
    float w0 = __expf(l0 - mm), w1 = __expf(l1 - mm), w2 = __expf(l2 - mm);
    const float inv = 1.0f / (w0 + w1 + w2);
    w0 *= inv; w1 *= inv; w2 *= inv;
    const uint4 a0 = *(const uint4*)(p.abr + ((size_t)0 * T + tok) * 512 + c * 8);
    const uint4 a1 = *(const uint4*)(p.abr + ((size_t)1 * T + tok) * 512 + c * 8);
    const uint4 a2 = *(const uint4*)(p.abr + ((size_t)2 * T + tok) * 512 + c * 8);
    uint4 o;
    o.x = pack2(w0 * lo2f(a0.x) + w1 * lo2f(a1.x) + w2 * lo2f(a2.x), w0 * hi2f(a0.x) + w1 * hi2f(a1.x) + w2 * hi2f(a2.x));
    o.y = pack2(w0 * lo2f(a0.y) + w1 * lo2f(a1.y) + w2 * lo2f(a2.y), w0 * hi2f(a0.y) + w1 * hi2f(a1.y) + w2 * hi2f(a2.y));
    o.z = pack2(w0 * lo2f(a0.z) + w1 * lo2f(a1.z) + w2 * lo2f(a2.z), w0 * hi2f(a0.z) + w1 * hi2f(a1.z) + w2 * hi2f(a2.z));
    o.w = pack2(w0 * lo2f(a0.w) + w1 * lo2f(a1.w) + w2 * lo2f(a2.w), w0 * hi2f(a0.w) + w1 * hi2f(a1.w) + w2 * hi2f(a2.w));
    *(uint4*)(p.mix + (size_t)tok * D + c * 8) = o;
}

constexpr int GO_QF = GL_R2, GO_QB = GO_QF + 8192, GO_KF = GO_QB + 8192, GO_KB = GO_KF + 8192, GO_VT = GL_R2, GO_AM = GL_ZS, GO_SF = GL_BF, GO_SB = GL_BF + 16384;
__device__ void gla_out_item(const Params& p, char* lds, int t, int it) {
    const int l = t & 63, w = t >> 6, i16 = l & 15, g = l >> 4;
    const int n = it & 63, h = (it >> 6) & 3, b = it >> 8;
    const int t0 = b * S + n * 64;
    float* zs = (float*)(lds + GL_ZS);
    const int sr = t >> 2, sc = t & 3;
    const float4* zsrc = (const float4*)(p.zbuf + (size_t)t0 * 32);
    const float4 zv0 = zsrc[t], zv1 = zsrc[t + 256];
    const u16* qp = p.proj + (size_t)(t0 + sr) * PJW + C_GQ + h * 64 + sc * 16;
    const u16* kp = p.proj + (size_t)(t0 + sr) * PJW + C_GK + h * 64 + sc * 16;
    const uint4 qr0 = *(const uint4*)(qp), qr1 = *(const uint4*)(qp + 8), kr0 = *(const uint4*)(kp), kr1 = *(const uint4*)(kp + 8);
    u32x4 vr[4], sv[8];
#pragma unroll
    for (int i = 0; i < 4; ++i) { const int j = t + 256 * i; vr[i] = *(const u32x4*)(p.proj + (size_t)(t0 + (j >> 4)) * PJW + C_GV + h * 128 + (j & 15) * 8); }
    const u16* SPG = p.Sp + (size_t)it * 2 * 128 * 64;
    __syncthreads();
    ((float4*)zs)[t] = zv0; ((float4*)zs)[t + 256] = zv1;
    gla_prep(p, lds, t, h);
#pragma unroll
    for (int i = 0; i < 8; ++i) { const int j = t + 256 * i; sv[i] = *(const u32x4*)(SPG + (size_t)j * 8); }
    const float* BF = (const float*)(lds + GL_BF); const float* BB = (const float*)(lds + GL_BB);
    char* QF = lds + GO_QF; char* QB = lds + GO_QB; char* KF = lds + GO_KF; char* KB = lds + GO_KB; char* VT = lds + GO_VT; char* AM = lds + GO_AM;
    char* SF = lds + GO_SF; char* SB = lds + GO_SB;
    {
        float qq[16], kk[16];
        { float tmp[8];
          unpack8(qr0, tmp);
#pragma unroll
          for (int j = 0; j < 8; ++j) qq[j] = tmp[j] * 0.125f;
          unpack8(qr1, tmp);
#pragma unroll
          for (int j = 0; j < 8; ++j) qq[8 + j] = tmp[j] * 0.125f;
          unpack8(kr0, tmp);
#pragma unroll
          for (int j = 0; j < 8; ++j) kk[j] = tmp[j];
          unpack8(kr1, tmp);
#pragma unroll
          for (int j = 0; j < 8; ++j) kk[8 + j] = tmp[j]; }
        float ef[16], eb[16];
#pragma unroll
        for (int q = 0; q < 4; ++q) {
            const float4 bf4 = *(const float4*)(BF + sr * GL_BS + sc * 16 + 4 * q), bb4 = *(const float4*)(BB + sr * GL_BS + sc * 16 + 4 * q);
            ef[4 * q + 0] = __expf(bf4.x); ef[4 * q + 1] = __expf(bf4.y); ef[4 * q + 2] = __expf(bf4.z); ef[4 * q + 3] = __expf(bf4.w);
            eb[4 * q + 0] = __expf(bb4.x); eb[4 * q + 1] = __expf(bb4.y); eb[4 * q + 2] = __expf(bb4.z); eb[4 * q + 3] = __expf(bb4.w);
        }
        float o8[8];
#pragma unroll
        for (int hh = 0; hh < 2; ++hh) {
            const int off = tile_off(sr, 2 * sc + hh);
#pragma unroll
            for (int j = 0; j < 8; ++j) o8[j] = qq[8 * hh + j] * ef[8 * hh + j];
            *(uint4*)(QF + off) = pack8(o8);
#pragma unroll
            for (int j = 0; j < 8; ++j) o8[j] = kk[8 * hh + j] / ef[8 * hh + j];
            *(uint4*)(KF + off) = pack8(o8);
#pragma unroll
            for (int j = 0; j < 8; ++j) o8[j] = qq[8 * hh + j] * eb[8 * hh + j];
            *(uint4*)(QB + off) = pack8(o8);
#pragma unroll
            for (int j = 0; j < 8; ++j) o8[j] = kk[8 * hh + j] / eb[8 * hh + j];
            *(uint4*)(KB + off) = pack8(o8);
        }
    }
    __syncthreads();
#pragma unroll
    for (int i = 0; i < 8; ++i) { const int j = t + 256 * i; *(u32x4*)((j >> 10 ? SB : SF) + tile_off((j >> 3) & 127, j & 7)) = sv[i]; }
    const int cq = 16 * w + i16;
    const bf16x8 qf0 = lds_frag(QF, cq, g), qf1 = lds_frag(QF, cq, 4 + g);
    const bf16x8 qb0 = lds_frag(QB, cq, g), qb1 = lds_frag(QB, cq, 4 + g);
    uint2 amo[4];
#pragma unroll
    for (int st = 0; st < 4; ++st) {
        f32x4 af = {0.f, 0.f, 0.f, 0.f}, ab = {0.f, 0.f, 0.f, 0.f};
        af = __builtin_amdgcn_mfma_f32_16x16x32_bf16(lds_frag(KF, 16 * st + i16, g), qf0, af, 0, 0, 0);
        af = __builtin_amdgcn_mfma_f32_16x16x32_bf16(lds_frag(KF, 16 * st + i16, 4 + g), qf1, af, 0, 0, 0);
        ab = __builtin_amdgcn_mfma_f32_16x16x32_bf16(lds_frag(KB, 16 * st + i16, g), qb0, ab, 0, 0, 0);
        ab = __builtin_amdgcn_mfma_f32_16x16x32_bf16(lds_frag(KB, 16 * st + i16, 4 + g), qb1, ab, 0, 0, 0);
        float am[4];
#pragma unroll
        for (int r = 0; r < 4; ++r) {
            const int s = 16 * st + 4 * g + r;
            am[r] = (s <= cq ? af[r] : 0.f) + (s >= cq ? ab[r] : 0.f);
        }
        amo[st].x = pack2(am[0], am[1]); amo[st].y = pack2(am[2], am[3]);
    }
#pragma unroll
    for (int st = 0; st < 4; ++st) { const int s0 = 16 * st + 4 * g; *(uint2*)(AM + tile_off(cq, s0 >> 3) + (s0 & 7) * 2) = amo[st]; }
    __syncthreads();
#pragma unroll
    for (int i = 0; i < 4; ++i) { const int j = t + 256 * i; *(u32x4*)(VT + (j >> 4) * 288 + (j & 15) * 16) = vr[i]; }
    __syncthreads();
    f32x4 oc[8];
#pragma unroll
    for (int et = 0; et < 8; ++et) oc[et] = (f32x4){0.f, 0.f, 0.f, 0.f};
#pragma unroll
    for (int ks = 0; ks < 2; ++ks) {
        const bf16x8 amf = lds_frag(AM, cq, ks * 4 + g);
        const bf16x8 qff = ks ? qf1 : qf0, qbf = ks ? qb1 : qb0;
        const int r0 = ks * 32 + 8 * g + (i16 >> 2);
#pragma unroll
        for (int et = 0; et < 8; ++et) {
            const int e0 = 16 * et + 4 * (i16 & 3);
            const bf16x8 vf = cat4(tr_read(VT + r0 * 288 + e0 * 2), tr_read(VT + (r0 + 4) * 288 + e0 * 2));
            oc[et] = __builtin_amdgcn_mfma_f32_16x16x32_bf16(vf, amf, oc[et], 0, 0, 0);
            oc[et] = __builtin_amdgcn_mfma_f32_16x16x32_bf16(lds_frag(SF, 16 * et + i16, ks * 4 + g), qff, oc[et], 0, 0, 0);
            oc[et] = __builtin_amdgcn_mfma_f32_16x16x32_bf16(lds_frag(SB, 16 * et + i16, ks * 4 + g), qbf, oc[et], 0, 0, 0);
        }
    }
    float ss = 0.f;
#pragma unroll
    for (int et = 0; et < 8; ++et)
#pragma unroll
        for (int r = 0; r < 4; ++r) ss += oc[et][r] * oc[et][r];
    ss += swz_xor<16>(ss); ss = half_sum(ss);
    const float rstd = rsqrtf(ss * (1.0f / 128.0f) + EPS);
    const size_t tok = (size_t)t0 + cq;
#pragma unroll
    for (int et = 0; et < 8; ++et) {
        const int e = 16 * et + 4 * g;
        const uint2 gg = *(const uint2*)(p.proj + tok * PJW + C_GO + h * 128 + e);
        const float4 ng = *(const float4*)(p.gla_ng + h * 128 + e);
        const float g0 = lo2f(gg.x), g1 = hi2f(gg.x), g2 = lo2f(gg.y), g3 = hi2f(gg.y);
        uint2 o;
        o.x = pack2(oc[et][0] * rstd * ng.x * (g0 / (1.0f + __expf(-g0))), oc[et][1] * rstd * ng.y * (g1 / (1.0f + __expf(-g1))));
        o.y = pack2(oc[et][2] * rstd * ng.z * (g2 / (1.0f + __expf(-g2))), oc[et][3] * rstd * ng.w * (g3 / (1.0f + __expf(-g3))));
        *(uint2*)(p.mix + tok * D + 512 + h * 128 + e) = o;
    }
}

constexpr int RT_RS = 1028;
constexpr int RT_XS = 0, RT_PART = 16 * RT_RS * 4, RT_PE = RT_PART + 4 * 16 * 32 * 4 + 512, RT_RANK = RT_PE + 1024, RT_HIST = RT_RANK + 1024, RT_BASE = RT_HIST + 128;
__device__ void ph_route(const Params& p, char* ldsall) {
    const int tid = tid_opaque(), t = tid & 255, half = tid >> 8, lane = t & 63, w = t >> 6;
    char* lds = ldsall + half * HALF_LDS;
    const int vb = blockIdx.x * 2 + half, nvb = gridDim.x * 2;
    float* xs = (float*)(lds + RT_XS); float* part = (float*)(lds + RT_PART);
    int* pe = (int*)(lds + RT_PE); int* rank = (int*)(lds + RT_RANK); int* hist = (int*)(lds + RT_HIST); int* base = (int*)(lds + RT_BASE);
    const int ngr = (T / 16 + nvb - 1) / nvb;
    for (int gl = 0; gl < ngr; ++gl) {
        const int gi = vb + gl * nvb;
        const bool live = gi < T / 16;
        const int tok0 = (live ? gi : 0) * 16;
        __syncthreads();
#pragma unroll
        for (int th = 0; th < 2; ++th) {
            f32x4 v[2][4];
#pragma unroll
            for (int tt = 0; tt < 2; ++tt) {
                const f32x4* xr = (const f32x4*)(p.x1 + (size_t)(tok0 + 4 * w + 2 * th + tt) * D);
#pragma unroll
                for (int i = 0; i < 4; ++i) v[tt][i] = xr[lane + 64 * i];
            }
#pragma unroll
            for (int tt = 0; tt < 2; ++tt) {
                const int tl = 4 * w + 2 * th + tt, tok = tok0 + tl;
                float ss = 0.f;
#pragma unroll
                for (int i = 0; i < 4; ++i) ss += v[tt][i][0] * v[tt][i][0] + v[tt][i][1] * v[tt][i][1] + v[tt][i][2] * v[tt][i][2] + v[tt][i][3] * v[tt][i][3];
                ss = wave_sum(ss);
                const float r = rsqrtf(ss * (1.0f / D) + EPS);
#pragma unroll
                for (int i = 0; i < 4; ++i) {
                    const f32x4 gq = ((const f32x4*)p.g2)[lane + 64 * i];
                    const f32x4 yv = v[tt][i] * r * gq;
                    *(f32x4*)(xs + tl * RT_RS + (lane + 64 * i) * 4) = yv;
                    if (live) { int pk = __builtin_amdgcn_cvt_pk_fp8_f32(yv[0], yv[1], 0, false); pk = __builtin_amdgcn_cvt_pk_fp8_f32(yv[2], yv[3], pk, true); *(int*)(p.xn28 + (size_t)tok * D + (lane + 64 * i) * 4) = pk; }
                }
            }
        }
        __syncthreads();
        {
            const int i16 = lane & 15, kq = lane >> 4;
            const float* xa = xs + i16 * RT_RS + 256 * w + 64 * kq;
            const float* rwp = p.rw + (size_t)(256 * w + 64 * kq) * 32 + i16;
            f32x4 a0 = {0.f, 0.f, 0.f, 0.f}, a1 = {0.f, 0.f, 0.f, 0.f};
            f32x4 bqA[8];
#define RT_LOADB(dst, b) do { _Pragma("unroll") for (int q = 0; q < 8; ++q) { \
                dst[q][0] = rwp[(size_t)((b) * 16 + 2 * q) * 32]; dst[q][1] = rwp[(size_t)((b) * 16 + 2 * q) * 32 + 16]; \
                dst[q][2] = rwp[(size_t)((b) * 16 + 2 * q + 1) * 32]; dst[q][3] = rwp[(size_t)((b) * 16 + 2 * q + 1) * 32 + 16]; } } while (0)
#define RT_MMA(src, b) do { _Pragma("unroll") for (int s4 = 0; s4 < 4; ++s4) { const float4 av = *(const float4*)(xa + 16 * (b) + 4 * s4); \
                a0 = __builtin_amdgcn_mfma_f32_16x16x4f32(av.x, src[2 * s4][0], a0, 0, 0, 0); a1 = __builtin_amdgcn_mfma_f32_16x16x4f32(av.x, src[2 * s4][1], a1, 0, 0, 0); \
                a0 = __builtin_amdgcn_mfma_f32_16x16x4f32(av.y, src[2 * s4][2], a0, 0, 0, 0); a1 = __builtin_amdgcn_mfma_f32_16x16x4f32(av.y, src[2 * s4][3], a1, 0, 0, 0); \
                a0 = __builtin_amdgcn_mfma_f32_16x16x4f32(av.z, src[2 * s4 + 1][0], a0, 0, 0, 0); a1 = __builtin_amdgcn_mfma_f32_16x16x4f32(av.z, src[2 * s4 + 1][1], a1, 0, 0, 0); \
                a0 = __builtin_amdgcn_mfma_f32_16x16x4f32(av.w, src[2 * s4 + 1][2], a0, 0, 0, 0); a1 = __builtin_amdgcn_mfma_f32_16x16x4f32(av.w, src[2 * s4 + 1][3], a1, 0, 0, 0); } } while (0)
#pragma unroll
            for (int b = 0; b < 4; ++b) {
                RT_LOADB(bqA, b);
                __builtin_amdgcn_sched_barrier(0);
                RT_MMA(bqA, b);
                __builtin_amdgcn_sched_barrier(0);
            }
#undef RT_LOADB
#undef RT_MMA
#pragma unroll
            for (int r = 0; r < 4; ++r) { part[(w * 16 + 4 * kq + r) * 32 + i16] = a0[r]; part[(w * 16 + 4 * kq + r) * 32 + 16 + i16] = a1[r]; }
        }
        __syncthreads();
#pragma unroll
        for (int ro = 0; ro < 2; ++ro) {
            const int tk = 4 * w + 2 * ro + (lane >> 5), e = lane & 31;
            float v = p.rb[e] + ((part[(0 * 16 + tk) * 32 + e] + part[(1 * 16 + tk) * 32 + e]) + (part[(2 * 16 + tk) * 32 + e] + part[(3 * 16 + tk) * 32 + e]));
            int rk = 0;
#pragma unroll
            for (int j = 0; j < 64; ++j) {
                const float bj = __builtin_bit_cast(float, __builtin_amdgcn_readlane(__builtin_bit_cast(int, v), j));
                if ((j >> 5) == (lane >> 5)) rk += (bj > v || (bj == v && (j & 31) < e)) ? 1 : 0;
            }
            float* selv = part + 2048 + (w * 2 + (lane >> 5)) * 8;
            if (rk < 4) { selv[rk] = v; selv[4 + rk] = __builtin_bit_cast(float, e); }
            __builtin_amdgcn_s_waitcnt(0xc07f);
            __builtin_amdgcn_wave_barrier();
            const float b0 = selv[0], b1 = selv[1], b2 = selv[2], b3 = selv[3];
            const float e1 = expf(b1 - b0), e2 = expf(b2 - b0), e3 = expf(b3 - b0);
            const float inv = 1.0f / (1.0f + e1 + e2 + e3);
            if (e < 4) {
                const int sel = __builtin_bit_cast(int, selv[4 + e]);
                const float gs = (e == 0) ? inv : (e == 1) ? e1 * inv : (e == 2) ? e2 * inv : e3 * inv;
                pe[gl * 64 + tk * 4 + e] = live ? (sel & 31) : -1;
                if (live) p.gate[(size_t)(tok0 + tk) * 4 + e] = gs;
            }
            __builtin_amdgcn_wave_barrier();
        }
    }
    __syncthreads();
    if (t < 32) hist[t] = 0;
    __syncthreads();
    for (int i = t; i < ngr * 64; i += 256) { const int e = pe[i]; if (e >= 0) rank[i] = atomicAdd(&hist[e], 1); }
    __syncthreads();
    if (t < 32) { const int c = hist[t]; base[t] = c ? atomicAdd(&p.counts[t], c) : 0; }
    __syncthreads();
    for (int i = t; i < ngr * 64; i += 256) {
        const int e = pe[i];
        if (e >= 0) { const int gl = i >> 6, gi = vb + gl * nvb; const int slot = (gi * 16 + ((i >> 2) & 15)) * 4 + (i & 3); p.lists[e * T + base[e] + rank[i]] = slot; }
    }
}

__device__ void ph_final(const Params& p) {
    const int tid = tid_opaque(), lane = tid & 63, gw = blockIdx.x * 8 + (tid >> 6), nw = gridDim.x * 8;
    for (int tok = gw; tok < T; tok += nw) {
        float v[2][8]; float ss = 0.f;
#pragma unroll
        for (int i = 0; i < 2; ++i) {
            const int c = lane * 8 + 512 * i;
            const float4 xa = *(const float4*)(p.x1 + (size_t)tok * D + c), xb = *(const float4*)(p.x1 + (size_t)tok * D + c + 4);
            v[i][0] = xa.x; v[i][1] = xa.y; v[i][2] = xa.z; v[i][3] = xa.w; v[i][4] = xb.x; v[i][5] = xb.y; v[i][6] = xb.z; v[i][7] = xb.w;
#pragma unroll
            for (int k = 0; k < 4; ++k) {
                const uint4 yy = *(const uint4*)(p.y + ((size_t)tok * 4 + k) * D + c);
                v[i][0] += lo2f(yy.x); v[i][1] += hi2f(yy.x); v[i][2] += lo2f(yy.y); v[i][3] += hi2f(yy.y);
                v[i][4] += lo2f(yy.z); v[i][5] += hi2f(yy.z); v[i][6] += lo2f(yy.w); v[i][7] += hi2f(yy.w);
            }
#pragma unroll
            for (int j = 0; j < 8; ++j) ss += v[i][j] * v[i][j];
        }
        ss = wave_sum(ss);
        const float r = rsqrtf(ss * (1.0f / D) + EPS);
#pragma unroll
        for (int i = 0; i < 2; ++i) {
            const int c = lane * 8 + 512 * i;
            const float4 ga = *(const float4*)(p.gf + c), gb = *(const float4*)(p.gf + c + 4);
            float4 oa, ob;
            oa.x = v[i][0] * r * ga.x; oa.y = v[i][1] * r * ga.y; oa.z = v[i][2] * r * ga.z; oa.w = v[i][3] * r * ga.w;
            ob.x = v[i][4] * r * gb.x; ob.y = v[i][5] * r * gb.y; ob.z = v[i][6] * r * gb.z; ob.w = v[i][7] * r * gb.w;
            *(float4*)(p.out + (size_t)tok * D + c) = oa; *(float4*)(p.out + (size_t)tok * D + c + 4) = ob;
        }
    }
}

#define XB_TMO      128
#define XB_XCNT(j)  (256  + 64 * (j))
#define XB_XSUB(j)  (1280 + 64 * (j))
#define XB_XGEN(j)  (2304 + 64 * (j))
#define XB_TOP      3328
#define XB_TOPGEN   3392
#define XCD_BAR_WORDS 3456
#define XB_SPIN_CAP (1u << 22)
__device__ __forceinline__ unsigned xb_ld(unsigned* p)              { return __hip_atomic_load(p, __ATOMIC_RELAXED, __HIP_MEMORY_SCOPE_AGENT); }
__device__ __forceinline__ unsigned xb_add(unsigned* p, unsigned v) { return __hip_atomic_fetch_add(p, v, __ATOMIC_RELAXED, __HIP_MEMORY_SCOPE_AGENT); }
__device__ __forceinline__ unsigned xb_xcc_id() { return (unsigned)__builtin_amdgcn_s_getreg((3 << 11) | 20) & 0xFu; }
#define XB_SPIN(cond, bar) do { unsigned _sp = 0; while (cond) { __builtin_amdgcn_s_sleep(1); \
    if ((++_sp & 255u) == 0u) { if (xb_ld(&(bar)[XB_TMO])) break; if (_sp > XB_SPIN_CAP) { atomicAdd(&(bar)[XB_TMO], 1u); break; } } } } while (0)
struct XcdBarrier { unsigned* bar; unsigned x; volatile LDS_AS unsigned* st; };
__device__ __forceinline__ XcdBarrier xcd_barrier_post(unsigned* bar, volatile LDS_AS unsigned* st) {
    XcdBarrier b; b.bar = bar; b.x = xb_xcc_id(); b.st = st;
    if (threadIdx.x == 0) (void)xb_add(&bar[XB_XCNT(b.x)], 1u);
    return b;
}
__device__ __forceinline__ void xcd_barrier_complete(unsigned* bar, unsigned x, unsigned& nloc, unsigned& nx) {
    const unsigned G = gridDim.x * gridDim.y * gridDim.z;
    unsigned sum, cnt, mine, sp = 0u;
    for (;;) {
        sum = 0u; cnt = 0u; mine = 0u;
#pragma unroll
        for (unsigned j = 0; j < 16; ++j) { const unsigned c = xb_ld(&bar[XB_XCNT(j)]); sum += c; cnt += (c > 0u) ? 1u : 0u; mine = (j == x) ? c : mine; }
        if (sum == G) break;
        __builtin_amdgcn_s_sleep(1);
        if ((++sp & 255u) == 0u) { if (xb_ld(&bar[XB_TMO])) break; if (sp > XB_SPIN_CAP) { atomicAdd(&bar[XB_TMO], 1u); break; } }
    }
    nloc = mine > 0u ? mine : 1u; nx = cnt > 0u ? cnt : 1u;
}
__device__ __forceinline__ void xcd_barrier(const XcdBarrier& b) {
    asm volatile("s_waitcnt vmcnt(0)" ::: "memory");
    __syncthreads();
    if (threadIdx.x == 0) {
        unsigned* bar = b.bar;
        __builtin_amdgcn_s_waitcnt(0);
        unsigned nloc = b.st[0], nx = b.st[1];
        if (nloc == 0u) { xcd_barrier_complete(bar, b.x, nloc, nx); b.st[0] = nloc; b.st[1] = nx; }
        const unsigned old = xb_add(&bar[XB_XSUB(b.x)], 1u);
        const unsigned gen = old / nloc;
        if (old + 1u == (gen + 1u) * nloc) {
            __builtin_amdgcn_fence(__ATOMIC_RELEASE, "agent");
            asm volatile("s_waitcnt vmcnt(0)" ::: "memory");
            const unsigned og = xb_add(&bar[XB_TOP], 1u);
            const unsigned tg = og / nx;
            if (og + 1u == (tg + 1u) * nx) xb_add(&bar[XB_TOPGEN], 1u);
            else XB_SPIN(xb_ld(&bar[XB_TOPGEN]) == tg, bar);
            __builtin_amdgcn_fence(__ATOMIC_ACQUIRE, "agent");
            xb_add(&bar[XB_XGEN(b.x)], 1u);
            asm volatile("s_waitcnt vmcnt(0)" ::: "memory");
        } else {
            XB_SPIN(xb_ld(&bar[XB_XGEN(b.x)]) == gen, bar);
            __builtin_amdgcn_fence(__ATOMIC_ACQUIRE, "agent");
            asm volatile("s_waitcnt vmcnt(0)" ::: "memory");
        }
    }
    __syncthreads();
}


#if defined(FLUSHMASK)
__device__ void ph_flush(const Params& p) {
    const int tid = tid_opaque();
    const float4* src = (const float4*)p.w1;
    float acc = 0.f;
    for (size_t i = (size_t)blockIdx.x * 512 + tid; i < (size_t)NE * D * 2 * DFF / 4; i += (size_t)gridDim.x * 512) { const float4 v = src[i]; acc += v.x + v.y + v.z + v.w; }
    if (acc == 123.456f) p.out[0] = acc;
}
#endif
enum { PH_PRO = 0, PH_PROJ, PH_MIX1, PH_MIX2, PH_MIX3, PH_OUTPROJ, PH_ROUTE, PH_MOE1, PH_MOE2, PH_FINAL, PH_END };
constexpr int N_GLA_ITEMS = B * GH * 64, N_ATT_ITEMS = B * AH * 3 * 64;
constexpr int MO_META = LDS_BYTES - 1024;

__device__ __forceinline__ void moe_meta(const Params& p, int* meta) {
    __syncthreads();
    if (threadIdx.x == 0) {
        int mp = 0, rbse = 0;
        for (int e = 0; e < NE; ++e) {
            const int c = p.counts[e];
            meta[e] = c; meta[32 + e] = mp; meta[72 + e] = rbse;
            mp += (c + 255) >> 8; rbse += c;
        }
        meta[32 + NE] = mp; meta[72 + NE] = rbse;
    }
    __syncthreads();
}

constexpr int MO_TABA = 128 * 1024, MO_MAXU = 12;
template <class SchedT>
__device__ __forceinline__ void moe_tables(const Params& p, char* lds, const SchedT& S) {
    unsigned* tabA = (unsigned*)(lds + MO_TABA);
    const int tid = tid_opaque(), r = tid & 255;
    for (int i = tid >> 8; i < MO_MAXU; i += 2) {
        pg::Unit u;
        if (!S.next(i, u)) break;
        const int slot = p.lists[u.e * T + (u.row0 - S.meta[72 + u.e]) + min(r, u.nvalid - 1)];
        tabA[i * 256 + r] = (unsigned)(slot >> 2) * (unsigned)S.rowb;
    }
    __syncthreads();
}

typedef const __attribute__((address_space(4))) Params* KParams;
#if defined(__HIP_DEVICE_COMPILE__)
#define PHASE_PARAMS() KParams _kq = kp; asm volatile("" : "+s"(_kq)); const Params p = *_kq
#define KP_INIT() KParams kp = (KParams)__builtin_amdgcn_kernarg_segment_ptr(); const int ph_lo = kp->ph_lo, ph_hi = kp->ph_hi; unsigned* const barw = kp->bar
#else
#define PHASE_PARAMS() const Params p = p_unused
#define KP_INIT() const int ph_lo = p_unused.ph_lo, ph_hi = p_unused.ph_hi; unsigned* const barw = p_unused.bar
#endif
__global__ void __launch_bounds__(512, 2) mega(Params p_unused) {
    extern __shared__ __attribute__((aligned(16))) char lds[];
    KP_INIT();
    cg::grid_group grid = cg::this_grid();
    volatile LDS_AS unsigned* xst = (volatile LDS_AS unsigned*)(lds + LDS_BYTES - 16);
    if (threadIdx.x == 0) { xst[0] = 0u; xst[1] = 0u; }
    __syncthreads();
    const XcdBarrier xb = xcd_barrier_post(barw, xst);
    if (ph_hi > PH_END) grid.sync();
    for (int ph = ph_lo; ph < ph_hi; ++ph) {
      const int nrep = ((REPMASK >> ph) & 1) ? 2 : 1;
      for (int rep = 0; rep < nrep; ++rep) {
        if (rep) xcd_barrier(xb);
#if defined(ROUTE2)
        if (rep && ph == PH_ROUTE) { PHASE_PARAMS(); if (blockIdx.x == 0 && threadIdx.x < 32) p.counts[threadIdx.x] = 0; xcd_barrier(xb); }
#endif
#if defined(FLUSHMASK)
        if (rep && ((FLUSHMASK >> ph) & 1)) { PHASE_PARAMS(); ph_flush(p); xcd_barrier(xb); }
#if defined(FLUSHONLY)
        if (rep && ((FLUSHMASK >> ph) & 1)) continue;
#endif
#endif
        switch (ph) {
        case PH_PRO: { PHASE_PARAMS(); ph_prologue(p); } break;
        case PH_PROJ: {
            PHASE_PARAMS();
            const int G = gridDim.x, ng = G - NCONV;
            if ((int)blockIdx.x < ng) {
                pg::DenseSched S; S.init(p.xn, p.winT, T, PJW, ng, blockIdx.x);
                pg::EpiProj E{p.proj};
                pg::gemm_phase((LDS_AS unsigned char*)lds, S, E);
            } else {
                const int tid = tid_opaque(), t = tid & 255, st = NCONV * 2;
                const int l = t & 63, w = t >> 6, kg = l & 7, ngq = w * 8 + (l >> 3);
#define CV_DECL(X) f32x4 X##0 = {0.f, 0.f, 0.f, 0.f}, X##1 = X##0, X##2 = X##0, X##3 = X##0, X##4 = X##0, X##5 = X##0, X##6 = X##0, X##7 = X##0
#define CV_LOAD(X, i_) do { const int e_ = (i_) >> 8, j_ = (i_) & 255; const float* s_ = p.w1 + (size_t)e_ * D * 2 * DFF + (size_t)((j_ >> 4) * 64 + 8 * kg) * (2 * DFF) + (j_ & 15) * 128 + 4 * ngq; \
        X##0 = *(const f32x4*)(s_); X##1 = *(const f32x4*)(s_ + 2 * DFF); X##2 = *(const f32x4*)(s_ + 2 * 2 * DFF); X##3 = *(const f32x4*)(s_ + 3 * 2 * DFF); \
        X##4 = *(const f32x4*)(s_ + 4 * 2 * DFF); X##5 = *(const f32x4*)(s_ + 5 * 2 * DFF); X##6 = *(const f32x4*)(s_ + 6 * 2 * DFF); X##7 = *(const f32x4*)(s_ + 7 * 2 * DFF); } while (0)
#define CV_STORE(X, i_) do { const int e_ = (i_) >> 8, j_ = (i_) & 255; unsigned char* d_ = p.w1T8 + (size_t)e_ * 2 * DFF * D + (size_t)((j_ & 15) * 128 + 4 * ngq) * 1024 + (j_ >> 4) * 64 + 8 * kg; \
        _Pragma("unroll") for (int c_ = 0; c_ < 4; ++c_) { \
            int lo_ = __builtin_amdgcn_cvt_pk_fp8_f32(X##0[c_] * 32.0f, X##1[c_] * 32.0f, 0, false); lo_ = __builtin_amdgcn_cvt_pk_fp8_f32(X##2[c_] * 32.0f, X##3[c_] * 32.0f, lo_, true); \
            int hi_ = __builtin_amdgcn_cvt_pk_fp8_f32(X##4[c_] * 32.0f, X##5[c_] * 32.0f, 0, false); hi_ = __builtin_amdgcn_cvt_pk_fp8_f32(X##6[c_] * 32.0f, X##7[c_] * 32.0f, hi_, true); \
            uint2 q_; q_.x = (unsigned)lo_; q_.y = (unsigned)hi_; *(uint2*)(d_ + c_ * 1024) = q_; } } while (0)
                CV_DECL(ra); CV_DECL(rb);
                const int hid = ((int)blockIdx.x - ng) * 2 + (tid >> 8), per = (W1_CONV + st - 1) / st;
                const int i0 = min(hid * per, W1_CONV - 1), ilast = min(i0 + per, W1_CONV) - 1;
                const int npair = (per + 1) / 2;
                CV_LOAD(ra, i0);
                for (int k = 0; k < npair; ++k) {
                    const int ia = min(i0 + 2 * k, ilast), ib = min(ia + 1, ilast), ic = min(ib + 1, ilast);
                    CV_LOAD(rb, ib);
                    CV_STORE(ra, ia);
                    CV_LOAD(ra, ic);
                    CV_STORE(rb, ib);
                }
#undef CV_DECL
#undef CV_LOAD
#undef CV_STORE
            }
            {
                const int tid2 = tid_opaque(), lane = tid2 & 63, i16 = lane & 15, g = lane >> 4;
                for (int task = (G - 1 - (int)blockIdx.x) * 8 + (tid2 >> 6); task < T / 16; task += G * 8) {
                    f32x4 z0 = {0.f, 0.f, 0.f, 0.f}, z1 = {0.f, 0.f, 0.f, 0.f};
                    const u16* ar = p.xn + (size_t)(task * 16 + i16) * D + 8 * g;
                    const u16* w0 = p.wzT + (size_t)i16 * D + 8 * g;
                    const u16* w1 = w0 + 16 * D;
#pragma unroll 8
                    for (int ks = 0; ks < 32; ++ks) {
                        const bf16x8 a = *(const bf16x8*)(ar + ks * 32);
                        z0 = __builtin_amdgcn_mfma_f32_16x16x32_bf16(a, *(const bf16x8*)(w0 + ks * 32), z0, 0, 0, 0);
                        z1 = __builtin_amdgcn_mfma_f32_16x16x32_bf16(a, *(const bf16x8*)(w1 + ks * 32), z1, 0, 0, 0);
                    }
#pragma unroll
                    for (int r = 0; r < 4; ++r) {
                        const size_t row = (size_t)task * 16 + 4 * g + r;
                        p.zbuf[row * 32 + i16] = z0[r]; p.zbuf[row * 32 + 16 + i16] = z1[r];
                    }
                }
            }
        } break;
        case PH_MIX1: {
            PHASE_PARAMS();
            const int tid = tid_opaque(), t = tid & 255, half = tid >> 8;
            char* hl = lds + half * HALF_LDS;
#ifndef MIX1_SKIP_GLA_ON_REP
            for (int it0 = blockIdx.x * 2; it0 < N_GLA_ITEMS; it0 += gridDim.x * 2) gla_ds_item(p, hl, t, min(it0 + half, N_GLA_ITEMS - 1));
#else
            if (!rep) for (int it0 = blockIdx.x * 2; it0 < N_GLA_ITEMS; it0 += gridDim.x * 2) gla_ds_item(p, hl, t, min(it0 + half, N_GLA_ITEMS - 1));
#endif
            {
                AttnRegs AR;
                attn_load(p, t, min((int)blockIdx.x * 2 + half, N_ATT_ITEMS - 1), AR);
                for (int it0 = blockIdx.x * 2; it0 < N_ATT_ITEMS; it0 += gridDim.x * 2) {
                    const int nx0 = it0 + gridDim.x * 2;
                    attn_item(p, hl, t, min(it0 + half, N_ATT_ITEMS - 1), nx0 < N_ATT_ITEMS ? min(nx0 + half, N_ATT_ITEMS - 1) : -1, AR);
                }
            }
        } break;
        case PH_MIX2: {
            PHASE_PARAMS();
            const int tid = tid_opaque();
            for (int gid = blockIdx.x * 512 + tid; gid < (1 << 17); gid += gridDim.x * 512) gla_scan_thread2(p, gid);
            for (int gid = blockIdx.x * 512 + tid; gid < T * 64; gid += gridDim.x * 512) attn_combine_thread(p, gid);
        } break;
        case PH_MIX3: {
            PHASE_PARAMS();
            const int tid = tid_opaque(), t = tid & 255, half = tid >> 8;
            char* hl = lds + half * HALF_LDS;
            for (int it0 = blockIdx.x * 2; it0 < N_GLA_ITEMS; it0 += gridDim.x * 2) gla_out_item(p, hl, t, min(it0 + half, N_GLA_ITEMS - 1));
        } break;
        case PH_OUTPROJ: {
            PHASE_PARAMS();
            pg::DenseSched S; S.init(p.mix, p.woT, T, D, gridDim.x, blockIdx.x);
            pg::EpiOut E{p.x, p.x1};
            pg::gemm_phase((LDS_AS unsigned char*)lds, S, E);
        } break;
        case PH_ROUTE: { PHASE_PARAMS(); ph_route(p, lds); } break;
        case PH_MOE1: {
            PHASE_PARAMS();
            int* meta = (int*)(lds + MO_META);
            moe_meta(p, meta);
            pg::MoeSchedT<true> S{(const u16*)p.xn28, (const u16*)p.w1T8, p.lists, (const LDS_AS int*)meta, 8, meta[32 + NE] * 8, (int)gridDim.x, (int)blockIdx.x, 1024, (const LDS_AS unsigned*)(lds + MO_TABA)};
            moe_tables(p, lds, S);
            pg::EpiMoe1 E{p.b1, p.act8};
            pg::gemm_phase<pg::EpiMoe1, pg::MoeSchedT<true>, true>((LDS_AS unsigned char*)lds, S, E);
            {
                const int G = gridDim.x, nun = S.nunits, r = nun % G, nshort = r ? G - r : G, sidx = r ? (int)blockIdx.x - r : (int)blockIdx.x;
                if (sidx >= 0) {
                    const int tid = tid_opaque(), t = tid & 255, hv = tid >> 8;
                    const int per = (W2_LATE + nshort * 2 - 1) / (nshort * 2), ib = (sidx * 2 + hv) * per;
                    for (int i = ib; i < min(ib + per, W2_LATE); ++i) { const int e = i >> 7, j = i & 127; cvt_tile8(p.w2 + (size_t)e * DFF * D, D, p.w2T8 + (size_t)e * D * DFF, (j >> 3) * 64, (j & 7) * 128, t); }
                }
            }
        } break;
        case PH_MOE2: {
            PHASE_PARAMS();
            int* meta = (int*)(lds + MO_META);
            moe_meta(p, meta);
            pg::MoeSchedT<false> S{(const u16*)p.act8, (const u16*)p.w2T8, p.lists, (const LDS_AS int*)meta, 4, meta[32 + NE] * 4, (int)gridDim.x, (int)blockIdx.x, 1024, nullptr};
            pg::EpiMoe2 E{p.b2, p.gate, p.lists, (const LDS_AS int*)meta, p.y};
            pg::gemm_phase<pg::EpiMoe2, pg::MoeSchedT<false>, true>((LDS_AS unsigned char*)lds, S, E);
        } break;
        case PH_FINAL: { PHASE_PARAMS(); ph_final(p); } break;
        default: break;
        }
      }
#ifdef EXTRA_BAR
        if (ph == PH_MIX2) { for (int q = 0; q < EXTRA_BAR; ++q) xcd_barrier(xb); }
#endif
        if (ph + 1 < ph_hi) xcd_barrier(xb);
    }
}


#include <cstdio>
extern "C" void kernel_launch(void* const* d_in, const int* in_sizes, int n_in, void* d_out, int out_size, void* d_ws, size_t ws_size, hipStream_t stream) {
    const float* x = (const float*)d_in[0];
    const float* norm1_g = (const float*)d_in[1];
    const float* w_in = (const float*)d_in[2];
    const float* rel_bias = (const float*)d_in[3];
    const float* wgf = (const float*)d_in[4];
    const float* bgf = (const float*)d_in[5];
    const float* wgb = (const float*)d_in[6];
    const float* bgb = (const float*)d_in[7];
    const float* gla_ng = (const float*)d_in[8];
    const float* w_out = (const float*)d_in[9];
    const float* norm2_g = (const float*)d_in[10];
    const float* router_w = (const float*)d_in[11];
    const float* router_b = (const float*)d_in[12];
    const float* w1 = (const float*)d_in[13];
    const float* b1 = (const float*)d_in[14];
    const float* w2 = (const float*)d_in[15];
    const float* b2 = (const float*)d_in[16];
    const float* final_g = (const float*)d_in[17];
    float* out = (float*)d_out;

    static int grid_blocks = 0;
    if (!grid_blocks) {
        int dev = 0, cus = 0, per_cu = 0;
        hipGetDevice(&dev);
        hipDeviceGetAttribute(&cus, hipDeviceAttributeMultiprocessorCount, dev);
        hipFuncSetAttribute((const void*)mega, hipFuncAttributeMaxDynamicSharedMemorySize, LDS_BYTES);
        hipOccupancyMaxActiveBlocksPerMultiprocessor(&per_cu, mega, 512, LDS_BYTES);
        if (per_cu > 1) per_cu = 1;
        if (per_cu < 1) per_cu = 1;
        grid_blocks = cus * per_cu;
    }

    char* ws = (char*)d_ws;
    size_t off = 0;
    auto take = [&](size_t bytes) { char* p = ws + off; off += (bytes + 255) & ~(size_t)255; return p; };
    Params p{};
    p.x = x; p.g1 = norm1_g; p.w_in = w_in; p.rel_bias = rel_bias; p.wgf = wgf; p.bgf = bgf; p.wgb = wgb; p.bgb = bgb; p.gla_ng = gla_ng;
    p.w_out = w_out; p.g2 = norm2_g; p.rw = router_w; p.rb = router_b; p.w1 = w1; p.b1 = b1; p.w2 = w2; p.b2 = b2; p.gf = final_g; p.out = out;
    p.winT = (u16*)take((size_t)PJW * D * 2);
    p.wzT = (u16*)take((size_t)32 * D * 2);
    p.woT = (u16*)take((size_t)D * D * 2);
    p.w1T = (u16*)take((size_t)NE * 2 * DFF * D * 2); p.w1T8 = (unsigned char*)p.w1T;
    p.w2T = (u16*)take((size_t)NE * D * DFF * 2); p.w2T8 = (unsigned char*)p.w2T;
    p.zbuf = (float*)take((size_t)T * 32 * 4);
    p.lse = (float*)take((size_t)3 * T * 8 * 4);
    p.dec = (float*)take((size_t)B * GH * 64 * 2 * 64 * 4);
    p.x1 = (float*)take((size_t)T * D * 4);
    p.counts = (int*)take(256);
    p.lists = (int*)take((size_t)NE * T * 4);
    p.gate = (float*)take((size_t)NSLOT * 4);
    p.bar = (unsigned*)take((size_t)XCD_BAR_WORDS * 4);
    p.xn = (u16*)take((size_t)T * D * 2); p.xn2 = p.xn; p.xn28 = (unsigned char*)p.xn;
    { char* ra = take((size_t)T * PJW * 2 + (size_t)3 * T * 512 * 2);
      p.proj = (u16*)ra; p.abr = (u16*)(ra + (size_t)T * PJW * 2); p.act = (u16*)ra; p.act8 = (unsigned char*)ra; }
    { char* rb = take((size_t)B * GH * 64 * 2 * 128 * 64 * 4 + (size_t)B * GH * 64 * 2 * 128 * 64 * 2 + (size_t)T * D * 2);
      p.dS = (float*)rb; p.Sp = (u16*)(rb + (size_t)B * GH * 64 * 2 * 128 * 64 * 4); p.mix = (u16*)(rb + (size_t)B * GH * 64 * 2 * 128 * 64 * 4 + (size_t)B * GH * 64 * 2 * 128 * 64 * 2); p.y = (u16*)rb; }

    auto run_fast = [&](int lo, int hi) {
        (void)hipMemsetAsync(p.bar, 0, (size_t)XCD_BAR_WORDS * 4, stream);
        p.ph_lo = lo; p.ph_hi = hi;
        void* args[] = {&p};
        hipError_t e = hipLaunchCooperativeKernel((const void*)mega, dim3(grid_blocks), dim3(512), args, LDS_BYTES, stream);
        if (e != hipSuccess) fprintf(stderr, "cooperative launch failed: %s (grid %d)\n", hipGetErrorString(e), grid_blocks);
    };

    run_fast(PH_PRO, PH_END);

}
```

```cpp
#define STAGE 6
#define REPMASK 0
#include <hip/hip_runtime.h>
#include <stdint.h>

namespace cfg {
constexpr int D = 1024, B = 4, S = 4096, T = B * S;
constexpr int AH = 8;
constexpr int GH = 4;
constexpr int INW = 3104;
constexpr int C_AQ = 0, C_AK = 512, C_AV = 1024, C_GQ = 1536, C_GK = 1792, C_GV = 2048, C_GO = 2560, C_GZ = 3072;
constexpr int NE = 32, DFF = 1024;
constexpr float EPS = 1e-5f;
}
using namespace cfg;

__device__ const unsigned char T5TAB[387] = {
11,11,11,11,11,11,11,11,11,11,11,11,11,11,11,10,10,10,10,10,10,10,10,10,10,10,10,10,10,10,10,10,10,10,10,10,10,10,9,9,9,9,9,9,9,9,9,9,9,9,8,8,8,8,8,8,8,7,6,5,4,3,2,1,0,17,18,19,20,21,22,23,24,24,24,24,24,24,24,25,25,25,25,25,25,25,25,25,25,25,25,26,26,26,26,26,26,26,26,26,26,26,26,26,26,26,26,26,26,26,26,26,26,26,27,27,27,27,27,27,27,27,27,27,27,27,27,27,27,
13,13,13,13,13,13,13,13,13,13,13,13,13,13,13,13,13,13,13,13,13,13,13,12,12,12,12,12,12,12,12,12,12,12,12,12,12,12,12,12,12,12,11,11,11,11,11,11,11,11,11,11,10,10,10,10,10,10,9,9,9,8,8,4,0,20,24,24,25,25,25,26,26,26,26,26,26,27,27,27,27,27,27,27,27,27,27,28,28,28,28,28,28,28,28,28,28,28,28,28,28,28,28,28,28,28,29,29,29,29,29,29,29,29,29,29,29,29,29,29,29,29,29,29,29,29,29,29,29,
15,15,15,15,15,15,15,15,15,15,15,15,15,15,15,15,15,15,15,15,15,15,15,15,15,15,15,15,15,15,14,14,14,14,14,14,14,14,14,14,14,14,14,14,14,13,13,13,13,13,13,13,13,13,12,12,12,12,12,11,11,10,10,9,0,25,26,26,27,27,28,28,28,28,28,29,29,29,29,29,29,29,29,29,30,30,30,30,30,30,30,30,30,30,30,30,30,30,30,31,31,31,31,31,31,31,31,31,31,31,31,31,31,31,31,31,31,31,31,31,31,31,31,31,31,31,31,31,31};

template <int MASK> __device__ __forceinline__ float swz_xor(float v) { return __builtin_bit_cast(float, __builtin_amdgcn_ds_swizzle(__builtin_bit_cast(int, v), (MASK << 10) | 0x1F)); }
__device__ __forceinline__ float half_sum(float v) {
    const auto r = __builtin_amdgcn_permlane32_swap(__builtin_bit_cast(unsigned, v), __builtin_bit_cast(unsigned, v), false, false);
    return __builtin_bit_cast(float, (unsigned)r[0]) + __builtin_bit_cast(float, (unsigned)r[1]);
}
__device__ __forceinline__ float half_max(float v) {
    const auto r = __builtin_amdgcn_permlane32_swap(__builtin_bit_cast(unsigned, v), __builtin_bit_cast(unsigned, v), false, false);
    return fmaxf(__builtin_bit_cast(float, (unsigned)r[0]), __builtin_bit_cast(float, (unsigned)r[1]));
}
__device__ __forceinline__ float wave_sum(float v) {
    v += swz_xor<1>(v); v += swz_xor<2>(v); v += swz_xor<4>(v); v += swz_xor<8>(v); v += swz_xor<16>(v);
    return half_sum(v);
}
__global__ void __launch_bounds__(256) nv_rmsnorm(const float* __restrict__ x, const float* __restrict__ g, float* __restrict__ y, int rows) {
    int row = blockIdx.x * 4 + (threadIdx.x >> 6), lane = threadIdx.x & 63;
    if (row >= rows) return;
    const float* xr = x + (size_t)row * D;
    float v[16]; float ss = 0.f;
#pragma unroll
    for (int i = 0; i < 16; ++i) { v[i] = xr[lane + 64 * i]; ss += v[i] * v[i]; }
    ss = wave_sum(ss);
    float r = rsqrtf(ss * (1.0f / D) + EPS);
#pragma unroll
    for (int i = 0; i < 16; ++i) y[(size_t)row * D + lane + 64 * i] = v[i] * r * g[lane + 64 * i];
}

enum { EPI_STORE = 0, EPI_RESID = 1, EPI_SWIGLU = 2 };
template <int EPI>
__global__ void __launch_bounds__(256) nv_gemm(const float* __restrict__ A, int lda, const int* __restrict__ rowmap, int rshift,
                                               const int* __restrict__ Mptr, int Mfix,
                                               const float* __restrict__ Bm, int ldb, int N, int K,
                                               float* __restrict__ C, int ldc,
                                               const float* __restrict__ aux1, const float* __restrict__ aux2) {
    __shared__ float As[16][68];
    __shared__ float Bs[16][64];
    const int M = Mptr ? *Mptr : Mfix;
    const int m0 = blockIdx.y * 64, n0 = blockIdx.x * 64;
    if (m0 >= M) return;
    const int tid = threadIdx.x, tx = tid & 15, ty = tid >> 4;
    float acc[4][4];
#pragma unroll
    for (int i = 0; i < 4; ++i)
#pragma unroll
        for (int j = 0; j < 4; ++j) acc[i][j] = 0.f;
    const int ar = tid >> 2, ak = (tid & 3) * 4;
    const int arow = m0 + ar; const bool av = arow < M;
    const int srcrow = av ? (rowmap ? (rowmap[arow] >> rshift) : arow) : 0;
    const float* ap = A + (size_t)srcrow * lda + ak;
    const int bk = tid >> 4, bn = (tid & 15) * 4;
    const bool bv = (n0 + bn) < N;
    for (int k0 = 0; k0 < K; k0 += 16) {
        float4 a4 = av ? *(const float4*)(ap + k0) : make_float4(0.f, 0.f, 0.f, 0.f);
        float4 b4 = bv ? *(const float4*)(Bm + (size_t)(k0 + bk) * ldb + n0 + bn) : make_float4(0.f, 0.f, 0.f, 0.f);
        As[ak + 0][ar] = a4.x; As[ak + 1][ar] = a4.y; As[ak + 2][ar] = a4.z; As[ak + 3][ar] = a4.w;
        *(float4*)&Bs[bk][bn] = b4;
        __syncthreads();
#pragma unroll
        for (int kk = 0; kk < 16; ++kk) {
            float4 a = *(const float4*)&As[kk][ty * 4];
            float4 b = *(const float4*)&Bs[kk][tx * 4];
            float aa[4] = {a.x, a.y, a.z, a.w}, bb[4] = {b.x, b.y, b.z, b.w};
#pragma unroll
            for (int i = 0; i < 4; ++i)
#pragma unroll
                for (int j = 0; j < 4; ++j) acc[i][j] = fmaf(aa[i], bb[j], acc[i][j]);
        }
        __syncthreads();
    }
#pragma unroll
    for (int i = 0; i < 4; ++i) {
        const int row = m0 + ty * 4 + i;
        if (row >= M) continue;
        const int col = n0 + tx * 4;
        if (col >= N) continue;
        if (EPI == EPI_STORE) {
#pragma unroll
            for (int j = 0; j < 4; ++j) C[(size_t)row * ldc + col + j] = acc[i][j];
        } else if (EPI == EPI_RESID) {
#pragma unroll
            for (int j = 0; j < 4; ++j) C[(size_t)row * ldc + col + j] = aux1[(size_t)row * ldc + col + j] + acc[i][j];
        } else if (EPI == EPI_SWIGLU) {
#pragma unroll
            for (int j = 0; j < 4; j += 2) {
                float glu = acc[i][j] + aux1[col + j], lin = acc[i][j + 1] + aux1[col + j + 1];
                glu = fminf(glu, 7.0f); lin = fminf(fmaxf(lin, -7.0f), 7.0f);
                float sg = 1.0f / (1.0f + expf(-1.702f * glu));
                C[(size_t)row * ldc + (col + j) / 2] = glu * sg * (lin + 1.0f);
            }
        }
    }
}

__global__ void __launch_bounds__(256) nv_attn(const float* __restrict__ proj, const float* __restrict__ rel_bias, float* __restrict__ mix) {
    const int wid = blockIdx.x * 4 + (threadIdx.x >> 6), lane = threadIdx.x & 63;
    const int h = wid & 7, tok = wid >> 3, b = tok / S, pos = tok % S;
    const float q = proj[(size_t)tok * INW + C_AQ + h * 64 + lane];
    float outs[3], lses[3];
#pragma unroll
    for (int br = 0; br < 3; ++br) {
        const int dil = (br == 0) ? 1 : (br == 1 ? 4 : 16);
        float m = -3.0e38f, l = 0.f, o = 0.f;
        for (int j = -64; j <= 64; ++j) {
            const int kp = pos + j * dil;
            if (kp < 0 || kp >= S) continue;
            const size_t kr = (size_t)(b * S + kp) * INW;
            float d = wave_sum(q * proj[kr + C_AK + h * 64 + lane]);
            float logit = d * 0.125f + rel_bias[T5TAB[br * 129 + j + 64] * AH + h];
            float mn = fmaxf(m, logit);
            float sc = expf(m - mn), p = expf(logit - mn);
            l = l * sc + p; o = o * sc + p * proj[kr + C_AV + h * 64 + lane];
            m = mn;
        }
        outs[br] = o / l; lses[br] = m + logf(l);
    }
    float mm = fmaxf(lses[0], fmaxf(lses[1], lses[2]));
    float w0 = expf(lses[0] - mm), w1 = expf(lses[1] - mm), w2 = expf(lses[2] - mm);
    float ws = w0 + w1 + w2;
    mix[(size_t)tok * D + h * 64 + lane] = (w0 * outs[0] + w1 * outs[1] + w2 * outs[2]) / ws;
}

__global__ void __launch_bounds__(256) nv_la(const float* __restrict__ proj, const float* __restrict__ wgf, const float* __restrict__ bgf,
                                             const float* __restrict__ wgb, const float* __restrict__ bgb, float* __restrict__ ea) {
    const int tok = blockIdx.x, col = threadIdx.x;
#pragma unroll
    for (int dir = 0; dir < 2; ++dir) {
        const float* wg = dir ? wgb : wgf; const float* bg = dir ? bgb : bgf;
        float a = bg[col];
        for (int r = 0; r < 16; ++r) a += proj[(size_t)tok * INW + C_GZ + dir * 16 + r] * wg[r * 256 + col];
        float ls = fminf(a, 0.f) - log1pf(expf(-fabsf(a)));
        ea[((size_t)dir * T + tok) * 256 + col] = expf(ls * (1.0f / 16.0f));
    }
}

__global__ void __launch_bounds__(128) nv_gla(const float* __restrict__ proj, const float* __restrict__ ea, float* __restrict__ og) {
    const int e = threadIdx.x, bhd = blockIdx.x, dir = bhd & 1, h = (bhd >> 1) & 3, b = bhd >> 3;
    float st[64];
#pragma unroll
    for (int d = 0; d < 64; ++d) st[d] = 0.f;
    for (int i = 0; i < S; ++i) {
        const int pos = dir ? (S - 1 - i) : i;
        const size_t tok = (size_t)b * S + pos;
        const float* pr = proj + tok * INW;
        const float* ar = ea + ((size_t)dir * T + tok) * 256 + h * 64;
        const float v = pr[C_GV + h * 128 + e];
        float o = 0.f;
#pragma unroll
        for (int d = 0; d < 64; ++d) {
            st[d] = fmaf(ar[d], st[d], pr[C_GK + h * 64 + d] * v);
            o = fmaf(pr[C_GQ + h * 64 + d] * 0.125f, st[d], o);
        }
        og[((size_t)dir * T + tok) * 512 + h * 128 + e] = o;
    }
}

__global__ void __launch_bounds__(256) nv_gla_out(const float* __restrict__ proj, const float* __restrict__ og, const float* __restrict__ ng, float* __restrict__ mix) {
    const int wid = blockIdx.x * 4 + (threadIdx.x >> 6), lane = threadIdx.x & 63;
    const int h = wid & 3, tok = wid >> 2;
    float o0 = og[(size_t)tok * 512 + h * 128 + lane] + og[((size_t)T + tok) * 512 + h * 128 + lane];
    float o1 = og[(size_t)tok * 512 + h * 128 + 64 + lane] + og[((size_t)T + tok) * 512 + h * 128 + 64 + lane];
    float ss = wave_sum(o0 * o0 + o1 * o1);
    float r = rsqrtf(ss * (1.0f / 128.0f) + EPS);
    float g0 = proj[(size_t)tok * INW + C_GO + h * 128 + lane], g1 = proj[(size_t)tok * INW + C_GO + h * 128 + 64 + lane];
    mix[(size_t)tok * D + 512 + h * 128 + lane] = o0 * r * ng[h * 128 + lane] * (g0 / (1.0f + expf(-g0)));
    mix[(size_t)tok * D + 512 + h * 128 + 64 + lane] = o1 * r * ng[h * 128 + 64 + lane] * (g1 / (1.0f + expf(-g1)));
}

__global__ void __launch_bounds__(256) nv_route(const float* __restrict__ x1, const float* __restrict__ g2, const float* __restrict__ rw, const float* __restrict__ rb,
                                                float* __restrict__ xn2, int* __restrict__ topi, float* __restrict__ gate) {
    __shared__ float xs[4][1024];
    __shared__ float lg[4][32];
    const int w = threadIdx.x >> 6, lane = threadIdx.x & 63, tok = blockIdx.x * 4 + w;
    const float* xr = x1 + (size_t)tok * D;
    float v[16]; float ss = 0.f;
#pragma unroll
    for (int i = 0; i < 16; ++i) { v[i] = xr[lane + 64 * i]; ss += v[i] * v[i]; }
    ss = wave_sum(ss);
    const float r = rsqrtf(ss * (1.0f / D) + EPS);
#pragma unroll
    for (int i = 0; i < 16; ++i) { float y = v[i] * r * g2[lane + 64 * i]; xs[w][lane + 64 * i] = y; xn2[(size_t)tok * D + lane + 64 * i] = y; }
    __syncthreads();
    const int e = lane & 31, half = lane >> 5;
    float a = 0.f;
    for (int k = half * 512; k < half * 512 + 512; ++k) a = fmaf(xs[w][k], rw[k * 32 + e], a);
    a += __shfl_xor(a, 32);
    if (lane < 32) lg[w][lane] = a + rb[lane];
    __syncthreads();
    if (lane == 0) {
        float bv[4]; int bi[4];
        unsigned used = 0u;
#pragma unroll
        for (int k = 0; k < 4; ++k) {
            float best = -3.0e38f; int bidx = 0;
            for (int j = 0; j < 32; ++j) { float x = lg[w][j]; if (!((used >> j) & 1u) && x > best) { best = x; bidx = j; } }
            used |= 1u << bidx; bv[k] = best; bi[k] = bidx;
        }
        float e0 = 1.0f, e1 = expf(bv[1] - bv[0]), e2 = expf(bv[2] - bv[0]), e3 = expf(bv[3] - bv[0]);
        float s = e0 + e1 + e2 + e3;
        topi[tok * 4 + 0] = bi[0]; topi[tok * 4 + 1] = bi[1]; topi[tok * 4 + 2] = bi[2]; topi[tok * 4 + 3] = bi[3];
        gate[tok * 4 + 0] = e0 / s; gate[tok * 4 + 1] = e1 / s; gate[tok * 4 + 2] = e2 / s; gate[tok * 4 + 3] = e3 / s;
    }
}

__global__ void nv_lists(const int* __restrict__ topi, int* __restrict__ lists, int* __restrict__ counts) {
    const int e = threadIdx.x;
    int c = 0;
    for (int s = 0; s < T * 4; ++s) if (topi[s] == e) lists[e * T + c++] = s;
    counts[e] = c;
}

__global__ void __launch_bounds__(256) nv_moe2(const float* __restrict__ A, const int* __restrict__ slots, const int* __restrict__ Mptr,
                                               const float* __restrict__ Bm, float* __restrict__ x2, const float* __restrict__ b2, const float* __restrict__ gate) {
    __shared__ float As[16][68];
    __shared__ float Bs[16][64];
    const int M = *Mptr;
    const int m0 = blockIdx.y * 64, n0 = blockIdx.x * 64;
    if (m0 >= M) return;
    const int tid = threadIdx.x, tx = tid & 15, ty = tid >> 4;
    float acc[4][4];
#pragma unroll
    for (int i = 0; i < 4; ++i)
#pragma unroll
        for (int j = 0; j < 4; ++j) acc[i][j] = 0.f;
    const int ar = tid >> 2, ak = (tid & 3) * 4;
    const int arow = m0 + ar; const bool av = arow < M;
    const float* ap = A + (size_t)(av ? arow : 0) * DFF + ak;
    const int bk = tid >> 4, bn = (tid & 15) * 4;
    for (int k0 = 0; k0 < DFF; k0 += 16) {
        float4 a4 = av ? *(const float4*)(ap + k0) : make_float4(0.f, 0.f, 0.f, 0.f);
        float4 b4 = *(const float4*)(Bm + (size_t)(k0 + bk) * D + n0 + bn);
        As[ak + 0][ar] = a4.x; As[ak + 1][ar] = a4.y; As[ak + 2][ar] = a4.z; As[ak + 3][ar] = a4.w;
        *(float4*)&Bs[bk][bn] = b4;
        __syncthreads();
#pragma unroll
        for (int kk = 0; kk < 16; ++kk) {
            float4 a = *(const float4*)&As[kk][ty * 4];
            float4 b = *(const float4*)&Bs[kk][tx * 4];
            float aa[4] = {a.x, a.y, a.z, a.w}, bb[4] = {b.x, b.y, b.z, b.w};
#pragma unroll
            for (int i = 0; i < 4; ++i)
#pragma unroll
                for (int j = 0; j < 4; ++j) acc[i][j] = fmaf(aa[i], bb[j], acc[i][j]);
        }
        __syncthreads();
    }
#pragma unroll
    for (int i = 0; i < 4; ++i) {
        const int row = m0 + ty * 4 + i;
        if (row >= M) continue;
        const int col = n0 + tx * 4;
        const int slot = slots[row]; const int tok = slot >> 2; const float gt = gate[slot];
#pragma unroll
        for (int j = 0; j < 4; ++j) x2[(size_t)tok * D + col + j] += gt * (acc[i][j] + b2[col + j]);
    }
}


#include <hip/hip_cooperative_groups.h>
namespace cg = cooperative_groups;

typedef unsigned short u16;
typedef short bf16x8 __attribute__((ext_vector_type(8)));
typedef short s16x4 __attribute__((ext_vector_type(4)));
typedef float f32x4 __attribute__((ext_vector_type(4)));
typedef unsigned u32x4 __attribute__((ext_vector_type(4)));
typedef __bf16 bfv2 __attribute__((ext_vector_type(2)));
typedef float fv2 __attribute__((ext_vector_type(2)));
#define LDS_AS __attribute__((address_space(3)))

constexpr int LDS_BYTES = 160 * 1024;
constexpr int HALF_LDS = 80 * 1024;
constexpr int NSLOT = T * 4;
constexpr int PJW = 3072;
#ifndef REPMASK
#define REPMASK 0
#endif

struct Params {
    const float *x, *g1, *w_in, *rel_bias, *wgf, *bgf, *wgb, *bgb, *gla_ng, *w_out, *g2, *rw, *rb, *w1, *b1, *w2, *b2, *gf;
    float* out;
    u16* winT;
    u16* wzT;
    u16* woT;
    u16* w1T;
    u16* w2T;
    u16* xn;
    u16* proj;
    float* zbuf;
    u16* abr;
    float* lse;
    float* dS;
    float* dec;
    u16* Sp;
    u16* mix;
    float* x1;
    u16* xn2;
    int* counts;
    int* lists;
    float* gate;
    u16* act;
    u16* y;
    unsigned char* xn28;
    unsigned char* w1T8;
    unsigned char* act8;
    unsigned char* w2T8;
    unsigned* bar;
    int ph_lo, ph_hi;
};

__device__ __forceinline__ int tid_opaque() { int t = threadIdx.x; asm volatile("" : "+v"(t)); return t; }
__device__ __forceinline__ float bf2f(u16 v) { return __uint_as_float((unsigned)v << 16); }
__device__ __forceinline__ unsigned pack2(float a, float b) {
    fv2 v = {a, b};
    bfv2 r = __builtin_convertvector(v, bfv2);
    return __builtin_bit_cast(unsigned, r);
}
__device__ __forceinline__ u16 f2bf(float a) { return (u16)(pack2(a, 0.f) & 0xffffu); }
__device__ __forceinline__ float lo2f(unsigned u) { return __uint_as_float(u << 16); }
__device__ __forceinline__ float hi2f(unsigned u) { return __uint_as_float(u & 0xffff0000u); }
__device__ __forceinline__ int tile_off(int row, int chunk) { return row * 128 + ((chunk ^ (row & 7)) << 4); }
__device__ __forceinline__ bf16x8 lds_frag(const char* base, int row, int chunk) { return *(const bf16x8*)(base + tile_off(row, chunk)); }
__device__ __forceinline__ s16x4 tr_read(const char* p) {
    return __builtin_amdgcn_ds_read_tr16_b64_v4i16((LDS_AS s16x4*)(p));
}
__device__ __forceinline__ bf16x8 cat4(s16x4 a, s16x4 b) { bf16x8 r = {a[0], a[1], a[2], a[3], b[0], b[1], b[2], b[3]}; return r; }
__device__ __forceinline__ float logsig(float a) { return fminf(a, 0.f) - log1pf(expf(-fabsf(a))); }

__device__ __forceinline__ void cvt_tile8(const float* __restrict__ src, int ldsrc, unsigned char* __restrict__ dst, int k0, int n0, int t) {
    const int l = t & 63, w = t >> 6, kg = l & 7, ng = w * 8 + (l >> 3);
    const float* s = src + (size_t)(k0 + 8 * kg) * ldsrc + n0 + 4 * ng;
    f32x4 bv[8];
#pragma unroll
    for (int j = 0; j < 8; ++j) bv[j] = *(const f32x4*)(s + (size_t)j * ldsrc) * 32.0f;
    unsigned char* d = dst + (size_t)(n0 + 4 * ng) * 1024 + k0 + 8 * kg;
#pragma unroll
    for (int c = 0; c < 4; ++c) {
        int lo = __builtin_amdgcn_cvt_pk_fp8_f32(bv[0][c], bv[1][c], 0, false); lo = __builtin_amdgcn_cvt_pk_fp8_f32(bv[2][c], bv[3][c], lo, true);
        int hi = __builtin_amdgcn_cvt_pk_fp8_f32(bv[4][c], bv[5][c], 0, false); hi = __builtin_amdgcn_cvt_pk_fp8_f32(bv[6][c], bv[7][c], hi, true);
        uint2 q; q.x = (unsigned)lo; q.y = (unsigned)hi;
        *(uint2*)(d + c * 1024) = q;
    }
}
__device__ __forceinline__ void cvt_tile(const float* __restrict__ src, int ldsrc, u16* __restrict__ dst, int k0, int n0, int t) {
    const int l = t & 63, w = t >> 6, kg = l & 7, ng = w * 8 + (l >> 3);
    const float* s = src + (size_t)(k0 + 8 * kg) * ldsrc + n0 + 4 * ng;
    float4 bv[8];
#pragma unroll
    for (int j = 0; j < 8; ++j) bv[j] = *(const float4*)(s + (size_t)j * ldsrc);
    u16* d = dst + (size_t)(n0 + 4 * ng) * 1024 + k0 + 8 * kg;
    uint4 q;
    q.x = pack2(bv[0].x, bv[1].x); q.y = pack2(bv[2].x, bv[3].x); q.z = pack2(bv[4].x, bv[5].x); q.w = pack2(bv[6].x, bv[7].x);
    *(uint4*)(d) = q;
    q.x = pack2(bv[0].y, bv[1].y); q.y = pack2(bv[2].y, bv[3].y); q.z = pack2(bv[4].y, bv[5].y); q.w = pack2(bv[6].y, bv[7].y);
    *(uint4*)(d + 1024) = q;
    q.x = pack2(bv[0].z, bv[1].z); q.y = pack2(bv[2].z, bv[3].z); q.z = pack2(bv[4].z, bv[5].z); q.w = pack2(bv[6].z, bv[7].z);
    *(uint4*)(d + 2048) = q;
    q.x = pack2(bv[0].w, bv[1].w); q.y = pack2(bv[2].w, bv[3].w); q.z = pack2(bv[4].w, bv[5].w); q.w = pack2(bv[6].w, bv[7].w);
    *(uint4*)(d + 3072) = q;
}
struct CvtRegs { f32x4 bv[8]; };
__device__ __forceinline__ void cvt_load(const float* __restrict__ src, int ldsrc, int k0, int n0, int t, CvtRegs& R) {
    const int l = t & 63, w = t >> 6, kg = l & 7, ng = w * 8 + (l >> 3);
    const float* s = src + (size_t)(k0 + 8 * kg) * ldsrc + n0 + 4 * ng;
#pragma unroll
    for (int j = 0; j < 8; ++j) R.bv[j] = *(const f32x4*)(s + (size_t)j * ldsrc);
}
__device__ __forceinline__ void cvt_store(u16* __restrict__ dst, int k0, int n0, int t, const CvtRegs& R) {
    const int l = t & 63, w = t >> 6, kg = l & 7, ng = w * 8 + (l >> 3);
    u16* d = dst + (size_t)(n0 + 4 * ng) * 1024 + k0 + 8 * kg;
#pragma unroll
    for (int c = 0; c < 4; ++c) {
        u32x4 q;
        q.x = pack2(R.bv[0][c], R.bv[1][c]); q.y = pack2(R.bv[2][c], R.bv[3][c]); q.z = pack2(R.bv[4][c], R.bv[5][c]); q.w = pack2(R.bv[6][c], R.bv[7][c]);
        *(u32x4*)(d + c * 1024) = q;
    }
}
__device__ __forceinline__ void w1_load(const Params& p, int i, int t, CvtRegs& R) { const int e = i >> 8, j = i & 255; cvt_load(p.w1 + (size_t)e * D * 2 * DFF, 2 * DFF, (j >> 4) * 64, (j & 15) * 128, t, R); }
__device__ __forceinline__ void w1_store(const Params& p, int i, int t, const CvtRegs& R) { const int e = i >> 8, j = i & 255; cvt_store(p.w1T + (size_t)e * 2 * DFF * D, (j >> 4) * 64, (j & 15) * 128, t, R); }
constexpr int CV_WIN = 384, CV_WZ = 1, CV_WO = 128, CV_W1 = NE * 256, CV_W2 = NE * 128;
constexpr int CV_TOTAL = CV_WIN + CV_WZ + CV_WO + CV_W1 + CV_W2;
constexpr int W2_LATE = 3072;
#ifndef NCONV
#define NCONV 102
#endif
#ifndef W1_CONV
#define W1_CONV 8192
#endif
__device__ void ph_prologue(const Params& p) {
    const int tid = tid_opaque();
    if (blockIdx.x == 0 && tid < 32) p.counts[tid] = 0;
    {
        const int lane = tid & 63, gw = blockIdx.x * 8 + (tid >> 6), nw = gridDim.x * 8;
        for (int row = gw; row < T; row += nw) {
            const float4* xr = (const float4*)(p.x + (size_t)row * D);
            float4 v[4]; float ss = 0.f;
#pragma unroll
            for (int i = 0; i < 4; ++i) { v[i] = xr[lane + 64 * i]; ss += v[i].x * v[i].x + v[i].y * v[i].y + v[i].z * v[i].z + v[i].w * v[i].w; }
            ss = wave_sum(ss);
            const float r = rsqrtf(ss * (1.0f / D) + EPS);
#pragma unroll
            for (int i = 0; i < 4; ++i) {
                const float4 g = ((const float4*)p.g1)[lane + 64 * i];
                uint2 o; o.x = pack2(v[i].x * r * g.x, v[i].y * r * g.y); o.y = pack2(v[i].z * r * g.z, v[i].w * r * g.w);
                *(uint2*)(p.xn + (size_t)row * D + (lane + 64 * i) * 4) = o;
            }
        }
    }
    const int t = tid & 255, vb = blockIdx.x * 2 + (tid >> 8), nvb = gridDim.x * 2;
    for (int it = vb; it < CV_TOTAL; it += nvb) {
        int i = it;
        if (i < CV_WIN) { cvt_tile(p.w_in, INW, p.winT, (i / 24) * 64, (i % 24) * 128, t); continue; }
        i -= CV_WIN;
        if (i < CV_WZ) {
            for (int c = t; c < 32 * 128; c += 256) {
                const int n = c >> 7, k8 = (c & 127) * 8;
                const float* s = p.w_in + (size_t)k8 * INW + PJW + n;
                uint4 q;
                q.x = pack2(s[0], s[INW]); q.y = pack2(s[2 * INW], s[3 * INW]); q.z = pack2(s[4 * INW], s[5 * INW]); q.w = pack2(s[6 * INW], s[7 * INW]);
                *(uint4*)(p.wzT + (size_t)n * 1024 + k8) = q;
            }
            continue;
        }
        i -= CV_WZ;
        if (i < CV_WO) { cvt_tile(p.w_out, D, p.woT, (i >> 3) * 64, (i & 7) * 128, t); continue; }
        i -= CV_WO;
        if (i < CV_W1) { if (i >= W1_CONV) { const int e = i >> 8, j = i & 255; cvt_tile8(p.w1 + (size_t)e * D * 2 * DFF, 2 * DFF, p.w1T8 + (size_t)e * 2 * DFF * D, (j >> 4) * 64, (j & 15) * 128, t); } continue; }
        i -= CV_W1;
        if (i >= W2_LATE) { const int e = i >> 7, j = i & 127; cvt_tile8(p.w2 + (size_t)e * DFF * D, D, p.w2T8 + (size_t)e * D * DFF, (j >> 3) * 64, (j & 7) * 128, t); }
    }
}

namespace pg {
constexpr int BM = 256, BK = 64, HALF = 128, HTB = HALF * BK * 2, KD = 1024;
__host__ __device__ __forceinline__ int lds_byte(int r, int c) { const int st = (r >> 4) * 2 + (c >> 5), rr = r & 15, cc = c & 31, ob = rr * 64 + cc * 2; return st * 1024 + (ob ^ (((ob >> 9) & 1) << 5)); }
__host__ __device__ __forceinline__ void stage_rc(int b, int& R, int& C) { const int st = b / 1024, sb = b % 1024, swz = sb ^ (((sb >> 9) & 1) << 5); R = (st >> 1) * 16 + swz / 64; C = (st & 1) * 32 + (swz % 64) / 2; }
__host__ __device__ __forceinline__ int perm32(int rho) { const int n = rho >> 4, i = rho & 15; return 8 * (i >> 2) + 4 * n + (i & 3); }

struct Unit { int pn, row0, nvalid, e, ord; };

typedef int v8i32 __attribute__((ext_vector_type(8)));
template <class Epi, class Sched, bool FP8 = false>
__device__ __forceinline__ void gemm_phase(LDS_AS unsigned char* lds, const Sched& S, const Epi& E) {
    const int tid = tid_opaque(), wid = __builtin_amdgcn_readfirstlane(tid >> 6), lane = tid & 63, wr = wid >> 2, wc = wid & 3, fr = lane & 15, fq = lane >> 4;
    constexpr int ROWB = FP8 ? KD : KD * 2;
    constexpr int nt = FP8 ? KD / 128 : KD / BK;
    int R0, C0; stage_rc(tid * 16, R0, C0);
    unsigned voffB[2];
#pragma unroll
    for (int i = 0; i < 2; ++i) { const int R = R0 + 64 * i; const int Rb = Epi::PERM ? ((R & ~31) + perm32(R & 31)) : R; voffB[i] = (unsigned)(Rb * ROWB + C0 * 2); }
    const size_t kstep = (size_t)(BK * 2);
    const size_t hstep = (size_t)HALF * ROWB;
    const unsigned ldsw = (unsigned)wid * 1024u;
    const int aoff = lds_byte(wr * 64 + fr, fq * 8), boff = lds_byte(wc * 32 + fr, fq * 8);
    const int aoff8a = lds_byte(wr * 64 + fr, fq * 16), boff8a = lds_byte(wc * 32 + fr, fq * 16);
#define PG_SA(b, h) (((b) * 2 + (h)) * HTB)
#define PG_SB(b, h) ((4 + (b) * 2 + (h)) * HTB)
#define PG_STAGE_B(bufoff, gbase) do { _Pragma("unroll") for (int _i = 0; _i < 2; ++_i) \
        __builtin_amdgcn_global_load_lds((const unsigned*)((const char*)(gbase) + voffB[_i]), (LDS_AS unsigned*)(lds + (bufoff) + ldsw + _i * 8192), 16, 0, 0); } while (0)
#define PG_STAGE_A(bufoff, o0, o1) do { \
        __builtin_amdgcn_global_load_lds((const unsigned*)(Abase + (o0)), (LDS_AS unsigned*)(lds + (bufoff) + ldsw), 16, 0, 0); \
        __builtin_amdgcn_global_load_lds((const unsigned*)(Abase + (o1)), (LDS_AS unsigned*)(lds + (bufoff) + ldsw + 8192), 16, 0, 0); } while (0)
#define PG_LDA16(dst, b, h) do { _Pragma("unroll") for (int m = 0; m < 4; ++m) _Pragma("unroll") for (int k = 0; k < 2; ++k) dst[m][k] = *(const LDS_AS bf16x8*)(lds + PG_SA(b, h) + aoff + m * 2048 + k * 1024); } while (0)
#define PG_LDB16(dst, b, h) do { _Pragma("unroll") for (int n = 0; n < 2; ++n) _Pragma("unroll") for (int k = 0; k < 2; ++k) dst[n][k] = *(const LDS_AS bf16x8*)(lds + PG_SB(b, h) + boff + n * 2048 + k * 1024); } while (0)
#define PG_RD16(off) __builtin_bit_cast(u32x4, *(const LDS_AS bf16x8*)(lds + (off)))
#define PG_LDA8(dst, b, h) do { _Pragma("unroll") for (int m = 0; m < 4; ++m) dst##8[m] = __builtin_bit_cast(v8i32, __builtin_shufflevector(PG_RD16(PG_SA(b, h) + aoff8a + m * 2048), PG_RD16(PG_SA(b, h) + aoff8a + 16 + m * 2048), 0, 1, 2, 3, 4, 5, 6, 7)); } while (0)
#define PG_LDB8(dst, b, h) do { _Pragma("unroll") for (int n = 0; n < 2; ++n) dst##8[n] = __builtin_bit_cast(v8i32, __builtin_shufflevector(PG_RD16(PG_SB(b, h) + boff8a + n * 2048), PG_RD16(PG_SB(b, h) + boff8a + 16 + n * 2048), 0, 1, 2, 3, 4, 5, 6, 7)); } while (0)
#define PG_LDA(dst, b, h) do { if constexpr (FP8) PG_LDA8(dst, b, h); else PG_LDA16(dst, b, h); } while (0)
#define PG_LDB(dst, b, h) do { if constexpr (FP8) PG_LDB8(dst, b, h); else PG_LDB16(dst, b, h); } while (0)
#define PG_MMA(ai, bj, At, Bt) do { __builtin_amdgcn_s_setprio(1); _Pragma("unroll") for (int m = 0; m < 4; ++m) _Pragma("unroll") for (int n = 0; n < 2; ++n) { \
        if constexpr (FP8) asm volatile("v_mfma_scale_f32_16x16x128_f8f6f4 %0, %1, %2, %0, %3, %4 op_sel_hi:[0,0,0]" : "+v"(acc[ai][bj][m][n]) : "v"(Bt##8[n]), "v"(At##8[m]), "v"(sclA), "v"(sclA)); \
        else { _Pragma("unroll") for (int k = 0; k < 2; ++k) acc[ai][bj][m][n] = __builtin_amdgcn_mfma_f32_16x16x32_bf16(Bt[n][k], At[m][k], acc[ai][bj][m][n], 0, 0, 0); } } \
        __builtin_amdgcn_s_setprio(0); } while (0)
#define PG_WAIT_V(n) asm volatile("s_waitcnt vmcnt(" #n ")" ::: "memory")
#define PG_WAIT_L(n) asm volatile("s_waitcnt lgkmcnt(" #n ")" ::: "memory")
#define PG_BAR __builtin_amdgcn_s_barrier()
#define PG_SCHED __builtin_amdgcn_sched_barrier(0)
    Unit cur, nxt; int ui = 0;
    if (!S.next(0, cur)) return;
    f32x4 acc[2][2][4][2];
    E.init(acc, cur, wr, wc, fr, fq);
    bf16x8 At[4][2], B0[2][2], B1[2][2];
    v8i32 At8[4], B08[2], B18[2];
    int sclA = 0x7F7F7F7F;
    asm volatile("" : "+v"(sclA));
    const char* Abase = (const char*)S.A;
    unsigned c00 = S.rowoff(cur, R0) + C0 * 2u, c01 = S.rowoff(cur, R0 + 64) + C0 * 2u, c10 = S.rowoff(cur, R0 + 128) + C0 * 2u, c11 = S.rowoff(cur, R0 + 192) + C0 * 2u;
    const char* cB = S.bbase(cur);
    PG_STAGE_B(PG_SB(0, 0), cB); PG_STAGE_A(PG_SA(0, 0), c00, c01); PG_STAGE_B(PG_SB(0, 1), cB + hstep); PG_STAGE_A(PG_SA(0, 1), c10, c11);
    if (wr == 1) PG_BAR;
    PG_WAIT_V(4); PG_BAR;
    PG_STAGE_B(PG_SB(1, 0), cB + kstep); PG_STAGE_A(PG_SA(1, 0), c00 + 128u, c01 + 128u); PG_STAGE_B(PG_SB(1, 1), cB + hstep + kstep);
    PG_WAIT_V(6); PG_BAR;
    for (;;) {
        const bool has_next = S.next(ui + 1, nxt);
        const char* nB = has_next ? S.bbase(nxt) : cB;
        unsigned dnx = 0u;
        if constexpr (Sched::LINEAR) { if (has_next) dnx = S.rowoff(nxt, 0) - S.rowoff(cur, 0); }

#pragma unroll 1
        for (int t = 0; t < nt; t += 2) {
            const bool last = (t == nt - 2);
            const unsigned k1 = (unsigned)(t + 1) * 128u, k2 = last ? 0u : (unsigned)(t + 2) * 128u, k3 = k2 + 128u;
            unsigned a2_00, a2_01, a2_10, a2_11, a3_00, a3_01;
            if constexpr (Sched::LINEAR) { const unsigned dl = last ? dnx : 0u; a2_00 = c00 + dl + k2; a2_01 = c01 + dl + k2; a2_10 = c10 + dl + k2; a2_11 = c11 + dl + k2; a3_00 = c00 + dl + k3; a3_01 = c01 + dl + k3; }
            else {
                a2_00 = c00; a2_01 = c01; a2_10 = c10; a2_11 = c11;
                if (last && has_next) { a2_00 = S.rowoff(nxt, R0) + C0 * 2u; a2_01 = S.rowoff(nxt, R0 + 64) + C0 * 2u; a2_10 = S.rowoff(nxt, R0 + 128) + C0 * 2u; a2_11 = S.rowoff(nxt, R0 + 192) + C0 * 2u; }
                a3_00 = a2_00 + k3; a3_01 = a2_01 + k3; a2_00 += k2; a2_01 += k2; a2_10 += k2; a2_11 += k2;
            }
            const char* b2 = last ? nB : cB + (size_t)(t + 2) * kstep;
            const char* b3 = b2 + kstep;
            PG_LDB(B0, 0, 0); PG_SCHED; PG_LDA(At, 0, 0); PG_STAGE_A(PG_SA(1, 1), c10 + k1, c11 + k1);
            PG_WAIT_L(8); PG_BAR; PG_WAIT_L(0); PG_MMA(0, 0, At, B0); PG_BAR; PG_SCHED;
            PG_LDB(B1, 0, 1); PG_STAGE_B(PG_SB(0, 0), b2);
            PG_BAR; PG_WAIT_L(0); PG_MMA(0, 1, At, B1); PG_BAR;
            PG_LDA(At, 0, 1); PG_STAGE_A(PG_SA(0, 0), a2_00, a2_01);
            PG_BAR; PG_WAIT_L(0); PG_MMA(1, 0, At, B0); PG_BAR; PG_SCHED;
            PG_STAGE_B(PG_SB(0, 1), b2 + hstep);
            PG_WAIT_V(6); PG_BAR; PG_MMA(1, 1, At, B1); PG_BAR;
            PG_LDB(B0, 1, 0); PG_SCHED; PG_LDA(At, 1, 0); PG_STAGE_A(PG_SA(0, 1), a2_10, a2_11);
            PG_WAIT_L(8); PG_BAR; PG_WAIT_L(0); PG_MMA(0, 0, At, B0); PG_BAR; PG_SCHED;
            PG_LDB(B1, 1, 1); PG_STAGE_B(PG_SB(1, 0), b3);
            PG_BAR; PG_WAIT_L(0); PG_MMA(0, 1, At, B1); PG_BAR;
            PG_LDA(At, 1, 1); PG_STAGE_A(PG_SA(1, 0), a3_00, a3_01);
            PG_BAR; PG_WAIT_L(0); PG_MMA(1, 0, At, B0); PG_BAR; PG_SCHED;
            PG_STAGE_B(PG_SB(1, 1), b3 + hstep);
            PG_WAIT_V(6); PG_BAR; PG_MMA(1, 1, At, B1); PG_BAR;
        }
        E(acc, cur, wr, wc, fr, fq);
        if (!has_next) break;
        E.init(acc, nxt, wr, wc, fr, fq);
        if constexpr (Sched::LINEAR) { c00 += dnx; c01 += dnx; c10 += dnx; c11 += dnx; }
        else { c00 = S.rowoff(nxt, R0) + C0 * 2u; c01 = S.rowoff(nxt, R0 + 64) + C0 * 2u; c10 = S.rowoff(nxt, R0 + 128) + C0 * 2u; c11 = S.rowoff(nxt, R0 + 192) + C0 * 2u; }
        cur = nxt; cB = nB; ++ui;
    }
    PG_WAIT_V(0);
    if (wr == 0) PG_BAR;
    PG_BAR;
#undef PG_SA
#undef PG_SB
#undef PG_STAGE_A
#undef PG_STAGE_B
#undef PG_LDA
#undef PG_LDB
#undef PG_LDA8
#undef PG_LDB8
#undef PG_LDA16
#undef PG_LDB16
#undef PG_RD16
#undef PG_MMA
#undef PG_WAIT_V
#undef PG_WAIT_L
#undef PG_BAR
#undef PG_SCHED
}

struct DenseSched {
    static constexpr bool LINEAR = true;
    const u16* A; const u16* Bt; int nM, nN, nwg, G, c;
    __device__ void init(const u16* A_, const u16* Bt_, int M, int N, int G_, int c_) { A = A_; Bt = Bt_; nM = M / BM; nN = N / BM; nwg = nM * nN; G = G_; c = c_; }
    __device__ __forceinline__ bool next(int i, Unit& u) const {
        const int L = i * G + c; if (L >= nwg) return false;
        int wgid = L; { const int q = nwg / 8, r = nwg % 8, xcd = wgid % 8, off = wgid / 8; wgid = (xcd < r ? xcd * (q + 1) : r * (q + 1) + (xcd - r) * q) + off; }
        const int nig = 8 * nN, gid = wgid / nig, fm = gid * 8, gsz = (nM - fm) < 8 ? (nM - fm) : 8;
        u.row0 = (fm + ((wgid % nig) % gsz)) * BM; u.pn = (wgid % nig) / gsz; u.nvalid = BM; u.e = 0; u.ord = i; return true;
    }
    __device__ __forceinline__ unsigned rowoff(const Unit& u, int r) const { return (unsigned)(u.row0 + r) * (unsigned)(KD * 2); }
    __device__ __forceinline__ const char* bbase(const Unit& u) const { return (const char*)Bt + (size_t)u.pn * BM * KD * 2; }
};

template <bool GATHER> struct MoeSchedT {
    static constexpr bool LINEAR = !GATHER;
    const u16* A; const u16* Bt; const int* lists; const LDS_AS int* meta; int NT, nunits, G, c; int rowb; const LDS_AS unsigned* rowtab;
    __device__ __forceinline__ bool next(int i, Unit& u) const {
        const int L = i * G + c; if (L >= nunits) return false;
        int wgid = L; { const int q = nunits / 8, r = nunits % 8, xcd = wgid % 8, off = wgid / 8; wgid = (xcd < r ? xcd * (q + 1) : r * (q + 1) + (xcd - r) * q) + off; }
        const int gm = wgid / NT; u.pn = wgid % NT;
        int e = 0;
        while (meta[32 + e + 1] <= gm) ++e;
        const int mi = gm - meta[32 + e];
        u.e = e; u.row0 = meta[72 + e] + mi * BM; u.nvalid = min(BM, meta[e] - mi * BM); u.ord = i;
        return true;
    }
    __device__ __forceinline__ unsigned rowoff(const Unit& u, int r) const {
        if constexpr (GATHER) return rowtab[u.ord * BM + r];
        else return (unsigned)(u.row0 + r) * (unsigned)rowb;
    }
    __device__ __forceinline__ const char* bbase(const Unit& u) const { return (const char*)Bt + ((size_t)u.e * NT + u.pn) * BM * (size_t)rowb; }
};

struct EpiProj {
    static constexpr int SCALE_A = 0x7F7F7F7F, SCALE_B = 0x7F7F7F7F;
    static constexpr bool PERM = true;
    u16* O;
    __device__ __forceinline__ void init(f32x4 (&acc)[2][2][4][2], const Unit&, int, int, int, int) const {
#pragma unroll
        for (int a = 0; a < 2; ++a)
#pragma unroll
            for (int b = 0; b < 2; ++b)
#pragma unroll
                for (int m = 0; m < 4; ++m)
#pragma unroll
                    for (int n = 0; n < 2; ++n) acc[a][b][m][n] = (f32x4){0.f, 0.f, 0.f, 0.f};
    }
    __device__ __forceinline__ void operator()(const f32x4 (&acc)[2][2][4][2], const Unit& u, int wr, int wc, int fr, int fq) const {
        const int row0 = u.row0 + wr * 64 + fr, col0 = u.pn * BM + wc * 32 + 8 * fq;
#pragma unroll
        for (int ai = 0; ai < 2; ++ai)
#pragma unroll
            for (int m = 0; m < 4; ++m) { u16* rowp = O + (size_t)(row0 + ai * HALF + m * 16) * PJW + col0;
#pragma unroll
                for (int bj = 0; bj < 2; ++bj) { const f32x4 v0 = acc[ai][bj][m][0], v1 = acc[ai][bj][m][1];
                    u32x4 w; w.x = pack2(v0[0], v0[1]); w.y = pack2(v0[2], v0[3]); w.z = pack2(v1[0], v1[1]); w.w = pack2(v1[2], v1[3]);
                    *(u32x4*)(rowp + bj * HALF) = w; } }
    }
};
struct EpiOut {
    static constexpr int SCALE_A = 0x7F7F7F7F, SCALE_B = 0x7F7F7F7F;
    static constexpr bool PERM = false;
    const float* X; float* C;
    __device__ __forceinline__ void init(f32x4 (&acc)[2][2][4][2], const Unit& u, int wr, int wc, int fr, int fq) const {
        const int row0 = u.row0 + wr * 64 + fr, col0 = u.pn * BM + wc * 32 + 4 * fq;
#pragma unroll
        for (int ai = 0; ai < 2; ++ai)
#pragma unroll
            for (int m = 0; m < 4; ++m) { const size_t ro = (size_t)(row0 + ai * HALF + m * 16) * D + col0;
#pragma unroll
                for (int bj = 0; bj < 2; ++bj)
#pragma unroll
                    for (int n = 0; n < 2; ++n) acc[ai][bj][m][n] = *(const f32x4*)(X + ro + bj * HALF + n * 16); }
    }
    __device__ __forceinline__ void operator()(const f32x4 (&acc)[2][2][4][2], const Unit& u, int wr, int wc, int fr, int fq) const {
        const int row0 = u.row0 + wr * 64 + fr, col0 = u.pn * BM + wc * 32 + 4 * fq;
#pragma unroll
        for (int ai = 0; ai < 2; ++ai)
#pragma unroll
            for (int m = 0; m < 4; ++m) { const size_t ro = (size_t)(row0 + ai * HALF + m * 16) * D + col0;
#pragma unroll
                for (int bj = 0; bj < 2; ++bj)
#pragma unroll
                    for (int n = 0; n < 2; ++n) *(f32x4*)(C + ro + bj * HALF + n * 16) = acc[ai][bj][m][n]; }
    }
};
struct EpiMoe1 {
    static constexpr int SCALE_A = 0x7F7F7F7F, SCALE_B = 0x7F7F7F7F;
    static constexpr bool PERM = true;
    const float* b1; unsigned char* act8;
    __device__ __forceinline__ void init(f32x4 (&acc)[2][2][4][2], const Unit&, int, int, int, int) const {
#pragma unroll
        for (int a = 0; a < 2; ++a)
#pragma unroll
            for (int b = 0; b < 2; ++b)
#pragma unroll
                for (int m = 0; m < 4; ++m)
#pragma unroll
                    for (int n = 0; n < 2; ++n) acc[a][b][m][n] = (f32x4){0.f, 0.f, 0.f, 0.f};
    }
    __device__ __forceinline__ void operator()(const f32x4 (&acc)[2][2][4][2], const Unit& u, int wr, int wc, int fr, int fq) const {
        const int r0 = wr * 64 + fr, col0 = u.pn * BM + wc * 32 + 8 * fq;
        const float* be = b1 + (size_t)u.e * 2 * DFF + col0;
        f32x4 bv[2][2];
#pragma unroll
        for (int bj = 0; bj < 2; ++bj)
#pragma unroll
            for (int n = 0; n < 2; ++n) bv[bj][n] = *(const f32x4*)(be + bj * HALF + 4 * n);
#pragma unroll
        for (int ai = 0; ai < 2; ++ai)
#pragma unroll
            for (int m = 0; m < 4; ++m) {
                const int r = r0 + ai * HALF + m * 16;
                if (r < u.nvalid) {
                    unsigned char* rowp = act8 + (size_t)(u.row0 + r) * DFF + (col0 >> 1);
#pragma unroll
                    for (int bj = 0; bj < 2; ++bj) {
                        const f32x4 v0 = acc[ai][bj][m][0] * 0.03125f + bv[bj][0], v1 = acc[ai][bj][m][1] * 0.03125f + bv[bj][1];
                        const float g0 = fminf(v0[0], 7.0f), l0 = fminf(fmaxf(v0[1], -7.0f), 7.0f);
                        const float g1 = fminf(v0[2], 7.0f), l1 = fminf(fmaxf(v0[3], -7.0f), 7.0f);
                        const float g2 = fminf(v1[0], 7.0f), l2 = fminf(fmaxf(v1[1], -7.0f), 7.0f);
                        const float g3 = fminf(v1[2], 7.0f), l3 = fminf(fmaxf(v1[3], -7.0f), 7.0f);
                        const float a0 = g0 * __builtin_amdgcn_rcpf(1.0f + __expf(-1.702f * g0)) * (l0 + 1.0f), a1 = g1 * __builtin_amdgcn_rcpf(1.0f + __expf(-1.702f * g1)) * (l1 + 1.0f);
                        const float a2 = g2 * __builtin_amdgcn_rcpf(1.0f + __expf(-1.702f * g2)) * (l2 + 1.0f), a3 = g3 * __builtin_amdgcn_rcpf(1.0f + __expf(-1.702f * g3)) * (l3 + 1.0f);
                        int pk = __builtin_amdgcn_cvt_pk_fp8_f32(a0, a1, 0, false);
                        pk = __builtin_amdgcn_cvt_pk_fp8_f32(a2, a3, pk, true);
                        *(int*)(rowp + bj * (HALF / 2)) = pk;
                    }
                }
            }
    }
};
struct EpiMoe2 {
    static constexpr bool PERM = true;
    static constexpr int SCALE_A = 0x7F7F7F7F, SCALE_B = 0x7A7A7A7A;
    const float* b2; const float* gate; const int* lists; const LDS_AS int* meta; u16* y;
    __device__ __forceinline__ void init(f32x4 (&acc)[2][2][4][2], const Unit&, int, int, int, int) const {
#pragma unroll
        for (int a = 0; a < 2; ++a)
#pragma unroll
            for (int b = 0; b < 2; ++b)
#pragma unroll
                for (int m = 0; m < 4; ++m)
#pragma unroll
                    for (int n = 0; n < 2; ++n) acc[a][b][m][n] = (f32x4){0.f, 0.f, 0.f, 0.f};
    }
    __device__ __forceinline__ void operator()(const f32x4 (&acc)[2][2][4][2], const Unit& u, int wr, int wc, int fr, int fq) const {
        const int r0 = wr * 64 + fr, col0 = u.pn * BM + wc * 32 + 8 * fq;
        const float* be = b2 + (size_t)u.e * D + col0;
        const int* le = lists + (size_t)u.e * T + (u.row0 - meta[72 + u.e]);
        f32x4 bv[2][2];
#pragma unroll
        for (int bj = 0; bj < 2; ++bj)
#pragma unroll
            for (int n = 0; n < 2; ++n) bv[bj][n] = *(const f32x4*)(be + bj * HALF + 4 * n);
        int slot[8]; float gt[8];
#pragma unroll
        for (int q = 0; q < 8; ++q) slot[q] = le[min(r0 + (q >> 2) * HALF + (q & 3) * 16, u.nvalid - 1)];
        __builtin_amdgcn_sched_barrier(0);
#pragma unroll
        for (int q = 0; q < 8; ++q) gt[q] = gate[slot[q]];
        __builtin_amdgcn_sched_barrier(0);
#pragma unroll
        for (int ai = 0; ai < 2; ++ai)
#pragma unroll
            for (int m = 0; m < 4; ++m) {
                const int r = r0 + ai * HALF + m * 16;
                if (r < u.nvalid) {
                    const float g1 = gt[ai * 4 + m];
                    unsigned char* rowp = (unsigned char*)y + (size_t)slot[ai * 4 + m] * D + col0;
                    const float g16 = g1 * 16.0f;
#pragma unroll
                    for (int bj = 0; bj < 2; ++bj) {
                        const f32x4 v0 = (acc[ai][bj][m][0] * 0.03125f + bv[bj][0]) * g16, v1 = (acc[ai][bj][m][1] * 0.03125f + bv[bj][1]) * g16;
                        int lo = __builtin_amdgcn_cvt_pk_fp8_f32(v0[0], v0[1], 0, false); lo = __builtin_amdgcn_cvt_pk_fp8_f32(v0[2], v0[3], lo, true);
                        int hi = __builtin_amdgcn_cvt_pk_fp8_f32(v1[0], v1[1], 0, false); hi = __builtin_amdgcn_cvt_pk_fp8_f32(v1[2], v1[3], hi, true);
                        uint2 w; w.x = (unsigned)lo; w.y = (unsigned)hi;
                        *(uint2*)(rowp + bj * HALF) = w;
                    }
                }
            }
    }
};
}

constexpr int AT_K = 0, AT_V = 208 * 128, AT_Q = AT_V + 208 * 160, AT_BIAS = AT_Q + 8192;
struct AttnRegs { u32x4 kv[6], vv[6], qv[2]; float tb[3]; };
__device__ __forceinline__ void attn_load(const Params& p, int t, int it, AttnRegs& R) {
    const int idx = it & 63, br = (it >> 6) % 3, h = (it / 192) & 7, b = it / 1536;
    const int dsh = br * 2, L = S >> dsh, nbl = L >> 6;
    const int res = idx / nbl, qb = idx % nbl;
#pragma unroll
    for (int i = 0; i < 6; ++i) {
        const int j = t + 256 * i, row = j >> 3, c = j & 7;
        const int ki = 64 * (qb - 1) + row;
        const bool ok = (ki >= 0 && ki < L);
        const size_t base = (size_t)(b * S + res + ((ok ? ki : 0) << dsh)) * PJW + h * 64 + c * 8;
        const u32x4 kx = *(const u32x4*)(p.proj + base + C_AK), vx = *(const u32x4*)(p.proj + base + C_AV);
        const u32x4 zz = {0u, 0u, 0u, 0u};
        R.kv[i] = ok ? kx : zz; R.vv[i] = ok ? vx : zz;
    }
#pragma unroll
    for (int i = 0; i < 2; ++i) {
        const int j = t + 256 * i, row = j >> 3, c = j & 7;
        const size_t base = (size_t)(b * S + res + ((64 * qb + row) << dsh)) * PJW + C_AQ + h * 64 + c * 8;
        R.qv[i] = *(const u32x4*)(p.proj + base);
    }
#pragma unroll
    for (int i = 0; i < 3; ++i) {
        const int en = t + 256 * i, c = en / 176, x = en - c * 176, y = x - c - 16;
        const bool ok = (en < 704) && (y >= 0) && (y <= 128);
        const float bvl = p.rel_bias[T5TAB[br * 129 + (ok ? y : 0)] * AH + h];
        R.tb[i] = ok ? bvl * 1.44269504f : -1.0e30f;
    }
}
__device__ void attn_item(const Params& p, char* lds, int t, int it, int nit, AttnRegs& R) {
    const int l = t & 63, w = t >> 6, i16 = l & 15, g = l >> 4;
    const int idx = it & 63, br = (it >> 6) % 3, h = (it / 192) & 7, b = it / 1536;
    const int dsh = br * 2, L = S >> dsh, nbl = L >> 6;
    const int res = idx / nbl, qb = idx % nbl;
    char* Ks = lds + AT_K; char* Vs = lds + AT_V; char* Qs = lds + AT_Q; float* biasf = (float*)(lds + AT_BIAS);
    __syncthreads();
#pragma unroll
    for (int i = 0; i < 6; ++i) {
        const int j = t + 256 * i, row = j >> 3, c = j & 7;
        *(u32x4*)(Ks + tile_off(row, c)) = R.kv[i];
        *(u32x4*)(Vs + row * 160 + c * 16) = R.vv[i];
    }
    { u32x4 zz = {0u, 0u, 0u, 0u}; asm volatile("" : "+v"(zz));
      if (t < 160) *(u32x4*)(Vs + 192 * 160 + t * 16) = zz; else if (t < 224) { *(u32x4*)(Ks + 192 * 128 + (t - 160) * 16) = zz; *(u32x4*)(Ks + 192 * 128 + (t - 96) * 16) = zz; } }
#pragma unroll
    for (int i = 0; i < 2; ++i) { const int j = t + 256 * i; *(u32x4*)(Qs + tile_off(j >> 3, j & 7)) = R.qv[i]; }
#pragma unroll
    for (int i = 0; i < 3; ++i) { const int en = t + 256 * i; if (en < 704) biasf[en] = R.tb[i]; }
    __syncthreads();
    if (nit >= 0) attn_load(p, t, nit, R);

    const bf16x8 qf0 = lds_frag(Qs, 16 * w + i16, g), qf1 = lds_frag(Qs, 16 * w + i16, 4 + g);
    const char* Kw = Ks + 16 * w * 128;
    f32x4 sc[10];
#pragma unroll
    for (int i = 0; i < 10; ++i) {
        const bf16x8 k0 = lds_frag(Kw, 16 * i + i16, g), k1 = lds_frag(Kw, 16 * i + i16, 4 + g);
        f32x4 a = {0.f, 0.f, 0.f, 0.f};
        a = __builtin_amdgcn_mfma_f32_16x16x32_bf16(k0, qf0, a, 0, 0, 0);
        a = __builtin_amdgcn_mfma_f32_16x16x32_bf16(k1, qf1, a, 0, 0, 0);
        sc[i] = a;
    }
    const int sq = 16 * w + i16;
    const float* tabc = biasf + (i16 & 3) * 176 + 4 * g - 4 * (i16 >> 2) + 16;
    float mx = -3.0e38f;
#pragma unroll
    for (int i = 0; i < 10; ++i) {
        const f32x4 b4 = *(const f32x4*)(tabc + 16 * i);
#pragma unroll
        for (int r = 0; r < 4; ++r) sc[i][r] = fmaf(sc[i][r], 0.125f * 1.44269504f, b4[r]);
    }
    if (qb == 0 || qb == nbl - 1) {
        const int lo = (qb == 0) ? 64 : 0, hi = (qb == nbl - 1) ? 128 : 192;
#pragma unroll
        for (int i = 0; i < 10; ++i)
#pragma unroll
            for (int r = 0; r < 4; ++r) { const int tk = 16 * (w + i) + 4 * g + r; sc[i][r] = (tk >= lo && tk < hi) ? sc[i][r] : -1.0e30f; }
    }
#pragma unroll
    for (int i = 0; i < 10; ++i) mx = fmaxf(mx, fmaxf(fmaxf(sc[i][0], sc[i][1]), fmaxf(sc[i][2], sc[i][3])));
    mx = fmaxf(mx, swz_xor<16>(mx)); mx = half_max(mx);
    float ls = 0.f;
#pragma unroll
    for (int i = 0; i < 10; ++i) {
#pragma unroll
        for (int r = 0; r < 4; ++r) { const float e = __builtin_amdgcn_exp2f(sc[i][r] - mx); sc[i][r] = e; ls += e; }
    }
    ls += swz_xor<16>(ls); ls = half_sum(ls);

    f32x4 oa[4];
#pragma unroll
    for (int e = 0; e < 4; ++e) oa[e] = (f32x4){0.f, 0.f, 0.f, 0.f};
    const char* Vw = Vs + (16 * w + 4 * g + (i16 >> 2)) * 160 + 4 * (i16 & 3) * 2;
#pragma unroll
    for (int i2 = 0; i2 < 5; ++i2) {
        uint4 pu;
        pu.x = pack2(sc[2 * i2][0], sc[2 * i2][1]); pu.y = pack2(sc[2 * i2][2], sc[2 * i2][3]);
        pu.z = pack2(sc[2 * i2 + 1][0], sc[2 * i2 + 1][1]); pu.w = pack2(sc[2 * i2 + 1][2], sc[2 * i2 + 1][3]);
        const bf16x8 pf = __builtin_bit_cast(bf16x8, pu);
#pragma unroll
        for (int et = 0; et < 4; ++et) {
            const s16x4 va = tr_read(Vw + (32 * i2) * 160 + et * 32);
            const s16x4 vb = tr_read(Vw + (32 * i2 + 16) * 160 + et * 32);
            oa[et] = __builtin_amdgcn_mfma_f32_16x16x32_bf16(cat4(va, vb), pf, oa[et], 0, 0, 0);
        }
    }
    const float inv = 1.0f / ls;
    const size_t tok = (size_t)b * S + res + ((64 * qb + sq) << dsh);
#pragma unroll
    for (int et = 0; et < 4; ++et) {
        uint2 o; o.x = pack2(oa[et][0] * inv, oa[et][1] * inv); o.y = pack2(oa[et][2] * inv, oa[et][3] * inv);
        *(uint2*)(p.abr + ((size_t)br * T + tok) * 512 + h * 64 + 16 * et + 4 * g) = o;
    }
    if (g == 0) p.lse[((size_t)br * T + tok) * 8 + h] = (mx + __log2f(ls)) * 0.69314718f;
}

constexpr int GL_ZS = 0, GL_TOT = 8192, GL_GG = 10240, GL_BF = 10752, GL_BS = 68, GL_BB = GL_BF + 64 * GL_BS * 4, GL_R2 = GL_BB + 64 * GL_BS * 4;
__device__ __forceinline__ float logsig_fast(float a) { return fminf(a, 0.f) - __logf(1.0f + __expf(-fabsf(a))); }
__device__ __forceinline__ void gla_prep(const Params& p, char* lds, int t, int h) {
    const int d = t & 63, w = t >> 6;
    float* zs = (float*)(lds + GL_ZS); float* tot = (float*)(lds + GL_TOT); float* GG = (float*)(lds + GL_GG);
    float* BF = (float*)(lds + GL_BF); float* BB = (float*)(lds + GL_BB);
    float wf[16], wb[16];
#pragma unroll
    for (int r = 0; r < 16; ++r) { wf[r] = p.wgf[r * 256 + h * 64 + d]; wb[r] = p.wgb[r * 256 + h * 64 + d]; }
    const float biasf = p.bgf[h * 64 + d], biasb = p.bgb[h * 64 + d];
    __syncthreads();
    float bfv[16], bbv[16];
#pragma unroll
    for (int i = 0; i < 16; ++i) {
        const float4* zr = (const float4*)(zs + (16 * w + i) * 32);
        float af = biasf, ab = biasb;
#pragma unroll
        for (int r4 = 0; r4 < 4; ++r4) {
            const float4 zf = zr[r4], zb = zr[4 + r4];
            af = fmaf(zf.x, wf[4 * r4], af); af = fmaf(zf.y, wf[4 * r4 + 1], af); af = fmaf(zf.z, wf[4 * r4 + 2], af); af = fmaf(zf.w, wf[4 * r4 + 3], af);
            ab = fmaf(zb.x, wb[4 * r4], ab); ab = fmaf(zb.y, wb[4 * r4 + 1], ab); ab = fmaf(zb.z, wb[4 * r4 + 2], ab); ab = fmaf(zb.w, wb[4 * r4 + 3], ab);
        }
        bfv[i] = logsig_fast(af) * (1.0f / 16.0f); bbv[i] = logsig_fast(ab) * (1.0f / 16.0f);
    }
#pragma unroll
    for (int i = 1; i < 16; ++i) bfv[i] += bfv[i - 1];
#pragma unroll
    for (int i = 14; i >= 0; --i) bbv[i] += bbv[i + 1];
    tot[(0 * 4 + w) * 64 + d] = bfv[15];
    tot[(1 * 4 + w) * 64 + d] = bbv[0];
    __syncthreads();
    float offf = 0.f, offb = 0.f, Gf = 0.f, Gb = 0.f;
#pragma unroll
    for (int ww = 0; ww < 4; ++ww) {
        const float a = tot[(0 * 4 + ww) * 64 + d], c = tot[(1 * 4 + ww) * 64 + d];
        Gf += a; Gb += c;
        if (ww < w) offf += a;
        if (ww > w) offb += c;
    }
#pragma unroll
    for (int i = 0; i < 16; ++i) { BF[(16 * w + i) * GL_BS + d] = bfv[i] + offf; BB[(16 * w + i) * GL_BS + d] = bbv[i] + offb; }
    if (w == 0) { GG[d] = Gf; GG[64 + d] = Gb; }
    __syncthreads();
}
__device__ __forceinline__ void unpack8(const uint4 u, float (&f)[8]) {
    f[0] = lo2f(u.x); f[1] = hi2f(u.x); f[2] = lo2f(u.y); f[3] = hi2f(u.y); f[4] = lo2f(u.z); f[5] = hi2f(u.z); f[6] = lo2f(u.w); f[7] = hi2f(u.w);
}
__device__ __forceinline__ uint4 pack8(const float (&f)[8]) { uint4 u; u.x = pack2(f[0], f[1]); u.y = pack2(f[2], f[3]); u.z = pack2(f[4], f[5]); u.w = pack2(f[6], f[7]); return u; }

constexpr int GD_KF = GL_R2, GD_KB = GD_KF + 64 * 160, GD_VT = GL_BF;
__device__ void gla_ds_item(const Params& p, char* lds, int t, int it) {
    const int l = t & 63, w = t >> 6, i16 = l & 15, g = l >> 4;
    const int n = it & 63, h = (it >> 6) & 3, b = it >> 8;
    const int t0 = b * S + n * 64;
    float* zs = (float*)(lds + GL_ZS);
    const int sr = t >> 2, sc = t & 3;
    const u16* kp = p.proj + (size_t)(t0 + sr) * PJW + C_GK + h * 64 + sc * 16;
    const uint4 kr0 = *(const uint4*)(kp), kr1 = *(const uint4*)(kp + 8);
    u32x4 vr[4];
#pragma unroll
    for (int i = 0; i < 4; ++i) { const int j = t + 256 * i; vr[i] = *(const u32x4*)(p.proj + (size_t)(t0 + (j >> 4)) * PJW + C_GV + h * 128 + (j & 15) * 8); }
    const float4* zsrc = (const float4*)(p.zbuf + (size_t)t0 * 32);
    const float4 zv0 = zsrc[t], zv1 = zsrc[t + 256];
    __syncthreads();
    ((float4*)zs)[t] = zv0; ((float4*)zs)[t + 256] = zv1;
    gla_prep(p, lds, t, h);
    const float* BF = (const float*)(lds + GL_BF); const float* BB = (const float*)(lds + GL_BB); const float* GG = (const float*)(lds + GL_GG);
    char* KF = lds + GD_KF; char* KB = lds + GD_KB; char* VT = lds + GD_VT;
    {
        float kk[16];
        { float tmp[8]; unpack8(kr0, tmp);
#pragma unroll
          for (int j = 0; j < 8; ++j) kk[j] = tmp[j];
          unpack8(kr1, tmp);
#pragma unroll
          for (int j = 0; j < 8; ++j) kk[8 + j] = tmp[j]; }
        float of[16], ob[16];
#pragma unroll
        for (int q = 0; q < 4; ++q) {
            const float4 bf4 = *(const float4*)(BF + sr * GL_BS + sc * 16 + 4 * q), bb4 = *(const float4*)(BB + sr * GL_BS + sc * 16 + 4 * q);
            const float4 gf4 = *(const float4*)(GG + sc * 16 + 4 * q), gb4 = *(const float4*)(GG + 64 + sc * 16 + 4 * q);
            of[4 * q + 0] = kk[4 * q + 0] * __expf(gf4.x - bf4.x); of[4 * q + 1] = kk[4 * q + 1] * __expf(gf4.y - bf4.y);
            of[4 * q + 2] = kk[4 * q + 2] * __expf(gf4.z - bf4.z); of[4 * q + 3] = kk[4 * q + 3] * __expf(gf4.w - bf4.w);
            ob[4 * q + 0] = kk[4 * q + 0] * __expf(gb4.x - bb4.x); ob[4 * q + 1] = kk[4 * q + 1] * __expf(gb4.y - bb4.y);
            ob[4 * q + 2] = kk[4 * q + 2] * __expf(gb4.z - bb4.z); ob[4 * q + 3] = kk[4 * q + 3] * __expf(gb4.w - bb4.w);
        }
        uint4 u;
        u.x = pack2(of[0], of[1]); u.y = pack2(of[2], of[3]); u.z = pack2(of[4], of[5]); u.w = pack2(of[6], of[7]);
        *(uint4*)(KF + sr * 160 + sc * 32) = u;
        u.x = pack2(of[8], of[9]); u.y = pack2(of[10], of[11]); u.z = pack2(of[12], of[13]); u.w = pack2(of[14], of[15]);
        *(uint4*)(KF + sr * 160 + sc * 32 + 16) = u;
        u.x = pack2(ob[0], ob[1]); u.y = pack2(ob[2], ob[3]); u.z = pack2(ob[4], ob[5]); u.w = pack2(ob[6], ob[7]);
        *(uint4*)(KB + sr * 160 + sc * 32) = u;
        u.x = pack2(ob[8], ob[9]); u.y = pack2(ob[10], ob[11]); u.z = pack2(ob[12], ob[13]); u.w = pack2(ob[14], ob[15]);
        *(uint4*)(KB + sr * 160 + sc * 32 + 16) = u;
        if (t < 64) { p.dec[((size_t)it * 2 + 0) * 64 + t] = __expf(GG[t]); p.dec[((size_t)it * 2 + 1) * 64 + t] = __expf(GG[64 + t]); }
    }
    __syncthreads();
#pragma unroll
    for (int i = 0; i < 4; ++i) { const int j = t + 256 * i; *(u32x4*)(VT + (j >> 4) * 288 + (j & 15) * 16) = vr[i]; }
    __syncthreads();
#pragma unroll
    for (int dir = 0; dir < 2; ++dir) {
        const char* KX = dir ? KB : KF;
        f32x4 acc[2][4];
#pragma unroll
        for (int a = 0; a < 2; ++a)
#pragma unroll
            for (int c = 0; c < 4; ++c) acc[a][c] = (f32x4){0.f, 0.f, 0.f, 0.f};
#pragma unroll
        for (int ks = 0; ks < 2; ++ks) {
            const int r0 = ks * 32 + 8 * g + (i16 >> 2);
            bf16x8 vf[2], kf[4];
#pragma unroll
            for (int a = 0; a < 2; ++a) {
                const int e0 = 16 * (2 * w + a) + 4 * (i16 & 3);
                vf[a] = cat4(tr_read(VT + r0 * 288 + e0 * 2), tr_read(VT + (r0 + 4) * 288 + e0 * 2));
            }
#pragma unroll
            for (int c = 0; c < 4; ++c) {
                const int d0 = 16 * c + 4 * (i16 & 3);
                kf[c] = cat4(tr_read(KX + r0 * 160 + d0 * 2), tr_read(KX + (r0 + 4) * 160 + d0 * 2));
            }
#pragma unroll
            for (int a = 0; a < 2; ++a)
#pragma unroll
                for (int c = 0; c < 4; ++c) acc[a][c] = __builtin_amdgcn_mfma_f32_16x16x32_bf16(kf[c], vf[a], acc[a][c], 0, 0, 0);
        }
        float* dst = p.dS + ((size_t)it * 2 + dir) * 128 * 64;
#pragma unroll
        for (int a = 0; a < 2; ++a)
#pragma unroll
            for (int c = 0; c < 4; ++c) *(f32x4*)(dst + (16 * (2 * w + a) + i16) * 64 + 16 * c + 4 * g) = acc[a][c];
    }
}

__device__ void gla_scan_thread2(const Params& p, int gid) {
    const int d = gid & 63, e = (gid >> 6) & 127, dir = (gid >> 13) & 1, bh0 = gid >> 14, bh1 = bh0 + 8;
    float s0 = 0.f, s1 = 0.f;
#pragma unroll 8
    for (int step = 0; step < 64; ++step) {
        const int n = dir ? (63 - step) : step;
        const size_t i0 = ((size_t)(bh0 * 64 + n)) * 2 + dir, i1 = ((size_t)(bh1 * 64 + n)) * 2 + dir;
        const float dc0 = p.dec[i0 * 64 + d], ds0 = p.dS[(i0 * 128 + e) * 64 + d];
        const float dc1 = p.dec[i1 * 64 + d], ds1 = p.dS[(i1 * 128 + e) * 64 + d];
        p.Sp[(i0 * 128 + e) * 64 + d] = f2bf(s0);
        p.Sp[(i1 * 128 + e) * 64 + d] = f2bf(s1);
        s0 = fmaf(dc0, s0, ds0); s1 = fmaf(dc1, s1, ds1);
    }
}

__device__ void attn_combine_thread(const Params& p, int gid) {
    const int tok = gid >> 6, c = gid & 63, h = c >> 3;
    const float l0 = p.lse[((size_t)0 * T + tok) * 8 + h], l1 = p.lse[((size_t)1 * T + tok) * 8 + h], l2 = p.lse[((size_t)2 * T + tok) * 8 + h];
    const float mm = fmaxf(l0, fmaxf(l1, l2));
    float w0 = __expf(l0 - mm), w1 = __expf(l1 - mm), w2 = __expf(l2 - mm);
    const float inv = 1.0f / (w0 + w1 + w2);
    w0 *= inv; w1 *= inv; w2 *= inv;
    const uint4 a0 = *(const uint4*)(p.abr + ((size_t)0 * T + tok) * 512 + c * 8);
    const uint4 a1 = *(const uint4*)(p.abr + ((size_t)1 * T + tok) * 512 + c * 8);
    const uint4 a2 = *(const uint4*)(p.abr + ((size_t)2 * T + tok) * 512 + c * 8);
    uint4 o;
    o.x = pack2(w0 * lo2f(a0.x) + w1 * lo2f(a1.x) + w2 * lo2f(a2.x), w0 * hi2f(a0.x) + w1 * hi2f(a1.x) + w2 * hi2f(a2.x));
    o.y = pack2(w0 * lo2f(a0.y) + w1 * lo2f(a1.y) + w2 * lo2f(a2.y), w0 * hi2f(a0.y) + w1 * hi2f(a1.y) + w2 * hi2f(a2.y));
    o.z = pack2(w0 * lo2f(a0.z) + w1 * lo2f(a1.z) + w2 * lo2f(a2.z), w0 * hi2f(a0.z) + w1 * hi2f(a1.z) + w2 * hi2f(a2.z));
    o.w = pack2(w0 * lo2f(a0.w) + w1 * lo2f(a1.w) + w2 * lo2f(a2.w), w0 * hi2f(a0.w) + w1 * hi2f(a1.w) + w2 * hi2f(a2.w));
    *(uint4*)(p.mix + (size_t)tok * D + c * 8) = o;
}

constexpr int GO_QF = GL_R2, GO_QB = GO_QF + 8192, GO_KF = GO_QB + 8192, GO_KB = GO_KF + 8192, GO_VT = GL_R2, GO_AM = GL_ZS, GO_SF = GL_BF, GO_SB = GL_BF + 16384;
__device__ void gla_out_item(const Params& p, char* lds, int t, int it) {
    const int l = t & 63, w = t >> 6, i16 = l & 15, g = l >> 4;
    const int n = it & 63, h = (it >> 6) & 3, b = it >> 8;
    const int t0 = b * S + n * 64;
    float* zs = (float*)(lds + GL_ZS);
    const int sr = t >> 2, sc = t & 3;
    const float4* zsrc = (const float4*)(p.zbuf + (size_t)t0 * 32);
    const float4 zv0 = zsrc[t], zv1 = zsrc[t + 256];
    const u16* qp = p.proj + (size_t)(t0 + sr) * PJW + C_GQ + h * 64 + sc * 16;
    const u16* kp = p.proj + (size_t)(t0 + sr) * PJW + C_GK + h * 64 + sc * 16;
    const uint4 qr0 = *(const uint4*)(qp), qr1 = *(const uint4*)(qp + 8), kr0 = *(const uint4*)(kp), kr1 = *(const uint4*)(kp + 8);
    u32x4 vr[4], sv[8];
#pragma unroll
    for (int i = 0; i < 4; ++i) { const int j = t + 256 * i; vr[i] = *(const u32x4*)(p.proj + (size_t)(t0 + (j >> 4)) * PJW + C_GV + h * 128 + (j & 15) * 8); }
    const u16* SPG = p.Sp + (size_t)it * 2 * 128 * 64;
    __syncthreads();
    ((float4*)zs)[t] = zv0; ((float4*)zs)[t + 256] = zv1;
    gla_prep(p, lds, t, h);
#pragma unroll
    for (int i = 0; i < 8; ++i) { const int j = t + 256 * i; sv[i] = *(const u32x4*)(SPG + (size_t)j * 8); }
    const float* BF = (const float*)(lds + GL_BF); const float* BB = (const float*)(lds + GL_BB);
    char* QF = lds + GO_QF; char* QB = lds + GO_QB; char* KF = lds + GO_KF; char* KB = lds + GO_KB; char* VT = lds + GO_VT; char* AM = lds + GO_AM;
    char* SF = lds + GO_SF; char* SB = lds + GO_SB;
    {
        float qq[16], kk[16];
        { float tmp[8];
          unpack8(qr0, tmp);
#pragma unroll
          for (int j = 0; j < 8; ++j) qq[j] = tmp[j] * 0.125f;
          unpack8(qr1, tmp);
#pragma unroll
          for (int j = 0; j < 8; ++j) qq[8 + j] = tmp[j] * 0.125f;
          unpack8(kr0, tmp);
#pragma unroll
          for (int j = 0; j < 8; ++j) kk[j] = tmp[j];
          unpack8(kr1, tmp);
#pragma unroll
          for (int j = 0; j < 8; ++j) kk[8 + j] = tmp[j]; }
        float ef[16], eb[16];
#pragma unroll
        for (int q = 0; q < 4; ++q) {
            const float4 bf4 = *(const float4*)(BF + sr * GL_BS + sc * 16 + 4 * q), bb4 = *(const float4*)(BB + sr * GL_BS + sc * 16 + 4 * q);
            ef[4 * q + 0] = __expf(bf4.x); ef[4 * q + 1] = __expf(bf4.y); ef[4 * q + 2] = __expf(bf4.z); ef[4 * q + 3] = __expf(bf4.w);
            eb[4 * q + 0] = __expf(bb4.x); eb[4 * q + 1] = __expf(bb4.y); eb[4 * q + 2] = __expf(bb4.z); eb[4 * q + 3] = __expf(bb4.w);
        }
        float o8[8];
#pragma unroll
        for (int hh = 0; hh < 2; ++hh) {
            const int off = tile_off(sr, 2 * sc + hh);
#pragma unroll
            for (int j = 0; j < 8; ++j) o8[j] = qq[8 * hh + j] * ef[8 * hh + j];
            *(uint4*)(QF + off) = pack8(o8);
#pragma unroll
            for (int j = 0; j < 8; ++j) o8[j] = kk[8 * hh + j] / ef[8 * hh + j];
            *(uint4*)(KF + off) = pack8(o8);
#pragma unroll
            for (int j = 0; j < 8; ++j) o8[j] = qq[8 * hh + j] * eb[8 * hh + j];
            *(uint4*)(QB + off) = pack8(o8);
#pragma unroll
            for (int j = 0; j < 8; ++j) o8[j] = kk[8 * hh + j] / eb[8 * hh + j];
            *(uint4*)(KB + off) = pack8(o8);
        }
    }
    __syncthreads();
#pragma unroll
    for (int i = 0; i < 8; ++i) { const int j = t + 256 * i; *(u32x4*)((j >> 10 ? SB : SF) + tile_off((j >> 3) & 127, j & 7)) = sv[i]; }
    const int cq = 16 * w + i16;
    const bf16x8 qf0 = lds_frag(QF, cq, g), qf1 = lds_frag(QF, cq, 4 + g);
    const bf16x8 qb0 = lds_frag(QB, cq, g), qb1 = lds_frag(QB, cq, 4 + g);
    uint2 amo[4];
#pragma unroll
    for (int st = 0; st < 4; ++st) {
        f32x4 af = {0.f, 0.f, 0.f, 0.f}, ab = {0.f, 0.f, 0.f, 0.f};
        af = __builtin_amdgcn_mfma_f32_16x16x32_bf16(lds_frag(KF, 16 * st + i16, g), qf0, af, 0, 0, 0);
        af = __builtin_amdgcn_mfma_f32_16x16x32_bf16(lds_frag(KF, 16 * st + i16, 4 + g), qf1, af, 0, 0, 0);
        ab = __builtin_amdgcn_mfma_f32_16x16x32_bf16(lds_frag(KB, 16 * st + i16, g), qb0, ab, 0, 0, 0);
        ab = __builtin_amdgcn_mfma_f32_16x16x32_bf16(lds_frag(KB, 16 * st + i16, 4 + g), qb1, ab, 0, 0, 0);
        float am[4];
#pragma unroll
        for (int r = 0; r < 4; ++r) {
            const int s = 16 * st + 4 * g + r;
            am[r] = (s <= cq ? af[r] : 0.f) + (s >= cq ? ab[r] : 0.f);
        }
        amo[st].x = pack2(am[0], am[1]); amo[st].y = pack2(am[2], am[3]);
    }
#pragma unroll
    for (int st = 0; st < 4; ++st) { const int s0 = 16 * st + 4 * g; *(uint2*)(AM + tile_off(cq, s0 >> 3) + (s0 & 7) * 2) = amo[st]; }
    __syncthreads();
#pragma unroll
    for (int i = 0; i < 4; ++i) { const int j = t + 256 * i; *(u32x4*)(VT + (j >> 4) * 288 + (j & 15) * 16) = vr[i]; }
    __syncthreads();
    f32x4 oc[8];
#pragma unroll
    for (int et = 0; et < 8; ++et) oc[et] = (f32x4){0.f, 0.f, 0.f, 0.f};
#pragma unroll
    for (int ks = 0; ks < 2; ++ks) {
        const bf16x8 amf = lds_frag(AM, cq, ks * 4 + g);
        const bf16x8 qff = ks ? qf1 : qf0, qbf = ks ? qb1 : qb0;
        const int r0 = ks * 32 + 8 * g + (i16 >> 2);
#pragma unroll
        for (int et = 0; et < 8; ++et) {
            const int e0 = 16 * et + 4 * (i16 & 3);
            const bf16x8 vf = cat4(tr_read(VT + r0 * 288 + e0 * 2), tr_read(VT + (r0 + 4) * 288 + e0 * 2));
            oc[et] = __builtin_amdgcn_mfma_f32_16x16x32_bf16(vf, amf, oc[et], 0, 0, 0);
            oc[et] = __builtin_amdgcn_mfma_f32_16x16x32_bf16(lds_frag(SF, 16 * et + i16, ks * 4 + g), qff, oc[et], 0, 0, 0);
            oc[et] = __builtin_amdgcn_mfma_f32_16x16x32_bf16(lds_frag(SB, 16 * et + i16, ks * 4 + g), qbf, oc[et], 0, 0, 0);
        }
    }
    float ss = 0.f;
#pragma unroll
    for (int et = 0; et < 8; ++et)
#pragma unroll
        for (int r = 0; r < 4; ++r) ss += oc[et][r] * oc[et][r];
    ss += swz_xor<16>(ss); ss = half_sum(ss);
    const float rstd = rsqrtf(ss * (1.0f / 128.0f) + EPS);
    const size_t tok = (size_t)t0 + cq;
#pragma unroll
    for (int et = 0; et < 8; ++et) {
        const int e = 16 * et + 4 * g;
        const uint2 gg = *(const uint2*)(p.proj + tok * PJW + C_GO + h * 128 + e);
        const float4 ng = *(const float4*)(p.gla_ng + h * 128 + e);
        const float g0 = lo2f(gg.x), g1 = hi2f(gg.x), g2 = lo2f(gg.y), g3 = hi2f(gg.y);
        uint2 o;
        o.x = pack2(oc[et][0] * rstd * ng.x * (g0 / (1.0f + __expf(-g0))), oc[et][1] * rstd * ng.y * (g1 / (1.0f + __expf(-g1))));
        o.y = pack2(oc[et][2] * rstd * ng.z * (g2 / (1.0f + __expf(-g2))), oc[et][3] * rstd * ng.w * (g3 / (1.0f + __expf(-g3))));
        *(uint2*)(p.mix + tok * D + 512 + h * 128 + e) = o;
    }
}

constexpr int RT_RS = 1028;
constexpr int RT_XS = 0, RT_PART = 16 * RT_RS * 4, RT_PE = RT_PART + 4 * 16 * 32 * 4 + 512, RT_RANK = RT_PE + 1024, RT_HIST = RT_RANK + 1024, RT_BASE = RT_HIST + 128;
__device__ void ph_route(const Params& p, char* ldsall) {
    const int tid = tid_opaque(), t = tid & 255, half = tid >> 8, lane = t & 63, w = t >> 6;
    char* lds = ldsall + half * HALF_LDS;
    const int vb = blockIdx.x * 2 + half, nvb = gridDim.x * 2;
    float* xs = (float*)(lds + RT_XS); float* part = (float*)(lds + RT_PART);
    int* pe = (int*)(lds + RT_PE); int* rank = (int*)(lds + RT_RANK); int* hist = (int*)(lds + RT_HIST); int* base = (int*)(lds + RT_BASE);
    const int ngr = (T / 16 + nvb - 1) / nvb;
    for (int gl = 0; gl < ngr; ++gl) {
        const int gi = vb + gl * nvb;
        const bool live = gi < T / 16;
        const int tok0 = (live ? gi : 0) * 16;
        __syncthreads();
#pragma unroll
        for (int th = 0; th < 2; ++th) {
            f32x4 v[2][4];
#pragma unroll
            for (int tt = 0; tt < 2; ++tt) {
                const f32x4* xr = (const f32x4*)(p.x1 + (size_t)(tok0 + 4 * w + 2 * th + tt) * D);
#pragma unroll
                for (int i = 0; i < 4; ++i) v[tt][i] = xr[lane + 64 * i];
            }
#pragma unroll
            for (int tt = 0; tt < 2; ++tt) {
                const int tl = 4 * w + 2 * th + tt, tok = tok0 + tl;
                float ss = 0.f;
#pragma unroll
                for (int i = 0; i < 4; ++i) ss += v[tt][i][0] * v[tt][i][0] + v[tt][i][1] * v[tt][i][1] + v[tt][i][2] * v[tt][i][2] + v[tt][i][3] * v[tt][i][3];
                ss = wave_sum(ss);
                const float r = rsqrtf(ss * (1.0f / D) + EPS);
#pragma unroll
                for (int i = 0; i < 4; ++i) {
                    const f32x4 gq = ((const f32x4*)p.g2)[lane + 64 * i];
                    const f32x4 yv = v[tt][i] * r * gq;
                    *(f32x4*)(xs + tl * RT_RS + (lane + 64 * i) * 4) = yv;
                    if (live) { int pk = __builtin_amdgcn_cvt_pk_fp8_f32(yv[0], yv[1], 0, false); pk = __builtin_amdgcn_cvt_pk_fp8_f32(yv[2], yv[3], pk, true); *(int*)(p.xn28 + (size_t)tok * D + (lane + 64 * i) * 4) = pk; }
                }
            }
        }
        __syncthreads();
        {
            const int i16 = lane & 15, kq = lane >> 4;
            const float* xa = xs + i16 * RT_RS + 256 * w + 64 * kq;
            const float* rwp = p.rw + (size_t)(256 * w + 64 * kq) * 32 + i16;
            f32x4 a0 = {0.f, 0.f, 0.f, 0.f}, a1 = {0.f, 0.f, 0.f, 0.f};
            f32x4 bqA[8];
#define RT_LOADB(dst, b) do { _Pragma("unroll") for (int q = 0; q < 8; ++q) { \
                dst[q][0] = rwp[(size_t)((b) * 16 + 2 * q) * 32]; dst[q][1] = rwp[(size_t)((b) * 16 + 2 * q) * 32 + 16]; \
                dst[q][2] = rwp[(size_t)((b) * 16 + 2 * q + 1) * 32]; dst[q][3] = rwp[(size_t)((b) * 16 + 2 * q + 1) * 32 + 16]; } } while (0)
#define RT_MMA(src, b) do { _Pragma("unroll") for (int s4 = 0; s4 < 4; ++s4) { const float4 av = *(const float4*)(xa + 16 * (b) + 4 * s4); \
                a0 = __builtin_amdgcn_mfma_f32_16x16x4f32(av.x, src[2 * s4][0], a0, 0, 0, 0); a1 = __builtin_amdgcn_mfma_f32_16x16x4f32(av.x, src[2 * s4][1], a1, 0, 0, 0); \
                a0 = __builtin_amdgcn_mfma_f32_16x16x4f32(av.y, src[2 * s4][2], a0, 0, 0, 0); a1 = __builtin_amdgcn_mfma_f32_16x16x4f32(av.y, src[2 * s4][3], a1, 0, 0, 0); \
                a0 = __builtin_amdgcn_mfma_f32_16x16x4f32(av.z, src[2 * s4 + 1][0], a0, 0, 0, 0); a1 = __builtin_amdgcn_mfma_f32_16x16x4f32(av.z, src[2 * s4 + 1][1], a1, 0, 0, 0); \
                a0 = __builtin_amdgcn_mfma_f32_16x16x4f32(av.w, src[2 * s4 + 1][2], a0, 0, 0, 0); a1 = __builtin_amdgcn_mfma_f32_16x16x4f32(av.w, src[2 * s4 + 1][3], a1, 0, 0, 0); } } while (0)
#pragma unroll
            for (int b = 0; b < 4; ++b) {
                RT_LOADB(bqA, b);
                __builtin_amdgcn_sched_barrier(0);
                RT_MMA(bqA, b);
                __builtin_amdgcn_sched_barrier(0);
            }
#undef RT_LOADB
#undef RT_MMA
#pragma unroll
            for (int r = 0; r < 4; ++r) { part[(w * 16 + 4 * kq + r) * 32 + i16] = a0[r]; part[(w * 16 + 4 * kq + r) * 32 + 16 + i16] = a1[r]; }
        }
        __syncthreads();
#pragma unroll
        for (int ro = 0; ro < 2; ++ro) {
            const int tk = 4 * w + 2 * ro + (lane >> 5), e = lane & 31;
            float v = p.rb[e] + ((part[(0 * 16 + tk) * 32 + e] + part[(1 * 16 + tk) * 32 + e]) + (part[(2 * 16 + tk) * 32 + e] + part[(3 * 16 + tk) * 32 + e]));
            int rk = 0;
#pragma unroll
            for (int j = 0; j < 64; ++j) {
                const float bj = __builtin_bit_cast(float, __builtin_amdgcn_readlane(__builtin_bit_cast(int, v), j));
                if ((j >> 5) == (lane >> 5)) rk += (bj > v || (bj == v && (j & 31) < e)) ? 1 : 0;
            }
            float* selv = part + 2048 + (w * 2 + (lane >> 5)) * 8;
            if (rk < 4) { selv[rk] = v; selv[4 + rk] = __builtin_bit_cast(float, e); }
            __builtin_amdgcn_s_waitcnt(0xc07f);
            __builtin_amdgcn_wave_barrier();
            const float b0 = selv[0], b1 = selv[1], b2 = selv[2], b3 = selv[3];
            const float e1 = expf(b1 - b0), e2 = expf(b2 - b0), e3 = expf(b3 - b0);
            const float inv = 1.0f / (1.0f + e1 + e2 + e3);
            if (e < 4) {
                const int sel = __builtin_bit_cast(int, selv[4 + e]);
                const float gs = (e == 0) ? inv : (e == 1) ? e1 * inv : (e == 2) ? e2 * inv : e3 * inv;
                pe[gl * 64 + tk * 4 + e] = live ? (sel & 31) : -1;
                if (live) p.gate[(size_t)(tok0 + tk) * 4 + e] = gs;
            }
            __builtin_amdgcn_wave_barrier();
        }
    }
    __syncthreads();
    if (t < 32) hist[t] = 0;
    __syncthreads();
    for (int i = t; i < ngr * 64; i += 256) { const int e = pe[i]; if (e >= 0) rank[i] = atomicAdd(&hist[e], 1); }
    __syncthreads();
    if (t < 32) { const int c = hist[t]; base[t] = c ? atomicAdd(&p.counts[t], c) : 0; }
    __syncthreads();
    for (int i = t; i < ngr * 64; i += 256) {
        const int e = pe[i];
        if (e >= 0) { const int gl = i >> 6, gi = vb + gl * nvb; const int slot = (gi * 16 + ((i >> 2) & 15)) * 4 + (i & 3); p.lists[e * T + base[e] + rank[i]] = slot; }
    }
}

__device__ void ph_final(const Params& p) {
    const int tid = tid_opaque(), lane = tid & 63, gw = blockIdx.x * 8 + (tid >> 6), nw = gridDim.x * 8;
    for (int tok = gw; tok < T; tok += nw) {
        float v[2][8]; float ss = 0.f;
#pragma unroll
        for (int i = 0; i < 2; ++i) {
            const int c = lane * 8 + 512 * i;
            const float4 xa = *(const float4*)(p.x1 + (size_t)tok * D + c), xb = *(const float4*)(p.x1 + (size_t)tok * D + c + 4);
            v[i][0] = xa.x; v[i][1] = xa.y; v[i][2] = xa.z; v[i][3] = xa.w; v[i][4] = xb.x; v[i][5] = xb.y; v[i][6] = xb.z; v[i][7] = xb.w;
#pragma unroll
            for (int k = 0; k < 4; ++k) {
                const uint2 yy = *(const uint2*)((const unsigned char*)p.y + ((size_t)tok * 4 + k) * D + c);
                const fv2 y01 = __builtin_amdgcn_cvt_pk_f32_fp8((int)yy.x, false), y23 = __builtin_amdgcn_cvt_pk_f32_fp8((int)yy.x, true);
                const fv2 y45 = __builtin_amdgcn_cvt_pk_f32_fp8((int)yy.y, false), y67 = __builtin_amdgcn_cvt_pk_f32_fp8((int)yy.y, true);
                v[i][0] += y01[0] * 0.0625f; v[i][1] += y01[1] * 0.0625f; v[i][2] += y23[0] * 0.0625f; v[i][3] += y23[1] * 0.0625f;
                v[i][4] += y45[0] * 0.0625f; v[i][5] += y45[1] * 0.0625f; v[i][6] += y67[0] * 0.0625f; v[i][7] += y67[1] * 0.0625f;
            }
#pragma unroll
            for (int j = 0; j < 8; ++j) ss += v[i][j] * v[i][j];
        }
        ss = wave_sum(ss);
        const float r = rsqrtf(ss * (1.0f / D) + EPS);
#pragma unroll
        for (int i = 0; i < 2; ++i) {
            const int c = lane * 8 + 512 * i;
            const float4 ga = *(const float4*)(p.gf + c), gb = *(const float4*)(p.gf + c + 4);
            float4 oa, ob;
            oa.x = v[i][0] * r * ga.x; oa.y = v[i][1] * r * ga.y; oa.z = v[i][2] * r * ga.z; oa.w = v[i][3] * r * ga.w;
            ob.x = v[i][4] * r * gb.x; ob.y = v[i][5] * r * gb.y; ob.z = v[i][6] * r * gb.z; ob.w = v[i][7] * r * gb.w;
            *(float4*)(p.out + (size_t)tok * D + c) = oa; *(float4*)(p.out + (size_t)tok * D + c + 4) = ob;
        }
    }
}

#define XB_TMO      128
#define XB_XCNT(j)  (256  + 64 * (j))
#define XB_XSUB(j)  (1280 + 64 * (j))
#define XB_XGEN(j)  (2304 + 64 * (j))
#define XB_TOP      3328
#define XB_TOPGEN   3392
#define XCD_BAR_WORDS 3456
#define XB_SPIN_CAP (1u << 22)
__device__ __forceinline__ unsigned xb_ld(unsigned* p)              { return __hip_atomic_load(p, __ATOMIC_RELAXED, __HIP_MEMORY_SCOPE_AGENT); }
__device__ __forceinline__ unsigned xb_add(unsigned* p, unsigned v) { return __hip_atomic_fetch_add(p, v, __ATOMIC_RELAXED, __HIP_MEMORY_SCOPE_AGENT); }
__device__ __forceinline__ unsigned xb_xcc_id() { return (unsigned)__builtin_amdgcn_s_getreg((3 << 11) | 20) & 0xFu; }
#define XB_SPIN(cond, bar) do { unsigned _sp = 0; while (cond) { __builtin_amdgcn_s_sleep(1); \
    if ((++_sp & 255u) == 0u) { if (xb_ld(&(bar)[XB_TMO])) break; if (_sp > XB_SPIN_CAP) { atomicAdd(&(bar)[XB_TMO], 1u); break; } } } } while (0)
struct XcdBarrier { unsigned* bar; unsigned x; volatile LDS_AS unsigned* st; };
__device__ __forceinline__ XcdBarrier xcd_barrier_post(unsigned* bar, volatile LDS_AS unsigned* st) {
    XcdBarrier b; b.bar = bar; b.x = xb_xcc_id(); b.st = st;
    if (threadIdx.x == 0) (void)xb_add(&bar[XB_XCNT(b.x)], 1u);
    return b;
}
__device__ __forceinline__ void xcd_barrier_complete(unsigned* bar, unsigned x, unsigned& nloc, unsigned& nx) {
    const unsigned G = gridDim.x * gridDim.y * gridDim.z;
    unsigned sum, cnt, mine, sp = 0u;
    for (;;) {
        sum = 0u; cnt = 0u; mine = 0u;
#pragma unroll
        for (unsigned j = 0; j < 16; ++j) { const unsigned c = xb_ld(&bar[XB_XCNT(j)]); sum += c; cnt += (c > 0u) ? 1u : 0u; mine = (j == x) ? c : mine; }
        if (sum == G) break;
        __builtin_amdgcn_s_sleep(1);
        if ((++sp & 255u) == 0u) { if (xb_ld(&bar[XB_TMO])) break; if (sp > XB_SPIN_CAP) { atomicAdd(&bar[XB_TMO], 1u); break; } }
    }
    nloc = mine > 0u ? mine : 1u; nx = cnt > 0u ? cnt : 1u;
}
__device__ __forceinline__ void xcd_barrier(const XcdBarrier& b) {
    asm volatile("s_waitcnt vmcnt(0)" ::: "memory");
    __syncthreads();
    if (threadIdx.x == 0) {
        unsigned* bar = b.bar;
        __builtin_amdgcn_s_waitcnt(0);
        unsigned nloc = b.st[0], nx = b.st[1];
        if (nloc == 0u) { xcd_barrier_complete(bar, b.x, nloc, nx); b.st[0] = nloc; b.st[1] = nx; }
        const unsigned old = xb_add(&bar[XB_XSUB(b.x)], 1u);
        const unsigned gen = old / nloc;
        if (old + 1u == (gen + 1u) * nloc) {
            __builtin_amdgcn_fence(__ATOMIC_RELEASE, "agent");
            asm volatile("s_waitcnt vmcnt(0)" ::: "memory");
            const unsigned og = xb_add(&bar[XB_TOP], 1u);
            const unsigned tg = og / nx;
            if (og + 1u == (tg + 1u) * nx) xb_add(&bar[XB_TOPGEN], 1u);
            else XB_SPIN(xb_ld(&bar[XB_TOPGEN]) == tg, bar);
            __builtin_amdgcn_fence(__ATOMIC_ACQUIRE, "agent");
            xb_add(&bar[XB_XGEN(b.x)], 1u);
            asm volatile("s_waitcnt vmcnt(0)" ::: "memory");
        } else {
            XB_SPIN(xb_ld(&bar[XB_XGEN(b.x)]) == gen, bar);
            __builtin_amdgcn_fence(__ATOMIC_ACQUIRE, "agent");
            asm volatile("s_waitcnt vmcnt(0)" ::: "memory");
        }
    }
    __syncthreads();
}


#if defined(FLUSHMASK)
__device__ void ph_flush(const Params& p) {
    const int tid = tid_opaque();
    const float4* src = (const float4*)p.w1;
    float acc = 0.f;
    for (size_t i = (size_t)blockIdx.x * 512 + tid; i < (size_t)NE * D * 2 * DFF / 4; i += (size_t)gridDim.x * 512) { const float4 v = src[i]; acc += v.x + v.y + v.z + v.w; }
    if (acc == 123.456f) p.out[0] = acc;
}
#endif
enum { PH_PRO = 0, PH_PROJ, PH_MIX1, PH_MIX2, PH_MIX3, PH_OUTPROJ, PH_ROUTE, PH_MOE1, PH_MOE2, PH_FINAL, PH_END };
constexpr int N_GLA_ITEMS = B * GH * 64, N_ATT_ITEMS = B * AH * 3 * 64;
constexpr int MO_META = LDS_BYTES - 1024;

__device__ __forceinline__ void moe_meta(const Params& p, int* meta) {
    __syncthreads();
    if (threadIdx.x == 0) {
        int mp = 0, rbse = 0;
        for (int e = 0; e < NE; ++e) {
            const int c = p.counts[e];
            meta[e] = c; meta[32 + e] = mp; meta[72 + e] = rbse;
            mp += (c + 255) >> 8; rbse += c;
        }
        meta[32 + NE] = mp; meta[72 + NE] = rbse;
    }
    __syncthreads();
}

constexpr int MO_TABA = 128 * 1024, MO_MAXU = 12;
template <class SchedT>
__device__ __forceinline__ void moe_tables(const Params& p, char* lds, const SchedT& S) {
    unsigned* tabA = (unsigned*)(lds + MO_TABA);
    const int tid = tid_opaque(), r = tid & 255;
    for (int i = tid >> 8; i < MO_MAXU; i += 2) {
        pg::Unit u;
        if (!S.next(i, u)) break;
        const int slot = p.lists[u.e * T + (u.row0 - S.meta[72 + u.e]) + min(r, u.nvalid - 1)];
        tabA[i * 256 + r] = (unsigned)(slot >> 2) * (unsigned)S.rowb;
    }
    __syncthreads();
}

typedef const __attribute__((address_space(4))) Params* KParams;
#if defined(__HIP_DEVICE_COMPILE__)
#define PHASE_PARAMS() KParams _kq = kp; asm volatile("" : "+s"(_kq)); const Params p = *_kq
#define KP_INIT() KParams kp = (KParams)__builtin_amdgcn_kernarg_segment_ptr(); const int ph_lo = kp->ph_lo, ph_hi = kp->ph_hi; unsigned* const barw = kp->bar
#else
#define PHASE_PARAMS() const Params p = p_unused
#define KP_INIT() const int ph_lo = p_unused.ph_lo, ph_hi = p_unused.ph_hi; unsigned* const barw = p_unused.bar
#endif
__global__ void __launch_bounds__(512, 2) mega(Params p_unused) {
    extern __shared__ __attribute__((aligned(16))) char lds[];
    KP_INIT();
    cg::grid_group grid = cg::this_grid();
    volatile LDS_AS unsigned* xst = (volatile LDS_AS unsigned*)(lds + LDS_BYTES - 16);
    if (threadIdx.x == 0) { xst[0] = 0u; xst[1] = 0u; }
    __syncthreads();
    const XcdBarrier xb = xcd_barrier_post(barw, xst);
    if (ph_hi > PH_END) grid.sync();
    for (int ph = ph_lo; ph < ph_hi; ++ph) {
      const int nrep = ((REPMASK >> ph) & 1) ? 2 : 1;
      for (int rep = 0; rep < nrep; ++rep) {
        if (rep) xcd_barrier(xb);
#if defined(ROUTE2)
        if (rep && ph == PH_ROUTE) { PHASE_PARAMS(); if (blockIdx.x == 0 && threadIdx.x < 32) p.counts[threadIdx.x] = 0; xcd_barrier(xb); }
#endif
#if defined(FLUSHMASK)
        if (rep && ((FLUSHMASK >> ph) & 1)) { PHASE_PARAMS(); ph_flush(p); xcd_barrier(xb); }
#if defined(FLUSHONLY)
        if (rep && ((FLUSHMASK >> ph) & 1)) continue;
#endif
#endif
        switch (ph) {
        case PH_PRO: { PHASE_PARAMS(); ph_prologue(p); } break;
        case PH_PROJ: {
            PHASE_PARAMS();
            const int G = gridDim.x, ng = G - NCONV;
            if ((int)blockIdx.x < ng) {
                pg::DenseSched S; S.init(p.xn, p.winT, T, PJW, ng, blockIdx.x);
                pg::EpiProj E{p.proj};
                pg::gemm_phase((LDS_AS unsigned char*)lds, S, E);
            } else {
                const int tid = tid_opaque(), t = tid & 255, st = NCONV * 2;
                const int l = t & 63, w = t >> 6, kg = l & 7, ngq = w * 8 + (l >> 3);
#define CV_DECL(X) f32x4 X##0 = {0.f, 0.f, 0.f, 0.f}, X##1 = X##0, X##2 = X##0, X##3 = X##0, X##4 = X##0, X##5 = X##0, X##6 = X##0, X##7 = X##0
#define CV_LOAD(X, i_) do { const int e_ = (i_) >> 8, j_ = (i_) & 255; const float* s_ = p.w1 + (size_t)e_ * D * 2 * DFF + (size_t)((j_ >> 4) * 64 + 8 * kg) * (2 * DFF) + (j_ & 15) * 128 + 4 * ngq; \
        X##0 = *(const f32x4*)(s_); X##1 = *(const f32x4*)(s_ + 2 * DFF); X##2 = *(const f32x4*)(s_ + 2 * 2 * DFF); X##3 = *(const f32x4*)(s_ + 3 * 2 * DFF); \
        X##4 = *(const f32x4*)(s_ + 4 * 2 * DFF); X##5 = *(const f32x4*)(s_ + 5 * 2 * DFF); X##6 = *(const f32x4*)(s_ + 6 * 2 * DFF); X##7 = *(const f32x4*)(s_ + 7 * 2 * DFF); } while (0)
#define CV_STORE(X, i_) do { const int e_ = (i_) >> 8, j_ = (i_) & 255; unsigned char* d_ = p.w1T8 + (size_t)e_ * 2 * DFF * D + (size_t)((j_ & 15) * 128 + 4 * ngq) * 1024 + (j_ >> 4) * 64 + 8 * kg; \
        _Pragma("unroll") for (int c_ = 0; c_ < 4; ++c_) { \
            int lo_ = __builtin_amdgcn_cvt_pk_fp8_f32(X##0[c_] * 32.0f, X##1[c_] * 32.0f, 0, false); lo_ = __builtin_amdgcn_cvt_pk_fp8_f32(X##2[c_] * 32.0f, X##3[c_] * 32.0f, lo_, true); \
            int hi_ = __builtin_amdgcn_cvt_pk_fp8_f32(X##4[c_] * 32.0f, X##5[c_] * 32.0f, 0, false); hi_ = __builtin_amdgcn_cvt_pk_fp8_f32(X##6[c_] * 32.0f, X##7[c_] * 32.0f, hi_, true); \
            uint2 q_; q_.x = (unsigned)lo_; q_.y = (unsigned)hi_; *(uint2*)(d_ + c_ * 1024) = q_; } } while (0)
                CV_DECL(ra); CV_DECL(rb);
                const int hid = ((int)blockIdx.x - ng) * 2 + (tid >> 8), per = (W1_CONV + st - 1) / st;
                const int i0 = min(hid * per, W1_CONV - 1), ilast = min(i0 + per, W1_CONV) - 1;
                const int npair = (per + 1) / 2;
                CV_LOAD(ra, i0);
                for (int k = 0; k < npair; ++k) {
                    const int ia = min(i0 + 2 * k, ilast), ib = min(ia + 1, ilast), ic = min(ib + 1, ilast);
                    CV_LOAD(rb, ib);
                    CV_STORE(ra, ia);
                    CV_LOAD(ra, ic);
                    CV_STORE(rb, ib);
                }
#undef CV_DECL
#undef CV_LOAD
#undef CV_STORE
            }
            {
                const int tid2 = tid_opaque(), lane = tid2 & 63, i16 = lane & 15, g = lane >> 4;
                for (int task = (G - 1 - (int)blockIdx.x) * 8 + (tid2 >> 6); task < T / 16; task += G * 8) {
                    f32x4 z0 = {0.f, 0.f, 0.f, 0.f}, z1 = {0.f, 0.f, 0.f, 0.f};
                    const u16* ar = p.xn + (size_t)(task * 16 + i16) * D + 8 * g;
                    const u16* w0 = p.wzT + (size_t)i16 * D + 8 * g;
                    const u16* w1 = w0 + 16 * D;
#pragma unroll 8
                    for (int ks = 0; ks < 32; ++ks) {
                        const bf16x8 a = *(const bf16x8*)(ar + ks * 32);
                        z0 = __builtin_amdgcn_mfma_f32_16x16x32_bf16(a, *(const bf16x8*)(w0 + ks * 32), z0, 0, 0, 0);
                        z1 = __builtin_amdgcn_mfma_f32_16x16x32_bf16(a, *(const bf16x8*)(w1 + ks * 32), z1, 0, 0, 0);
                    }
#pragma unroll
                    for (int r = 0; r < 4; ++r) {
                        const size_t row = (size_t)task * 16 + 4 * g + r;
                        p.zbuf[row * 32 + i16] = z0[r]; p.zbuf[row * 32 + 16 + i16] = z1[r];
                    }
                }
            }
        } break;
        case PH_MIX1: {
            PHASE_PARAMS();
            const int tid = tid_opaque(), t = tid & 255, half = tid >> 8;
            char* hl = lds + half * HALF_LDS;
#ifndef MIX1_SKIP_GLA_ON_REP
            for (int it0 = blockIdx.x * 2; it0 < N_GLA_ITEMS; it0 += gridDim.x * 2) gla_ds_item(p, hl, t, min(it0 + half, N_GLA_ITEMS - 1));
#else
            if (!rep) for (int it0 = blockIdx.x * 2; it0 < N_GLA_ITEMS; it0 += gridDim.x * 2) gla_ds_item(p, hl, t, min(it0 + half, N_GLA_ITEMS - 1));
#endif
            {
                AttnRegs AR;
                attn_load(p, t, min((int)blockIdx.x * 2 + half, N_ATT_ITEMS - 1), AR);
                for (int it0 = blockIdx.x * 2; it0 < N_ATT_ITEMS; it0 += gridDim.x * 2) {
                    const int nx0 = it0 + gridDim.x * 2;
                    attn_item(p, hl, t, min(it0 + half, N_ATT_ITEMS - 1), nx0 < N_ATT_ITEMS ? min(nx0 + half, N_ATT_ITEMS - 1) : -1, AR);
                }
            }
        } break;
        case PH_MIX2: {
            PHASE_PARAMS();
            const int tid = tid_opaque();
            for (int gid = blockIdx.x * 512 + tid; gid < (1 << 17); gid += gridDim.x * 512) gla_scan_thread2(p, gid);
            for (int gid = blockIdx.x * 512 + tid; gid < T * 64; gid += gridDim.x * 512) attn_combine_thread(p, gid);
        } break;
        case PH_MIX3: {
            PHASE_PARAMS();
            const int tid = tid_opaque(), t = tid & 255, half = tid >> 8;
            char* hl = lds + half * HALF_LDS;
            for (int it0 = blockIdx.x * 2; it0 < N_GLA_ITEMS; it0 += gridDim.x * 2) gla_out_item(p, hl, t, min(it0 + half, N_GLA_ITEMS - 1));
        } break;
        case PH_OUTPROJ: {
            PHASE_PARAMS();
            pg::DenseSched S; S.init(p.mix, p.woT, T, D, gridDim.x, blockIdx.x);
            pg::EpiOut E{p.x, p.x1};
            pg::gemm_phase((LDS_AS unsigned char*)lds, S, E);
        } break;
        case PH_ROUTE: { PHASE_PARAMS(); ph_route(p, lds); } break;
        case PH_MOE1: {
            PHASE_PARAMS();
            int* meta = (int*)(lds + MO_META);
            moe_meta(p, meta);
            pg::MoeSchedT<true> S{(const u16*)p.xn28, (const u16*)p.w1T8, p.lists, (const LDS_AS int*)meta, 8, meta[32 + NE] * 8, (int)gridDim.x, (int)blockIdx.x, 1024, (const LDS_AS unsigned*)(lds + MO_TABA)};
            moe_tables(p, lds, S);
            pg::EpiMoe1 E{p.b1, p.act8};
            pg::gemm_phase<pg::EpiMoe1, pg::MoeSchedT<true>, true>((LDS_AS unsigned char*)lds, S, E);
            {
                const int G = gridDim.x, nun = S.nunits, r = nun % G, nshort = r ? G - r : G, sidx = r ? (int)blockIdx.x - r : (int)blockIdx.x;
                if (sidx >= 0) {
                    const int tid = tid_opaque(), t = tid & 255, hv = tid >> 8;
                    const int per = (W2_LATE + nshort * 2 - 1) / (nshort * 2), ib = (sidx * 2 + hv) * per;
                    for (int i = ib; i < min(ib + per, W2_LATE); ++i) { const int e = i >> 7, j = i & 127; cvt_tile8(p.w2 + (size_t)e * DFF * D, D, p.w2T8 + (size_t)e * D * DFF, (j >> 3) * 64, (j & 7) * 128, t); }
                }
            }
        } break;
        case PH_MOE2: {
            PHASE_PARAMS();
            int* meta = (int*)(lds + MO_META);
            moe_meta(p, meta);
            pg::MoeSchedT<false> S{(const u16*)p.act8, (const u16*)p.w2T8, p.lists, (const LDS_AS int*)meta, 4, meta[32 + NE] * 4, (int)gridDim.x, (int)blockIdx.x, 1024, nullptr};
            pg::EpiMoe2 E{p.b2, p.gate, p.lists, (const LDS_AS int*)meta, p.y};
            pg::gemm_phase<pg::EpiMoe2, pg::MoeSchedT<false>, true>((LDS_AS unsigned char*)lds, S, E);
        } break;
        case PH_FINAL: { PHASE_PARAMS(); ph_final(p); } break;
        default: break;
        }
      }
#ifdef EXTRA_BAR
        if (ph == PH_MIX2) { for (int q = 0; q < EXTRA_BAR; ++q) xcd_barrier(xb); }
#endif
        if (ph + 1 < ph_hi) xcd_barrier(xb);
    }
}

#ifndef STAGE
#define STAGE 6
#endif

__global__ void __launch_bounds__(256) cvt_bf16_f32(const u16* __restrict__ src, int lds_, float* __restrict__ dst, int ldd, int rows, int cols) {
    const size_t n = (size_t)rows * cols;
    for (size_t i = (size_t)blockIdx.x * 256 + threadIdx.x; i < n; i += (size_t)gridDim.x * 256) {
        const size_t r = i / cols, c = i % cols;
        dst[r * ldd + c] = bf2f(src[r * lds_ + c]);
    }
}

#include <cstdio>
extern "C" void kernel_launch(void* const* d_in, const int* in_sizes, int n_in, void* d_out, int out_size, void* d_ws, size_t ws_size, hipStream_t stream) {
    const float* x = (const float*)d_in[0];
    const float* norm1_g = (const float*)d_in[1];
    const float* w_in = (const float*)d_in[2];
    const float* rel_bias = (const float*)d_in[3];
    const float* wgf = (const float*)d_in[4];
    const float* bgf = (const float*)d_in[5];
    const float* wgb = (const float*)d_in[6];
    const float* bgb = (const float*)d_in[7];
    const float* gla_ng = (const float*)d_in[8];
    const float* w_out = (const float*)d_in[9];
    const float* norm2_g = (const float*)d_in[10];
    const float* router_w = (const float*)d_in[11];
    const float* router_b = (const float*)d_in[12];
    const float* w1 = (const float*)d_in[13];
    const float* b1 = (const float*)d_in[14];
    const float* w2 = (const float*)d_in[15];
    const float* b2 = (const float*)d_in[16];
    const float* final_g = (const float*)d_in[17];
    float* out = (float*)d_out;

    static int grid_blocks = 0;
    if (!grid_blocks) {
        int dev = 0, cus = 0, per_cu = 0;
        hipGetDevice(&dev);
        hipDeviceGetAttribute(&cus, hipDeviceAttributeMultiprocessorCount, dev);
        hipFuncSetAttribute((const void*)mega, hipFuncAttributeMaxDynamicSharedMemorySize, LDS_BYTES);
        hipOccupancyMaxActiveBlocksPerMultiprocessor(&per_cu, mega, 512, LDS_BYTES);
        if (per_cu > 1) per_cu = 1;
        if (per_cu < 1) per_cu = 1;
        grid_blocks = cus * per_cu;
    }

    char* ws = (char*)d_ws;
    size_t off = 0;
    auto take = [&](size_t bytes) { char* p = ws + off; off += (bytes + 255) & ~(size_t)255; return p; };
    Params p{};
    p.x = x; p.g1 = norm1_g; p.w_in = w_in; p.rel_bias = rel_bias; p.wgf = wgf; p.bgf = bgf; p.wgb = wgb; p.bgb = bgb; p.gla_ng = gla_ng;
    p.w_out = w_out; p.g2 = norm2_g; p.rw = router_w; p.rb = router_b; p.w1 = w1; p.b1 = b1; p.w2 = w2; p.b2 = b2; p.gf = final_g; p.out = out;
    p.winT = (u16*)take((size_t)PJW * D * 2);
    p.wzT = (u16*)take((size_t)32 * D * 2);
    p.woT = (u16*)take((size_t)D * D * 2);
    p.w1T = (u16*)take((size_t)NE * 2 * DFF * D * 2); p.w1T8 = (unsigned char*)p.w1T;
    p.w2T = (u16*)take((size_t)NE * D * DFF * 2); p.w2T8 = (unsigned char*)p.w2T;
    p.zbuf = (float*)take((size_t)T * 32 * 4);
    p.lse = (float*)take((size_t)3 * T * 8 * 4);
    p.dec = (float*)take((size_t)B * GH * 64 * 2 * 64 * 4);
    p.x1 = (float*)take((size_t)T * D * 4);
    p.counts = (int*)take(256);
    p.lists = (int*)take((size_t)NE * T * 4);
    p.gate = (float*)take((size_t)NSLOT * 4);
    p.bar = (unsigned*)take((size_t)XCD_BAR_WORDS * 4);
    p.xn = (u16*)take((size_t)T * D * 2); p.xn2 = p.xn; p.xn28 = (unsigned char*)p.xn;
    { char* ra = take((size_t)T * PJW * 2 + (size_t)3 * T * 512 * 2);
      p.proj = (u16*)ra; p.abr = (u16*)(ra + (size_t)T * PJW * 2); p.act = (u16*)ra; p.act8 = (unsigned char*)ra; }
    { char* rb = take((size_t)B * GH * 64 * 2 * 128 * 64 * 4 + (size_t)B * GH * 64 * 2 * 128 * 64 * 2 + (size_t)T * D * 2);
      p.dS = (float*)rb; p.Sp = (u16*)(rb + (size_t)B * GH * 64 * 2 * 128 * 64 * 4); p.mix = (u16*)(rb + (size_t)B * GH * 64 * 2 * 128 * 64 * 4 + (size_t)B * GH * 64 * 2 * 128 * 64 * 2); p.y = (u16*)rb; }
    const size_t off_shared = off;

    auto run_fast = [&](int lo, int hi) {
        (void)hipMemsetAsync(p.bar, 0, (size_t)XCD_BAR_WORDS * 4, stream);
        p.ph_lo = lo; p.ph_hi = hi;
        void* args[] = {&p};
        hipError_t e = hipLaunchCooperativeKernel((const void*)mega, dim3(grid_blocks), dim3(512), args, LDS_BYTES, stream);
        if (e != hipSuccess) fprintf(stderr, "cooperative launch failed: %s (grid %d)\n", hipGetErrorString(e), grid_blocks);
    };

#if STAGE >= 6
    run_fast(PH_PRO, PH_END);
#else
    off = off_shared;
    float* n_xn = (float*)take((size_t)T * D * 4);
    float* n_x2 = (float*)take((size_t)T * D * 4);
    float* n_mix = (float*)take((size_t)T * D * 4);
    int* n_topi = (int*)take((size_t)T * 4 * 4);
    float* n_hact = (float*)take((size_t)T * DFF * 4);
    float* n_x1 = p.x1;
    int* n_lists = p.lists; int* n_counts = p.counts; float* n_gate = p.gate;
#if STAGE == 3
    run_fast(PH_PRO, PH_MIX3 + 1);
#elif STAGE == 4
    run_fast(PH_PRO, PH_OUTPROJ + 1);
#elif STAGE == 5
    run_fast(PH_PRO, PH_ROUTE + 1);
#else
#error "hybrid STAGE must be 3, 4 or 5"
#endif
#if STAGE == 3
    cvt_bf16_f32<<<2048, 256, 0, stream>>>(p.mix, D, n_mix, D, T, D);
#endif
#if STAGE <= 3
    nv_gemm<EPI_RESID><<<dim3(D / 64, T / 64), 256, 0, stream>>>(n_mix, D, nullptr, 0, nullptr, T, w_out, D, D, D, n_x1, D, x, nullptr);
#endif
#if STAGE <= 4
    nv_route<<<T / 4, 256, 0, stream>>>(n_x1, norm2_g, router_w, router_b, n_xn, n_topi, n_gate);
    nv_lists<<<1, 32, 0, stream>>>(n_topi, n_lists, n_counts);
#endif
#if STAGE == 5
    cvt_bf16_f32<<<2048, 256, 0, stream>>>(p.xn2, D, n_xn, D, T, D);
#endif
    (void)hipMemcpyAsync(n_x2, n_x1, (size_t)T * D * 4, hipMemcpyDeviceToDevice, stream);
    for (int e = 0; e < NE; ++e) {
        nv_gemm<EPI_SWIGLU><<<dim3(2 * DFF / 64, T / 64), 256, 0, stream>>>(n_xn, D, n_lists + (size_t)e * T, 2, n_counts + e, 0,
                                                                          w1 + (size_t)e * D * 2 * DFF, 2 * DFF, 2 * DFF, D, n_hact, DFF, b1 + (size_t)e * 2 * DFF, nullptr);
        nv_moe2<<<dim3(D / 64, T / 64), 256, 0, stream>>>(n_hact, n_lists + (size_t)e * T, n_counts + e, w2 + (size_t)e * DFF * D, n_x2, b2 + (size_t)e * D, n_gate);
    }
    nv_rmsnorm<<<T / 4, 256, 0, stream>>>(n_x2, final_g, out, T);
#endif
}
```

```cpp
#define STAGE 6
#define REPMASK 0
#include <hip/hip_runtime.h>
#include <stdint.h>

namespace cfg {
constexpr int D = 1024, B = 4, S = 4096, T = B * S;
constexpr int AH = 8;
constexpr int GH = 4;
constexpr int INW = 3104;
constexpr int C_AQ = 0, C_AK = 512, C_AV = 1024, C_GQ = 1536, C_GK = 1792, C_GV = 2048, C_GO = 2560, C_GZ = 3072;
constexpr int NE = 32, DFF = 1024;
constexpr float EPS = 1e-5f;
}
using namespace cfg;

__device__ const unsigned char T5TAB[387] = {
11,11,11,11,11,11,11,11,11,11,11,11,11,11,11,10,10,10,10,10,10,10,10,10,10,10,10,10,10,10,10,10,10,10,10,10,10,10,9,9,9,9,9,9,9,9,9,9,9,9,8,8,8,8,8,8,8,7,6,5,4,3,2,1,0,17,18,19,20,21,22,23,24,24,24,24,24,24,24,25,25,25,25,25,25,25,25,25,25,25,25,26,26,26,26,26,26,26,26,26,26,26,26,26,26,26,26,26,26,26,26,26,26,26,27,27,27,27,27,27,27,27,27,27,27,27,27,27,27,
13,13,13,13,13,13,13,13,13,13,13,13,13,13,13,13,13,13,13,13,13,13,13,12,12,12,12,12,12,12,12,12,12,12,12,12,12,12,12,12,12,12,11,11,11,11,11,11,11,11,11,11,10,10,10,10,10,10,9,9,9,8,8,4,0,20,24,24,25,25,25,26,26,26,26,26,26,27,27,27,27,27,27,27,27,27,27,28,28,28,28,28,28,28,28,28,28,28,28,28,28,28,28,28,28,28,29,29,29,29,29,29,29,29,29,29,29,29,29,29,29,29,29,29,29,29,29,29,29,
15,15,15,15,15,15,15,15,15,15,15,15,15,15,15,15,15,15,15,15,15,15,15,15,15,15,15,15,15,15,14,14,14,14,14,14,14,14,14,14,14,14,14,14,14,13,13,13,13,13,13,13,13,13,12,12,12,12,12,11,11,10,10,9,0,25,26,26,27,27,28,28,28,28,28,29,29,29,29,29,29,29,29,29,30,30,30,30,30,30,30,30,30,30,30,30,30,30,30,31,31,31,31,31,31,31,31,31,31,31,31,31,31,31,31,31,31,31,31,31,31,31,31,31,31,31,31,31,31};

template <int MASK> __device__ __forceinline__ float swz_xor(float v) { return __builtin_bit_cast(float, __builtin_amdgcn_ds_swizzle(__builtin_bit_cast(int, v), (MASK << 10) | 0x1F)); }
__device__ __forceinline__ float half_sum(float v) {
    const auto r = __builtin_amdgcn_permlane32_swap(__builtin_bit_cast(unsigned, v), __builtin_bit_cast(unsigned, v), false, false);
    return __builtin_bit_cast(float, (unsigned)r[0]) + __builtin_bit_cast(float, (unsigned)r[1]);
}
__device__ __forceinline__ float half_max(float v) {
    const auto r = __builtin_amdgcn_permlane32_swap(__builtin_bit_cast(unsigned, v), __builtin_bit_cast(unsigned, v), false, false);
    return fmaxf(__builtin_bit_cast(float, (unsigned)r[0]), __builtin_bit_cast(float, (unsigned)r[1]));
}
__device__ __forceinline__ float wave_sum(float v) {
    v += swz_xor<1>(v); v += swz_xor<2>(v); v += swz_xor<4>(v); v += swz_xor<8>(v); v += swz_xor<16>(v);
    return half_sum(v);
}
__global__ void __launch_bounds__(256) nv_rmsnorm(const float* __restrict__ x, const float* __restrict__ g, float* __restrict__ y, int rows) {
    int row = blockIdx.x * 4 + (threadIdx.x >> 6), lane = threadIdx.x & 63;
    if (row >= rows) return;
    const float* xr = x + (size_t)row * D;
    float v[16]; float ss = 0.f;
#pragma unroll
    for (int i = 0; i < 16; ++i) { v[i] = xr[lane + 64 * i]; ss += v[i] * v[i]; }
    ss = wave_sum(ss);
    float r = rsqrtf(ss * (1.0f / D) + EPS);
#pragma unroll
    for (int i = 0; i < 16; ++i) y[(size_t)row * D + lane + 64 * i] = v[i] * r * g[lane + 64 * i];
}

enum { EPI_STORE = 0, EPI_RESID = 1, EPI_SWIGLU = 2 };
template <int EPI>
__global__ void __launch_bounds__(256) nv_gemm(const float* __restrict__ A, int lda, const int* __restrict__ rowmap, int rshift,
                                               const int* __restrict__ Mptr, int Mfix,
                                               const float* __restrict__ Bm, int ldb, int N, int K,
                                               float* __restrict__ C, int ldc,
                                               const float* __restrict__ aux1, const float* __restrict__ aux2) {
    __shared__ float As[16][68];
    __shared__ float Bs[16][64];
    const int M = Mptr ? *Mptr : Mfix;
    const int m0 = blockIdx.y * 64, n0 = blockIdx.x * 64;
    if (m0 >= M) return;
    const int tid = threadIdx.x, tx = tid & 15, ty = tid >> 4;
    float acc[4][4];
#pragma unroll
    for (int i = 0; i < 4; ++i)
#pragma unroll
        for (int j = 0; j < 4; ++j) acc[i][j] = 0.f;
    const int ar = tid >> 2, ak = (tid & 3) * 4;
    const int arow = m0 + ar; const bool av = arow < M;
    const int srcrow = av ? (rowmap ? (rowmap[arow] >> rshift) : arow) : 0;
    const float* ap = A + (size_t)srcrow * lda + ak;
    const int bk = tid >> 4, bn = (tid & 15) * 4;
    const bool bv = (n0 + bn) < N;
    for (int k0 = 0; k0 < K; k0 += 16) {
        float4 a4 = av ? *(const float4*)(ap + k0) : make_float4(0.f, 0.f, 0.f, 0.f);
        float4 b4 = bv ? *(const float4*)(Bm + (size_t)(k0 + bk) * ldb + n0 + bn) : make_float4(0.f, 0.f, 0.f, 0.f);
        As[ak + 0][ar] = a4.x; As[ak + 1][ar] = a4.y; As[ak + 2][ar] = a4.z; As[ak + 3][ar] = a4.w;
        *(float4*)&Bs[bk][bn] = b4;
        __syncthreads();
#pragma unroll
        for (int kk = 0; kk < 16; ++kk) {
            float4 a = *(const float4*)&As[kk][ty * 4];
            float4 b = *(const float4*)&Bs[kk][tx * 4];
            float aa[4] = {a.x, a.y, a.z, a.w}, bb[4] = {b.x, b.y, b.z, b.w};
#pragma unroll
            for (int i = 0; i < 4; ++i)
#pragma unroll
                for (int j = 0; j < 4; ++j) acc[i][j] = fmaf(aa[i], bb[j], acc[i][j]);
        }
        __syncthreads();
    }
#pragma unroll
    for (int i = 0; i < 4; ++i) {
        const int row = m0 + ty * 4 + i;
        if (row >= M) continue;
        const int col = n0 + tx * 4;
        if (col >= N) continue;
        if (EPI == EPI_STORE) {
#pragma unroll
            for (int j = 0; j < 4; ++j) C[(size_t)row * ldc + col + j] = acc[i][j];
        } else if (EPI == EPI_RESID) {
#pragma unroll
            for (int j = 0; j < 4; ++j) C[(size_t)row * ldc + col + j] = aux1[(size_t)row * ldc + col + j] + acc[i][j];
        } else if (EPI == EPI_SWIGLU) {
#pragma unroll
            for (int j = 0; j < 4; j += 2) {
                float glu = acc[i][j] + aux1[col + j], lin = acc[i][j + 1] + aux1[col + j + 1];
                glu = fminf(glu, 7.0f); lin = fminf(fmaxf(lin, -7.0f), 7.0f);
                float sg = 1.0f / (1.0f + expf(-1.702f * glu));
                C[(size_t)row * ldc + (col + j) / 2] = glu * sg * (lin + 1.0f);
            }
        }
    }
}

__global__ void __launch_bounds__(256) nv_attn(const float* __restrict__ proj, const float* __restrict__ rel_bias, float* __restrict__ mix) {
    const int wid = blockIdx.x * 4 + (threadIdx.x >> 6), lane = threadIdx.x & 63;
    const int h = wid & 7, tok = wid >> 3, b = tok / S, pos = tok % S;
    const float q = proj[(size_t)tok * INW + C_AQ + h * 64 + lane];
    float outs[3], lses[3];
#pragma unroll
    for (int br = 0; br < 3; ++br) {
        const int dil = (br == 0) ? 1 : (br == 1 ? 4 : 16);
        float m = -3.0e38f, l = 0.f, o = 0.f;
        for (int j = -64; j <= 64; ++j) {
            const int kp = pos + j * dil;
            if (kp < 0 || kp >= S) continue;
            const size_t kr = (size_t)(b * S + kp) * INW;
            float d = wave_sum(q * proj[kr + C_AK + h * 64 + lane]);
            float logit = d * 0.125f + rel_bias[T5TAB[br * 129 + j + 64] * AH + h];
            float mn = fmaxf(m, logit);
            float sc = expf(m - mn), p = expf(logit - mn);
            l = l * sc + p; o = o * sc + p * proj[kr + C_AV + h * 64 + lane];
            m = mn;
        }
        outs[br] = o / l; lses[br] = m + logf(l);
    }
    float mm = fmaxf(lses[0], fmaxf(lses[1], lses[2]));
    float w0 = expf(lses[0] - mm), w1 = expf(lses[1] - mm), w2 = expf(lses[2] - mm);
    float ws = w0 + w1 + w2;
    mix[(size_t)tok * D + h * 64 + lane] = (w0 * outs[0] + w1 * outs[1] + w2 * outs[2]) / ws;
}

__global__ void __launch_bounds__(256) nv_la(const float* __restrict__ proj, const float* __restrict__ wgf, const float* __restrict__ bgf,
                                             const float* __restrict__ wgb, const float* __restrict__ bgb, float* __restrict__ ea) {
    const int tok = blockIdx.x, col = threadIdx.x;
#pragma unroll
    for (int dir = 0; dir < 2; ++dir) {
        const float* wg = dir ? wgb : wgf; const float* bg = dir ? bgb : bgf;
        float a = bg[col];
        for (int r = 0; r < 16; ++r) a += proj[(size_t)tok * INW + C_GZ + dir * 16 + r] * wg[r * 256 + col];
        float ls = fminf(a, 0.f) - log1pf(expf(-fabsf(a)));
        ea[((size_t)dir * T + tok) * 256 + col] = expf(ls * (1.0f / 16.0f));
    }
}

__global__ void __launch_bounds__(128) nv_gla(const float* __restrict__ proj, const float* __restrict__ ea, float* __restrict__ og) {
    const int e = threadIdx.x, bhd = blockIdx.x, dir = bhd & 1, h = (bhd >> 1) & 3, b = bhd >> 3;
    float st[64];
#pragma unroll
    for (int d = 0; d < 64; ++d) st[d] = 0.f;
    for (int i = 0; i < S; ++i) {
        const int pos = dir ? (S - 1 - i) : i;
        const size_t tok = (size_t)b * S + pos;
        const float* pr = proj + tok * INW;
        const float* ar = ea + ((size_t)dir * T + tok) * 256 + h * 64;
        const float v = pr[C_GV + h * 128 + e];
        float o = 0.f;
#pragma unroll
        for (int d = 0; d < 64; ++d) {
            st[d] = fmaf(ar[d], st[d], pr[C_GK + h * 64 + d] * v);
            o = fmaf(pr[C_GQ + h * 64 + d] * 0.125f, st[d], o);
        }
        og[((size_t)dir * T + tok) * 512 + h * 128 + e] = o;
    }
}

__global__ void __launch_bounds__(256) nv_gla_out(const float* __restrict__ proj, const float* __restrict__ og, const float* __restrict__ ng, float* __restrict__ mix) {
    const int wid = blockIdx.x * 4 + (threadIdx.x >> 6), lane = threadIdx.x & 63;
    const int h = wid & 3, tok = wid >> 2;
    float o0 = og[(size_t)tok * 512 + h * 128 + lane] + og[((size_t)T + tok) * 512 + h * 128 + lane];
    float o1 = og[(size_t)tok * 512 + h * 128 + 64 + lane] + og[((size_t)T + tok) * 512 + h * 128 + 64 + lane];
    float ss = wave_sum(o0 * o0 + o1 * o1);
    float r = rsqrtf(ss * (1.0f / 128.0f) + EPS);
    float g0 = proj[(size_t)tok * INW + C_GO + h * 128 + lane], g1 = proj[(size_t)tok * INW + C_GO + h * 128 + 64 + lane];
    mix[(size_t)tok * D + 512 + h * 128 + lane] = o0 * r * ng[h * 128 + lane] * (g0 / (1.0f + expf(-g0)));
    mix[(size_t)tok * D + 512 + h * 128 + 64 + lane] = o1 * r * ng[h * 128 + 64 + lane] * (g1 / (1.0f + expf(-g1)));
}

__global__ void __launch_bounds__(256) nv_route(const float* __restrict__ x1, const float* __restrict__ g2, const float* __restrict__ rw, const float* __restrict__ rb,
                                                float* __restrict__ xn2, int* __restrict__ topi, float* __restrict__ gate) {
    __shared__ float xs[4][1024];
    __shared__ float lg[4][32];
    const int w = threadIdx.x >> 6, lane = threadIdx.x & 63, tok = blockIdx.x * 4 + w;
    const float* xr = x1 + (size_t)tok * D;
    float v[16]; float ss = 0.f;
#pragma unroll
    for (int i = 0; i < 16; ++i) { v[i] = xr[lane + 64 * i]; ss += v[i] * v[i]; }
    ss = wave_sum(ss);
    const float r = rsqrtf(ss * (1.0f / D) + EPS);
#pragma unroll
    for (int i = 0; i < 16; ++i) { float y = v[i] * r * g2[lane + 64 * i]; xs[w][lane + 64 * i] = y; xn2[(size_t)tok * D + lane + 64 * i] = y; }
    __syncthreads();
    const int e = lane & 31, half = lane >> 5;
    float a = 0.f;
    for (int k = half * 512; k < half * 512 + 512; ++k) a = fmaf(xs[w][k], rw[k * 32 + e], a);
    a += __shfl_xor(a, 32);
    if (lane < 32) lg[w][lane] = a + rb[lane];
    __syncthreads();
    if (lane == 0) {
        float bv[4]; int bi[4];
        unsigned used = 0u;
#pragma unroll
        for (int k = 0; k < 4; ++k) {
            float best = -3.0e38f; int bidx = 0;
            for (int j = 0; j < 32; ++j) { float x = lg[w][j]; if (!((used >> j) & 1u) && x > best) { best = x; bidx = j; } }
            used |= 1u << bidx; bv[k] = best; bi[k] = bidx;
        }
        float e0 = 1.0f, e1 = expf(bv[1] - bv[0]), e2 = expf(bv[2] - bv[0]), e3 = expf(bv[3] - bv[0]);
        float s = e0 + e1 + e2 + e3;
        topi[tok * 4 + 0] = bi[0]; topi[tok * 4 + 1] = bi[1]; topi[tok * 4 + 2] = bi[2]; topi[tok * 4 + 3] = bi[3];
        gate[tok * 4 + 0] = e0 / s; gate[tok * 4 + 1] = e1 / s; gate[tok * 4 + 2] = e2 / s; gate[tok * 4 + 3] = e3 / s;
    }
}

__global__ void nv_lists(const int* __restrict__ topi, int* __restrict__ lists, int* __restrict__ counts) {
    const int e = threadIdx.x;
    int c = 0;
    for (int s = 0; s < T * 4; ++s) if (topi[s] == e) lists[e * T + c++] = s;
    counts[e] = c;
}

__global__ void __launch_bounds__(256) nv_moe2(const float* __restrict__ A, const int* __restrict__ slots, const int* __restrict__ Mptr,
                                               const float* __restrict__ Bm, float* __restrict__ x2, const float* __restrict__ b2, const float* __restrict__ gate) {
    __shared__ float As[16][68];
    __shared__ float Bs[16][64];
    const int M = *Mptr;
    const int m0 = blockIdx.y * 64, n0 = blockIdx.x * 64;
    if (m0 >= M) return;
    const int tid = threadIdx.x, tx = tid & 15, ty = tid >> 4;
    float acc[4][4];
#pragma unroll
    for (int i = 0; i < 4; ++i)
#pragma unroll
        for (int j = 0; j < 4; ++j) acc[i][j] = 0.f;
    const int ar = tid >> 2, ak = (tid & 3) * 4;
    const int arow = m0 + ar; const bool av = arow < M;
    const float* ap = A + (size_t)(av ? arow : 0) * DFF + ak;
    const int bk = tid >> 4, bn = (tid & 15) * 4;
    for (int k0 = 0; k0 < DFF; k0 += 16) {
        float4 a4 = av ? *(const float4*)(ap + k0) : make_float4(0.f, 0.f, 0.f, 0.f);
        float4 b4 = *(const float4*)(Bm + (size_t)(k0 + bk) * D + n0 + bn);
        As[ak + 0][ar] = a4.x; As[ak + 1][ar] = a4.y; As[ak + 2][ar] = a4.z; As[ak + 3][ar] = a4.w;
        *(float4*)&Bs[bk][bn] = b4;
        __syncthreads();
#pragma unroll
        for (int kk = 0; kk < 16; ++kk) {
            float4 a = *(const float4*)&As[kk][ty * 4];
            float4 b = *(const float4*)&Bs[kk][tx * 4];
            float aa[4] = {a.x, a.y, a.z, a.w}, bb[4] = {b.x, b.y, b.z, b.w};
#pragma unroll
            for (int i = 0; i < 4; ++i)
#pragma unroll
                for (int j = 0; j < 4; ++j) acc[i][j] = fmaf(aa[i], bb[j], acc[i][j]);
        }
        __syncthreads();
    }
#pragma unroll
    for (int i = 0; i < 4; ++i) {
        const int row = m0 + ty * 4 + i;
        if (row >= M) continue;
        const int col = n0 + tx * 4;
        const int slot = slots[row]; const int tok = slot >> 2; const float gt = gate[slot];
#pragma unroll
        for (int j = 0; j < 4; ++j) x2[(size_t)tok * D + col + j] += gt * (acc[i][j] + b2[col + j]);
    }
}


#include <hip/hip_cooperative_groups.h>
namespace cg = cooperative_groups;

typedef unsigned short u16;
typedef short bf16x8 __attribute__((ext_vector_type(8)));
typedef short s16x4 __attribute__((ext_vector_type(4)));
typedef float f32x4 __attribute__((ext_vector_type(4)));
typedef unsigned u32x4 __attribute__((ext_vector_type(4)));
typedef __bf16 bfv2 __attribute__((ext_vector_type(2)));
typedef float fv2 __attribute__((ext_vector_type(2)));
#define LDS_AS __attribute__((address_space(3)))

constexpr int LDS_BYTES = 160 * 1024;
constexpr int HALF_LDS = 80 * 1024;
constexpr int NSLOT = T * 4;
constexpr int PJW = 3072;
#ifndef REPMASK
#define REPMASK 0
#endif

struct Params {
    const float *x, *g1, *w_in, *rel_bias, *wgf, *bgf, *wgb, *bgb, *gla_ng, *w_out, *g2, *rw, *rb, *w1, *b1, *w2, *b2, *gf;
    float* out;
    u16* winT;
    u16* wzT;
    u16* woT;
    u16* w1T;
    u16* w2T;
    u16* xn;
    u16* proj;
    float* zbuf;
    u16* abr;
    float* lse;
    float* dS;
    float* dec;
    u16* Sp;
    u16* mix;
    float* x1;
    u16* xn2;
    int* counts;
    int* lists;
    float* gate;
    u16* act;
    u16* y;
    unsigned char* xn28;
    unsigned char* w1T8;
    unsigned char* act8;
    unsigned char* w2T8;
    unsigned* bar;
    int ph_lo, ph_hi;
};

__device__ __forceinline__ int tid_opaque() { int t = threadIdx.x; asm volatile("" : "+v"(t)); return t; }
__device__ __forceinline__ float bf2f(u16 v) { return __uint_as_float((unsigned)v << 16); }
__device__ __forceinline__ unsigned pack2(float a, float b) {
    fv2 v = {a, b};
    bfv2 r = __builtin_convertvector(v, bfv2);
    return __builtin_bit_cast(unsigned, r);
}
__device__ __forceinline__ u16 f2bf(float a) { return (u16)(pack2(a, 0.f) & 0xffffu); }
__device__ __forceinline__ float lo2f(unsigned u) { return __uint_as_float(u << 16); }
__device__ __forceinline__ float hi2f(unsigned u) { return __uint_as_float(u & 0xffff0000u); }
__device__ __forceinline__ int tile_off(int row, int chunk) { return row * 128 + ((chunk ^ (row & 7)) << 4); }
__device__ __forceinline__ bf16x8 lds_frag(const char* base, int row, int chunk) { return *(const bf16x8*)(base + tile_off(row, chunk)); }
__device__ __forceinline__ s16x4 tr_read(const char* p) {
    return __builtin_amdgcn_ds_read_tr16_b64_v4i16((LDS_AS s16x4*)(p));
}
__device__ __forceinline__ bf16x8 cat4(s16x4 a, s16x4 b) { bf16x8 r = {a[0], a[1], a[2], a[3], b[0], b[1], b[2], b[3]}; return r; }
__device__ __forceinline__ float logsig(float a) { return fminf(a, 0.f) - log1pf(expf(-fabsf(a))); }

__device__ __forceinline__ void cvt_tile8(const float* __restrict__ src, int ldsrc, unsigned char* __restrict__ dst, int k0, int n0, int t) {
    const int l = t & 63, w = t >> 6, kg = l & 7, ng = w * 8 + (l >> 3);
    const float* s = src + (size_t)(k0 + 8 * kg) * ldsrc + n0 + 4 * ng;
    f32x4 bv[8];
#pragma unroll
    for (int j = 0; j < 8; ++j) bv[j] = *(const f32x4*)(s + (size_t)j * ldsrc) * 32.0f;
    unsigned char* d = dst + (size_t)(n0 + 4 * ng) * 1024 + k0 + 8 * kg;
#pragma unroll
    for (int c = 0; c < 4; ++c) {
        int lo = __builtin_amdgcn_cvt_pk_fp8_f32(bv[0][c], bv[1][c], 0, false); lo = __builtin_amdgcn_cvt_pk_fp8_f32(bv[2][c], bv[3][c], lo, true);
        int hi = __builtin_amdgcn_cvt_pk_fp8_f32(bv[4][c], bv[5][c], 0, false); hi = __builtin_amdgcn_cvt_pk_fp8_f32(bv[6][c], bv[7][c], hi, true);
        uint2 q; q.x = (unsigned)lo; q.y = (unsigned)hi;
        *(uint2*)(d + c * 1024) = q;
    }
}
__device__ __forceinline__ void cvt_tile(const float* __restrict__ src, int ldsrc, u16* __restrict__ dst, int k0, int n0, int t) {
    const int l = t & 63, w = t >> 6, kg = l & 7, ng = w * 8 + (l >> 3);
    const float* s = src + (size_t)(k0 + 8 * kg) * ldsrc + n0 + 4 * ng;
    float4 bv[8];
#pragma unroll
    for (int j = 0; j < 8; ++j) bv[j] = *(const float4*)(s + (size_t)j * ldsrc);
    u16* d = dst + (size_t)(n0 + 4 * ng) * 1024 + k0 + 8 * kg;
    uint4 q;
    q.x = pack2(bv[0].x, bv[1].x); q.y = pack2(bv[2].x, bv[3].x); q.z = pack2(bv[4].x, bv[5].x); q.w = pack2(bv[6].x, bv[7].x);
    *(uint4*)(d) = q;
    q.x = pack2(bv[0].y, bv[1].y); q.y = pack2(bv[2].y, bv[3].y); q.z = pack2(bv[4].y, bv[5].y); q.w = pack2(bv[6].y, bv[7].y);
    *(uint4*)(d + 1024) = q;
    q.x = pack2(bv[0].z, bv[1].z); q.y = pack2(bv[2].z, bv[3].z); q.z = pack2(bv[4].z, bv[5].z); q.w = pack2(bv[6].z, bv[7].z);
    *(uint4*)(d + 2048) = q;
    q.x = pack2(bv[0].w, bv[1].w); q.y = pack2(bv[2].w, bv[3].w); q.z = pack2(bv[4].w, bv[5].w); q.w = pack2(bv[6].w, bv[7].w);
    *(uint4*)(d + 3072) = q;
}
struct CvtRegs { f32x4 bv[8]; };
__device__ __forceinline__ void cvt_load(const float* __restrict__ src, int ldsrc, int k0, int n0, int t, CvtRegs& R) {
    const int l = t & 63, w = t >> 6, kg = l & 7, ng = w * 8 + (l >> 3);
    const float* s = src + (size_t)(k0 + 8 * kg) * ldsrc + n0 + 4 * ng;
#pragma unroll
    for (int j = 0; j < 8; ++j) R.bv[j] = *(const f32x4*)(s + (size_t)j * ldsrc);
}
__device__ __forceinline__ void cvt_store(u16* __restrict__ dst, int k0, int n0, int t, const CvtRegs& R) {
    const int l = t & 63, w = t >> 6, kg = l & 7, ng = w * 8 + (l >> 3);
    u16* d = dst + (size_t)(n0 + 4 * ng) * 1024 + k0 + 8 * kg;
#pragma unroll
    for (int c = 0; c < 4; ++c) {
        u32x4 q;
        q.x = pack2(R.bv[0][c], R.bv[1][c]); q.y = pack2(R.bv[2][c], R.bv[3][c]); q.z = pack2(R.bv[4][c], R.bv[5][c]); q.w = pack2(R.bv[6][c], R.bv[7][c]);
        *(u32x4*)(d + c * 1024) = q;
    }
}
__device__ __forceinline__ void w1_load(const Params& p, int i, int t, CvtRegs& R) { const int e = i >> 8, j = i & 255; cvt_load(p.w1 + (size_t)e * D * 2 * DFF, 2 * DFF, (j >> 4) * 64, (j & 15) * 128, t, R); }
__device__ __forceinline__ void w1_store(const Params& p, int i, int t, const CvtRegs& R) { const int e = i >> 8, j = i & 255; cvt_store(p.w1T + (size_t)e * 2 * DFF * D, (j >> 4) * 64, (j & 15) * 128, t, R); }
constexpr int CV_WIN = 384, CV_WZ = 1, CV_WO = 128, CV_W1 = NE * 256, CV_W2 = NE * 128;
constexpr int CV_TOTAL = CV_WIN + CV_WZ + CV_WO + CV_W1 + CV_W2;
constexpr int W2_BG = 4096;
constexpr int W2_LATE = 4096;
#ifndef NCONV
#define NCONV 102
#endif
#ifndef W1_CONV
#define W1_CONV 8192
#endif
__device__ void ph_prologue(const Params& p) {
    const int tid = tid_opaque();
    if (blockIdx.x == 0 && tid < 32) p.counts[tid] = 0;
    {
        const int lane = tid & 63, gw = blockIdx.x * 8 + (tid >> 6), nw = gridDim.x * 8;
        for (int row = gw; row < T; row += nw) {
            const float4* xr = (const float4*)(p.x + (size_t)row * D);
            float4 v[4]; float ss = 0.f;
#pragma unroll
            for (int i = 0; i < 4; ++i) { v[i] = xr[lane + 64 * i]; ss += v[i].x * v[i].x + v[i].y * v[i].y + v[i].z * v[i].z + v[i].w * v[i].w; }
            ss = wave_sum(ss);
            const float r = rsqrtf(ss * (1.0f / D) + EPS);
#pragma unroll
            for (int i = 0; i < 4; ++i) {
                const float4 g = ((const float4*)p.g1)[lane + 64 * i];
                uint2 o; o.x = pack2(v[i].x * r * g.x, v[i].y * r * g.y); o.y = pack2(v[i].z * r * g.z, v[i].w * r * g.w);
                *(uint2*)(p.xn + (size_t)row * D + (lane + 64 * i) * 4) = o;
            }
        }
    }
    const int t = tid & 255, vb = blockIdx.x * 2 + (tid >> 8), nvb = gridDim.x * 2;
    for (int it = vb; it < CV_TOTAL; it += nvb) {
        int i = it;
        if (i < CV_WIN) { cvt_tile(p.w_in, INW, p.winT, (i / 24) * 64, (i % 24) * 128, t); continue; }
        i -= CV_WIN;
        if (i < CV_WZ) {
            for (int c = t; c < 32 * 128; c += 256) {
                const int n = c >> 7, k8 = (c & 127) * 8;
                const float* s = p.w_in + (size_t)k8 * INW + PJW + n;
                uint4 q;
                q.x = pack2(s[0], s[INW]); q.y = pack2(s[2 * INW], s[3 * INW]); q.z = pack2(s[4 * INW], s[5 * INW]); q.w = pack2(s[6 * INW], s[7 * INW]);
                *(uint4*)(p.wzT + (size_t)n * 1024 + k8) = q;
            }
            continue;
        }
        i -= CV_WZ;
        if (i < CV_WO) { cvt_tile(p.w_out, D, p.woT, (i >> 3) * 64, (i & 7) * 128, t); continue; }
        i -= CV_WO;
        if (i < CV_W1) { if (i >= W1_CONV) { const int e = i >> 8, j = i & 255; cvt_tile8(p.w1 + (size_t)e * D * 2 * DFF, 2 * DFF, p.w1T8 + (size_t)e * 2 * DFF * D, (j >> 4) * 64, (j & 15) * 128, t); } continue; }
        i -= CV_W1;
        if (i >= W2_LATE) { const int e = i >> 7, j = i & 127; cvt_tile8(p.w2 + (size_t)e * DFF * D, D, p.w2T8 + (size_t)e * D * DFF, (j >> 3) * 64, (j & 7) * 128, t); }
    }
}

namespace pg {
constexpr int BM = 256, BK = 64, HALF = 128, HTB = HALF * BK * 2, KD = 1024;
__host__ __device__ __forceinline__ int lds_byte(int r, int c) { const int st = (r >> 4) * 2 + (c >> 5), rr = r & 15, cc = c & 31, ob = rr * 64 + cc * 2; return st * 1024 + (ob ^ (((ob >> 9) & 1) << 5)); }
__host__ __device__ __forceinline__ void stage_rc(int b, int& R, int& C) { const int st = b / 1024, sb = b % 1024, swz = sb ^ (((sb >> 9) & 1) << 5); R = (st >> 1) * 16 + swz / 64; C = (st & 1) * 32 + (swz % 64) / 2; }
__host__ __device__ __forceinline__ int perm32(int rho) { const int n = rho >> 4, i = rho & 15; return 8 * (i >> 2) + 4 * n + (i & 3); }

struct Unit { int pn, row0, nvalid, e, ord; };

typedef int v8i32 __attribute__((ext_vector_type(8)));
template <class Epi, class Sched, bool FP8 = false>
__device__ __forceinline__ void gemm_phase(LDS_AS unsigned char* lds, const Sched& S, const Epi& E) {
    const int tid = tid_opaque(), wid = __builtin_amdgcn_readfirstlane(tid >> 6), lane = tid & 63, wr = wid >> 2, wc = wid & 3, fr = lane & 15, fq = lane >> 4;
    constexpr int ROWB = FP8 ? KD : KD * 2;
    constexpr int nt = FP8 ? KD / 128 : KD / BK;
    int R0, C0; stage_rc(tid * 16, R0, C0);
    unsigned voffB[2];
#pragma unroll
    for (int i = 0; i < 2; ++i) { const int R = R0 + 64 * i; const int Rb = Epi::PERM ? ((R & ~31) + perm32(R & 31)) : R; voffB[i] = (unsigned)(Rb * ROWB + C0 * 2); }
    const size_t kstep = (size_t)(BK * 2);
    const size_t hstep = (size_t)HALF * ROWB;
    const unsigned ldsw = (unsigned)wid * 1024u;
    const int aoff = lds_byte(wr * 64 + fr, fq * 8), boff = lds_byte(wc * 32 + fr, fq * 8);
    const int aoff8a = lds_byte(wr * 64 + fr, fq * 16), boff8a = lds_byte(wc * 32 + fr, fq * 16);
#define PG_SA(b, h) (((b) * 2 + (h)) * HTB)
#define PG_SB(b, h) ((4 + (b) * 2 + (h)) * HTB)
#define PG_STAGE_B(bufoff, gbase) do { _Pragma("unroll") for (int _i = 0; _i < 2; ++_i) \
        __builtin_amdgcn_global_load_lds((const unsigned*)((const char*)(gbase) + voffB[_i]), (LDS_AS unsigned*)(lds + (bufoff) + ldsw + _i * 8192), 16, 0, 0); } while (0)
#define PG_STAGE_A(bufoff, o0, o1) do { \
        __builtin_amdgcn_global_load_lds((const unsigned*)(Abase + (o0)), (LDS_AS unsigned*)(lds + (bufoff) + ldsw), 16, 0, 0); \
        __builtin_amdgcn_global_load_lds((const unsigned*)(Abase + (o1)), (LDS_AS unsigned*)(lds + (bufoff) + ldsw + 8192), 16, 0, 0); } while (0)
#define PG_LDA16(dst, b, h) do { _Pragma("unroll") for (int m = 0; m < 4; ++m) _Pragma("unroll") for (int k = 0; k < 2; ++k) dst[m][k] = *(const LDS_AS bf16x8*)(lds + PG_SA(b, h) + aoff + m * 2048 + k * 1024); } while (0)
#define PG_LDB16(dst, b, h) do { _Pragma("unroll") for (int n = 0; n < 2; ++n) _Pragma("unroll") for (int k = 0; k < 2; ++k) dst[n][k] = *(const LDS_AS bf16x8*)(lds + PG_SB(b, h) + boff + n * 2048 + k * 1024); } while (0)
#define PG_RD16(off) __builtin_bit_cast(u32x4, *(const LDS_AS bf16x8*)(lds + (off)))
#define PG_LDA8(dst, b, h) do { _Pragma("unroll") for (int m = 0; m < 4; ++m) dst##8[m] = __builtin_bit_cast(v8i32, __builtin_shufflevector(PG_RD16(PG_SA(b, h) + aoff8a + m * 2048), PG_RD16(PG_SA(b, h) + aoff8a + 16 + m * 2048), 0, 1, 2, 3, 4, 5, 6, 7)); } while (0)
#define PG_LDB8(dst, b, h) do { _Pragma("unroll") for (int n = 0; n < 2; ++n) dst##8[n] = __builtin_bit_cast(v8i32, __builtin_shufflevector(PG_RD16(PG_SB(b, h) + boff8a + n * 2048), PG_RD16(PG_SB(b, h) + boff8a + 16 + n * 2048), 0, 1, 2, 3, 4, 5, 6, 7)); } while (0)
#define PG_LDA(dst, b, h) do { if constexpr (FP8) PG_LDA8(dst, b, h); else PG_LDA16(dst, b, h); } while (0)
#define PG_LDB(dst, b, h) do { if constexpr (FP8) PG_LDB8(dst, b, h); else PG_LDB16(dst, b, h); } while (0)
#define PG_MMA(ai, bj, At, Bt) do { __builtin_amdgcn_s_setprio(1); _Pragma("unroll") for (int m = 0; m < 4; ++m) _Pragma("unroll") for (int n = 0; n < 2; ++n) { \
        if constexpr (FP8) asm volatile("v_mfma_scale_f32_16x16x128_f8f6f4 %0, %1, %2, %0, %3, %4 op_sel_hi:[0,0,0]" : "+v"(acc[ai][bj][m][n]) : "v"(Bt##8[n]), "v"(At##8[m]), "v"(sclA), "v"(sclA)); \
        else { _Pragma("unroll") for (int k = 0; k < 2; ++k) acc[ai][bj][m][n] = __builtin_amdgcn_mfma_f32_16x16x32_bf16(Bt[n][k], At[m][k], acc[ai][bj][m][n], 0, 0, 0); } } \
        __builtin_amdgcn_s_setprio(0); } while (0)
#define PG_WAIT_V(n) asm volatile("s_waitcnt vmcnt(" #n ")" ::: "memory")
#define PG_WAIT_L(n) asm volatile("s_waitcnt lgkmcnt(" #n ")" ::: "memory")
#define PG_BAR __builtin_amdgcn_s_barrier()
#define PG_SCHED __builtin_amdgcn_sched_barrier(0)
    Unit cur, nxt; int ui = 0;
    if (!S.next(0, cur)) return;
    f32x4 acc[2][2][4][2];
    E.init(acc, cur, wr, wc, fr, fq);
    bf16x8 At[4][2], B0[2][2], B1[2][2];
    v8i32 At8[4], B08[2], B18[2];
    int sclA = 0x7F7F7F7F;
    asm volatile("" : "+v"(sclA));
    const char* Abase = (const char*)S.A;
    unsigned c00 = S.rowoff(cur, R0) + C0 * 2u, c01 = S.rowoff(cur, R0 + 64) + C0 * 2u, c10 = S.rowoff(cur, R0 + 128) + C0 * 2u, c11 = S.rowoff(cur, R0 + 192) + C0 * 2u;
    const char* cB = S.bbase(cur);
    PG_STAGE_B(PG_SB(0, 0), cB); PG_STAGE_A(PG_SA(0, 0), c00, c01); PG_STAGE_B(PG_SB(0, 1), cB + hstep); PG_STAGE_A(PG_SA(0, 1), c10, c11);
    if (wr == 1) PG_BAR;
    PG_WAIT_V(4); PG_BAR;
    PG_STAGE_B(PG_SB(1, 0), cB + kstep); PG_STAGE_A(PG_SA(1, 0), c00 + 128u, c01 + 128u); PG_STAGE_B(PG_SB(1, 1), cB + hstep + kstep);
    PG_WAIT_V(6); PG_BAR;
    for (;;) {
        const bool has_next = S.next(ui + 1, nxt);
        const char* nB = has_next ? S.bbase(nxt) : cB;
        unsigned dnx = 0u;
        if constexpr (Sched::LINEAR) { if (has_next) dnx = S.rowoff(nxt, 0) - S.rowoff(cur, 0); }

#pragma unroll 1
        for (int t = 0; t < nt; t += 2) {
            const bool last = (t == nt - 2);
            const unsigned k1 = (unsigned)(t + 1) * 128u, k2 = last ? 0u : (unsigned)(t + 2) * 128u, k3 = k2 + 128u;
            unsigned a2_00, a2_01, a2_10, a2_11, a3_00, a3_01;
            if constexpr (Sched::LINEAR) { const unsigned dl = last ? dnx : 0u; a2_00 = c00 + dl + k2; a2_01 = c01 + dl + k2; a2_10 = c10 + dl + k2; a2_11 = c11 + dl + k2; a3_00 = c00 + dl + k3; a3_01 = c01 + dl + k3; }
            else {
                a2_00 = c00; a2_01 = c01; a2_10 = c10; a2_11 = c11;
                if (last && has_next) { a2_00 = S.rowoff(nxt, R0) + C0 * 2u; a2_01 = S.rowoff(nxt, R0 + 64) + C0 * 2u; a2_10 = S.rowoff(nxt, R0 + 128) + C0 * 2u; a2_11 = S.rowoff(nxt, R0 + 192) + C0 * 2u; }
                a3_00 = a2_00 + k3; a3_01 = a2_01 + k3; a2_00 += k2; a2_01 += k2; a2_10 += k2; a2_11 += k2;
            }
            const char* b2 = last ? nB : cB + (size_t)(t + 2) * kstep;
            const char* b3 = b2 + kstep;
            PG_LDB(B0, 0, 0); PG_SCHED; PG_LDA(At, 0, 0); PG_STAGE_A(PG_SA(1, 1), c10 + k1, c11 + k1);
            PG_WAIT_L(8); PG_BAR; PG_WAIT_L(0); PG_MMA(0, 0, At, B0); PG_BAR; PG_SCHED;
            PG_LDB(B1, 0, 1); PG_STAGE_B(PG_SB(0, 0), b2);
            PG_BAR; PG_WAIT_L(0); PG_MMA(0, 1, At, B1); PG_BAR;
            PG_LDA(At, 0, 1); PG_STAGE_A(PG_SA(0, 0), a2_00, a2_01);
            PG_BAR; PG_WAIT_L(0); PG_MMA(1, 0, At, B0); PG_BAR; PG_SCHED;
            PG_STAGE_B(PG_SB(0, 1), b2 + hstep);
            PG_WAIT_V(6); PG_BAR; PG_MMA(1, 1, At, B1); PG_BAR;
            PG_LDB(B0, 1, 0); PG_SCHED; PG_LDA(At, 1, 0); PG_STAGE_A(PG_SA(0, 1), a2_10, a2_11);
            PG_WAIT_L(8); PG_BAR; PG_WAIT_L(0); PG_MMA(0, 0, At, B0); PG_BAR; PG_SCHED;
            PG_LDB(B1, 1, 1); PG_STAGE_B(PG_SB(1, 0), b3);
            PG_BAR; PG_WAIT_L(0); PG_MMA(0, 1, At, B1); PG_BAR;
            PG_LDA(At, 1, 1); PG_STAGE_A(PG_SA(1, 0), a3_00, a3_01);
            PG_BAR; PG_WAIT_L(0); PG_MMA(1, 0, At, B0); PG_BAR; PG_SCHED;
            PG_STAGE_B(PG_SB(1, 1), b3 + hstep);
            PG_WAIT_V(6); PG_BAR; PG_MMA(1, 1, At, B1); PG_BAR;
        }
        E(acc, cur, wr, wc, fr, fq);
        if (!has_next) break;
        E.init(acc, nxt, wr, wc, fr, fq);
        if constexpr (Sched::LINEAR) { c00 += dnx; c01 += dnx; c10 += dnx; c11 += dnx; }
        else { c00 = S.rowoff(nxt, R0) + C0 * 2u; c01 = S.rowoff(nxt, R0 + 64) + C0 * 2u; c10 = S.rowoff(nxt, R0 + 128) + C0 * 2u; c11 = S.rowoff(nxt, R0 + 192) + C0 * 2u; }
        cur = nxt; cB = nB; ++ui;
    }
    PG_WAIT_V(0);
    if (wr == 0) PG_BAR;
    PG_BAR;
#undef PG_SA
#undef PG_SB
#undef PG_STAGE_A
#undef PG_STAGE_B
#undef PG_LDA
#undef PG_LDB
#undef PG_LDA8
#undef PG_LDB8
#undef PG_LDA16
#undef PG_LDB16
#undef PG_RD16
#undef PG_MMA
#undef PG_WAIT_V
#undef PG_WAIT_L
#undef PG_BAR
#undef PG_SCHED
}

struct DenseSched {
    static constexpr bool LINEAR = true;
    const u16* A; const u16* Bt; int nM, nN, nwg, G, c;
    __device__ void init(const u16* A_, const u16* Bt_, int M, int N, int G_, int c_) { A = A_; Bt = Bt_; nM = M / BM; nN = N / BM; nwg = nM * nN; G = G_; c = c_; }
    __device__ __forceinline__ bool next(int i, Unit& u) const {
        const int L = i * G + c; if (L >= nwg) return false;
        int wgid = L; { const int q = nwg / 8, r = nwg % 8, xcd = wgid % 8, off = wgid / 8; wgid = (xcd < r ? xcd * (q + 1) : r * (q + 1) + (xcd - r) * q) + off; }
        const int nig = 8 * nN, gid = wgid / nig, fm = gid * 8, gsz = (nM - fm) < 8 ? (nM - fm) : 8;
        u.row0 = (fm + ((wgid % nig) % gsz)) * BM; u.pn = (wgid % nig) / gsz; u.nvalid = BM; u.e = 0; u.ord = i; return true;
    }
    __device__ __forceinline__ unsigned rowoff(const Unit& u, int r) const { return (unsigned)(u.row0 + r) * (unsigned)(KD * 2); }
    __device__ __forceinline__ const char* bbase(const Unit& u) const { return (const char*)Bt + (size_t)u.pn * BM * KD * 2; }
};

template <bool GATHER> struct MoeSchedT {
    static constexpr bool LINEAR = !GATHER;
    const u16* A; const u16* Bt; const int* lists; const LDS_AS int* meta; int NT, nunits, G, c; int rowb; const LDS_AS unsigned* rowtab;
    __device__ __forceinline__ bool next(int i, Unit& u) const {
        const int L = i * G + c; if (L >= nunits) return false;
        int wgid = L; { const int q = nunits / 8, r = nunits % 8, xcd = wgid % 8, off = wgid / 8; wgid = (xcd < r ? xcd * (q + 1) : r * (q + 1) + (xcd - r) * q) + off; }
        const int gm = wgid / NT; u.pn = wgid % NT;
        int e = 0;
        while (meta[32 + e + 1] <= gm) ++e;
        const int mi = gm - meta[32 + e];
        u.e = e; u.row0 = meta[72 + e] + mi * BM; u.nvalid = min(BM, meta[e] - mi * BM); u.ord = i;
        return true;
    }
    __device__ __forceinline__ unsigned rowoff(const Unit& u, int r) const {
        if constexpr (GATHER) return rowtab[u.ord * BM + r];
        else return (unsigned)(u.row0 + r) * (unsigned)rowb;
    }
    __device__ __forceinline__ const char* bbase(const Unit& u) const { return (const char*)Bt + ((size_t)u.e * NT + u.pn) * BM * (size_t)rowb; }
};

struct EpiProj {
    static constexpr int SCALE_A = 0x7F7F7F7F, SCALE_B = 0x7F7F7F7F;
    static constexpr bool PERM = true;
    u16* O;
    __device__ __forceinline__ void init(f32x4 (&acc)[2][2][4][2], const Unit&, int, int, int, int) const {
#pragma unroll
        for (int a = 0; a < 2; ++a)
#pragma unroll
            for (int b = 0; b < 2; ++b)
#pragma unroll
                for (int m = 0; m < 4; ++m)
#pragma unroll
                    for (int n = 0; n < 2; ++n) acc[a][b][m][n] = (f32x4){0.f, 0.f, 0.f, 0.f};
    }
    __device__ __forceinline__ void operator()(const f32x4 (&acc)[2][2][4][2], const Unit& u, int wr, int wc, int fr, int fq) const {
        const int row0 = u.row0 + wr * 64 + fr, col0 = u.pn * BM + wc * 32 + 8 * fq;
#pragma unroll
        for (int ai = 0; ai < 2; ++ai)
#pragma unroll
            for (int m = 0; m < 4; ++m) { u16* rowp = O + (size_t)(row0 + ai * HALF + m * 16) * PJW + col0;
#pragma unroll
                for (int bj = 0; bj < 2; ++bj) { const f32x4 v0 = acc[ai][bj][m][0], v1 = acc[ai][bj][m][1];
                    u32x4 w; w.x = pack2(v0[0], v0[1]); w.y = pack2(v0[2], v0[3]); w.z = pack2(v1[0], v1[1]); w.w = pack2(v1[2], v1[3]);
                    *(u32x4*)(rowp + bj * HALF) = w; } }
    }
};
struct EpiOut {
    static constexpr int SCALE_A = 0x7F7F7F7F, SCALE_B = 0x7F7F7F7F;
    static constexpr bool PERM = false;
    const float* X; float* C;
    __device__ __forceinline__ void init(f32x4 (&acc)[2][2][4][2], const Unit& u, int wr, int wc, int fr, int fq) const {
        const int row0 = u.row0 + wr * 64 + fr, col0 = u.pn * BM + wc * 32 + 4 * fq;
#pragma unroll
        for (int ai = 0; ai < 2; ++ai)
#pragma unroll
            for (int m = 0; m < 4; ++m) { const size_t ro = (size_t)(row0 + ai * HALF + m * 16) * D + col0;
#pragma unroll
                for (int bj = 0; bj < 2; ++bj)
#pragma unroll
                    for (int n = 0; n < 2; ++n) acc[ai][bj][m][n] = *(const f32x4*)(X + ro + bj * HALF + n * 16); }
    }
    __device__ __forceinline__ void operator()(const f32x4 (&acc)[2][2][4][2], const Unit& u, int wr, int wc, int fr, int fq) const {
        const int row0 = u.row0 + wr * 64 + fr, col0 = u.pn * BM + wc * 32 + 4 * fq;
#pragma unroll
        for (int ai = 0; ai < 2; ++ai)
#pragma unroll
            for (int m = 0; m < 4; ++m) { const size_t ro = (size_t)(row0 + ai * HALF + m * 16) * D + col0;
#pragma unroll
                for (int bj = 0; bj < 2; ++bj)
#pragma unroll
                    for (int n = 0; n < 2; ++n) *(f32x4*)(C + ro + bj * HALF + n * 16) = acc[ai][bj][m][n]; }
    }
};
struct EpiMoe1 {
    static constexpr int SCALE_A = 0x7F7F7F7F, SCALE_B = 0x7F7F7F7F;
    static constexpr bool PERM = true;
    const float* b1; unsigned char* act8;
    __device__ __forceinline__ void init(f32x4 (&acc)[2][2][4][2], const Unit&, int, int, int, int) const {
#pragma unroll
        for (int a = 0; a < 2; ++a)
#pragma unroll
            for (int b = 0; b < 2; ++b)
#pragma unroll
                for (int m = 0; m < 4; ++m)
#pragma unroll
                    for (int n = 0; n < 2; ++n) acc[a][b][m][n] = (f32x4){0.f, 0.f, 0.f, 0.f};
    }
    __device__ __forceinline__ void operator()(const f32x4 (&acc)[2][2][4][2], const Unit& u, int wr, int wc, int fr, int fq) const {
        const int r0 = wr * 64 + fr, col0 = u.pn * BM + wc * 32 + 8 * fq;
        const float* be = b1 + (size_t)u.e * 2 * DFF + col0;
        f32x4 bv[2][2];
#pragma unroll
        for (int bj = 0; bj < 2; ++bj)
#pragma unroll
            for (int n = 0; n < 2; ++n) bv[bj][n] = *(const f32x4*)(be + bj * HALF + 4 * n);
#pragma unroll
        for (int ai = 0; ai < 2; ++ai)
#pragma unroll
            for (int m = 0; m < 4; ++m) {
                const int r = r0 + ai * HALF + m * 16;
                if (r < u.nvalid) {
                    unsigned char* rowp = act8 + (size_t)(u.row0 + r) * DFF + (col0 >> 1);
#pragma unroll
                    for (int bj = 0; bj < 2; ++bj) {
                        const f32x4 v0 = acc[ai][bj][m][0] * 0.03125f + bv[bj][0], v1 = acc[ai][bj][m][1] * 0.03125f + bv[bj][1];
                        const float g0 = fminf(v0[0], 7.0f), l0 = fminf(fmaxf(v0[1], -7.0f), 7.0f);
                        const float g1 = fminf(v0[2], 7.0f), l1 = fminf(fmaxf(v0[3], -7.0f), 7.0f);
                        const float g2 = fminf(v1[0], 7.0f), l2 = fminf(fmaxf(v1[1], -7.0f), 7.0f);
                        const float g3 = fminf(v1[2], 7.0f), l3 = fminf(fmaxf(v1[3], -7.0f), 7.0f);
                        const float a0 = g0 * __builtin_amdgcn_rcpf(1.0f + __expf(-1.702f * g0)) * (l0 + 1.0f), a1 = g1 * __builtin_amdgcn_rcpf(1.0f + __expf(-1.702f * g1)) * (l1 + 1.0f);
                        const float a2 = g2 * __builtin_amdgcn_rcpf(1.0f + __expf(-1.702f * g2)) * (l2 + 1.0f), a3 = g3 * __builtin_amdgcn_rcpf(1.0f + __expf(-1.702f * g3)) * (l3 + 1.0f);
                        int pk = __builtin_amdgcn_cvt_pk_fp8_f32(a0, a1, 0, false);
                        pk = __builtin_amdgcn_cvt_pk_fp8_f32(a2, a3, pk, true);
                        *(int*)(rowp + bj * (HALF / 2)) = pk;
                    }
                }
            }
    }
};
struct EpiMoe2 {
    static constexpr bool PERM = true;
    static constexpr int SCALE_A = 0x7F7F7F7F, SCALE_B = 0x7A7A7A7A;
    const float* b2; const float* gate; const int* lists; const LDS_AS int* meta; u16* y;
    __device__ __forceinline__ void init(f32x4 (&acc)[2][2][4][2], const Unit&, int, int, int, int) const {
#pragma unroll
        for (int a = 0; a < 2; ++a)
#pragma unroll
            for (int b = 0; b < 2; ++b)
#pragma unroll
                for (int m = 0; m < 4; ++m)
#pragma unroll
                    for (int n = 0; n < 2; ++n) acc[a][b][m][n] = (f32x4){0.f, 0.f, 0.f, 0.f};
    }
    __device__ __forceinline__ void operator()(const f32x4 (&acc)[2][2][4][2], const Unit& u, int wr, int wc, int fr, int fq) const {
        const int r0 = wr * 64 + fr, col0 = u.pn * BM + wc * 32 + 8 * fq;
        const float* be = b2 + (size_t)u.e * D + col0;
        const int* le = lists + (size_t)u.e * T + (u.row0 - meta[72 + u.e]);
        f32x4 bv[2][2];
#pragma unroll
        for (int bj = 0; bj < 2; ++bj)
#pragma unroll
            for (int n = 0; n < 2; ++n) bv[bj][n] = *(const f32x4*)(be + bj * HALF + 4 * n);
        int slot[8]; float gt[8];
#pragma unroll
        for (int q = 0; q < 8; ++q) slot[q] = le[min(r0 + (q >> 2) * HALF + (q & 3) * 16, u.nvalid - 1)];
        __builtin_amdgcn_sched_barrier(0);
#pragma unroll
        for (int q = 0; q < 8; ++q) gt[q] = gate[slot[q]];
        __builtin_amdgcn_sched_barrier(0);
#pragma unroll
        for (int ai = 0; ai < 2; ++ai)
#pragma unroll
            for (int m = 0; m < 4; ++m) {
                const int r = r0 + ai * HALF + m * 16;
                if (r < u.nvalid) {
                    const float g1 = gt[ai * 4 + m];
                    unsigned char* rowp = (unsigned char*)y + (size_t)slot[ai * 4 + m] * D + col0;
                    const float g16 = g1 * 16.0f;
#pragma unroll
                    for (int bj = 0; bj < 2; ++bj) {
                        const f32x4 v0 = (acc[ai][bj][m][0] * 0.03125f + bv[bj][0]) * g16, v1 = (acc[ai][bj][m][1] * 0.03125f + bv[bj][1]) * g16;
                        int lo = __builtin_amdgcn_cvt_pk_fp8_f32(v0[0], v0[1], 0, false); lo = __builtin_amdgcn_cvt_pk_fp8_f32(v0[2], v0[3], lo, true);
                        int hi = __builtin_amdgcn_cvt_pk_fp8_f32(v1[0], v1[1], 0, false); hi = __builtin_amdgcn_cvt_pk_fp8_f32(v1[2], v1[3], hi, true);
                        uint2 w; w.x = (unsigned)lo; w.y = (unsigned)hi;
                        *(uint2*)(rowp + bj * HALF) = w;
                    }
                }
            }
    }
};
}

constexpr int AT_K = 0, AT_V = 208 * 128, AT_Q = AT_V + 208 * 160, AT_BIAS = AT_Q + 8192;
struct AttnRegs { float tb[3]; };
__device__ __forceinline__ void attn_load(const Params& p, int t, int it, AttnRegs& R) {
    const int br = (it >> 6) % 3, h = (it / 192) & 7;
#pragma unroll
    for (int i = 0; i < 3; ++i) {
        const int en = t + 256 * i, c = en / 176, x = en - c * 176, y = x - c - 16;
        const bool ok = (en < 704) && (y >= 0) && (y <= 128);
        const float bvl = p.rel_bias[T5TAB[br * 129 + (ok ? y : 0)] * AH + h];
        R.tb[i] = ok ? bvl * 1.44269504f : -1.0e30f;
    }
}
__device__ void attn_item(const Params& p, char* lds, int t, int it, int nit, AttnRegs& R, int bgt) {
    const int l = t & 63, w = t >> 6, i16 = l & 15, g = l >> 4;
    const int idx = it & 63, br = (it >> 6) % 3, h = (it / 192) & 7, b = it / 1536;
    const int dsh = br * 2, L = S >> dsh, nbl = L >> 6;
    const int res = idx / nbl, qb = idx % nbl;
    char* Ks = lds + AT_K; char* Vs = lds + AT_V; char* Qs = lds + AT_Q; float* biasf = (float*)(lds + AT_BIAS);
    __syncthreads();
    f32x4 cb0 = {0.f, 0.f, 0.f, 0.f}, cb1 = cb0, cb2 = cb0, cb3 = cb0, cb4 = cb0, cb5 = cb0, cb6 = cb0, cb7 = cb0;
    const int bge = bgt >> 7, bgj = bgt & 127, bkg = l & 7, bng = w * 8 + (l >> 3);
    if (bgt >= 0) {
        const float* s_ = p.w2 + (size_t)bge * DFF * D + (size_t)((bgj >> 3) * 64 + 8 * bkg) * D + (bgj & 7) * 128 + 4 * bng;
        cb0 = *(const f32x4*)(s_); cb1 = *(const f32x4*)(s_ + D); cb2 = *(const f32x4*)(s_ + 2 * D); cb3 = *(const f32x4*)(s_ + 3 * D);
        cb4 = *(const f32x4*)(s_ + 4 * D); cb5 = *(const f32x4*)(s_ + 5 * D); cb6 = *(const f32x4*)(s_ + 6 * D); cb7 = *(const f32x4*)(s_ + 7 * D);
    }
#pragma unroll
    for (int i = 0; i < 6; ++i) {
        const int j = t + 256 * i, row = j >> 3, c = j & 7;
        const int ki = 64 * (qb - 1) + row;
        u32x4 kx = {0u, 0u, 0u, 0u}, vx = kx;
        if (ki >= 0 && ki < L) {
            const size_t base = (size_t)(b * S + res + (ki << dsh)) * PJW + h * 64 + c * 8;
            kx = *(const u32x4*)(p.proj + base + C_AK); vx = *(const u32x4*)(p.proj + base + C_AV);
        }
        *(u32x4*)(Ks + tile_off(row, c)) = kx;
        *(u32x4*)(Vs + row * 160 + c * 16) = vx;
    }
    { u32x4 zz = {0u, 0u, 0u, 0u}; asm volatile("" : "+v"(zz));
      if (t < 160) *(u32x4*)(Vs + 192 * 160 + t * 16) = zz; else if (t < 224) { *(u32x4*)(Ks + 192 * 128 + (t - 160) * 16) = zz; *(u32x4*)(Ks + 192 * 128 + (t - 96) * 16) = zz; } }
#pragma unroll
    for (int i = 0; i < 2; ++i) { const int j = t + 256 * i, row = j >> 3, c = j & 7;
        *(u32x4*)(Qs + tile_off(row, c)) = *(const u32x4*)(p.proj + (size_t)(b * S + res + ((64 * qb + row) << dsh)) * PJW + C_AQ + h * 64 + c * 8); }
#pragma unroll
    for (int i = 0; i < 3; ++i) { const int en = t + 256 * i; if (en < 704) biasf[en] = R.tb[i]; }
    __syncthreads();
    if (nit >= 0) attn_load(p, t, nit, R);

    const bf16x8 qf0 = lds_frag(Qs, 16 * w + i16, g), qf1 = lds_frag(Qs, 16 * w + i16, 4 + g);
    const char* Kw = Ks + 16 * w * 128;
    f32x4 sc[10];
#pragma unroll
    for (int i = 0; i < 10; ++i) {
        const bf16x8 k0 = lds_frag(Kw, 16 * i + i16, g), k1 = lds_frag(Kw, 16 * i + i16, 4 + g);
        f32x4 a = {0.f, 0.f, 0.f, 0.f};
        a = __builtin_amdgcn_mfma_f32_16x16x32_bf16(k0, qf0, a, 0, 0, 0);
        a = __builtin_amdgcn_mfma_f32_16x16x32_bf16(k1, qf1, a, 0, 0, 0);
        sc[i] = a;
    }
    const int sq = 16 * w + i16;
    const float* tabc = biasf + (i16 & 3) * 176 + 4 * g - 4 * (i16 >> 2) + 16;
    float mx = -3.0e38f;
#pragma unroll
    for (int i = 0; i < 10; ++i) {
        const f32x4 b4 = *(const f32x4*)(tabc + 16 * i);
#pragma unroll
        for (int r = 0; r < 4; ++r) sc[i][r] = fmaf(sc[i][r], 0.125f * 1.44269504f, b4[r]);
    }
    if (qb == 0 || qb == nbl - 1) {
        const int lo = (qb == 0) ? 64 : 0, hi = (qb == nbl - 1) ? 128 : 192;
#pragma unroll
        for (int i = 0; i < 10; ++i)
#pragma unroll
            for (int r = 0; r < 4; ++r) { const int tk = 16 * (w + i) + 4 * g + r; sc[i][r] = (tk >= lo && tk < hi) ? sc[i][r] : -1.0e30f; }
    }
#pragma unroll
    for (int i = 0; i < 10; ++i) mx = fmaxf(mx, fmaxf(fmaxf(sc[i][0], sc[i][1]), fmaxf(sc[i][2], sc[i][3])));
    mx = fmaxf(mx, swz_xor<16>(mx)); mx = half_max(mx);
    float ls = 0.f;
#pragma unroll
    for (int i = 0; i < 10; ++i) {
#pragma unroll
        for (int r = 0; r < 4; ++r) { const float e = __builtin_amdgcn_exp2f(sc[i][r] - mx); sc[i][r] = e; ls += e; }
    }
    ls += swz_xor<16>(ls); ls = half_sum(ls);

    f32x4 oa[4];
#pragma unroll
    for (int e = 0; e < 4; ++e) oa[e] = (f32x4){0.f, 0.f, 0.f, 0.f};
    const char* Vw = Vs + (16 * w + 4 * g + (i16 >> 2)) * 160 + 4 * (i16 & 3) * 2;
#pragma unroll
    for (int i2 = 0; i2 < 5; ++i2) {
        uint4 pu;
        pu.x = pack2(sc[2 * i2][0], sc[2 * i2][1]); pu.y = pack2(sc[2 * i2][2], sc[2 * i2][3]);
        pu.z = pack2(sc[2 * i2 + 1][0], sc[2 * i2 + 1][1]); pu.w = pack2(sc[2 * i2 + 1][2], sc[2 * i2 + 1][3]);
        const bf16x8 pf = __builtin_bit_cast(bf16x8, pu);
#pragma unroll
        for (int et = 0; et < 4; ++et) {
            const s16x4 va = tr_read(Vw + (32 * i2) * 160 + et * 32);
            const s16x4 vb = tr_read(Vw + (32 * i2 + 16) * 160 + et * 32);
            oa[et] = __builtin_amdgcn_mfma_f32_16x16x32_bf16(cat4(va, vb), pf, oa[et], 0, 0, 0);
        }
    }
    const float inv = 1.0f / ls;
    const size_t tok = (size_t)b * S + res + ((64 * qb + sq) << dsh);
#pragma unroll
    for (int et = 0; et < 4; ++et) {
        uint2 o; o.x = pack2(oa[et][0] * inv, oa[et][1] * inv); o.y = pack2(oa[et][2] * inv, oa[et][3] * inv);
        *(uint2*)(p.abr + ((size_t)br * T + tok) * 512 + h * 64 + 16 * et + 4 * g) = o;
    }
    if (g == 0) p.lse[((size_t)br * T + tok) * 8 + h] = (mx + __log2f(ls)) * 0.69314718f;
    if (bgt >= 0) {
        unsigned char* d_ = p.w2T8 + (size_t)bge * D * DFF + (size_t)((bgj & 7) * 128 + 4 * bng) * 1024 + (bgj >> 3) * 64 + 8 * bkg;
#pragma unroll
        for (int c_ = 0; c_ < 4; ++c_) {
            int lo_ = __builtin_amdgcn_cvt_pk_fp8_f32(cb0[c_] * 32.0f, cb1[c_] * 32.0f, 0, false); lo_ = __builtin_amdgcn_cvt_pk_fp8_f32(cb2[c_] * 32.0f, cb3[c_] * 32.0f, lo_, true);
            int hi_ = __builtin_amdgcn_cvt_pk_fp8_f32(cb4[c_] * 32.0f, cb5[c_] * 32.0f, 0, false); hi_ = __builtin_amdgcn_cvt_pk_fp8_f32(cb6[c_] * 32.0f, cb7[c_] * 32.0f, hi_, true);
            uint2 q_; q_.x = (unsigned)lo_; q_.y = (unsigned)hi_; *(uint2*)(d_ + c_ * 1024) = q_;
        }
    }
}

constexpr int GL_ZS = 0, GL_TOT = 8192, GL_GG = 10240, GL_BF = 10752, GL_BS = 68, GL_BB = GL_BF + 64 * GL_BS * 4, GL_R2 = GL_BB + 64 * GL_BS * 4;
__device__ __forceinline__ float logsig_fast(float a) { return fminf(a, 0.f) - __logf(1.0f + __expf(-fabsf(a))); }
__device__ __forceinline__ void gla_prep(const Params& p, char* lds, int t, int h) {
    const int d = t & 63, w = t >> 6;
    float* zs = (float*)(lds + GL_ZS); float* tot = (float*)(lds + GL_TOT); float* GG = (float*)(lds + GL_GG);
    float* BF = (float*)(lds + GL_BF); float* BB = (float*)(lds + GL_BB);
    float wf[16], wb[16];
#pragma unroll
    for (int r = 0; r < 16; ++r) { wf[r] = p.wgf[r * 256 + h * 64 + d]; wb[r] = p.wgb[r * 256 + h * 64 + d]; }
    const float biasf = p.bgf[h * 64 + d], biasb = p.bgb[h * 64 + d];
    __syncthreads();
    float bfv[16], bbv[16];
#pragma unroll
    for (int i = 0; i < 16; ++i) {
        const float4* zr = (const float4*)(zs + (16 * w + i) * 32);
        float af = biasf, ab = biasb;
#pragma unroll
        for (int r4 = 0; r4 < 4; ++r4) {
            const float4 zf = zr[r4], zb = zr[4 + r4];
            af = fmaf(zf.x, wf[4 * r4], af); af = fmaf(zf.y, wf[4 * r4 + 1], af); af = fmaf(zf.z, wf[4 * r4 + 2], af); af = fmaf(zf.w, wf[4 * r4 + 3], af);
            ab = fmaf(zb.x, wb[4 * r4], ab); ab = fmaf(zb.y, wb[4 * r4 + 1], ab); ab = fmaf(zb.z, wb[4 * r4 + 2], ab); ab = fmaf(zb.w, wb[4 * r4 + 3], ab);
        }
        bfv[i] = logsig_fast(af) * (1.0f / 16.0f); bbv[i] = logsig_fast(ab) * (1.0f / 16.0f);
    }
#pragma unroll
    for (int i = 1; i < 16; ++i) bfv[i] += bfv[i - 1];
#pragma unroll
    for (int i = 14; i >= 0; --i) bbv[i] += bbv[i + 1];
    tot[(0 * 4 + w) * 64 + d] = bfv[15];
    tot[(1 * 4 + w) * 64 + d] = bbv[0];
    __syncthreads();
    float offf = 0.f, offb = 0.f, Gf = 0.f, Gb = 0.f;
#pragma unroll
    for (int ww = 0; ww < 4; ++ww) {
        const float a = tot[(0 * 4 + ww) * 64 + d], c = tot[(1 * 4 + ww) * 64 + d];
        Gf += a; Gb += c;
        if (ww < w) offf += a;
        if (ww > w) offb += c;
    }
#pragma unroll
    for (int i = 0; i < 16; ++i) { BF[(16 * w + i) * GL_BS + d] = bfv[i] + offf; BB[(16 * w + i) * GL_BS + d] = bbv[i] + offb; }
    if (w == 0) { GG[d] = Gf; GG[64 + d] = Gb; }
    __syncthreads();
}
__device__ __forceinline__ void unpack8(const uint4 u, float (&f)[8]) {
    f[0] = lo2f(u.x); f[1] = hi2f(u.x); f[2] = lo2f(u.y); f[3] = hi2f(u.y); f[4] = lo2f(u.z); f[5] = hi2f(u.z); f[6] = lo2f(u.w); f[7] = hi2f(u.w);
}
__device__ __forceinline__ uint4 pack8(const float (&f)[8]) { uint4 u; u.x = pack2(f[0], f[1]); u.y = pack2(f[2], f[3]); u.z = pack2(f[4], f[5]); u.w = pack2(f[6], f[7]); return u; }

constexpr int GD_KF = GL_R2, GD_KB = GD_KF + 64 * 160, GD_VT = GL_BF;
__device__ void gla_ds_item(const Params& p, char* lds, int t, int it) {
    const int l = t & 63, w = t >> 6, i16 = l & 15, g = l >> 4;
    const int n = it & 63, h = (it >> 6) & 3, b = it >> 8;
    const int t0 = b * S + n * 64;
    float* zs = (float*)(lds + GL_ZS);
    const int sr = t >> 2, sc = t & 3;
    const u16* kp = p.proj + (size_t)(t0 + sr) * PJW + C_GK + h * 64 + sc * 16;
    const uint4 kr0 = *(const uint4*)(kp), kr1 = *(const uint4*)(kp + 8);
    u32x4 vr[4];
#pragma unroll
    for (int i = 0; i < 4; ++i) { const int j = t + 256 * i; vr[i] = *(const u32x4*)(p.proj + (size_t)(t0 + (j >> 4)) * PJW + C_GV + h * 128 + (j & 15) * 8); }
    const float4* zsrc = (const float4*)(p.zbuf + (size_t)t0 * 32);
    const float4 zv0 = zsrc[t], zv1 = zsrc[t + 256];
    __syncthreads();
    ((float4*)zs)[t] = zv0; ((float4*)zs)[t + 256] = zv1;
    gla_prep(p, lds, t, h);
    const float* BF = (const float*)(lds + GL_BF); const float* BB = (const float*)(lds + GL_BB); const float* GG = (const float*)(lds + GL_GG);
    char* KF = lds + GD_KF; char* KB = lds + GD_KB; char* VT = lds + GD_VT;
    {
        float kk[16];
        { float tmp[8]; unpack8(kr0, tmp);
#pragma unroll
          for (int j = 0; j < 8; ++j) kk[j] = tmp[j];
          unpack8(kr1, tmp);
#pragma unroll
          for (int j = 0; j < 8; ++j) kk[8 + j] = tmp[j]; }
        float of[16], ob[16];
#pragma unroll
        for (int q = 0; q < 4; ++q) {
            const float4 bf4 = *(const float4*)(BF + sr * GL_BS + sc * 16 + 4 * q), bb4 = *(const float4*)(BB + sr * GL_BS + sc * 16 + 4 * q);
            const float4 gf4 = *(const float4*)(GG + sc * 16 + 4 * q), gb4 = *(const float4*)(GG + 64 + sc * 16 + 4 * q);
            of[4 * q + 0] = kk[4 * q + 0] * __expf(gf4.x - bf4.x); of[4 * q + 1] = kk[4 * q + 1] * __expf(gf4.y - bf4.y);
            of[4 * q + 2] = kk[4 * q + 2] * __expf(gf4.z - bf4.z); of[4 * q + 3] = kk[4 * q + 3] * __expf(gf4.w - bf4.w);
            ob[4 * q + 0] = kk[4 * q + 0] * __expf(gb4.x - bb4.x); ob[4 * q + 1] = kk[4 * q + 1] * __expf(gb4.y - bb4.y);
            ob[4 * q + 2] = kk[4 * q + 2] * __expf(gb4.z - bb4.z); ob[4 * q + 3] = kk[4 * q + 3] * __expf(gb4.w - bb4.w);
        }
        uint4 u;
        u.x = pack2(of[0], of[1]); u.y = pack2(of[2], of[3]); u.z = pack2(of[4], of[5]); u.w = pack2(of[6], of[7]);
        *(uint4*)(KF + sr * 160 + sc * 32) = u;
        u.x = pack2(of[8], of[9]); u.y = pack2(of[10], of[11]); u.z = pack2(of[12], of[13]); u.w = pack2(of[14], of[15]);
        *(uint4*)(KF + sr * 160 + sc * 32 + 16) = u;
        u.x = pack2(ob[0], ob[1]); u.y = pack2(ob[2], ob[3]); u.z = pack2(ob[4], ob[5]); u.w = pack2(ob[6], ob[7]);
        *(uint4*)(KB + sr * 160 + sc * 32) = u;
        u.x = pack2(ob[8], ob[9]); u.y = pack2(ob[10], ob[11]); u.z = pack2(ob[12], ob[13]); u.w = pack2(ob[14], ob[15]);
        *(uint4*)(KB + sr * 160 + sc * 32 + 16) = u;
        if (t < 64) { p.dec[((size_t)it * 2 + 0) * 64 + t] = __expf(GG[t]); p.dec[((size_t)it * 2 + 1) * 64 + t] = __expf(GG[64 + t]); }
    }
    __syncthreads();
#pragma unroll
    for (int i = 0; i < 4; ++i) { const int j = t + 256 * i; *(u32x4*)(VT + (j >> 4) * 288 + (j & 15) * 16) = vr[i]; }
    __syncthreads();
#pragma unroll
    for (int dir = 0; dir < 2; ++dir) {
        const char* KX = dir ? KB : KF;
        f32x4 acc[2][4];
#pragma unroll
        for (int a = 0; a < 2; ++a)
#pragma unroll
            for (int c = 0; c < 4; ++c) acc[a][c] = (f32x4){0.f, 0.f, 0.f, 0.f};
#pragma unroll
        for (int ks = 0; ks < 2; ++ks) {
            const int r0 = ks * 32 + 8 * g + (i16 >> 2);
            bf16x8 vf[2], kf[4];
#pragma unroll
            for (int a = 0; a < 2; ++a) {
                const int e0 = 16 * (2 * w + a) + 4 * (i16 & 3);
                vf[a] = cat4(tr_read(VT + r0 * 288 + e0 * 2), tr_read(VT + (r0 + 4) * 288 + e0 * 2));
            }
#pragma unroll
            for (int c = 0; c < 4; ++c) {
                const int d0 = 16 * c + 4 * (i16 & 3);
                kf[c] = cat4(tr_read(KX + r0 * 160 + d0 * 2), tr_read(KX + (r0 + 4) * 160 + d0 * 2));
            }
#pragma unroll
            for (int a = 0; a < 2; ++a)
#pragma unroll
                for (int c = 0; c < 4; ++c) acc[a][c] = __builtin_amdgcn_mfma_f32_16x16x32_bf16(kf[c], vf[a], acc[a][c], 0, 0, 0);
        }
        float* dst = p.dS + ((size_t)it * 2 + dir) * 128 * 64;
#pragma unroll
        for (int a = 0; a < 2; ++a)
#pragma unroll
            for (int c = 0; c < 4; ++c) *(f32x4*)(dst + (16 * (2 * w + a) + i16) * 64 + 16 * c + 4 * g) = acc[a][c];
    }
}

__device__ void gla_scan_thread2(const Params& p, int gid) {
    const int d = gid & 63, e = (gid >> 6) & 127, dir = (gid >> 13) & 1, bh0 = gid >> 14, bh1 = bh0 + 8;
    float s0 = 0.f, s1 = 0.f;
#pragma unroll 8
    for (int step = 0; step < 64; ++step) {
        const int n = dir ? (63 - step) : step;
        const size_t i0 = ((size_t)(bh0 * 64 + n)) * 2 + dir, i1 = ((size_t)(bh1 * 64 + n)) * 2 + dir;
        const float dc0 = p.dec[i0 * 64 + d], ds0 = p.dS[(i0 * 128 + e) * 64 + d];
        const float dc1 = p.dec[i1 * 64 + d], ds1 = p.dS[(i1 * 128 + e) * 64 + d];
        p.Sp[(i0 * 128 + e) * 64 + d] = f2bf(s0);
        p.Sp[(i1 * 128 + e) * 64 + d] = f2bf(s1);
        s0 = fmaf(dc0, s0, ds0); s1 = fmaf(dc1, s1, ds1);
    }
}

__device__ void attn_combine_thread(const Params& p, int gid) {
    const int tok = gid >> 6, c = gid & 63, h = c >> 3;
    const float l0 = p.lse[((size_t)0 * T + tok) * 8 + h], l1 = p.lse[((size_t)1 * T + tok) * 8 + h], l2 = p.lse[((size_t)2 * T + tok) * 8 + h];
    const float mm = fmaxf(l0, fmaxf(l1, l2));
    float w0 = __expf(l0 - mm), w1 = __expf(l1 - mm), w2 = __expf(l2 - mm);
    const float inv = 1.0f / (w0 + w1 + w2);
    w0 *= inv; w1 *= inv; w2 *= inv;
    const uint4 a0 = *(const uint4*)(p.abr + ((size_t)0 * T + tok) * 512 + c * 8);
    const uint4 a1 = *(const uint4*)(p.abr + ((size_t)1 * T + tok) * 512 + c * 8);
    const uint4 a2 = *(const uint4*)(p.abr + ((size_t)2 * T + tok) * 512 + c * 8);
    uint4 o;
    o.x = pack2(w0 * lo2f(a0.x) + w1 * lo2f(a1.x) + w2 * lo2f(a2.x), w0 * hi2f(a0.x) + w1 * hi2f(a1.x) + w2 * hi2f(a2.x));
    o.y = pack2(w0 * lo2f(a0.y) + w1 * lo2f(a1.y) + w2 * lo2f(a2.y), w0 * hi2f(a0.y) + w1 * hi2f(a1.y) + w2 * hi2f(a2.y));
    o.z = pack2(w0 * lo2f(a0.z) + w1 * lo2f(a1.z) + w2 * lo2f(a2.z), w0 * hi2f(a0.z) + w1 * hi2f(a1.z) + w2 * hi2f(a2.z));
    o.w = pack2(w0 * lo2f(a0.w) + w1 * lo2f(a1.w) + w2 * lo2f(a2.w), w0 * hi2f(a0.w) + w1 * hi2f(a1.w) + w2 * hi2f(a2.w));
    *(uint4*)(p.mix + (size_t)tok * D + c * 8) = o;
}

constexpr int GO_QF = GL_R2, GO_QB = GO_QF + 8192, GO_KF = GO_QB + 8192, GO_KB = GO_KF + 8192, GO_VT = GL_R2, GO_AM = GL_ZS, GO_SF = GL_BF, GO_SB = GL_BF + 16384;
__device__ void gla_out_item(const Params& p, char* lds, int t, int it) {
    const int l = t & 63, w = t >> 6, i16 = l & 15, g = l >> 4;
    const int n = it & 63, h = (it >> 6) & 3, b = it >> 8;
    const int t0 = b * S + n * 64;
    float* zs = (float*)(lds + GL_ZS);
    const int sr = t >> 2, sc = t & 3;
    const float4* zsrc = (const float4*)(p.zbuf + (size_t)t0 * 32);
    const float4 zv0 = zsrc[t], zv1 = zsrc[t + 256];
    const u16* qp = p.proj + (size_t)(t0 + sr) * PJW + C_GQ + h * 64 + sc * 16;
    const u16* kp = p.proj + (size_t)(t0 + sr) * PJW + C_GK + h * 64 + sc * 16;
    const uint4 qr0 = *(const uint4*)(qp), qr1 = *(const uint4*)(qp + 8), kr0 = *(const uint4*)(kp), kr1 = *(const uint4*)(kp + 8);
    u32x4 vr[4], sv[8];
#pragma unroll
    for (int i = 0; i < 4; ++i) { const int j = t + 256 * i; vr[i] = *(const u32x4*)(p.proj + (size_t)(t0 + (j >> 4)) * PJW + C_GV + h * 128 + (j & 15) * 8); }
    const u16* SPG = p.Sp + (size_t)it * 2 * 128 * 64;
    __syncthreads();
    ((float4*)zs)[t] = zv0; ((float4*)zs)[t + 256] = zv1;
    gla_prep(p, lds, t, h);
#pragma unroll
    for (int i = 0; i < 8; ++i) { const int j = t + 256 * i; sv[i] = *(const u32x4*)(SPG + (size_t)j * 8); }
    const float* BF = (const float*)(lds + GL_BF); const float* BB = (const float*)(lds + GL_BB);
    char* QF = lds + GO_QF; char* QB = lds + GO_QB; char* KF = lds + GO_KF; char* KB = lds + GO_KB; char* VT = lds + GO_VT; char* AM = lds + GO_AM;
    char* SF = lds + GO_SF; char* SB = lds + GO_SB;
    {
        float qq[16], kk[16];
        { float tmp[8];
          unpack8(qr0, tmp);
#pragma unroll
          for (int j = 0; j < 8; ++j) qq[j] = tmp[j] * 0.125f;
          unpack8(qr1, tmp);
#pragma unroll
          for (int j = 0; j < 8; ++j) qq[8 + j] = tmp[j] * 0.125f;
          unpack8(kr0, tmp);
#pragma unroll
          for (int j = 0; j < 8; ++j) kk[j] = tmp[j];
          unpack8(kr1, tmp);
#pragma unroll
          for (int j = 0; j < 8; ++j) kk[8 + j] = tmp[j]; }
        float ef[16], eb[16];
#pragma unroll
        for (int q = 0; q < 4; ++q) {
            const float4 bf4 = *(const float4*)(BF + sr * GL_BS + sc * 16 + 4 * q), bb4 = *(const float4*)(BB + sr * GL_BS + sc * 16 + 4 * q);
            ef[4 * q + 0] = __expf(bf4.x); ef[4 * q + 1] = __expf(bf4.y); ef[4 * q + 2] = __expf(bf4.z); ef[4 * q + 3] = __expf(bf4.w);
            eb[4 * q + 0] = __expf(bb4.x); eb[4 * q + 1] = __expf(bb4.y); eb[4 * q + 2] = __expf(bb4.z); eb[4 * q + 3] = __expf(bb4.w);
        }
        float o8[8];
#pragma unroll
        for (int hh = 0; hh < 2; ++hh) {
            const int off = tile_off(sr, 2 * sc + hh);
#pragma unroll
            for (int j = 0; j < 8; ++j) o8[j] = qq[8 * hh + j] * ef[8 * hh + j];
            *(uint4*)(QF + off) = pack8(o8);
#pragma unroll
            for (int j = 0; j < 8; ++j) o8[j] = kk[8 * hh + j] / ef[8 * hh + j];
            *(uint4*)(KF + off) = pack8(o8);
#pragma unroll
            for (int j = 0; j < 8; ++j) o8[j] = qq[8 * hh + j] * eb[8 * hh + j];
            *(uint4*)(QB + off) = pack8(o8);
#pragma unroll
            for (int j = 0; j < 8; ++j) o8[j] = kk[8 * hh + j] / eb[8 * hh + j];
            *(uint4*)(KB + off) = pack8(o8);
        }
    }
    __syncthreads();
#pragma unroll
    for (int i = 0; i < 8; ++i) { const int j = t + 256 * i; *(u32x4*)((j >> 10 ? SB : SF) + tile_off((j >> 3) & 127, j & 7)) = sv[i]; }
    const int cq = 16 * w + i16;
    const bf16x8 qf0 = lds_frag(QF, cq, g), qf1 = lds_frag(QF, cq, 4 + g);
    const bf16x8 qb0 = lds_frag(QB, cq, g), qb1 = lds_frag(QB, cq, 4 + g);
    uint2 amo[4];
#pragma unroll
    for (int st = 0; st < 4; ++st) {
        f32x4 af = {0.f, 0.f, 0.f, 0.f}, ab = {0.f, 0.f, 0.f, 0.f};
        af = __builtin_amdgcn_mfma_f32_16x16x32_bf16(lds_frag(KF, 16 * st + i16, g), qf0, af, 0, 0, 0);
        af = __builtin_amdgcn_mfma_f32_16x16x32_bf16(lds_frag(KF, 16 * st + i16, 4 + g), qf1, af, 0, 0, 0);
        ab = __builtin_amdgcn_mfma_f32_16x16x32_bf16(lds_frag(KB, 16 * st + i16, g), qb0, ab, 0, 0, 0);
        ab = __builtin_amdgcn_mfma_f32_16x16x32_bf16(lds_frag(KB, 16 * st + i16, 4 + g), qb1, ab, 0, 0, 0);
        float am[4];
#pragma unroll
        for (int r = 0; r < 4; ++r) {
            const int s = 16 * st + 4 * g + r;
            am[r] = (s <= cq ? af[r] : 0.f) + (s >= cq ? ab[r] : 0.f);
        }
        amo[st].x = pack2(am[0], am[1]); amo[st].y = pack2(am[2], am[3]);
    }
#pragma unroll
    for (int st = 0; st < 4; ++st) { const int s0 = 16 * st + 4 * g; *(uint2*)(AM + tile_off(cq, s0 >> 3) + (s0 & 7) * 2) = amo[st]; }
    __syncthreads();
#pragma unroll
    for (int i = 0; i < 4; ++i) { const int j = t + 256 * i; *(u32x4*)(VT + (j >> 4) * 288 + (j & 15) * 16) = vr[i]; }
    __syncthreads();
    f32x4 oc[8];
#pragma unroll
    for (int et = 0; et < 8; ++et) oc[et] = (f32x4){0.f, 0.f, 0.f, 0.f};
#pragma unroll
    for (int ks = 0; ks < 2; ++ks) {
        const bf16x8 amf = lds_frag(AM, cq, ks * 4 + g);
        const bf16x8 qff = ks ? qf1 : qf0, qbf = ks ? qb1 : qb0;
        const int r0 = ks * 32 + 8 * g + (i16 >> 2);
#pragma unroll
        for (int et = 0; et < 8; ++et) {
            const int e0 = 16 * et + 4 * (i16 & 3);
            const bf16x8 vf = cat4(tr_read(VT + r0 * 288 + e0 * 2), tr_read(VT + (r0 + 4) * 288 + e0 * 2));
            oc[et] = __builtin_amdgcn_mfma_f32_16x16x32_bf16(vf, amf, oc[et], 0, 0, 0);
            oc[et] = __builtin_amdgcn_mfma_f32_16x16x32_bf16(lds_frag(SF, 16 * et + i16, ks * 4 + g), qff, oc[et], 0, 0, 0);
            oc[et] = __builtin_amdgcn_mfma_f32_16x16x32_bf16(lds_frag(SB, 16 * et + i16, ks * 4 + g), qbf, oc[et], 0, 0, 0);
        }
    }
    float ss = 0.f;
#pragma unroll
    for (int et = 0; et < 8; ++et)
#pragma unroll
        for (int r = 0; r < 4; ++r) ss += oc[et][r] * oc[et][r];
    ss += swz_xor<16>(ss); ss = half_sum(ss);
    const float rstd = rsqrtf(ss * (1.0f / 128.0f) + EPS);
    const size_t tok = (size_t)t0 + cq;
#pragma unroll
    for (int et = 0; et < 8; ++et) {
        const int e = 16 * et + 4 * g;
        const uint2 gg = *(const uint2*)(p.proj + tok * PJW + C_GO + h * 128 + e);
        const float4 ng = *(const float4*)(p.gla_ng + h * 128 + e);
        const float g0 = lo2f(gg.x), g1 = hi2f(gg.x), g2 = lo2f(gg.y), g3 = hi2f(gg.y);
        uint2 o;
        o.x = pack2(oc[et][0] * rstd * ng.x * (g0 / (1.0f + __expf(-g0))), oc[et][1] * rstd * ng.y * (g1 / (1.0f + __expf(-g1))));
        o.y = pack2(oc[et][2] * rstd * ng.z * (g2 / (1.0f + __expf(-g2))), oc[et][3] * rstd * ng.w * (g3 / (1.0f + __expf(-g3))));
        *(uint2*)(p.mix + tok * D + 512 + h * 128 + e) = o;
    }
}

constexpr int RT_RS = 1028;
constexpr int RT_XS = 0, RT_PART = 16 * RT_RS * 4, RT_PE = RT_PART + 4 * 16 * 32 * 4 + 512, RT_RANK = RT_PE + 1024, RT_HIST = RT_RANK + 1024, RT_BASE = RT_HIST + 128;
__device__ void ph_route(const Params& p, char* ldsall) {
    const int tid = tid_opaque(), t = tid & 255, half = tid >> 8, lane = t & 63, w = t >> 6;
    char* lds = ldsall + half * HALF_LDS;
    const int vb = blockIdx.x * 2 + half, nvb = gridDim.x * 2;
    float* xs = (float*)(lds + RT_XS); float* part = (float*)(lds + RT_PART);
    int* pe = (int*)(lds + RT_PE); int* rank = (int*)(lds + RT_RANK); int* hist = (int*)(lds + RT_HIST); int* base = (int*)(lds + RT_BASE);
    const int ngr = (T / 16 + nvb - 1) / nvb;
    for (int gl = 0; gl < ngr; ++gl) {
        const int gi = vb + gl * nvb;
        const bool live = gi < T / 16;
        const int tok0 = (live ? gi : 0) * 16;
        __syncthreads();
#pragma unroll
        for (int th = 0; th < 2; ++th) {
            f32x4 v[2][4];
#pragma unroll
            for (int tt = 0; tt < 2; ++tt) {
                const f32x4* xr = (const f32x4*)(p.x1 + (size_t)(tok0 + 4 * w + 2 * th + tt) * D);
#pragma unroll
                for (int i = 0; i < 4; ++i) v[tt][i] = xr[lane + 64 * i];
            }
#pragma unroll
            for (int tt = 0; tt < 2; ++tt) {
                const int tl = 4 * w + 2 * th + tt, tok = tok0 + tl;
                float ss = 0.f;
#pragma unroll
                for (int i = 0; i < 4; ++i) ss += v[tt][i][0] * v[tt][i][0] + v[tt][i][1] * v[tt][i][1] + v[tt][i][2] * v[tt][i][2] + v[tt][i][3] * v[tt][i][3];
                ss = wave_sum(ss);
                const float r = rsqrtf(ss * (1.0f / D) + EPS);
#pragma unroll
                for (int i = 0; i < 4; ++i) {
                    const f32x4 gq = ((const f32x4*)p.g2)[lane + 64 * i];
                    const f32x4 yv = v[tt][i] * r * gq;
                    *(f32x4*)(xs + tl * RT_RS + (lane + 64 * i) * 4) = yv;
                    if (live) { int pk = __builtin_amdgcn_cvt_pk_fp8_f32(yv[0], yv[1], 0, false); pk = __builtin_amdgcn_cvt_pk_fp8_f32(yv[2], yv[3], pk, true); *(int*)(p.xn28 + (size_t)tok * D + (lane + 64 * i) * 4) = pk; }
                }
            }
        }
        __syncthreads();
        {
            const int i16 = lane & 15, kq = lane >> 4;
            const float* xa = xs + i16 * RT_RS + 256 * w + 64 * kq;
            const float* rwp = p.rw + (size_t)(256 * w + 64 * kq) * 32 + i16;
            f32x4 a0 = {0.f, 0.f, 0.f, 0.f}, a1 = {0.f, 0.f, 0.f, 0.f};
            f32x4 bqA[8];
#define RT_LOADB(dst, b) do { _Pragma("unroll") for (int q = 0; q < 8; ++q) { \
                dst[q][0] = rwp[(size_t)((b) * 16 + 2 * q) * 32]; dst[q][1] = rwp[(size_t)((b) * 16 + 2 * q) * 32 + 16]; \
                dst[q][2] = rwp[(size_t)((b) * 16 + 2 * q + 1) * 32]; dst[q][3] = rwp[(size_t)((b) * 16 + 2 * q + 1) * 32 + 16]; } } while (0)
#define RT_MMA(src, b) do { _Pragma("unroll") for (int s4 = 0; s4 < 4; ++s4) { const float4 av = *(const float4*)(xa + 16 * (b) + 4 * s4); \
                a0 = __builtin_amdgcn_mfma_f32_16x16x4f32(av.x, src[2 * s4][0], a0, 0, 0, 0); a1 = __builtin_amdgcn_mfma_f32_16x16x4f32(av.x, src[2 * s4][1], a1, 0, 0, 0); \
                a0 = __builtin_amdgcn_mfma_f32_16x16x4f32(av.y, src[2 * s4][2], a0, 0, 0, 0); a1 = __builtin_amdgcn_mfma_f32_16x16x4f32(av.y, src[2 * s4][3], a1, 0, 0, 0); \
                a0 = __builtin_amdgcn_mfma_f32_16x16x4f32(av.z, src[2 * s4 + 1][0], a0, 0, 0, 0); a1 = __builtin_amdgcn_mfma_f32_16x16x4f32(av.z, src[2 * s4 + 1][1], a1, 0, 0, 0); \
                a0 = __builtin_amdgcn_mfma_f32_16x16x4f32(av.w, src[2 * s4 + 1][2], a0, 0, 0, 0); a1 = __builtin_amdgcn_mfma_f32_16x16x4f32(av.w, src[2 * s4 + 1][3], a1, 0, 0, 0); } } while (0)
#pragma unroll
            for (int b = 0; b < 4; ++b) {
                RT_LOADB(bqA, b);
                __builtin_amdgcn_sched_barrier(0);
                RT_MMA(bqA, b);
                __builtin_amdgcn_sched_barrier(0);
            }
#undef RT_LOADB
#undef RT_MMA
#pragma unroll
            for (int r = 0; r < 4; ++r) { part[(w * 16 + 4 * kq + r) * 32 + i16] = a0[r]; part[(w * 16 + 4 * kq + r) * 32 + 16 + i16] = a1[r]; }
        }
        __syncthreads();
#pragma unroll
        for (int ro = 0; ro < 2; ++ro) {
            const int tk = 4 * w + 2 * ro + (lane >> 5), e = lane & 31;
            float v = p.rb[e] + ((part[(0 * 16 + tk) * 32 + e] + part[(1 * 16 + tk) * 32 + e]) + (part[(2 * 16 + tk) * 32 + e] + part[(3 * 16 + tk) * 32 + e]));
            int rk = 0;
#pragma unroll
            for (int j = 0; j < 64; ++j) {
                const float bj = __builtin_bit_cast(float, __builtin_amdgcn_readlane(__builtin_bit_cast(int, v), j));
                if ((j >> 5) == (lane >> 5)) rk += (bj > v || (bj == v && (j & 31) < e)) ? 1 : 0;
            }
            float* selv = part + 2048 + (w * 2 + (lane >> 5)) * 8;
            if (rk < 4) { selv[rk] = v; selv[4 + rk] = __builtin_bit_cast(float, e); }
            __builtin_amdgcn_s_waitcnt(0xc07f);
            __builtin_amdgcn_wave_barrier();
            const float b0 = selv[0], b1 = selv[1], b2 = selv[2], b3 = selv[3];
            const float e1 = expf(b1 - b0), e2 = expf(b2 - b0), e3 = expf(b3 - b0);
            const float inv = 1.0f / (1.0f + e1 + e2 + e3);
            if (e < 4) {
                const int sel = __builtin_bit_cast(int, selv[4 + e]);
                const float gs = (e == 0) ? inv : (e == 1) ? e1 * inv : (e == 2) ? e2 * inv : e3 * inv;
                pe[gl * 64 + tk * 4 + e] = live ? (sel & 31) : -1;
                if (live) p.gate[(size_t)(tok0 + tk) * 4 + e] = gs;
            }
            __builtin_amdgcn_wave_barrier();
        }
    }
    __syncthreads();
    if (t < 32) hist[t] = 0;
    __syncthreads();
    for (int i = t; i < ngr * 64; i += 256) { const int e = pe[i]; if (e >= 0) rank[i] = atomicAdd(&hist[e], 1); }
    __syncthreads();
    if (t < 32) { const int c = hist[t]; base[t] = c ? atomicAdd(&p.counts[t], c) : 0; }
    __syncthreads();
    for (int i = t; i < ngr * 64; i += 256) {
        const int e = pe[i];
        if (e >= 0) { const int gl = i >> 6, gi = vb + gl * nvb; const int slot = (gi * 16 + ((i >> 2) & 15)) * 4 + (i & 3); p.lists[e * T + base[e] + rank[i]] = slot; }
    }
}

__device__ void ph_final(const Params& p) {
    const int tid = tid_opaque(), lane = tid & 63, gw = blockIdx.x * 8 + (tid >> 6), nw = gridDim.x * 8;
    for (int tok = gw; tok < T; tok += nw) {
        float v[2][8]; float ss = 0.f;
#pragma unroll
        for (int i = 0; i < 2; ++i) {
            const int c = lane * 8 + 512 * i;
            const float4 xa = *(const float4*)(p.x1 + (size_t)tok * D + c), xb = *(const float4*)(p.x1 + (size_t)tok * D + c + 4);
            v[i][0] = xa.x; v[i][1] = xa.y; v[i][2] = xa.z; v[i][3] = xa.w; v[i][4] = xb.x; v[i][5] = xb.y; v[i][6] = xb.z; v[i][7] = xb.w;
#pragma unroll
            for (int k = 0; k < 4; ++k) {
                const uint2 yy = *(const uint2*)((const unsigned char*)p.y + ((size_t)tok * 4 + k) * D + c);
                const fv2 y01 = __builtin_amdgcn_cvt_pk_f32_fp8((int)yy.x, false), y23 = __builtin_amdgcn_cvt_pk_f32_fp8((int)yy.x, true);
                const fv2 y45 = __builtin_amdgcn_cvt_pk_f32_fp8((int)yy.y, false), y67 = __builtin_amdgcn_cvt_pk_f32_fp8((int)yy.y, true);
                v[i][0] += y01[0] * 0.0625f; v[i][1] += y01[1] * 0.0625f; v[i][2] += y23[0] * 0.0625f; v[i][3] += y23[1] * 0.0625f;
                v[i][4] += y45[0] * 0.0625f; v[i][5] += y45[1] * 0.0625f; v[i][6] += y67[0] * 0.0625f; v[i][7] += y67[1] * 0.0625f;
            }
#pragma unroll
            for (int j = 0; j < 8; ++j) ss += v[i][j] * v[i][j];
        }
        ss = wave_sum(ss);
        const float r = rsqrtf(ss * (1.0f / D) + EPS);
#pragma unroll
        for (int i = 0; i < 2; ++i) {
            const int c = lane * 8 + 512 * i;
            const float4 ga = *(const float4*)(p.gf + c), gb = *(const float4*)(p.gf + c + 4);
            float4 oa, ob;
            oa.x = v[i][0] * r * ga.x; oa.y = v[i][1] * r * ga.y; oa.z = v[i][2] * r * ga.z; oa.w = v[i][3] * r * ga.w;
            ob.x = v[i][4] * r * gb.x; ob.y = v[i][5] * r * gb.y; ob.z = v[i][6] * r * gb.z; ob.w = v[i][7] * r * gb.w;
            *(float4*)(p.out + (size_t)tok * D + c) = oa; *(float4*)(p.out + (size_t)tok * D + c + 4) = ob;
        }
    }
}

#define XB_TMO      128
#define XB_XCNT(j)  (256  + 64 * (j))
#define XB_XSUB(j)  (1280 + 64 * (j))
#define XB_XGEN(j)  (2304 + 64 * (j))
#define XB_TOP      3328
#define XB_TOPGEN   3392
#define XCD_BAR_WORDS 3456
#define XB_SPIN_CAP (1u << 22)
__device__ __forceinline__ unsigned xb_ld(unsigned* p)              { return __hip_atomic_load(p, __ATOMIC_RELAXED, __HIP_MEMORY_SCOPE_AGENT); }
__device__ __forceinline__ unsigned xb_add(unsigned* p, unsigned v) { return __hip_atomic_fetch_add(p, v, __ATOMIC_RELAXED, __HIP_MEMORY_SCOPE_AGENT); }
__device__ __forceinline__ unsigned xb_xcc_id() { return (unsigned)__builtin_amdgcn_s_getreg((3 << 11) | 20) & 0xFu; }
#define XB_SPIN(cond, bar) do { unsigned _sp = 0; while (cond) { __builtin_amdgcn_s_sleep(1); \
    if ((++_sp & 255u) == 0u) { if (xb_ld(&(bar)[XB_TMO])) break; if (_sp > XB_SPIN_CAP) { atomicAdd(&(bar)[XB_TMO], 1u); break; } } } } while (0)
struct XcdBarrier { unsigned* bar; unsigned x; volatile LDS_AS unsigned* st; };
__device__ __forceinline__ XcdBarrier xcd_barrier_post(unsigned* bar, volatile LDS_AS unsigned* st) {
    XcdBarrier b; b.bar = bar; b.x = xb_xcc_id(); b.st = st;
    if (threadIdx.x == 0) (void)xb_add(&bar[XB_XCNT(b.x)], 1u);
    return b;
}
__device__ __forceinline__ void xcd_barrier_complete(unsigned* bar, unsigned x, unsigned& nloc, unsigned& nx) {
    const unsigned G = gridDim.x * gridDim.y * gridDim.z;
    unsigned sum, cnt, mine, sp = 0u;
    for (;;) {
        sum = 0u; cnt = 0u; mine = 0u;
#pragma unroll
        for (unsigned j = 0; j < 16; ++j) { const unsigned c = xb_ld(&bar[XB_XCNT(j)]); sum += c; cnt += (c > 0u) ? 1u : 0u; mine = (j == x) ? c : mine; }
        if (sum == G) break;
        __builtin_amdgcn_s_sleep(1);
        if ((++sp & 255u) == 0u) { if (xb_ld(&bar[XB_TMO])) break; if (sp > XB_SPIN_CAP) { atomicAdd(&bar[XB_TMO], 1u); break; } }
    }
    nloc = mine > 0u ? mine : 1u; nx = cnt > 0u ? cnt : 1u;
}
__device__ __forceinline__ void xcd_barrier(const XcdBarrier& b) {
    asm volatile("s_waitcnt vmcnt(0)" ::: "memory");
    __syncthreads();
    if (threadIdx.x == 0) {
        unsigned* bar = b.bar;
        __builtin_amdgcn_s_waitcnt(0);
        unsigned nloc = b.st[0], nx = b.st[1];
        if (nloc == 0u) { xcd_barrier_complete(bar, b.x, nloc, nx); b.st[0] = nloc; b.st[1] = nx; }
        const unsigned old = xb_add(&bar[XB_XSUB(b.x)], 1u);
        const unsigned gen = old / nloc;
        if (old + 1u == (gen + 1u) * nloc) {
            __builtin_amdgcn_fence(__ATOMIC_RELEASE, "agent");
            asm volatile("s_waitcnt vmcnt(0)" ::: "memory");
            const unsigned og = xb_add(&bar[XB_TOP], 1u);
            const unsigned tg = og / nx;
            if (og + 1u == (tg + 1u) * nx) xb_add(&bar[XB_TOPGEN], 1u);
            else XB_SPIN(xb_ld(&bar[XB_TOPGEN]) == tg, bar);
            __builtin_amdgcn_fence(__ATOMIC_ACQUIRE, "agent");
            xb_add(&bar[XB_XGEN(b.x)], 1u);
            asm volatile("s_waitcnt vmcnt(0)" ::: "memory");
        } else {
            XB_SPIN(xb_ld(&bar[XB_XGEN(b.x)]) == gen, bar);
            __builtin_amdgcn_fence(__ATOMIC_ACQUIRE, "agent");
            asm volatile("s_waitcnt vmcnt(0)" ::: "memory");
        }
    }
    __syncthreads();
}


#if defined(FLUSHMASK)
__device__ void ph_flush(const Params& p) {
    const int tid = tid_opaque();
    const float4* src = (const float4*)p.w1;
    float acc = 0.f;
    for (size_t i = (size_t)blockIdx.x * 512 + tid; i < (size_t)NE * D * 2 * DFF / 4; i += (size_t)gridDim.x * 512) { const float4 v = src[i]; acc += v.x + v.y + v.z + v.w; }
    if (acc == 123.456f) p.out[0] = acc;
}
#endif
enum { PH_PRO = 0, PH_PROJ, PH_MIX1, PH_MIX2, PH_MIX3, PH_OUTPROJ, PH_ROUTE, PH_MOE1, PH_MOE2, PH_FINAL, PH_END };
constexpr int N_GLA_ITEMS = B * GH * 64, N_ATT_ITEMS = B * AH * 3 * 64;
constexpr int MO_META = LDS_BYTES - 1024;

__device__ __forceinline__ void moe_meta(const Params& p, int* meta) {
    __syncthreads();
    if (threadIdx.x == 0) {
        int mp = 0, rbse = 0;
        for (int e = 0; e < NE; ++e) {
            const int c = p.counts[e];
            meta[e] = c; meta[32 + e] = mp; meta[72 + e] = rbse;
            mp += (c + 255) >> 8; rbse += c;
        }
        meta[32 + NE] = mp; meta[72 + NE] = rbse;
    }
    __syncthreads();
}

constexpr int MO_TABA = 128 * 1024, MO_MAXU = 12;
template <class SchedT>
__device__ __forceinline__ void moe_tables(const Params& p, char* lds, const SchedT& S) {
    unsigned* tabA = (unsigned*)(lds + MO_TABA);
    const int tid = tid_opaque(), r = tid & 255;
    for (int i = tid >> 8; i < MO_MAXU; i += 2) {
        pg::Unit u;
        if (!S.next(i, u)) break;
        const int slot = p.lists[u.e * T + (u.row0 - S.meta[72 + u.e]) + min(r, u.nvalid - 1)];
        tabA[i * 256 + r] = (unsigned)(slot >> 2) * (unsigned)S.rowb;
    }
    __syncthreads();
}

typedef const __attribute__((address_space(4))) Params* KParams;
#if defined(__HIP_DEVICE_COMPILE__)
#define PHASE_PARAMS() KParams _kq = kp; asm volatile("" : "+s"(_kq)); const Params p = *_kq
#define KP_INIT() KParams kp = (KParams)__builtin_amdgcn_kernarg_segment_ptr(); const int ph_lo = kp->ph_lo, ph_hi = kp->ph_hi; unsigned* const barw = kp->bar
#else
#define PHASE_PARAMS() const Params p = p_unused
#define KP_INIT() const int ph_lo = p_unused.ph_lo, ph_hi = p_unused.ph_hi; unsigned* const barw = p_unused.bar
#endif
__global__ void __launch_bounds__(512, 2) mega(Params p_unused) {
    extern __shared__ __attribute__((aligned(16))) char lds[];
    KP_INIT();
    cg::grid_group grid = cg::this_grid();
    volatile LDS_AS unsigned* xst = (volatile LDS_AS unsigned*)(lds + LDS_BYTES - 16);
    if (threadIdx.x == 0) { xst[0] = 0u; xst[1] = 0u; }
    __syncthreads();
    const XcdBarrier xb = xcd_barrier_post(barw, xst);
    if (ph_hi > PH_END) grid.sync();
    for (int ph = ph_lo; ph < ph_hi; ++ph) {
      const int nrep = ((REPMASK >> ph) & 1) ? 2 : 1;
      for (int rep = 0; rep < nrep; ++rep) {
        if (rep) xcd_barrier(xb);
#if defined(ROUTE2)
        if (rep && ph == PH_ROUTE) { PHASE_PARAMS(); if (blockIdx.x == 0 && threadIdx.x < 32) p.counts[threadIdx.x] = 0; xcd_barrier(xb); }
#endif
#if defined(FLUSHMASK)
        if (rep && ((FLUSHMASK >> ph) & 1)) { PHASE_PARAMS(); ph_flush(p); xcd_barrier(xb); }
#if defined(FLUSHONLY)
        if (rep && ((FLUSHMASK >> ph) & 1)) continue;
#endif
#endif
        switch (ph) {
        case PH_PRO: { PHASE_PARAMS(); ph_prologue(p); } break;
        case PH_PROJ: {
            PHASE_PARAMS();
            const int G = gridDim.x, ng = G - NCONV;
            if ((int)blockIdx.x < ng) {
                pg::DenseSched S; S.init(p.xn, p.winT, T, PJW, ng, blockIdx.x);
                pg::EpiProj E{p.proj};
                pg::gemm_phase((LDS_AS unsigned char*)lds, S, E);
            } else {
                const int tid = tid_opaque(), t = tid & 255, st = NCONV * 2;
                const int l = t & 63, w = t >> 6, kg = l & 7, ngq = w * 8 + (l >> 3);
#define CV_DECL(X) f32x4 X##0 = {0.f, 0.f, 0.f, 0.f}, X##1 = X##0, X##2 = X##0, X##3 = X##0, X##4 = X##0, X##5 = X##0, X##6 = X##0, X##7 = X##0
#define CV_LOAD(X, i_) do { const int e_ = (i_) >> 8, j_ = (i_) & 255; const float* s_ = p.w1 + (size_t)e_ * D * 2 * DFF + (size_t)((j_ >> 4) * 64 + 8 * kg) * (2 * DFF) + (j_ & 15) * 128 + 4 * ngq; \
        X##0 = *(const f32x4*)(s_); X##1 = *(const f32x4*)(s_ + 2 * DFF); X##2 = *(const f32x4*)(s_ + 2 * 2 * DFF); X##3 = *(const f32x4*)(s_ + 3 * 2 * DFF); \
        X##4 = *(const f32x4*)(s_ + 4 * 2 * DFF); X##5 = *(const f32x4*)(s_ + 5 * 2 * DFF); X##6 = *(const f32x4*)(s_ + 6 * 2 * DFF); X##7 = *(const f32x4*)(s_ + 7 * 2 * DFF); } while (0)
#define CV_STORE(X, i_) do { const int e_ = (i_) >> 8, j_ = (i_) & 255; unsigned char* d_ = p.w1T8 + (size_t)e_ * 2 * DFF * D + (size_t)((j_ & 15) * 128 + 4 * ngq) * 1024 + (j_ >> 4) * 64 + 8 * kg; \
        _Pragma("unroll") for (int c_ = 0; c_ < 4; ++c_) { \
            int lo_ = __builtin_amdgcn_cvt_pk_fp8_f32(X##0[c_] * 32.0f, X##1[c_] * 32.0f, 0, false); lo_ = __builtin_amdgcn_cvt_pk_fp8_f32(X##2[c_] * 32.0f, X##3[c_] * 32.0f, lo_, true); \
            int hi_ = __builtin_amdgcn_cvt_pk_fp8_f32(X##4[c_] * 32.0f, X##5[c_] * 32.0f, 0, false); hi_ = __builtin_amdgcn_cvt_pk_fp8_f32(X##6[c_] * 32.0f, X##7[c_] * 32.0f, hi_, true); \
            uint2 q_; q_.x = (unsigned)lo_; q_.y = (unsigned)hi_; *(uint2*)(d_ + c_ * 1024) = q_; } } while (0)
                CV_DECL(ra); CV_DECL(rb);
                const int hid = ((int)blockIdx.x - ng) * 2 + (tid >> 8), per = (W1_CONV + st - 1) / st;
                const int i0 = min(hid * per, W1_CONV - 1), ilast = min(i0 + per, W1_CONV) - 1;
                const int npair = (per + 1) / 2;
                CV_LOAD(ra, i0);
                for (int k = 0; k < npair; ++k) {
                    const int ia = min(i0 + 2 * k, ilast), ib = min(ia + 1, ilast), ic = min(ib + 1, ilast);
                    CV_LOAD(rb, ib);
                    CV_STORE(ra, ia);
                    CV_LOAD(ra, ic);
                    CV_STORE(rb, ib);
                }
#undef CV_DECL
#undef CV_LOAD
#undef CV_STORE
            }
            {
                const int tid2 = tid_opaque(), lane = tid2 & 63, i16 = lane & 15, g = lane >> 4;
                for (int task = (G - 1 - (int)blockIdx.x) * 8 + (tid2 >> 6); task < T / 16; task += G * 8) {
                    f32x4 z0 = {0.f, 0.f, 0.f, 0.f}, z1 = {0.f, 0.f, 0.f, 0.f};
                    const u16* ar = p.xn + (size_t)(task * 16 + i16) * D + 8 * g;
                    const u16* w0 = p.wzT + (size_t)i16 * D + 8 * g;
                    const u16* w1 = w0 + 16 * D;
#pragma unroll 8
                    for (int ks = 0; ks < 32; ++ks) {
                        const bf16x8 a = *(const bf16x8*)(ar + ks * 32);
                        z0 = __builtin_amdgcn_mfma_f32_16x16x32_bf16(a, *(const bf16x8*)(w0 + ks * 32), z0, 0, 0, 0);
                        z1 = __builtin_amdgcn_mfma_f32_16x16x32_bf16(a, *(const bf16x8*)(w1 + ks * 32), z1, 0, 0, 0);
                    }
#pragma unroll
                    for (int r = 0; r < 4; ++r) {
                        const size_t row = (size_t)task * 16 + 4 * g + r;
                        p.zbuf[row * 32 + i16] = z0[r]; p.zbuf[row * 32 + 16 + i16] = z1[r];
                    }
                }
            }
        } break;
        case PH_MIX1: {
            PHASE_PARAMS();
            const int tid = tid_opaque(), t = tid & 255, half = tid >> 8;
            char* hl = lds + half * HALF_LDS;
#ifndef MIX1_SKIP_GLA_ON_REP
            for (int it0 = blockIdx.x * 2; it0 < N_GLA_ITEMS; it0 += gridDim.x * 2) gla_ds_item(p, hl, t, min(it0 + half, N_GLA_ITEMS - 1));
#else
            if (!rep) for (int it0 = blockIdx.x * 2; it0 < N_GLA_ITEMS; it0 += gridDim.x * 2) gla_ds_item(p, hl, t, min(it0 + half, N_GLA_ITEMS - 1));
#endif
            {
                AttnRegs AR;
                attn_load(p, t, min((int)blockIdx.x * 2 + half, N_ATT_ITEMS - 1), AR);
                int bgt = blockIdx.x * 2 + half;
                for (int it0 = blockIdx.x * 2; it0 < N_ATT_ITEMS; it0 += gridDim.x * 2, bgt += gridDim.x * 2) {
                    const int nx0 = it0 + gridDim.x * 2;
                    attn_item(p, hl, t, min(it0 + half, N_ATT_ITEMS - 1), nx0 < N_ATT_ITEMS ? min(nx0 + half, N_ATT_ITEMS - 1) : -1, AR, bgt < W2_BG ? bgt : -1);
                }
                for (; bgt < W2_BG; bgt += gridDim.x * 2) { const int e = bgt >> 7, j = bgt & 127; cvt_tile8(p.w2 + (size_t)e * DFF * D, D, p.w2T8 + (size_t)e * D * DFF, (j >> 3) * 64, (j & 7) * 128, t); }
            }
        } break;
        case PH_MIX2: {
            PHASE_PARAMS();
            const int tid = tid_opaque();
            for (int gid = blockIdx.x * 512 + tid; gid < (1 << 17); gid += gridDim.x * 512) gla_scan_thread2(p, gid);
            for (int gid = blockIdx.x * 512 + tid; gid < T * 64; gid += gridDim.x * 512) attn_combine_thread(p, gid);
        } break;
        case PH_MIX3: {
            PHASE_PARAMS();
            const int tid = tid_opaque(), t = tid & 255, half = tid >> 8;
            char* hl = lds + half * HALF_LDS;
            for (int it0 = blockIdx.x * 2; it0 < N_GLA_ITEMS; it0 += gridDim.x * 2) gla_out_item(p, hl, t, min(it0 + half, N_GLA_ITEMS - 1));
        } break;
        case PH_OUTPROJ: {
            PHASE_PARAMS();
            pg::DenseSched S; S.init(p.mix, p.woT, T, D, gridDim.x, blockIdx.x);
            pg::EpiOut E{p.x, p.x1};
            pg::gemm_phase((LDS_AS unsigned char*)lds, S, E);
        } break;
        case PH_ROUTE: { PHASE_PARAMS(); ph_route(p, lds); } break;
        case PH_MOE1: {
            PHASE_PARAMS();
            int* meta = (int*)(lds + MO_META);
            moe_meta(p, meta);
            pg::MoeSchedT<true> S{(const u16*)p.xn28, (const u16*)p.w1T8, p.lists, (const LDS_AS int*)meta, 8, meta[32 + NE] * 8, (int)gridDim.x, (int)blockIdx.x, 1024, (const LDS_AS unsigned*)(lds + MO_TABA)};
            moe_tables(p, lds, S);
            pg::EpiMoe1 E{p.b1, p.act8};
            pg::gemm_phase<pg::EpiMoe1, pg::MoeSchedT<true>, true>((LDS_AS unsigned char*)lds, S, E);
            {
                const int G = gridDim.x, nun = S.nunits, r = nun % G, nshort = r ? G - r : G, sidx = r ? (int)blockIdx.x - r : (int)blockIdx.x;
                if (sidx >= 0) {
                    const int tid = tid_opaque(), t = tid & 255, hv = tid >> 8;
                    const int per = (W2_LATE - W2_BG + nshort * 2 - 1) / (nshort * 2), ib = W2_BG + (sidx * 2 + hv) * per;
                    for (int i = ib; i < min(ib + per, W2_LATE); ++i) { const int e = i >> 7, j = i & 127; cvt_tile8(p.w2 + (size_t)e * DFF * D, D, p.w2T8 + (size_t)e * D * DFF, (j >> 3) * 64, (j & 7) * 128, t); }
                }
            }
        } break;
        case PH_MOE2: {
            PHASE_PARAMS();
            int* meta = (int*)(lds + MO_META);
            moe_meta(p, meta);
            pg::MoeSchedT<false> S{(const u16*)p.act8, (const u16*)p.w2T8, p.lists, (const LDS_AS int*)meta, 4, meta[32 + NE] * 4, (int)gridDim.x, (int)blockIdx.x, 1024, nullptr};
            pg::EpiMoe2 E{p.b2, p.gate, p.lists, (const LDS_AS int*)meta, p.y};
            pg::gemm_phase<pg::EpiMoe2, pg::MoeSchedT<false>, true>((LDS_AS unsigned char*)lds, S, E);
        } break;
        case PH_FINAL: { PHASE_PARAMS(); ph_final(p); } break;
        default: break;
        }
      }
#ifdef EXTRA_BAR
        if (ph == PH_MIX2) { for (int q = 0; q < EXTRA_BAR; ++q) xcd_barrier(xb); }
#endif
        if (ph + 1 < ph_hi) xcd_barrier(xb);
    }
}

#ifndef STAGE
#define STAGE 6
#endif

__global__ void __launch_bounds__(256) cvt_bf16_f32(const u16* __restrict__ src, int lds_, float* __restrict__ dst, int ldd, int rows, int cols) {
    const size_t n = (size_t)rows * cols;
    for (size_t i = (size_t)blockIdx.x * 256 + threadIdx.x; i < n; i += (size_t)gridDim.x * 256) {
        const size_t r = i / cols, c = i % cols;
        dst[r * ldd + c] = bf2f(src[r * lds_ + c]);
    }
}

#include <cstdio>
extern "C" void kernel_launch(void* const* d_in, const int* in_sizes, int n_in, void* d_out, int out_size, void* d_ws, size_t ws_size, hipStream_t stream) {
    const float* x = (const float*)d_in[0];
    const float* norm1_g = (const float*)d_in[1];
    const float* w_in = (const float*)d_in[2];
    const float* rel_bias = (const float*)d_in[3];
    const float* wgf = (const float*)d_in[4];
    const float* bgf = (const float*)d_in[5];
    const float* wgb = (const float*)d_in[6];
    const float* bgb = (const float*)d_in[7];
    const float* gla_ng = (const float*)d_in[8];
    const float* w_out = (const float*)d_in[9];
    const float* norm2_g = (const float*)d_in[10];
    const float* router_w = (const float*)d_in[11];
    const float* router_b = (const float*)d_in[12];
    const float* w1 = (const float*)d_in[13];
    const float* b1 = (const float*)d_in[14];
    const float* w2 = (const float*)d_in[15];
    const float* b2 = (const float*)d_in[16];
    const float* final_g = (const float*)d_in[17];
    float* out = (float*)d_out;

    static int grid_blocks = 0;
    if (!grid_blocks) {
        int dev = 0, cus = 0, per_cu = 0;
        hipGetDevice(&dev);
        hipDeviceGetAttribute(&cus, hipDeviceAttributeMultiprocessorCount, dev);
        hipFuncSetAttribute((const void*)mega, hipFuncAttributeMaxDynamicSharedMemorySize, LDS_BYTES);
        hipOccupancyMaxActiveBlocksPerMultiprocessor(&per_cu, mega, 512, LDS_BYTES);
        if (per_cu > 1) per_cu = 1;
        if (per_cu < 1) per_cu = 1;
        grid_blocks = cus * per_cu;
    }

    char* ws = (char*)d_ws;
    size_t off = 0;
    auto take = [&](size_t bytes) { char* p = ws + off; off += (bytes + 255) & ~(size_t)255; return p; };
    Params p{};
    p.x = x; p.g1 = norm1_g; p.w_in = w_in; p.rel_bias = rel_bias; p.wgf = wgf; p.bgf = bgf; p.wgb = wgb; p.bgb = bgb; p.gla_ng = gla_ng;
    p.w_out = w_out; p.g2 = norm2_g; p.rw = router_w; p.rb = router_b; p.w1 = w1; p.b1 = b1; p.w2 = w2; p.b2 = b2; p.gf = final_g; p.out = out;
    p.winT = (u16*)take((size_t)PJW * D * 2);
    p.wzT = (u16*)take((size_t)32 * D * 2);
    p.woT = (u16*)take((size_t)D * D * 2);
    p.w1T = (u16*)take((size_t)NE * 2 * DFF * D * 2); p.w1T8 = (unsigned char*)p.w1T;
    p.w2T = (u16*)take((size_t)NE * D * DFF * 2); p.w2T8 = (unsigned char*)p.w2T;
    p.zbuf = (float*)take((size_t)T * 32 * 4);
    p.lse = (float*)take((size_t)3 * T * 8 * 4);
    p.dec = (float*)take((size_t)B * GH * 64 * 2 * 64 * 4);
    p.x1 = (float*)take((size_t)T * D * 4);
    p.counts = (int*)take(256);
    p.lists = (int*)take((size_t)NE * T * 4);
    p.gate = (float*)take((size_t)NSLOT * 4);
    p.bar = (unsigned*)take((size_t)XCD_BAR_WORDS * 4);
    p.xn = (u16*)take((size_t)T * D * 2); p.xn2 = p.xn; p.xn28 = (unsigned char*)p.xn;
    { char* ra = take((size_t)T * PJW * 2 + (size_t)3 * T * 512 * 2);
      p.proj = (u16*)ra; p.abr = (u16*)(ra + (size_t)T * PJW * 2); p.act = (u16*)ra; p.act8 = (unsigned char*)ra; }
    { char* rb = take((size_t)B * GH * 64 * 2 * 128 * 64 * 4 + (size_t)B * GH * 64 * 2 * 128 * 64 * 2 + (size_t)T * D * 2);
      p.dS = (float*)rb; p.Sp = (u16*)(rb + (size_t)B * GH * 64 * 2 * 128 * 64 * 4); p.mix = (u16*)(rb + (size_t)B * GH * 64 * 2 * 128 * 64 * 4 + (size_t)B * GH * 64 * 2 * 128 * 64 * 2); p.y = (u16*)rb; }
    const size_t off_shared = off;

    auto run_fast = [&](int lo, int hi) {
        (void)hipMemsetAsync(p.bar, 0, (size_t)XCD_BAR_WORDS * 4, stream);
        p.ph_lo = lo; p.ph_hi = hi;
        void* args[] = {&p};
        hipError_t e = hipLaunchCooperativeKernel((const void*)mega, dim3(grid_blocks), dim3(512), args, LDS_BYTES, stream);
        if (e != hipSuccess) fprintf(stderr, "cooperative launch failed: %s (grid %d)\n", hipGetErrorString(e), grid_blocks);
    };

#if STAGE >= 6
    run_fast(PH_PRO, PH_END);
#else
    off = off_shared;
    float* n_xn = (float*)take((size_t)T * D * 4);
    float* n_x2 = (float*)take((size_t)T * D * 4);
    float* n_mix = (float*)take((size_t)T * D * 4);
    int* n_topi = (int*)take((size_t)T * 4 * 4);
    float* n_hact = (float*)take((size_t)T * DFF * 4);
    float* n_x1 = p.x1;
    int* n_lists = p.lists; int* n_counts = p.counts; float* n_gate = p.gate;
#if STAGE == 3
    run_fast(PH_PRO, PH_MIX3 + 1);
#elif STAGE == 4
    run_fast(PH_PRO, PH_OUTPROJ + 1);
#elif STAGE == 5
    run_fast(PH_PRO, PH_ROUTE + 1);
#else
#error "hybrid STAGE must be 3, 4 or 5"
#endif
#if STAGE == 3
    cvt_bf16_f32<<<2048, 256, 0, stream>>>(p.mix, D, n_mix, D, T, D);
#endif
#if STAGE <= 3
    nv_gemm<EPI_RESID><<<dim3(D / 64, T / 64), 256, 0, stream>>>(n_mix, D, nullptr, 0, nullptr, T, w_out, D, D, D, n_x1, D, x, nullptr);
#endif
#if STAGE <= 4
    nv_route<<<T / 4, 256, 0, stream>>>(n_x1, norm2_g, router_w, router_b, n_xn, n_topi, n_gate);
    nv_lists<<<1, 32, 0, stream>>>(n_topi, n_lists, n_counts);
#endif
#if STAGE == 5
    cvt_bf16_f32<<<2048, 256, 0, stream>>>(p.xn2, D, n_xn, D, T, D);
#endif
    (void)hipMemcpyAsync(n_x2, n_x1, (size_t)T * D * 4, hipMemcpyDeviceToDevice, stream);
    for (int e = 0; e < NE; ++e) {
        nv_gemm<EPI_SWIGLU><<<dim3(2 * DFF / 64, T / 64), 256, 0, stream>>>(n_xn, D, n_lists + (size_t)e * T, 2, n_counts + e, 0,
                                                                          w1 + (size_t)e * D * 2 * DFF, 2 * DFF, 2 * DFF, D, n_hact, DFF, b1 + (size_t)e * 2 * DFF, nullptr);
        nv_moe2<<<dim3(D / 64, T / 64), 256, 0, stream>>>(n_hact, n_lists + (size_t)e * T, n_counts + e, w2 + (size_t)e * DFF * D, n_x2, b2 + (size_t)e * D, n_gate);
    }
    nv_rmsnorm<<<T / 4, 256, 0, stream>>>(n_x2, final_g, out, T);
#endif
}
```

```cpp
#define STAGE 6
#define REPMASK 0
#include <hip/hip_runtime.h>
#include <stdint.h>

namespace cfg {
constexpr int D = 1024, B = 4, S = 4096, T = B * S;
constexpr int AH = 8;
constexpr int GH = 4;
constexpr int INW = 3104;
constexpr int C_AQ = 0, C_AK = 512, C_AV = 1024, C_GQ = 1536, C_GK = 1792, C_GV = 2048, C_GO = 2560, C_GZ = 3072;
constexpr int NE = 32, DFF = 1024;
constexpr float EPS = 1e-5f;
}
using namespace cfg;

__device__ const unsigned char T5TAB[387] = {
11,11,11,11,11,11,11,11,11,11,11,11,11,11,11,10,10,10,10,10,10,10,10,10,10,10,10,10,10,10,10,10,10,10,10,10,10,10,9,9,9,9,9,9,9,9,9,9,9,9,8,8,8,8,8,8,8,7,6,5,4,3,2,1,0,17,18,19,20,21,22,23,24,24,24,24,24,24,24,25,25,25,25,25,25,25,25,25,25,25,25,26,26,26,26,26,26,26,26,26,26,26,26,26,26,26,26,26,26,26,26,26,26,26,27,27,27,27,27,27,27,27,27,27,27,27,27,27,27,
13,13,13,13,13,13,13,13,13,13,13,13,13,13,13,13,13,13,13,13,13,13,13,12,12,12,12,12,12,12,12,12,12,12,12,12,12,12,12,12,12,12,11,11,11,11,11,11,11,11,11,11,10,10,10,10,10,10,9,9,9,8,8,4,0,20,24,24,25,25,25,26,26,26,26,26,26,27,27,27,27,27,27,27,27,27,27,28,28,28,28,28,28,28,28,28,28,28,28,28,28,28,28,28,28,28,29,29,29,29,29,29,29,29,29,29,29,29,29,29,29,29,29,29,29,29,29,29,29,
15,15,15,15,15,15,15,15,15,15,15,15,15,15,15,15,15,15,15,15,15,15,15,15,15,15,15,15,15,15,14,14,14,14,14,14,14,14,14,14,14,14,14,14,14,13,13,13,13,13,13,13,13,13,12,12,12,12,12,11,11,10,10,9,0,25,26,26,27,27,28,28,28,28,28,29,29,29,29,29,29,29,29,29,30,30,30,30,30,30,30,30,30,30,30,30,30,30,30,31,31,31,31,31,31,31,31,31,31,31,31,31,31,31,31,31,31,31,31,31,31,31,31,31,31,31,31,31,31};

template <int MASK> __device__ __forceinline__ float swz_xor(float v) { return __builtin_bit_cast(float, __builtin_amdgcn_ds_swizzle(__builtin_bit_cast(int, v), (MASK << 10) | 0x1F)); }
__device__ __forceinline__ float half_sum(float v) {
    const auto r = __builtin_amdgcn_permlane32_swap(__builtin_bit_cast(unsigned, v), __builtin_bit_cast(unsigned, v), false, false);
    return __builtin_bit_cast(float, (unsigned)r[0]) + __builtin_bit_cast(float, (unsigned)r[1]);
}
__device__ __forceinline__ float half_max(float v) {
    const auto r = __builtin_amdgcn_permlane32_swap(__builtin_bit_cast(unsigned, v), __builtin_bit_cast(unsigned, v), false, false);
    return fmaxf(__builtin_bit_cast(float, (unsigned)r[0]), __builtin_bit_cast(float, (unsigned)r[1]));
}
__device__ __forceinline__ float wave_sum(float v) {
    v += swz_xor<1>(v); v += swz_xor<2>(v); v += swz_xor<4>(v); v += swz_xor<8>(v); v += swz_xor<16>(v);
    return half_sum(v);
}
__global__ void __launch_bounds__(256) nv_rmsnorm(const float* __restrict__ x, const float* __restrict__ g, float* __restrict__ y, int rows) {
    int row = blockIdx.x * 4 + (threadIdx.x >> 6), lane = threadIdx.x & 63;
    if (row >= rows) return;
    const float* xr = x + (size_t)row * D;
    float v[16]; float ss = 0.f;
#pragma unroll
    for (int i = 0; i < 16; ++i) { v[i] = xr[lane + 64 * i]; ss += v[i] * v[i]; }
    ss = wave_sum(ss);
    float r = rsqrtf(ss * (1.0f / D) + EPS);
#pragma unroll
    for (int i = 0; i < 16; ++i) y[(size_t)row * D + lane + 64 * i] = v[i] * r * g[lane + 64 * i];
}

enum { EPI_STORE = 0, EPI_RESID = 1, EPI_SWIGLU = 2 };
template <int EPI>
__global__ void __launch_bounds__(256) nv_gemm(const float* __restrict__ A, int lda, const int* __restrict__ rowmap, int rshift,
                                               const int* __restrict__ Mptr, int Mfix,
                                               const float* __restrict__ Bm, int ldb, int N, int K,
                                               float* __restrict__ C, int ldc,
                                               const float* __restrict__ aux1, const float* __restrict__ aux2) {
    __shared__ float As[16][68];
    __shared__ float Bs[16][64];
    const int M = Mptr ? *Mptr : Mfix;
    const int m0 = blockIdx.y * 64, n0 = blockIdx.x * 64;
    if (m0 >= M) return;
    const int tid = threadIdx.x, tx = tid & 15, ty = tid >> 4;
    float acc[4][4];
#pragma unroll
    for (int i = 0; i < 4; ++i)
#pragma unroll
        for (int j = 0; j < 4; ++j) acc[i][j] = 0.f;
    const int ar = tid >> 2, ak = (tid & 3) * 4;
    const int arow = m0 + ar; const bool av = arow < M;
    const int srcrow = av ? (rowmap ? (rowmap[arow] >> rshift) : arow) : 0;
    const float* ap = A + (size_t)srcrow * lda + ak;
    const int bk = tid >> 4, bn = (tid & 15) * 4;
    const bool bv = (n0 + bn) < N;
    for (int k0 = 0; k0 < K; k0 += 16) {
        float4 a4 = av ? *(const float4*)(ap + k0) : make_float4(0.f, 0.f, 0.f, 0.f);
        float4 b4 = bv ? *(const float4*)(Bm + (size_t)(k0 + bk) * ldb + n0 + bn) : make_float4(0.f, 0.f, 0.f, 0.f);
        As[ak + 0][ar] = a4.x; As[ak + 1][ar] = a4.y; As[ak + 2][ar] = a4.z; As[ak + 3][ar] = a4.w;
        *(float4*)&Bs[bk][bn] = b4;
        __syncthreads();
#pragma unroll
        for (int kk = 0; kk < 16; ++kk) {
            float4 a = *(const float4*)&As[kk][ty * 4];
            float4 b = *(const float4*)&Bs[kk][tx * 4];
            float aa[4] = {a.x, a.y, a.z, a.w}, bb[4] = {b.x, b.y, b.z, b.w};
#pragma unroll
            for (int i = 0; i < 4; ++i)
#pragma unroll
                for (int j = 0; j < 4; ++j) acc[i][j] = fmaf(aa[i], bb[j], acc[i][j]);
        }
        __syncthreads();
    }
#pragma unroll
    for (int i = 0; i < 4; ++i) {
        const int row = m0 + ty * 4 + i;
        if (row >= M) continue;
        const int col = n0 + tx * 4;
        if (col >= N) continue;
        if (EPI == EPI_STORE) {
#pragma unroll
            for (int j = 0; j < 4; ++j) C[(size_t)row * ldc + col + j] = acc[i][j];
        } else if (EPI == EPI_RESID) {
#pragma unroll
            for (int j = 0; j < 4; ++j) C[(size_t)row * ldc + col + j] = aux1[(size_t)row * ldc + col + j] + acc[i][j];
        } else if (EPI == EPI_SWIGLU) {
#pragma unroll
            for (int j = 0; j < 4; j += 2) {
                float glu = acc[i][j] + aux1[col + j], lin = acc[i][j + 1] + aux1[col + j + 1];
                glu = fminf(glu, 7.0f); lin = fminf(fmaxf(lin, -7.0f), 7.0f);
                float sg = 1.0f / (1.0f + expf(-1.702f * glu));
                C[(size_t)row * ldc + (col + j) / 2] = glu * sg * (lin + 1.0f);
            }
        }
    }
}

__global__ void __launch_bounds__(256) nv_attn(const float* __restrict__ proj, const float* __restrict__ rel_bias, float* __restrict__ mix) {
    const int wid = blockIdx.x * 4 + (threadIdx.x >> 6), lane = threadIdx.x & 63;
    const int h = wid & 7, tok = wid >> 3, b = tok / S, pos = tok % S;
    const float q = proj[(size_t)tok * INW + C_AQ + h * 64 + lane];
    float outs[3], lses[3];
#pragma unroll
    for (int br = 0; br < 3; ++br) {
        const int dil = (br == 0) ? 1 : (br == 1 ? 4 : 16);
        float m = -3.0e38f, l = 0.f, o = 0.f;
        for (int j = -64; j <= 64; ++j) {
            const int kp = pos + j * dil;
            if (kp < 0 || kp >= S) continue;
            const size_t kr = (size_t)(b * S + kp) * INW;
            float d = wave_sum(q * proj[kr + C_AK + h * 64 + lane]);
            float logit = d * 0.125f + rel_bias[T5TAB[br * 129 + j + 64] * AH + h];
            float mn = fmaxf(m, logit);
            float sc = expf(m - mn), p = expf(logit - mn);
            l = l * sc + p; o = o * sc + p * proj[kr + C_AV + h * 64 + lane];
            m = mn;
        }
        outs[br] = o / l; lses[br] = m + logf(l);
    }
    float mm = fmaxf(lses[0], fmaxf(lses[1], lses[2]));
    float w0 = expf(lses[0] - mm), w1 = expf(lses[1] - mm), w2 = expf(lses[2] - mm);
    float ws = w0 + w1 + w2;
    mix[(size_t)tok * D + h * 64 + lane] = (w0 * outs[0] + w1 * outs[1] + w2 * outs[2]) / ws;
}

__global__ void __launch_bounds__(256) nv_la(const float* __restrict__ proj, const float* __restrict__ wgf, const float* __restrict__ bgf,
                                             const float* __restrict__ wgb, const float* __restrict__ bgb, float* __restrict__ ea) {
    const int tok = blockIdx.x, col = threadIdx.x;
#pragma unroll
    for (int dir = 0; dir < 2; ++dir) {
        const float* wg = dir ? wgb : wgf; const float* bg = dir ? bgb : bgf;
        float a = bg[col];
        for (int r = 0; r < 16; ++r) a += proj[(size_t)tok * INW + C_GZ + dir * 16 + r] * wg[r * 256 + col];
        float ls = fminf(a, 0.f) - log1pf(expf(-fabsf(a)));
        ea[((size_t)dir * T + tok) * 256 + col] = expf(ls * (1.0f / 16.0f));
    }
}

__global__ void __launch_bounds__(128) nv_gla(const float* __restrict__ proj, const float* __restrict__ ea, float* __restrict__ og) {
    const int e = threadIdx.x, bhd = blockIdx.x, dir = bhd & 1, h = (bhd >> 1) & 3, b = bhd >> 3;
    float st[64];
#pragma unroll
    for (int d = 0; d < 64; ++d) st[d] = 0.f;
    for (int i = 0; i < S; ++i) {
        const int pos = dir ? (S - 1 - i) : i;
        const size_t tok = (size_t)b * S + pos;
        const float* pr = proj + tok * INW;
        const float* ar = ea + ((size_t)dir * T + tok) * 256 + h * 64;
        const float v = pr[C_GV + h * 128 + e];
        float o = 0.f;
#pragma unroll
        for (int d = 0; d < 64; ++d) {
            st[d] = fmaf(ar[d], st[d], pr[C_GK + h * 64 + d] * v);
            o = fmaf(pr[C_GQ + h * 64 + d] * 0.125f, st[d], o);
        }
        og[((size_t)dir * T + tok) * 512 + h * 128 + e] = o;
    }
}

__global__ void __launch_bounds__(256) nv_gla_out(const float* __restrict__ proj, const float* __restrict__ og, const float* __restrict__ ng, float* __restrict__ mix) {
    const int wid = blockIdx.x * 4 + (threadIdx.x >> 6), lane = threadIdx.x & 63;
    const int h = wid & 3, tok = wid >> 2;
    float o0 = og[(size_t)tok * 512 + h * 128 + lane] + og[((size_t)T + tok) * 512 + h * 128 + lane];
    float o1 = og[(size_t)tok * 512 + h * 128 + 64 + lane] + og[((size_t)T + tok) * 512 + h * 128 + 64 + lane];
    float ss = wave_sum(o0 * o0 + o1 * o1);
    float r = rsqrtf(ss * (1.0f / 128.0f) + EPS);
    float g0 = proj[(size_t)tok * INW + C_GO + h * 128 + lane], g1 = proj[(size_t)tok * INW + C_GO + h * 128 + 64 + lane];
    mix[(size_t)tok * D + 512 + h * 128 + lane] = o0 * r * ng[h * 128 + lane] * (g0 / (1.0f + expf(-g0)));
    mix[(size_t)tok * D + 512 + h * 128 + 64 + lane] = o1 * r * ng[h * 128 + 64 + lane] * (g1 / (1.0f + expf(-g1)));
}

__global__ void __launch_bounds__(256) nv_route(const float* __restrict__ x1, const float* __restrict__ g2, const float* __restrict__ rw, const float* __restrict__ rb,
                                                float* __restrict__ xn2, int* __restrict__ topi, float* __restrict__ gate) {
    __shared__ float xs[4][1024];
    __shared__ float lg[4][32];
    const int w = threadIdx.x >> 6, lane = threadIdx.x & 63, tok = blockIdx.x * 4 + w;
    const float* xr = x1 + (size_t)tok * D;
    float v[16]; float ss = 0.f;
#pragma unroll
    for (int i = 0; i < 16; ++i) { v[i] = xr[lane + 64 * i]; ss += v[i] * v[i]; }
    ss = wave_sum(ss);
    const float r = rsqrtf(ss * (1.0f / D) + EPS);
#pragma unroll
    for (int i = 0; i < 16; ++i) { float y = v[i] * r * g2[lane + 64 * i]; xs[w][lane + 64 * i] = y; xn2[(size_t)tok * D + lane + 64 * i] = y; }
    __syncthreads();
    const int e = lane & 31, half = lane >> 5;
    float a = 0.f;
    for (int k = half * 512; k < half * 512 + 512; ++k) a = fmaf(xs[w][k], rw[k * 32 + e], a);
    a += __shfl_xor(a, 32);
    if (lane < 32) lg[w][lane] = a + rb[lane];
    __syncthreads();
    if (lane == 0) {
        float bv[4]; int bi[4];
        unsigned used = 0u;
#pragma unroll
        for (int k = 0; k < 4; ++k) {
            float best = -3.0e38f; int bidx = 0;
            for (int j = 0; j < 32; ++j) { float x = lg[w][j]; if (!((used >> j) & 1u) && x > best) { best = x; bidx = j; } }
            used |= 1u << bidx; bv[k] = best; bi[k] = bidx;
        }
        float e0 = 1.0f, e1 = expf(bv[1] - bv[0]), e2 = expf(bv[2] - bv[0]), e3 = expf(bv[3] - bv[0]);
        float s = e0 + e1 + e2 + e3;
        topi[tok * 4 + 0] = bi[0]; topi[tok * 4 + 1] = bi[1]; topi[tok * 4 + 2] = bi[2]; topi[tok * 4 + 3] = bi[3];
        gate[tok * 4 + 0] = e0 / s; gate[tok * 4 + 1] = e1 / s; gate[tok * 4 + 2] = e2 / s; gate[tok * 4 + 3] = e3 / s;
    }
}

__global__ void nv_lists(const int* __restrict__ topi, int* __restrict__ lists, int* __restrict__ counts) {
    const int e = threadIdx.x;
    int c = 0;
    for (int s = 0; s < T * 4; ++s) if (topi[s] == e) lists[e * T + c++] = s;
    counts[e] = c;
}

__global__ void __launch_bounds__(256) nv_moe2(const float* __restrict__ A, const int* __restrict__ slots, const int* __restrict__ Mptr,
                                               const float* __restrict__ Bm, float* __restrict__ x2, const float* __restrict__ b2, const float* __restrict__ gate) {
    __shared__ float As[16][68];
    __shared__ float Bs[16][64];
    const int M = *Mptr;
    const int m0 = blockIdx.y * 64, n0 = blockIdx.x * 64;
    if (m0 >= M) return;
    const int tid = threadIdx.x, tx = tid & 15, ty = tid >> 4;
    float acc[4][4];
#pragma unroll
    for (int i = 0; i < 4; ++i)
#pragma unroll
        for (int j = 0; j < 4; ++j) acc[i][j] = 0.f;
    const int ar = tid >> 2, ak = (tid & 3) * 4;
    const int arow = m0 + ar; const bool av = arow < M;
    const float* ap = A + (size_t)(av ? arow : 0) * DFF + ak;
    const int bk = tid >> 4, bn = (tid & 15) * 4;
    for (int k0 = 0; k0 < DFF; k0 += 16) {
        float4 a4 = av ? *(const float4*)(ap + k0) : make_float4(0.f, 0.f, 0.f, 0.f);
        float4 b4 = *(const float4*)(Bm + (size_t)(k0 + bk) * D + n0 + bn);
        As[ak + 0][ar] = a4.x; As[ak + 1][ar] = a4.y; As[ak + 2][ar] = a4.z; As[ak + 3][ar] = a4.w;
        *(float4*)&Bs[bk][bn] = b4;
        __syncthreads();
#pragma unroll
        for (int kk = 0; kk < 16; ++kk) {
            float4 a = *(const float4*)&As[kk][ty * 4];
            float4 b = *(const float4*)&Bs[kk][tx * 4];
            float aa[4] = {a.x, a.y, a.z, a.w}, bb[4] = {b.x, b.y, b.z, b.w};
#pragma unroll
            for (int i = 0; i < 4; ++i)
#pragma unroll
                for (int j = 0; j < 4; ++j) acc[i][j] = fmaf(aa[i], bb[j], acc[i][j]);
        }
        __syncthreads();
    }
#pragma unroll
    for (int i = 0; i < 4; ++i) {
        const int row = m0 + ty * 4 + i;
        if (row >= M) continue;
        const int col = n0 + tx * 4;
        const int slot = slots[row]; const int tok = slot >> 2; const float gt = gate[slot];
#pragma unroll
        for (int j = 0; j < 4; ++j) x2[(size_t)tok * D + col + j] += gt * (acc[i][j] + b2[col + j]);
    }
}


#include <hip/hip_cooperative_groups.h>
namespace cg = cooperative_groups;

typedef unsigned short u16;
typedef short bf16x8 __attribute__((ext_vector_type(8)));
typedef short s16x4 __attribute__((ext_vector_type(4)));
typedef float f32x4 __attribute__((ext_vector_type(4)));
typedef unsigned u32x4 __attribute__((ext_vector_type(4)));
typedef __bf16 bfv2 __attribute__((ext_vector_type(2)));
typedef float fv2 __attribute__((ext_vector_type(2)));
#define LDS_AS __attribute__((address_space(3)))

constexpr int LDS_BYTES = 160 * 1024;
constexpr int HALF_LDS = 80 * 1024;
constexpr int NSLOT = T * 4;
constexpr int PJW = 3072;
#ifndef REPMASK
#define REPMASK 0
#endif

struct Params {
    const float *x, *g1, *w_in, *rel_bias, *wgf, *bgf, *wgb, *bgb, *gla_ng, *w_out, *g2, *rw, *rb, *w1, *b1, *w2, *b2, *gf;
    float* out;
    u16* winT;
    u16* wzT;
    u16* woT;
    u16* w1T;
    u16* w2T;
    u16* xn;
    u16* proj;
    float* zbuf;
    float* btab;
    u16* abr;
    float* lse;
    float* dS;
    float* dec;
    u16* Sp;
    u16* mix;
    float* x1;
    u16* xn2;
    int* counts;
    int* lists;
    float* gate;
    u16* act;
    u16* y;
    unsigned char* xn28;
    unsigned char* w1T8;
    unsigned char* act8;
    unsigned char* w2T8;
    unsigned* bar;
    int ph_lo, ph_hi;
};

__device__ __forceinline__ int tid_from_wave(int wv) { int l; asm volatile("v_mbcnt_lo_u32_b32 %0, -1, 0\n\tv_mbcnt_hi_u32_b32 %0, -1, %0" : "=v"(l)); return (wv << 6) | l; }
#define tid_opaque() tid_from_wave(wv__)
__device__ __forceinline__ float bf2f(u16 v) { return __uint_as_float((unsigned)v << 16); }
__device__ __forceinline__ unsigned pack2(float a, float b) {
    fv2 v = {a, b};
    bfv2 r = __builtin_convertvector(v, bfv2);
    return __builtin_bit_cast(unsigned, r);
}
__device__ __forceinline__ u16 f2bf(float a) { return (u16)(pack2(a, 0.f) & 0xffffu); }
__device__ __forceinline__ float lo2f(unsigned u) { return __uint_as_float(u << 16); }
__device__ __forceinline__ float hi2f(unsigned u) { return __uint_as_float(u & 0xffff0000u); }
__device__ __forceinline__ int tile_off(int row, int chunk) { return row * 128 + ((chunk ^ (row & 7)) << 4); }
__device__ __forceinline__ bf16x8 lds_frag(const char* base, int row, int chunk) { return *(const bf16x8*)(base + tile_off(row, chunk)); }
__device__ __forceinline__ s16x4 tr_read(const char* p) {
    return __builtin_amdgcn_ds_read_tr16_b64_v4i16((LDS_AS s16x4*)(p));
}
__device__ __forceinline__ bf16x8 cat4(s16x4 a, s16x4 b) { bf16x8 r = {a[0], a[1], a[2], a[3], b[0], b[1], b[2], b[3]}; return r; }
__device__ __forceinline__ float logsig(float a) { return fminf(a, 0.f) - log1pf(expf(-fabsf(a))); }

__device__ __forceinline__ void cvt_tile8(const float* __restrict__ src, int ldsrc, unsigned char* __restrict__ dst, int k0, int n0, int t) {
    const int l = t & 63, w = t >> 6, kg = l & 7, ng = w * 8 + (l >> 3);
    const float* s = src + (size_t)(k0 + 8 * kg) * ldsrc + n0 + 4 * ng;
    f32x4 bv[8];
#pragma unroll
    for (int j = 0; j < 8; ++j) bv[j] = *(const f32x4*)(s + (size_t)j * ldsrc) * 32.0f;
    unsigned char* d = dst + (size_t)(n0 + 4 * ng) * 1024 + k0 + 8 * kg;
#pragma unroll
    for (int c = 0; c < 4; ++c) {
        int lo = __builtin_amdgcn_cvt_pk_fp8_f32(bv[0][c], bv[1][c], 0, false); lo = __builtin_amdgcn_cvt_pk_fp8_f32(bv[2][c], bv[3][c], lo, true);
        int hi = __builtin_amdgcn_cvt_pk_fp8_f32(bv[4][c], bv[5][c], 0, false); hi = __builtin_amdgcn_cvt_pk_fp8_f32(bv[6][c], bv[7][c], hi, true);
        uint2 q; q.x = (unsigned)lo; q.y = (unsigned)hi;
        *(uint2*)(d + c * 1024) = q;
    }
}
__device__ __forceinline__ void cvt_tile(const float* __restrict__ src, int ldsrc, u16* __restrict__ dst, int k0, int n0, int t) {
    const int l = t & 63, w = t >> 6, kg = l & 7, ng = w * 8 + (l >> 3);
    const float* s = src + (size_t)(k0 + 8 * kg) * ldsrc + n0 + 4 * ng;
    float4 bv[8];
#pragma unroll
    for (int j = 0; j < 8; ++j) bv[j] = *(const float4*)(s + (size_t)j * ldsrc);
    u16* d = dst + (size_t)(n0 + 4 * ng) * 1024 + k0 + 8 * kg;
    uint4 q;
    q.x = pack2(bv[0].x, bv[1].x); q.y = pack2(bv[2].x, bv[3].x); q.z = pack2(bv[4].x, bv[5].x); q.w = pack2(bv[6].x, bv[7].x);
    *(uint4*)(d) = q;
    q.x = pack2(bv[0].y, bv[1].y); q.y = pack2(bv[2].y, bv[3].y); q.z = pack2(bv[4].y, bv[5].y); q.w = pack2(bv[6].y, bv[7].y);
    *(uint4*)(d + 1024) = q;
    q.x = pack2(bv[0].z, bv[1].z); q.y = pack2(bv[2].z, bv[3].z); q.z = pack2(bv[4].z, bv[5].z); q.w = pack2(bv[6].z, bv[7].z);
    *(uint4*)(d + 2048) = q;
    q.x = pack2(bv[0].w, bv[1].w); q.y = pack2(bv[2].w, bv[3].w); q.z = pack2(bv[4].w, bv[5].w); q.w = pack2(bv[6].w, bv[7].w);
    *(uint4*)(d + 3072) = q;
}
struct CvtRegs { f32x4 bv[8]; };
__device__ __forceinline__ void cvt_load(const float* __restrict__ src, int ldsrc, int k0, int n0, int t, CvtRegs& R) {
    const int l = t & 63, w = t >> 6, kg = l & 7, ng = w * 8 + (l >> 3);
    const float* s = src + (size_t)(k0 + 8 * kg) * ldsrc + n0 + 4 * ng;
#pragma unroll
    for (int j = 0; j < 8; ++j) R.bv[j] = *(const f32x4*)(s + (size_t)j * ldsrc);
}
__device__ __forceinline__ void cvt_store(u16* __restrict__ dst, int k0, int n0, int t, const CvtRegs& R) {
    const int l = t & 63, w = t >> 6, kg = l & 7, ng = w * 8 + (l >> 3);
    u16* d = dst + (size_t)(n0 + 4 * ng) * 1024 + k0 + 8 * kg;
#pragma unroll
    for (int c = 0; c < 4; ++c) {
        u32x4 q;
        q.x = pack2(R.bv[0][c], R.bv[1][c]); q.y = pack2(R.bv[2][c], R.bv[3][c]); q.z = pack2(R.bv[4][c], R.bv[5][c]); q.w = pack2(R.bv[6][c], R.bv[7][c]);
        *(u32x4*)(d + c * 1024) = q;
    }
}
__device__ __forceinline__ void w1_load(const Params& p, int i, int t, CvtRegs& R) { const int e = i >> 8, j = i & 255; cvt_load(p.w1 + (size_t)e * D * 2 * DFF, 2 * DFF, (j >> 4) * 64, (j & 15) * 128, t, R); }
__device__ __forceinline__ void w1_store(const Params& p, int i, int t, const CvtRegs& R) { const int e = i >> 8, j = i & 255; cvt_store(p.w1T + (size_t)e * 2 * DFF * D, (j >> 4) * 64, (j & 15) * 128, t, R); }
constexpr int CV_WIN = 384, CV_WZ = 1, CV_WO = 128, CV_W1 = NE * 256, CV_W2 = NE * 128;
constexpr int CV_TOTAL = CV_WIN + CV_WZ + CV_WO + CV_W1 + CV_W2;
constexpr int W2_BG = 4096;
constexpr int W2_LATE = 4096;
#ifndef NCONV
#define NCONV 102
#endif
#ifndef W1_CONV
#define W1_CONV 6144
#endif
constexpr int N_BG = W2_BG + 8192 - W1_CONV;
__device__ void ph_prologue(const Params& p, int wv__) {
    const int tid = tid_opaque();
    if (blockIdx.x == 0 && tid < 32) p.counts[tid] = 0;
    if (blockIdx.x >= gridDim.x - 24) {
        const int cmb = gridDim.x - 1 - blockIdx.x, br = cmb >> 3, h = cmb & 7;
        for (int en = tid; en < 704; en += 512) {
            const int c = en / 176, x = en - c * 176, y = x - c - 16;
            const bool ok = (y >= 0) && (y <= 128);
            const float bvl = p.rel_bias[T5TAB[br * 129 + (ok ? y : 0)] * AH + h];
            p.btab[cmb * 704 + en] = ok ? bvl * 1.44269504f : -1.0e30f;
        }
    }
    {
        const int lane = tid & 63, gw = blockIdx.x * 8 + (tid >> 6), nw = gridDim.x * 8;
        for (int row = gw; row < T; row += nw) {
            const float4* xr = (const float4*)(p.x + (size_t)row * D);
            float4 v[4]; float ss = 0.f;
#pragma unroll
            for (int i = 0; i < 4; ++i) { v[i] = xr[lane + 64 * i]; ss += v[i].x * v[i].x + v[i].y * v[i].y + v[i].z * v[i].z + v[i].w * v[i].w; }
            ss = wave_sum(ss);
            const float r = rsqrtf(ss * (1.0f / D) + EPS);
#pragma unroll
            for (int i = 0; i < 4; ++i) {
                const float4 g = ((const float4*)p.g1)[lane + 64 * i];
                uint2 o; o.x = pack2(v[i].x * r * g.x, v[i].y * r * g.y); o.y = pack2(v[i].z * r * g.z, v[i].w * r * g.w);
                *(uint2*)(p.xn + (size_t)row * D + (lane + 64 * i) * 4) = o;
            }
        }
    }
    const int t = tid & 255, vb = blockIdx.x * 2 + (tid >> 8), nvb = gridDim.x * 2;
    for (int it = vb; it < CV_TOTAL; it += nvb) {
        int i = it;
        if (i < CV_WIN) { cvt_tile(p.w_in, INW, p.winT, (i / 24) * 64, (i % 24) * 128, t); continue; }
        i -= CV_WIN;
        if (i < CV_WZ) {
            for (int c = t; c < 32 * 128; c += 256) {
                const int n = c >> 7, k8 = (c & 127) * 8;
                const float* s = p.w_in + (size_t)k8 * INW + PJW + n;
                uint4 q;
                q.x = pack2(s[0], s[INW]); q.y = pack2(s[2 * INW], s[3 * INW]); q.z = pack2(s[4 * INW], s[5 * INW]); q.w = pack2(s[6 * INW], s[7 * INW]);
                *(uint4*)(p.wzT + (size_t)n * 1024 + k8) = q;
            }
            continue;
        }
        i -= CV_WZ;
        if (i < CV_WO) { cvt_tile(p.w_out, D, p.woT, (i >> 3) * 64, (i & 7) * 128, t); continue; }
        i -= CV_WO;
        if (i < CV_W1) continue;
        i -= CV_W1;
        if (i >= W2_LATE) { const int e = i >> 7, j = i & 127; cvt_tile8(p.w2 + (size_t)e * DFF * D, D, p.w2T8 + (size_t)e * D * DFF, (j >> 3) * 64, (j & 7) * 128, t); }
    }
}

namespace pg {
constexpr int BM = 256, BK = 64, HALF = 128, HTB = HALF * BK * 2, KD = 1024;
__host__ __device__ __forceinline__ int lds_byte(int r, int c) { const int st = (r >> 4) * 2 + (c >> 5), rr = r & 15, cc = c & 31, ob = rr * 64 + cc * 2; return st * 1024 + (ob ^ (((ob >> 9) & 1) << 5)); }
__host__ __device__ __forceinline__ void stage_rc(int b, int& R, int& C) { const int st = b / 1024, sb = b % 1024, swz = sb ^ (((sb >> 9) & 1) << 5); R = (st >> 1) * 16 + swz / 64; C = (st & 1) * 32 + (swz % 64) / 2; }
__host__ __device__ __forceinline__ int perm32(int rho) { const int n = rho >> 4, i = rho & 15; return 8 * (i >> 2) + 4 * n + (i & 3); }

struct Unit { int pn, row0, nvalid, e, ord; };

typedef int v8i32 __attribute__((ext_vector_type(8)));
template <class Epi, class Sched, bool FP8 = false>
__device__ __forceinline__ void gemm_phase(LDS_AS unsigned char* lds, const Sched& S, const Epi& E, int wv__) {
    const int tid = tid_opaque(), wid = __builtin_amdgcn_readfirstlane(tid >> 6), lane = tid & 63, wr = wid >> 2, wc = wid & 3, fr = lane & 15, fq = lane >> 4;
    constexpr int ROWB = FP8 ? KD : KD * 2;
    constexpr int nt = FP8 ? KD / 128 : KD / BK;
    int R0, C0; stage_rc(tid * 16, R0, C0);
    unsigned voffB[2];
#pragma unroll
    for (int i = 0; i < 2; ++i) { const int R = R0 + 64 * i; const int Rb = Epi::PERM ? ((R & ~31) + perm32(R & 31)) : R; voffB[i] = (unsigned)(Rb * ROWB + C0 * 2); }
    const size_t kstep = (size_t)(BK * 2);
    const size_t hstep = (size_t)HALF * ROWB;
    const unsigned ldsw = (unsigned)wid * 1024u;
    const int aoff = lds_byte(wr * 64 + fr, fq * 8), boff = lds_byte(wc * 32 + fr, fq * 8);
    const int aoff8a = lds_byte(wr * 64 + fr, fq * 16), boff8a = lds_byte(wc * 32 + fr, fq * 16);
#define PG_SA(b, h) (((b) * 2 + (h)) * HTB)
#define PG_SB(b, h) ((4 + (b) * 2 + (h)) * HTB)
#define PG_STAGE_B(bufoff, gbase) do { _Pragma("unroll") for (int _i = 0; _i < 2; ++_i) \
        __builtin_amdgcn_global_load_lds((const unsigned*)((const char*)(gbase) + voffB[_i]), (LDS_AS unsigned*)(lds + (bufoff) + ldsw + _i * 8192), 16, 0, 0); } while (0)
#define PG_STAGE_A(bufoff, o0, o1) do { \
        __builtin_amdgcn_global_load_lds((const unsigned*)(Abase + (o0)), (LDS_AS unsigned*)(lds + (bufoff) + ldsw), 16, 0, 0); \
        __builtin_amdgcn_global_load_lds((const unsigned*)(Abase + (o1)), (LDS_AS unsigned*)(lds + (bufoff) + ldsw + 8192), 16, 0, 0); } while (0)
#define PG_LDA16(dst, b, h) do { _Pragma("unroll") for (int m = 0; m < 4; ++m) _Pragma("unroll") for (int k = 0; k < 2; ++k) dst[m][k] = *(const LDS_AS bf16x8*)(lds + PG_SA(b, h) + aoff + m * 2048 + k * 1024); } while (0)
#define PG_LDB16(dst, b, h) do { _Pragma("unroll") for (int n = 0; n < 2; ++n) _Pragma("unroll") for (int k = 0; k < 2; ++k) dst[n][k] = *(const LDS_AS bf16x8*)(lds + PG_SB(b, h) + boff + n * 2048 + k * 1024); } while (0)
#define PG_RD16(off) __builtin_bit_cast(u32x4, *(const LDS_AS bf16x8*)(lds + (off)))
#define PG_LDA8(dst, b, h) do { _Pragma("unroll") for (int m = 0; m < 4; ++m) dst##8[m] = __builtin_bit_cast(v8i32, __builtin_shufflevector(PG_RD16(PG_SA(b, h) + aoff8a + m * 2048), PG_RD16(PG_SA(b, h) + aoff8a + 16 + m * 2048), 0, 1, 2, 3, 4, 5, 6, 7)); } while (0)
#define PG_LDB8(dst, b, h) do { _Pragma("unroll") for (int n = 0; n < 2; ++n) dst##8[n] = __builtin_bit_cast(v8i32, __builtin_shufflevector(PG_RD16(PG_SB(b, h) + boff8a + n * 2048), PG_RD16(PG_SB(b, h) + boff8a + 16 + n * 2048), 0, 1, 2, 3, 4, 5, 6, 7)); } while (0)
#define PG_LDA(dst, b, h) do { if constexpr (FP8) PG_LDA8(dst, b, h); else PG_LDA16(dst, b, h); } while (0)
#define PG_LDB(dst, b, h) do { if constexpr (FP8) PG_LDB8(dst, b, h); else PG_LDB16(dst, b, h); } while (0)
#define PG_MMA(ai, bj, At, Bt) do { __builtin_amdgcn_s_setprio(1); _Pragma("unroll") for (int m = 0; m < 4; ++m) _Pragma("unroll") for (int n = 0; n < 2; ++n) { \
        if constexpr (FP8) asm volatile("v_mfma_scale_f32_16x16x128_f8f6f4 %0, %1, %2, %0, %3, %4 op_sel_hi:[0,0,0]" : "+v"(acc[ai][bj][m][n]) : "v"(Bt##8[n]), "v"(At##8[m]), "v"(sclA), "v"(sclA)); \
        else { _Pragma("unroll") for (int k = 0; k < 2; ++k) acc[ai][bj][m][n] = __builtin_amdgcn_mfma_f32_16x16x32_bf16(Bt[n][k], At[m][k], acc[ai][bj][m][n], 0, 0, 0); } } \
        __builtin_amdgcn_s_setprio(0); } while (0)
#define PG_WAIT_V(n) asm volatile("s_waitcnt vmcnt(" #n ")" ::: "memory")
#define PG_WAIT_L(n) asm volatile("s_waitcnt lgkmcnt(" #n ")" ::: "memory")
#define PG_BAR __builtin_amdgcn_s_barrier()
#define PG_SCHED __builtin_amdgcn_sched_barrier(0)
    Unit cur, nxt; int ui = 0;
    if (!S.next(0, cur)) return;
    f32x4 acc[2][2][4][2];
    E.init(acc, cur, wr, wc, fr, fq);
    bf16x8 At[4][2], B0[2][2], B1[2][2];
    v8i32 At8[4], B08[2], B18[2];
    int sclA = 0x7F7F7F7F;
    asm volatile("" : "+v"(sclA));
    const char* Abase = (const char*)S.A;
    unsigned c00 = S.rowoff(cur, R0) + C0 * 2u, c01 = S.rowoff(cur, R0 + 64) + C0 * 2u, c10 = S.rowoff(cur, R0 + 128) + C0 * 2u, c11 = S.rowoff(cur, R0 + 192) + C0 * 2u;
    const char* cB = S.bbase(cur);
    PG_STAGE_B(PG_SB(0, 0), cB); PG_STAGE_A(PG_SA(0, 0), c00, c01); PG_STAGE_B(PG_SB(0, 1), cB + hstep); PG_STAGE_A(PG_SA(0, 1), c10, c11);
    if (wr == 1) PG_BAR;
    PG_WAIT_V(4); PG_BAR;
    PG_STAGE_B(PG_SB(1, 0), cB + kstep); PG_STAGE_A(PG_SA(1, 0), c00 + 128u, c01 + 128u); PG_STAGE_B(PG_SB(1, 1), cB + hstep + kstep);
    PG_WAIT_V(6); PG_BAR;
    for (;;) {
        const bool has_next = S.next(ui + 1, nxt);
        const char* nB = has_next ? S.bbase(nxt) : cB;
        unsigned dnx = 0u;
        if constexpr (Sched::LINEAR) { if (has_next) dnx = S.rowoff(nxt, 0) - S.rowoff(cur, 0); }

#pragma unroll 1
        for (int t = 0; t < nt; t += 2) {
            const bool last = (t == nt - 2);
            const unsigned k1 = (unsigned)(t + 1) * 128u, k2 = last ? 0u : (unsigned)(t + 2) * 128u, k3 = k2 + 128u;
            unsigned a2_00, a2_01, a2_10, a2_11, a3_00, a3_01;
            if constexpr (Sched::LINEAR) { const unsigned dl = last ? dnx : 0u; a2_00 = c00 + dl + k2; a2_01 = c01 + dl + k2; a2_10 = c10 + dl + k2; a2_11 = c11 + dl + k2; a3_00 = c00 + dl + k3; a3_01 = c01 + dl + k3; }
            else {
                a2_00 = c00; a2_01 = c01; a2_10 = c10; a2_11 = c11;
                if (last && has_next) { a2_00 = S.rowoff(nxt, R0) + C0 * 2u; a2_01 = S.rowoff(nxt, R0 + 64) + C0 * 2u; a2_10 = S.rowoff(nxt, R0 + 128) + C0 * 2u; a2_11 = S.rowoff(nxt, R0 + 192) + C0 * 2u; }
                a3_00 = a2_00 + k3; a3_01 = a2_01 + k3; a2_00 += k2; a2_01 += k2; a2_10 += k2; a2_11 += k2;
            }
            const char* b2 = last ? nB : cB + (size_t)(t + 2) * kstep;
            const char* b3 = b2 + kstep;
            PG_LDB(B0, 0, 0); PG_SCHED; PG_LDA(At, 0, 0); PG_STAGE_A(PG_SA(1, 1), c10 + k1, c11 + k1);
            PG_WAIT_L(8); PG_BAR; PG_WAIT_L(0); PG_MMA(0, 0, At, B0); PG_BAR; PG_SCHED;
            PG_LDB(B1, 0, 1); PG_STAGE_B(PG_SB(0, 0), b2);
            PG_BAR; PG_WAIT_L(0); PG_MMA(0, 1, At, B1); PG_BAR;
            PG_LDA(At, 0, 1); PG_STAGE_A(PG_SA(0, 0), a2_00, a2_01);
            PG_BAR; PG_WAIT_L(0); PG_MMA(1, 0, At, B0); PG_BAR; PG_SCHED;
            PG_STAGE_B(PG_SB(0, 1), b2 + hstep);
            PG_WAIT_V(6); PG_BAR; PG_MMA(1, 1, At, B1); PG_BAR;
            PG_LDB(B0, 1, 0); PG_SCHED; PG_LDA(At, 1, 0); PG_STAGE_A(PG_SA(0, 1), a2_10, a2_11);
            PG_WAIT_L(8); PG_BAR; PG_WAIT_L(0); PG_MMA(0, 0, At, B0); PG_BAR; PG_SCHED;
            PG_LDB(B1, 1, 1); PG_STAGE_B(PG_SB(1, 0), b3);
            PG_BAR; PG_WAIT_L(0); PG_MMA(0, 1, At, B1); PG_BAR;
            PG_LDA(At, 1, 1); PG_STAGE_A(PG_SA(1, 0), a3_00, a3_01);
            PG_BAR; PG_WAIT_L(0); PG_MMA(1, 0, At, B0); PG_BAR; PG_SCHED;
            PG_STAGE_B(PG_SB(1, 1), b3 + hstep);
            PG_WAIT_V(6); PG_BAR; PG_MMA(1, 1, At, B1); PG_BAR;
        }
        E(acc, cur, wr, wc, fr, fq);
        if (!has_next) break;
        E.init(acc, nxt, wr, wc, fr, fq);
        if constexpr (Sched::LINEAR) { c00 += dnx; c01 += dnx; c10 += dnx; c11 += dnx; }
        else { c00 = S.rowoff(nxt, R0) + C0 * 2u; c01 = S.rowoff(nxt, R0 + 64) + C0 * 2u; c10 = S.rowoff(nxt, R0 + 128) + C0 * 2u; c11 = S.rowoff(nxt, R0 + 192) + C0 * 2u; }
        cur = nxt; cB = nB; ++ui;
    }
    PG_WAIT_V(0);
    if (wr == 0) PG_BAR;
    PG_BAR;
#undef PG_SA
#undef PG_SB
#undef PG_STAGE_A
#undef PG_STAGE_B
#undef PG_LDA
#undef PG_LDB
#undef PG_LDA8
#undef PG_LDB8
#undef PG_LDA16
#undef PG_LDB16
#undef PG_RD16
#undef PG_MMA
#undef PG_WAIT_V
#undef PG_WAIT_L
#undef PG_BAR
#undef PG_SCHED
}

struct DenseSched {
    static constexpr bool LINEAR = true;
    const u16* A; const u16* Bt; int nM, nN, nwg, G, c;
    __device__ void init(const u16* A_, const u16* Bt_, int M, int N, int G_, int c_) { A = A_; Bt = Bt_; nM = M / BM; nN = N / BM; nwg = nM * nN; G = G_; c = c_; }
    __device__ __forceinline__ bool next(int i, Unit& u) const {
        const int L = i * G + c; if (L >= nwg) return false;
        int wgid = L; { const int q = nwg / 8, r = nwg % 8, xcd = wgid % 8, off = wgid / 8; wgid = (xcd < r ? xcd * (q + 1) : r * (q + 1) + (xcd - r) * q) + off; }
        const int nig = 8 * nN, gid = wgid / nig, fm = gid * 8, gsz = (nM - fm) < 8 ? (nM - fm) : 8;
        u.row0 = (fm + ((wgid % nig) % gsz)) * BM; u.pn = (wgid % nig) / gsz; u.nvalid = BM; u.e = 0; u.ord = i; return true;
    }
    __device__ __forceinline__ unsigned rowoff(const Unit& u, int r) const { return (unsigned)(u.row0 + r) * (unsigned)(KD * 2); }
    __device__ __forceinline__ const char* bbase(const Unit& u) const { return (const char*)Bt + (size_t)u.pn * BM * KD * 2; }
};

template <bool GATHER> struct MoeSchedT {
    static constexpr bool LINEAR = !GATHER;
    const u16* A; const u16* Bt; const int* lists; const LDS_AS int* meta; int NT, nunits, G, c; int rowb; const LDS_AS unsigned* rowtab;
    __device__ __forceinline__ bool next(int i, Unit& u) const {
        const int L = i * G + c; if (L >= nunits) return false;
        int wgid = L; { const int q = nunits / 8, r = nunits % 8, xcd = wgid % 8, off = wgid / 8; wgid = (xcd < r ? xcd * (q + 1) : r * (q + 1) + (xcd - r) * q) + off; }
        const int gm = wgid / NT; u.pn = wgid % NT;
        int e = 0;
        while (meta[32 + e + 1] <= gm) ++e;
        const int mi = gm - meta[32 + e];
        u.e = e; u.row0 = meta[72 + e] + mi * BM; u.nvalid = min(BM, meta[e] - mi * BM); u.ord = i;
        return true;
    }
    __device__ __forceinline__ unsigned rowoff(const Unit& u, int r) const {
        if constexpr (GATHER) return rowtab[u.ord * BM + r];
        else return (unsigned)(u.row0 + r) * (unsigned)rowb;
    }
    __device__ __forceinline__ const char* bbase(const Unit& u) const { return (const char*)Bt + ((size_t)u.e * NT + u.pn) * BM * (size_t)rowb; }
};

struct EpiProj {
    static constexpr int SCALE_A = 0x7F7F7F7F, SCALE_B = 0x7F7F7F7F;
    static constexpr bool PERM = true;
    u16* O;
    __device__ __forceinline__ void init(f32x4 (&acc)[2][2][4][2], const Unit&, int, int, int, int) const {
#pragma unroll
        for (int a = 0; a < 2; ++a)
#pragma unroll
            for (int b = 0; b < 2; ++b)
#pragma unroll
                for (int m = 0; m < 4; ++m)
#pragma unroll
                    for (int n = 0; n < 2; ++n) acc[a][b][m][n] = (f32x4){0.f, 0.f, 0.f, 0.f};
    }
    __device__ __forceinline__ void operator()(const f32x4 (&acc)[2][2][4][2], const Unit& u, int wr, int wc, int fr, int fq) const {
        const int row0 = u.row0 + wr * 64 + fr, col0 = u.pn * BM + wc * 32 + 8 * fq;
#pragma unroll
        for (int ai = 0; ai < 2; ++ai)
#pragma unroll
            for (int m = 0; m < 4; ++m) { u16* rowp = O + (size_t)(row0 + ai * HALF + m * 16) * PJW + col0;
#pragma unroll
                for (int bj = 0; bj < 2; ++bj) { const f32x4 v0 = acc[ai][bj][m][0], v1 = acc[ai][bj][m][1];
                    u32x4 w; w.x = pack2(v0[0], v0[1]); w.y = pack2(v0[2], v0[3]); w.z = pack2(v1[0], v1[1]); w.w = pack2(v1[2], v1[3]);
                    *(u32x4*)(rowp + bj * HALF) = w; } }
    }
};
struct EpiOut {
    static constexpr int SCALE_A = 0x7F7F7F7F, SCALE_B = 0x7F7F7F7F;
    static constexpr bool PERM = false;
    const float* X; float* C;
    __device__ __forceinline__ void init(f32x4 (&acc)[2][2][4][2], const Unit& u, int wr, int wc, int fr, int fq) const {
        const int row0 = u.row0 + wr * 64 + fr, col0 = u.pn * BM + wc * 32 + 4 * fq;
#pragma unroll
        for (int ai = 0; ai < 2; ++ai)
#pragma unroll
            for (int m = 0; m < 4; ++m) { const size_t ro = (size_t)(row0 + ai * HALF + m * 16) * D + col0;
#pragma unroll
                for (int bj = 0; bj < 2; ++bj)
#pragma unroll
                    for (int n = 0; n < 2; ++n) acc[ai][bj][m][n] = *(const f32x4*)(X + ro + bj * HALF + n * 16); }
    }
    __device__ __forceinline__ void operator()(const f32x4 (&acc)[2][2][4][2], const Unit& u, int wr, int wc, int fr, int fq) const {
        const int row0 = u.row0 + wr * 64 + fr, col0 = u.pn * BM + wc * 32 + 4 * fq;
#pragma unroll
        for (int ai = 0; ai < 2; ++ai)
#pragma unroll
            for (int m = 0; m < 4; ++m) { const size_t ro = (size_t)(row0 + ai * HALF + m * 16) * D + col0;
#pragma unroll
                for (int bj = 0; bj < 2; ++bj)
#pragma unroll
                    for (int n = 0; n < 2; ++n) *(f32x4*)(C + ro + bj * HALF + n * 16) = acc[ai][bj][m][n]; }
    }
};
struct EpiMoe1 {
    static constexpr int SCALE_A = 0x7F7F7F7F, SCALE_B = 0x7F7F7F7F;
    static constexpr bool PERM = true;
    const float* b1; unsigned char* act8;
    __device__ __forceinline__ void init(f32x4 (&acc)[2][2][4][2], const Unit&, int, int, int, int) const {
#pragma unroll
        for (int a = 0; a < 2; ++a)
#pragma unroll
            for (int b = 0; b < 2; ++b)
#pragma unroll
                for (int m = 0; m < 4; ++m)
#pragma unroll
                    for (int n = 0; n < 2; ++n) acc[a][b][m][n] = (f32x4){0.f, 0.f, 0.f, 0.f};
    }
    __device__ __forceinline__ void operator()(const f32x4 (&acc)[2][2][4][2], const Unit& u, int wr, int wc, int fr, int fq) const {
        const int r0 = wr * 64 + fr, col0 = u.pn * BM + wc * 32 + 8 * fq;
        const float* be = b1 + (size_t)u.e * 2 * DFF + col0;
        f32x4 bv[2][2];
#pragma unroll
        for (int bj = 0; bj < 2; ++bj)
#pragma unroll
            for (int n = 0; n < 2; ++n) bv[bj][n] = *(const f32x4*)(be + bj * HALF + 4 * n);
#pragma unroll
        for (int ai = 0; ai < 2; ++ai)
#pragma unroll
            for (int m = 0; m < 4; ++m) {
                const int r = r0 + ai * HALF + m * 16;
                if (r < u.nvalid) {
                    unsigned char* rowp = act8 + (size_t)(u.row0 + r) * DFF + (col0 >> 1);
#pragma unroll
                    for (int bj = 0; bj < 2; ++bj) {
                        const f32x4 v0 = acc[ai][bj][m][0] * 0.03125f + bv[bj][0], v1 = acc[ai][bj][m][1] * 0.03125f + bv[bj][1];
                        const float g0 = fminf(v0[0], 7.0f), l0 = fminf(fmaxf(v0[1], -7.0f), 7.0f);
                        const float g1 = fminf(v0[2], 7.0f), l1 = fminf(fmaxf(v0[3], -7.0f), 7.0f);
                        const float g2 = fminf(v1[0], 7.0f), l2 = fminf(fmaxf(v1[1], -7.0f), 7.0f);
                        const float g3 = fminf(v1[2], 7.0f), l3 = fminf(fmaxf(v1[3], -7.0f), 7.0f);
                        const float a0 = g0 * __builtin_amdgcn_rcpf(1.0f + __expf(-1.702f * g0)) * (l0 + 1.0f), a1 = g1 * __builtin_amdgcn_rcpf(1.0f + __expf(-1.702f * g1)) * (l1 + 1.0f);
                        const float a2 = g2 * __builtin_amdgcn_rcpf(1.0f + __expf(-1.702f * g2)) * (l2 + 1.0f), a3 = g3 * __builtin_amdgcn_rcpf(1.0f + __expf(-1.702f * g3)) * (l3 + 1.0f);
                        int pk = __builtin_amdgcn_cvt_pk_fp8_f32(a0, a1, 0, false);
                        pk = __builtin_amdgcn_cvt_pk_fp8_f32(a2, a3, pk, true);
                        *(int*)(rowp + bj * (HALF / 2)) = pk;
                    }
                }
            }
    }
};
struct EpiMoe2 {
    static constexpr bool PERM = true;
    static constexpr int SCALE_A = 0x7F7F7F7F, SCALE_B = 0x7A7A7A7A;
    const float* b2; const float* gate; const int* lists; const LDS_AS int* meta; u16* y;
    __device__ __forceinline__ void init(f32x4 (&acc)[2][2][4][2], const Unit&, int, int, int, int) const {
#pragma unroll
        for (int a = 0; a < 2; ++a)
#pragma unroll
            for (int b = 0; b < 2; ++b)
#pragma unroll
                for (int m = 0; m < 4; ++m)
#pragma unroll
                    for (int n = 0; n < 2; ++n) acc[a][b][m][n] = (f32x4){0.f, 0.f, 0.f, 0.f};
    }
    __device__ __forceinline__ void operator()(const f32x4 (&acc)[2][2][4][2], const Unit& u, int wr, int wc, int fr, int fq) const {
        const int r0 = wr * 64 + fr, col0 = u.pn * BM + wc * 32 + 8 * fq;
        const float* be = b2 + (size_t)u.e * D + col0;
        const int* le = lists + (size_t)u.e * T + (u.row0 - meta[72 + u.e]);
        f32x4 bv[2][2];
#pragma unroll
        for (int bj = 0; bj < 2; ++bj)
#pragma unroll
            for (int n = 0; n < 2; ++n) bv[bj][n] = *(const f32x4*)(be + bj * HALF + 4 * n);
        int slot[8]; float gt[8];
#pragma unroll
        for (int q = 0; q < 8; ++q) slot[q] = le[min(r0 + (q >> 2) * HALF + (q & 3) * 16, u.nvalid - 1)];
        __builtin_amdgcn_sched_barrier(0);
#pragma unroll
        for (int q = 0; q < 8; ++q) gt[q] = gate[slot[q]];
        __builtin_amdgcn_sched_barrier(0);
#pragma unroll
        for (int ai = 0; ai < 2; ++ai)
#pragma unroll
            for (int m = 0; m < 4; ++m) {
                const int r = r0 + ai * HALF + m * 16;
                if (r < u.nvalid) {
                    const float g1 = gt[ai * 4 + m];
                    unsigned char* rowp = (unsigned char*)y + (size_t)slot[ai * 4 + m] * D + col0;
                    const float g16 = g1 * 16.0f;
#pragma unroll
                    for (int bj = 0; bj < 2; ++bj) {
                        const f32x4 v0 = (acc[ai][bj][m][0] * 0.03125f + bv[bj][0]) * g16, v1 = (acc[ai][bj][m][1] * 0.03125f + bv[bj][1]) * g16;
                        int lo = __builtin_amdgcn_cvt_pk_fp8_f32(v0[0], v0[1], 0, false); lo = __builtin_amdgcn_cvt_pk_fp8_f32(v0[2], v0[3], lo, true);
                        int hi = __builtin_amdgcn_cvt_pk_fp8_f32(v1[0], v1[1], 0, false); hi = __builtin_amdgcn_cvt_pk_fp8_f32(v1[2], v1[3], hi, true);
                        uint2 w; w.x = (unsigned)lo; w.y = (unsigned)hi;
                        *(uint2*)(rowp + bj * HALF) = w;
                    }
                }
            }
    }
};
}

__device__ __forceinline__ void bg_decode(const Params& p, int s, const float*& src, int& sstr, unsigned char*& dst) {
    const bool isw2 = s < W2_BG;
    const int wi = isw2 ? s : s - W2_BG + W1_CONV;
    const int e = isw2 ? (wi >> 7) : (wi >> 8), j = isw2 ? (wi & 127) : (wi & 255);
    const int kt = isw2 ? (j >> 3) : (j >> 4), nt = isw2 ? (j & 7) : (j & 15);
    sstr = isw2 ? D : 2 * DFF;
    src = (isw2 ? p.w2 + (size_t)e * DFF * D : p.w1 + (size_t)e * D * 2 * DFF) + (size_t)(kt * 64) * sstr + nt * 128;
    dst = (isw2 ? p.w2T8 + (size_t)e * D * DFF : p.w1T8 + (size_t)e * 2 * DFF * D) + (size_t)(nt * 128) * 1024 + kt * 64;
}
constexpr int AT_K = 0, AT_V = 208 * 128, AT_Q = AT_V + 208 * 160, AT_BIAS = AT_Q + 8192;
struct AttnRegs { float tb[3]; };
__device__ __forceinline__ void attn_load(const Params& p, int t, int it, AttnRegs& R) {
    const int br = (it >> 6) % 3, h = (it / 192) & 7;
    const float* bt = p.btab + (br * 8 + h) * 704;
#pragma unroll
    for (int i = 0; i < 3; ++i) { const int en = t + 256 * i; R.tb[i] = bt[en < 704 ? en : 703]; }
}
__device__ void attn_item(const Params& p, char* lds, int t, int it, int nit, AttnRegs& R, int bgt) {
    const int l = t & 63, w = t >> 6, i16 = l & 15, g = l >> 4;
    const int idx = it & 63, br = (it >> 6) % 3, h = (it / 192) & 7, b = it / 1536;
    const int dsh = br * 2, L = S >> dsh, nbl = L >> 6;
    const int res = idx / nbl, qb = idx % nbl;
    char* Ks = lds + AT_K; char* Vs = lds + AT_V; char* Qs = lds + AT_Q; float* biasf = (float*)(lds + AT_BIAS);
    __syncthreads();
    unsigned z0_; asm volatile("v_mov_b32 %0, 0" : "=v"(z0_));
#define AT_LDKV(i) const int kj##i = t + 256 * i, ki##i = 64 * (qb - 1) + (kj##i >> 3); \
        const size_t kb##i = (size_t)(b * S + res + (min(max(ki##i, 0), L - 1) << dsh)) * PJW + h * 64 + (kj##i & 7) * 8; \
        u32x4 kx##i = *(const u32x4*)(p.proj + kb##i + C_AK), vx##i = *(const u32x4*)(p.proj + kb##i + C_AV);
    AT_LDKV(0) AT_LDKV(1) AT_LDKV(2) AT_LDKV(3) AT_LDKV(4) AT_LDKV(5)
#undef AT_LDKV
    const u32x4 qx0 = *(const u32x4*)(p.proj + (size_t)(b * S + res + ((64 * qb + (t >> 3)) << dsh)) * PJW + C_AQ + h * 64 + (t & 7) * 8);
    const u32x4 qx1 = *(const u32x4*)(p.proj + (size_t)(b * S + res + ((64 * qb + 32 + (t >> 3)) << dsh)) * PJW + C_AQ + h * 64 + (t & 7) * 8);
    const float tbc0 = R.tb[0], tbc1 = R.tb[1], tbc2 = R.tb[2];
    attn_load(p, t, nit >= 0 ? nit : it, R);
    asm volatile("" ::: "memory");
    const int bkg = l & 7, bng = w * 8 + (l >> 3);
    f32x4 cb0, cb1, cb2, cb3, cb4, cb5, cb6, cb7;
    {
        const float* s_; int ss_; unsigned char* dd_;
        bg_decode(p, bgt, s_, ss_, dd_);
        s_ += (size_t)(8 * bkg) * ss_ + 4 * bng;
        cb0 = *(const f32x4*)(s_); cb1 = *(const f32x4*)(s_ + ss_); cb2 = *(const f32x4*)(s_ + 2 * ss_); cb3 = *(const f32x4*)(s_ + 3 * ss_);
        cb4 = *(const f32x4*)(s_ + 4 * ss_); cb5 = *(const f32x4*)(s_ + 5 * ss_); cb6 = *(const f32x4*)(s_ + 6 * ss_); cb7 = *(const f32x4*)(s_ + 7 * ss_);
    }
    asm volatile("" ::: "memory");
#define AT_STKV(i) { const int row_ = kj##i >> 3, c_ = kj##i & 7; *(u32x4*)(Ks + tile_off(row_, c_)) = kx##i; *(u32x4*)(Vs + row_ * 160 + c_ * 16) = vx##i; }
    AT_STKV(0) AT_STKV(1) AT_STKV(2) AT_STKV(3) AT_STKV(4) AT_STKV(5)
#undef AT_STKV
    { const u32x4 zz = {z0_, z0_, z0_, z0_};
      if (t < 160) *(u32x4*)(Vs + 192 * 160 + t * 16) = zz; else if (t < 224) { *(u32x4*)(Ks + 192 * 128 + (t - 160) * 16) = zz; *(u32x4*)(Ks + 192 * 128 + (t - 96) * 16) = zz; } }
    *(u32x4*)(Qs + tile_off(t >> 3, t & 7)) = qx0;
    *(u32x4*)(Qs + tile_off(32 + (t >> 3), t & 7)) = qx1;
    biasf[t] = tbc0; biasf[t + 256] = tbc1; if (t + 512 < 704) biasf[t + 512] = tbc2;
    __syncthreads();

    const bf16x8 qf0 = lds_frag(Qs, 16 * w + i16, g), qf1 = lds_frag(Qs, 16 * w + i16, 4 + g);
    const char* Kw = Ks + 16 * w * 128;
    f32x4 sc[10];
#pragma unroll
    for (int i = 0; i < 10; ++i) {
        const bf16x8 k0 = lds_frag(Kw, 16 * i + i16, g), k1 = lds_frag(Kw, 16 * i + i16, 4 + g);
        f32x4 a = {0.f, 0.f, 0.f, 0.f};
        a = __builtin_amdgcn_mfma_f32_16x16x32_bf16(k0, qf0, a, 0, 0, 0);
        a = __builtin_amdgcn_mfma_f32_16x16x32_bf16(k1, qf1, a, 0, 0, 0);
        sc[i] = a;
    }
    const int sq = 16 * w + i16;
    const float* tabc = biasf + (i16 & 3) * 176 + 4 * g - 4 * (i16 >> 2) + 16;
    float mx = -3.0e38f;
#pragma unroll
    for (int i = 0; i < 10; ++i) {
        const f32x4 b4 = *(const f32x4*)(tabc + 16 * i);
#pragma unroll
        for (int r = 0; r < 4; ++r) sc[i][r] = fmaf(sc[i][r], 0.125f * 1.44269504f, b4[r]);
    }
    if (qb == 0 || qb == nbl - 1) {
        const int lo = (qb == 0) ? 64 : 0, hi = (qb == nbl - 1) ? 128 : 192;
#pragma unroll
        for (int i = 0; i < 10; ++i)
#pragma unroll
            for (int r = 0; r < 4; ++r) { const int tk = 16 * (w + i) + 4 * g + r; sc[i][r] = (tk >= lo && tk < hi) ? sc[i][r] : -1.0e30f; }
    }
#pragma unroll
    for (int i = 0; i < 10; ++i) mx = fmaxf(mx, fmaxf(fmaxf(sc[i][0], sc[i][1]), fmaxf(sc[i][2], sc[i][3])));
    mx = fmaxf(mx, swz_xor<16>(mx)); mx = half_max(mx);
    float ls = 0.f;
#pragma unroll
    for (int i = 0; i < 10; ++i) {
#pragma unroll
        for (int r = 0; r < 4; ++r) { const float e = __builtin_amdgcn_exp2f(sc[i][r] - mx); sc[i][r] = e; ls += e; }
    }
    ls += swz_xor<16>(ls); ls = half_sum(ls);

    f32x4 oa[4];
#pragma unroll
    for (int e = 0; e < 4; ++e) oa[e] = (f32x4){0.f, 0.f, 0.f, 0.f};
    const char* Vw = Vs + (16 * w + 4 * g + (i16 >> 2)) * 160 + 4 * (i16 & 3) * 2;
#pragma unroll
    for (int i2 = 0; i2 < 5; ++i2) {
        uint4 pu;
        pu.x = pack2(sc[2 * i2][0], sc[2 * i2][1]); pu.y = pack2(sc[2 * i2][2], sc[2 * i2][3]);
        pu.z = pack2(sc[2 * i2 + 1][0], sc[2 * i2 + 1][1]); pu.w = pack2(sc[2 * i2 + 1][2], sc[2 * i2 + 1][3]);
        const bf16x8 pf = __builtin_bit_cast(bf16x8, pu);
#pragma unroll
        for (int et = 0; et < 4; ++et) {
            const s16x4 va = tr_read(Vw + (32 * i2) * 160 + et * 32);
            const s16x4 vb = tr_read(Vw + (32 * i2 + 16) * 160 + et * 32);
            oa[et] = __builtin_amdgcn_mfma_f32_16x16x32_bf16(cat4(va, vb), pf, oa[et], 0, 0, 0);
        }
    }
    const float inv = 1.0f / ls;
    const size_t tok = (size_t)b * S + res + ((64 * qb + sq) << dsh);
#pragma unroll
    for (int et = 0; et < 4; ++et) {
        uint2 o; o.x = pack2(oa[et][0] * inv, oa[et][1] * inv); o.y = pack2(oa[et][2] * inv, oa[et][3] * inv);
        *(uint2*)(p.abr + ((size_t)br * T + tok) * 512 + h * 64 + 16 * et + 4 * g) = o;
    }
    if (g == 0) p.lse[((size_t)br * T + tok) * 8 + h] = (mx + __log2f(ls)) * 0.69314718f;
    {
        const float* s_; int ss_; unsigned char* d_;
        bg_decode(p, bgt, s_, ss_, d_);
        d_ += (size_t)(4 * bng) * 1024 + 8 * bkg;
#pragma unroll
        for (int c_ = 0; c_ < 4; ++c_) {
            int lo_ = __builtin_amdgcn_cvt_pk_fp8_f32(cb0[c_] * 32.0f, cb1[c_] * 32.0f, 0, false); lo_ = __builtin_amdgcn_cvt_pk_fp8_f32(cb2[c_] * 32.0f, cb3[c_] * 32.0f, lo_, true);
            int hi_ = __builtin_amdgcn_cvt_pk_fp8_f32(cb4[c_] * 32.0f, cb5[c_] * 32.0f, 0, false); hi_ = __builtin_amdgcn_cvt_pk_fp8_f32(cb6[c_] * 32.0f, cb7[c_] * 32.0f, hi_, true);
            uint2 q_; q_.x = (unsigned)lo_; q_.y = (unsigned)hi_; *(uint2*)(d_ + c_ * 1024) = q_;
        }
    }
}

constexpr int GL_ZS = 0, GL_TOT = 8192, GL_GG = 10240, GL_BF = 10752, GL_BS = 68, GL_BB = GL_BF + 64 * GL_BS * 4, GL_R2 = GL_BB + 64 * GL_BS * 4;
__device__ __forceinline__ float logsig_fast(float a) { return fminf(a, 0.f) - __logf(1.0f + __expf(-fabsf(a))); }
__device__ __forceinline__ void gla_prep(const Params& p, char* lds, int t, int h) {
    const int d = t & 63, w = t >> 6;
    float* zs = (float*)(lds + GL_ZS); float* tot = (float*)(lds + GL_TOT); float* GG = (float*)(lds + GL_GG);
    float* BF = (float*)(lds + GL_BF); float* BB = (float*)(lds + GL_BB);
    float wf[16], wb[16];
#pragma unroll
    for (int r = 0; r < 16; ++r) { wf[r] = p.wgf[r * 256 + h * 64 + d]; wb[r] = p.wgb[r * 256 + h * 64 + d]; }
    const float biasf = p.bgf[h * 64 + d], biasb = p.bgb[h * 64 + d];
    __syncthreads();
    float bfv[16], bbv[16];
#pragma unroll
    for (int i = 0; i < 16; ++i) {
        const float4* zr = (const float4*)(zs + (16 * w + i) * 32);
        float af = biasf, ab = biasb;
#pragma unroll
        for (int r4 = 0; r4 < 4; ++r4) {
            const float4 zf = zr[r4], zb = zr[4 + r4];
            af = fmaf(zf.x, wf[4 * r4], af); af = fmaf(zf.y, wf[4 * r4 + 1], af); af = fmaf(zf.z, wf[4 * r4 + 2], af); af = fmaf(zf.w, wf[4 * r4 + 3], af);
            ab = fmaf(zb.x, wb[4 * r4], ab); ab = fmaf(zb.y, wb[4 * r4 + 1], ab); ab = fmaf(zb.z, wb[4 * r4 + 2], ab); ab = fmaf(zb.w, wb[4 * r4 + 3], ab);
        }
        bfv[i] = logsig_fast(af) * (1.0f / 16.0f); bbv[i] = logsig_fast(ab) * (1.0f / 16.0f);
    }
#pragma unroll
    for (int i = 1; i < 16; ++i) bfv[i] += bfv[i - 1];
#pragma unroll
    for (int i = 14; i >= 0; --i) bbv[i] += bbv[i + 1];
    tot[(0 * 4 + w) * 64 + d] = bfv[15];
    tot[(1 * 4 + w) * 64 + d] = bbv[0];
    __syncthreads();
    float offf = 0.f, offb = 0.f, Gf = 0.f, Gb = 0.f;
#pragma unroll
    for (int ww = 0; ww < 4; ++ww) {
        const float a = tot[(0 * 4 + ww) * 64 + d], c = tot[(1 * 4 + ww) * 64 + d];
        Gf += a; Gb += c;
        if (ww < w) offf += a;
        if (ww > w) offb += c;
    }
#pragma unroll
    for (int i = 0; i < 16; ++i) { BF[(16 * w + i) * GL_BS + d] = bfv[i] + offf; BB[(16 * w + i) * GL_BS + d] = bbv[i] + offb; }
    if (w == 0) { GG[d] = Gf; GG[64 + d] = Gb; }
    __syncthreads();
}
__device__ __forceinline__ void unpack8(const uint4 u, float (&f)[8]) {
    f[0] = lo2f(u.x); f[1] = hi2f(u.x); f[2] = lo2f(u.y); f[3] = hi2f(u.y); f[4] = lo2f(u.z); f[5] = hi2f(u.z); f[6] = lo2f(u.w); f[7] = hi2f(u.w);
}
__device__ __forceinline__ uint4 pack8(const float (&f)[8]) { uint4 u; u.x = pack2(f[0], f[1]); u.y = pack2(f[2], f[3]); u.z = pack2(f[4], f[5]); u.w = pack2(f[6], f[7]); return u; }

constexpr int GD_KF = GL_R2, GD_KB = GD_KF + 64 * 160, GD_VT = GL_BF;
__device__ void gla_ds_item(const Params& p, char* lds, int t, int it) {
    const int l = t & 63, w = t >> 6, i16 = l & 15, g = l >> 4;
    const int n = it & 63, h = (it >> 6) & 3, b = it >> 8;
    const int t0 = b * S + n * 64;
    float* zs = (float*)(lds + GL_ZS);
    const int sr = t >> 2, sc = t & 3;
    const u16* kp = p.proj + (size_t)(t0 + sr) * PJW + C_GK + h * 64 + sc * 16;
    const uint4 kr0 = *(const uint4*)(kp), kr1 = *(const uint4*)(kp + 8);
    u32x4 vr[4];
#pragma unroll
    for (int i = 0; i < 4; ++i) { const int j = t + 256 * i; vr[i] = *(const u32x4*)(p.proj + (size_t)(t0 + (j >> 4)) * PJW + C_GV + h * 128 + (j & 15) * 8); }
    const float4* zsrc = (const float4*)(p.zbuf + (size_t)t0 * 32);
    const float4 zv0 = zsrc[t], zv1 = zsrc[t + 256];
    __syncthreads();
    ((float4*)zs)[t] = zv0; ((float4*)zs)[t + 256] = zv1;
    gla_prep(p, lds, t, h);
    const float* BF = (const float*)(lds + GL_BF); const float* BB = (const float*)(lds + GL_BB); const float* GG = (const float*)(lds + GL_GG);
    char* KF = lds + GD_KF; char* KB = lds + GD_KB; char* VT = lds + GD_VT;
    {
        float kk[16];
        { float tmp[8]; unpack8(kr0, tmp);
#pragma unroll
          for (int j = 0; j < 8; ++j) kk[j] = tmp[j];
          unpack8(kr1, tmp);
#pragma unroll
          for (int j = 0; j < 8; ++j) kk[8 + j] = tmp[j]; }
        float of[16], ob[16];
#pragma unroll
        for (int q = 0; q < 4; ++q) {
            const float4 bf4 = *(const float4*)(BF + sr * GL_BS + sc * 16 + 4 * q), bb4 = *(const float4*)(BB + sr * GL_BS + sc * 16 + 4 * q);
            const float4 gf4 = *(const float4*)(GG + sc * 16 + 4 * q), gb4 = *(const float4*)(GG + 64 + sc * 16 + 4 * q);
            of[4 * q + 0] = kk[4 * q + 0] * __expf(gf4.x - bf4.x); of[4 * q + 1] = kk[4 * q + 1] * __expf(gf4.y - bf4.y);
            of[4 * q + 2] = kk[4 * q + 2] * __expf(gf4.z - bf4.z); of[4 * q + 3] = kk[4 * q + 3] * __expf(gf4.w - bf4.w);
            ob[4 * q + 0] = kk[4 * q + 0] * __expf(gb4.x - bb4.x); ob[4 * q + 1] = kk[4 * q + 1] * __expf(gb4.y - bb4.y);
            ob[4 * q + 2] = kk[4 * q + 2] * __expf(gb4.z - bb4.z); ob[4 * q + 3] = kk[4 * q + 3] * __expf(gb4.w - bb4.w);
        }
        uint4 u;
        u.x = pack2(of[0], of[1]); u.y = pack2(of[2], of[3]); u.z = pack2(of[4], of[5]); u.w = pack2(of[6], of[7]);
        *(uint4*)(KF + sr * 160 + sc * 32) = u;
        u.x = pack2(of[8], of[9]); u.y = pack2(of[10], of[11]); u.z = pack2(of[12], of[13]); u.w = pack2(of[14], of[15]);
        *(uint4*)(KF + sr * 160 + sc * 32 + 16) = u;
        u.x = pack2(ob[0], ob[1]); u.y = pack2(ob[2], ob[3]); u.z = pack2(ob[4], ob[5]); u.w = pack2(ob[6], ob[7]);
        *(uint4*)(KB + sr * 160 + sc * 32) = u;
        u.x = pack2(ob[8], ob[9]); u.y = pack2(ob[10], ob[11]); u.z = pack2(ob[12], ob[13]); u.w = pack2(ob[14], ob[15]);
        *(uint4*)(KB + sr * 160 + sc * 32 + 16) = u;
        if (t < 64) { p.dec[((size_t)it * 2 + 0) * 64 + t] = __expf(GG[t]); p.dec[((size_t)it * 2 + 1) * 64 + t] = __expf(GG[64 + t]); }
    }
    __syncthreads();
#pragma unroll
    for (int i = 0; i < 4; ++i) { const int j = t + 256 * i; *(u32x4*)(VT + (j >> 4) * 288 + (j & 15) * 16) = vr[i]; }
    __syncthreads();
#pragma unroll
    for (int dir = 0; dir < 2; ++dir) {
        const char* KX = dir ? KB : KF;
        f32x4 acc[2][4];
#pragma unroll
        for (int a = 0; a < 2; ++a)
#pragma unroll
            for (int c = 0; c < 4; ++c) acc[a][c] = (f32x4){0.f, 0.f, 0.f, 0.f};
#pragma unroll
        for (int ks = 0; ks < 2; ++ks) {
            const int r0 = ks * 32 + 8 * g + (i16 >> 2);
            bf16x8 vf[2], kf[4];
#pragma unroll
            for (int a = 0; a < 2; ++a) {
                const int e0 = 16 * (2 * w + a) + 4 * (i16 & 3);
                vf[a] = cat4(tr_read(VT + r0 * 288 + e0 * 2), tr_read(VT + (r0 + 4) * 288 + e0 * 2));
            }
#pragma unroll
            for (int c = 0; c < 4; ++c) {
                const int d0 = 16 * c + 4 * (i16 & 3);
                kf[c] = cat4(tr_read(KX + r0 * 160 + d0 * 2), tr_read(KX + (r0 + 4) * 160 + d0 * 2));
            }
#pragma unroll
            for (int a = 0; a < 2; ++a)
#pragma unroll
                for (int c = 0; c < 4; ++c) acc[a][c] = __builtin_amdgcn_mfma_f32_16x16x32_bf16(kf[c], vf[a], acc[a][c], 0, 0, 0);
        }
        float* dst = p.dS + ((size_t)it * 2 + dir) * 128 * 64;
#pragma unroll
        for (int a = 0; a < 2; ++a)
#pragma unroll
            for (int c = 0; c < 4; ++c) *(f32x4*)(dst + (16 * (2 * w + a) + i16) * 64 + 16 * c + 4 * g) = acc[a][c];
    }
}

__device__ void gla_scan_thread2(const Params& p, int gid) {
    const int d = gid & 63, e = (gid >> 6) & 127, dir = (gid >> 13) & 1, bh0 = gid >> 14, bh1 = bh0 + 8;
    float s0 = 0.f, s1 = 0.f;
#pragma unroll 8
    for (int step = 0; step < 64; ++step) {
        const int n = dir ? (63 - step) : step;
        const size_t i0 = ((size_t)(bh0 * 64 + n)) * 2 + dir, i1 = ((size_t)(bh1 * 64 + n)) * 2 + dir;
        const float dc0 = p.dec[i0 * 64 + d], ds0 = p.dS[(i0 * 128 + e) * 64 + d];
        const float dc1 = p.dec[i1 * 64 + d], ds1 = p.dS[(i1 * 128 + e) * 64 + d];
        p.Sp[(i0 * 128 + e) * 64 + d] = f2bf(s0);
        p.Sp[(i1 * 128 + e) * 64 + d] = f2bf(s1);
        s0 = fmaf(dc0, s0, ds0); s1 = fmaf(dc1, s1, ds1);
    }
}

__device__ void attn_combine_thread(const Params& p, int gid) {
    const int tok = gid >> 6, c = gid & 63, h = c >> 3;
    const float l0 = p.lse[((size_t)0 * T + tok) * 8 + h], l1 = p.lse[((size_t)1 * T + tok) * 8 + h], l2 = p.lse[((size_t)2 * T + tok) * 8 + h];
    const float mm = fmaxf(l0, fmaxf(l1, l2));
    float w0 = __expf(l0 - mm), w1 = __expf(l1 - mm), w2 = __expf(l2 - mm);
    const float inv = 1.0f / (w0 + w1 + w2);
    w0 *= inv; w1 *= inv; w2 *= inv;
    const uint4 a0 = *(const uint4*)(p.abr + ((size_t)0 * T + tok) * 512 + c * 8);
    const uint4 a1 = *(const uint4*)(p.abr + ((size_t)1 * T + tok) * 512 + c * 8);
    const uint4 a2 = *(const uint4*)(p.abr + ((size_t)2 * T + tok) * 512 + c * 8);
    uint4 o;
    o.x = pack2(w0 * lo2f(a0.x) + w1 * lo2f(a1.x) + w2 * lo2f(a2.x), w0 * hi2f(a0.x) + w1 * hi2f(a1.x) + w2 * hi2f(a2.x));
    o.y = pack2(w0 * lo2f(a0.y) + w1 * lo2f(a1.y) + w2 * lo2f(a2.y), w0 * hi2f(a0.y) + w1 * hi2f(a1.y) + w2 * hi2f(a2.y));
    o.z = pack2(w0 * lo2f(a0.z) + w1 * lo2f(a1.z) + w2 * lo2f(a2.z), w0 * hi2f(a0.z) + w1 * hi2f(a1.z) + w2 * hi2f(a2.z));
    o.w = pack2(w0 * lo2f(a0.w) + w1 * lo2f(a1.w) + w2 * lo2f(a2.w), w0 * hi2f(a0.w) + w1 * hi2f(a1.w) + w2 * hi2f(a2.w));
    *(uint4*)(p.mix + (size_t)tok * D + c * 8) = o;
}

constexpr int GO_QF = GL_R2, GO_QB = GO_QF + 8192, GO_KF = GO_QB + 8192, GO_KB = GO_KF + 8192, GO_VT = GL_R2, GO_AM = GL_ZS, GO_SF = GL_BF, GO_SB = GL_BF + 16384;
__device__ void gla_out_item(const Params& p, char* lds, int t, int it) {
    const int l = t & 63, w = t >> 6, i16 = l & 15, g = l >> 4;
    const int n = it & 63, h = (it >> 6) & 3, b = it >> 8;
    const int t0 = b * S + n * 64;
    float* zs = (float*)(lds + GL_ZS);
    const int sr = t >> 2, sc = t & 3;
    const float4* zsrc = (const float4*)(p.zbuf + (size_t)t0 * 32);
    const float4 zv0 = zsrc[t], zv1 = zsrc[t + 256];
    const u16* qp = p.proj + (size_t)(t0 + sr) * PJW + C_GQ + h * 64 + sc * 16;
    const u16* kp = p.proj + (size_t)(t0 + sr) * PJW + C_GK + h * 64 + sc * 16;
    const uint4 qr0 = *(const uint4*)(qp), qr1 = *(const uint4*)(qp + 8), kr0 = *(const uint4*)(kp), kr1 = *(const uint4*)(kp + 8);
    u32x4 vr[4], sv[8];
#pragma unroll
    for (int i = 0; i < 4; ++i) { const int j = t + 256 * i; vr[i] = *(const u32x4*)(p.proj + (size_t)(t0 + (j >> 4)) * PJW + C_GV + h * 128 + (j & 15) * 8); }
    const u16* SPG = p.Sp + (size_t)it * 2 * 128 * 64;
    __syncthreads();
    ((float4*)zs)[t] = zv0; ((float4*)zs)[t + 256] = zv1;
    gla_prep(p, lds, t, h);
#pragma unroll
    for (int i = 0; i < 8; ++i) { const int j = t + 256 * i; sv[i] = *(const u32x4*)(SPG + (size_t)j * 8); }
    const float* BF = (const float*)(lds + GL_BF); const float* BB = (const float*)(lds + GL_BB);
    char* QF = lds + GO_QF; char* QB = lds + GO_QB; char* KF = lds + GO_KF; char* KB = lds + GO_KB; char* VT = lds + GO_VT; char* AM = lds + GO_AM;
    char* SF = lds + GO_SF; char* SB = lds + GO_SB;
    {
        float qq[16], kk[16];
        { float tmp[8];
          unpack8(qr0, tmp);
#pragma unroll
          for (int j = 0; j < 8; ++j) qq[j] = tmp[j] * 0.125f;
          unpack8(qr1, tmp);
#pragma unroll
          for (int j = 0; j < 8; ++j) qq[8 + j] = tmp[j] * 0.125f;
          unpack8(kr0, tmp);
#pragma unroll
          for (int j = 0; j < 8; ++j) kk[j] = tmp[j];
          unpack8(kr1, tmp);
#pragma unroll
          for (int j = 0; j < 8; ++j) kk[8 + j] = tmp[j]; }
        float ef[16], eb[16];
#pragma unroll
        for (int q = 0; q < 4; ++q) {
            const float4 bf4 = *(const float4*)(BF + sr * GL_BS + sc * 16 + 4 * q), bb4 = *(const float4*)(BB + sr * GL_BS + sc * 16 + 4 * q);
            ef[4 * q + 0] = __expf(bf4.x); ef[4 * q + 1] = __expf(bf4.y); ef[4 * q + 2] = __expf(bf4.z); ef[4 * q + 3] = __expf(bf4.w);
            eb[4 * q + 0] = __expf(bb4.x); eb[4 * q + 1] = __expf(bb4.y); eb[4 * q + 2] = __expf(bb4.z); eb[4 * q + 3] = __expf(bb4.w);
        }
        float o8[8];
#pragma unroll
        for (int hh = 0; hh < 2; ++hh) {
            const int off = tile_off(sr, 2 * sc + hh);
#pragma unroll
            for (int j = 0; j < 8; ++j) o8[j] = qq[8 * hh + j] * ef[8 * hh + j];
            *(uint4*)(QF + off) = pack8(o8);
#pragma unroll
            for (int j = 0; j < 8; ++j) o8[j] = kk[8 * hh + j] / ef[8 * hh + j];
            *(uint4*)(KF + off) = pack8(o8);
#pragma unroll
            for (int j = 0; j < 8; ++j) o8[j] = qq[8 * hh + j] * eb[8 * hh + j];
            *(uint4*)(QB + off) = pack8(o8);
#pragma unroll
            for (int j = 0; j < 8; ++j) o8[j] = kk[8 * hh + j] / eb[8 * hh + j];
            *(uint4*)(KB + off) = pack8(o8);
        }
    }
    __syncthreads();
#pragma unroll
    for (int i = 0; i < 8; ++i) { const int j = t + 256 * i; *(u32x4*)((j >> 10 ? SB : SF) + tile_off((j >> 3) & 127, j & 7)) = sv[i]; }
    const int cq = 16 * w + i16;
    const bf16x8 qf0 = lds_frag(QF, cq, g), qf1 = lds_frag(QF, cq, 4 + g);
    const bf16x8 qb0 = lds_frag(QB, cq, g), qb1 = lds_frag(QB, cq, 4 + g);
    uint2 amo[4];
#pragma unroll
    for (int st = 0; st < 4; ++st) {
        f32x4 af = {0.f, 0.f, 0.f, 0.f}, ab = {0.f, 0.f, 0.f, 0.f};
        af = __builtin_amdgcn_mfma_f32_16x16x32_bf16(lds_frag(KF, 16 * st + i16, g), qf0, af, 0, 0, 0);
        af = __builtin_amdgcn_mfma_f32_16x16x32_bf16(lds_frag(KF, 16 * st + i16, 4 + g), qf1, af, 0, 0, 0);
        ab = __builtin_amdgcn_mfma_f32_16x16x32_bf16(lds_frag(KB, 16 * st + i16, g), qb0, ab, 0, 0, 0);
        ab = __builtin_amdgcn_mfma_f32_16x16x32_bf16(lds_frag(KB, 16 * st + i16, 4 + g), qb1, ab, 0, 0, 0);
        float am[4];
#pragma unroll
        for (int r = 0; r < 4; ++r) {
            const int s = 16 * st + 4 * g + r;
            am[r] = (s <= cq ? af[r] : 0.f) + (s >= cq ? ab[r] : 0.f);
        }
        amo[st].x = pack2(am[0], am[1]); amo[st].y = pack2(am[2], am[3]);
    }
#pragma unroll
    for (int st = 0; st < 4; ++st) { const int s0 = 16 * st + 4 * g; *(uint2*)(AM + tile_off(cq, s0 >> 3) + (s0 & 7) * 2) = amo[st]; }
    __syncthreads();
#pragma unroll
    for (int i = 0; i < 4; ++i) { const int j = t + 256 * i; *(u32x4*)(VT + (j >> 4) * 288 + (j & 15) * 16) = vr[i]; }
    __syncthreads();
    f32x4 oc[8];
#pragma unroll
    for (int et = 0; et < 8; ++et) oc[et] = (f32x4){0.f, 0.f, 0.f, 0.f};
#pragma unroll
    for (int ks = 0; ks < 2; ++ks) {
        const bf16x8 amf = lds_frag(AM, cq, ks * 4 + g);
        const bf16x8 qff = ks ? qf1 : qf0, qbf = ks ? qb1 : qb0;
        const int r0 = ks * 32 + 8 * g + (i16 >> 2);
#pragma unroll
        for (int et = 0; et < 8; ++et) {
            const int e0 = 16 * et + 4 * (i16 & 3);
            const bf16x8 vf = cat4(tr_read(VT + r0 * 288 + e0 * 2), tr_read(VT + (r0 + 4) * 288 + e0 * 2));
            oc[et] = __builtin_amdgcn_mfma_f32_16x16x32_bf16(vf, amf, oc[et], 0, 0, 0);
            oc[et] = __builtin_amdgcn_mfma_f32_16x16x32_bf16(lds_frag(SF, 16 * et + i16, ks * 4 + g), qff, oc[et], 0, 0, 0);
            oc[et] = __builtin_amdgcn_mfma_f32_16x16x32_bf16(lds_frag(SB, 16 * et + i16, ks * 4 + g), qbf, oc[et], 0, 0, 0);
        }
    }
    float ss = 0.f;
#pragma unroll
    for (int et = 0; et < 8; ++et)
#pragma unroll
        for (int r = 0; r < 4; ++r) ss += oc[et][r] * oc[et][r];
    ss += swz_xor<16>(ss); ss = half_sum(ss);
    const float rstd = rsqrtf(ss * (1.0f / 128.0f) + EPS);
    const size_t tok = (size_t)t0 + cq;
#pragma unroll
    for (int et = 0; et < 8; ++et) {
        const int e = 16 * et + 4 * g;
        const uint2 gg = *(const uint2*)(p.proj + tok * PJW + C_GO + h * 128 + e);
        const float4 ng = *(const float4*)(p.gla_ng + h * 128 + e);
        const float g0 = lo2f(gg.x), g1 = hi2f(gg.x), g2 = lo2f(gg.y), g3 = hi2f(gg.y);
        uint2 o;
        o.x = pack2(oc[et][0] * rstd * ng.x * (g0 / (1.0f + __expf(-g0))), oc[et][1] * rstd * ng.y * (g1 / (1.0f + __expf(-g1))));
        o.y = pack2(oc[et][2] * rstd * ng.z * (g2 / (1.0f + __expf(-g2))), oc[et][3] * rstd * ng.w * (g3 / (1.0f + __expf(-g3))));
        *(uint2*)(p.mix + tok * D + 512 + h * 128 + e) = o;
    }
}

constexpr int RT_RS = 1028;
constexpr int RT_XS = 0, RT_PART = 16 * RT_RS * 4, RT_PE = RT_PART + 4 * 16 * 32 * 4 + 512, RT_RANK = RT_PE + 1024, RT_HIST = RT_RANK + 1024, RT_BASE = RT_HIST + 128;
__device__ void ph_route(const Params& p, char* ldsall, int wv__) {
    const int tid = tid_opaque(), t = tid & 255, half = tid >> 8, lane = t & 63, w = t >> 6;
    char* lds = ldsall + half * HALF_LDS;
    const int vb = blockIdx.x * 2 + half, nvb = gridDim.x * 2;
    float* xs = (float*)(lds + RT_XS); float* part = (float*)(lds + RT_PART);
    int* pe = (int*)(lds + RT_PE); int* rank = (int*)(lds + RT_RANK); int* hist = (int*)(lds + RT_HIST); int* base = (int*)(lds + RT_BASE);
    const int ngr = (T / 16 + nvb - 1) / nvb;
    for (int gl = 0; gl < ngr; ++gl) {
        const int gi = vb + gl * nvb;
        const bool live = gi < T / 16;
        const int tok0 = (live ? gi : 0) * 16;
        __syncthreads();
#pragma unroll
        for (int th = 0; th < 2; ++th) {
            f32x4 v[2][4];
#pragma unroll
            for (int tt = 0; tt < 2; ++tt) {
                const f32x4* xr = (const f32x4*)(p.x1 + (size_t)(tok0 + 4 * w + 2 * th + tt) * D);
#pragma unroll
                for (int i = 0; i < 4; ++i) v[tt][i] = xr[lane + 64 * i];
            }
#pragma unroll
            for (int tt = 0; tt < 2; ++tt) {
                const int tl = 4 * w + 2 * th + tt, tok = tok0 + tl;
                float ss = 0.f;
#pragma unroll
                for (int i = 0; i < 4; ++i) ss += v[tt][i][0] * v[tt][i][0] + v[tt][i][1] * v[tt][i][1] + v[tt][i][2] * v[tt][i][2] + v[tt][i][3] * v[tt][i][3];
                ss = wave_sum(ss);
                const float r = rsqrtf(ss * (1.0f / D) + EPS);
#pragma unroll
                for (int i = 0; i < 4; ++i) {
                    const f32x4 gq = ((const f32x4*)p.g2)[lane + 64 * i];
                    const f32x4 yv = v[tt][i] * r * gq;
                    *(f32x4*)(xs + tl * RT_RS + (lane + 64 * i) * 4) = yv;
                    if (live) { int pk = __builtin_amdgcn_cvt_pk_fp8_f32(yv[0], yv[1], 0, false); pk = __builtin_amdgcn_cvt_pk_fp8_f32(yv[2], yv[3], pk, true); *(int*)(p.xn28 + (size_t)tok * D + (lane + 64 * i) * 4) = pk; }
                }
            }
        }
        __syncthreads();
        {
            const int i16 = lane & 15, kq = lane >> 4;
            const float* xa = xs + i16 * RT_RS + 256 * w + 64 * kq;
            const float* rwp = p.rw + (size_t)(256 * w + 64 * kq) * 32 + i16;
            f32x4 a0 = {0.f, 0.f, 0.f, 0.f}, a1 = {0.f, 0.f, 0.f, 0.f};
            f32x4 bqA[8];
#define RT_LOADB(dst, b) do { _Pragma("unroll") for (int q = 0; q < 8; ++q) { \
                dst[q][0] = rwp[(size_t)((b) * 16 + 2 * q) * 32]; dst[q][1] = rwp[(size_t)((b) * 16 + 2 * q) * 32 + 16]; \
                dst[q][2] = rwp[(size_t)((b) * 16 + 2 * q + 1) * 32]; dst[q][3] = rwp[(size_t)((b) * 16 + 2 * q + 1) * 32 + 16]; } } while (0)
#define RT_MMA(src, b) do { _Pragma("unroll") for (int s4 = 0; s4 < 4; ++s4) { const float4 av = *(const float4*)(xa + 16 * (b) + 4 * s4); \
                a0 = __builtin_amdgcn_mfma_f32_16x16x4f32(av.x, src[2 * s4][0], a0, 0, 0, 0); a1 = __builtin_amdgcn_mfma_f32_16x16x4f32(av.x, src[2 * s4][1], a1, 0, 0, 0); \
                a0 = __builtin_amdgcn_mfma_f32_16x16x4f32(av.y, src[2 * s4][2], a0, 0, 0, 0); a1 = __builtin_amdgcn_mfma_f32_16x16x4f32(av.y, src[2 * s4][3], a1, 0, 0, 0); \
                a0 = __builtin_amdgcn_mfma_f32_16x16x4f32(av.z, src[2 * s4 + 1][0], a0, 0, 0, 0); a1 = __builtin_amdgcn_mfma_f32_16x16x4f32(av.z, src[2 * s4 + 1][1], a1, 0, 0, 0); \
                a0 = __builtin_amdgcn_mfma_f32_16x16x4f32(av.w, src[2 * s4 + 1][2], a0, 0, 0, 0); a1 = __builtin_amdgcn_mfma_f32_16x16x4f32(av.w, src[2 * s4 + 1][3], a1, 0, 0, 0); } } while (0)
#pragma unroll
            for (int b = 0; b < 4; ++b) {
                RT_LOADB(bqA, b);
                __builtin_amdgcn_sched_barrier(0);
                RT_MMA(bqA, b);
                __builtin_amdgcn_sched_barrier(0);
            }
#undef RT_LOADB
#undef RT_MMA
#pragma unroll
            for (int r = 0; r < 4; ++r) { part[(w * 16 + 4 * kq + r) * 32 + i16] = a0[r]; part[(w * 16 + 4 * kq + r) * 32 + 16 + i16] = a1[r]; }
        }
        __syncthreads();
#pragma unroll
        for (int ro = 0; ro < 2; ++ro) {
            const int tk = 4 * w + 2 * ro + (lane >> 5), e = lane & 31;
            float v = p.rb[e] + ((part[(0 * 16 + tk) * 32 + e] + part[(1 * 16 + tk) * 32 + e]) + (part[(2 * 16 + tk) * 32 + e] + part[(3 * 16 + tk) * 32 + e]));
            int rk = 0;
#pragma unroll
            for (int j = 0; j < 64; ++j) {
                const float bj = __builtin_bit_cast(float, __builtin_amdgcn_readlane(__builtin_bit_cast(int, v), j));
                if ((j >> 5) == (lane >> 5)) rk += (bj > v || (bj == v && (j & 31) < e)) ? 1 : 0;
            }
            float* selv = part + 2048 + (w * 2 + (lane >> 5)) * 8;
            if (rk < 4) { selv[rk] = v; selv[4 + rk] = __builtin_bit_cast(float, e); }
            __builtin_amdgcn_s_waitcnt(0xc07f);
            __builtin_amdgcn_wave_barrier();
            const float b0 = selv[0], b1 = selv[1], b2 = selv[2], b3 = selv[3];
            const float e1 = expf(b1 - b0), e2 = expf(b2 - b0), e3 = expf(b3 - b0);
            const float inv = 1.0f / (1.0f + e1 + e2 + e3);
            if (e < 4) {
                const int sel = __builtin_bit_cast(int, selv[4 + e]);
                const float gs = (e == 0) ? inv : (e == 1) ? e1 * inv : (e == 2) ? e2 * inv : e3 * inv;
                pe[gl * 64 + tk * 4 + e] = live ? (sel & 31) : -1;
                if (live) p.gate[(size_t)(tok0 + tk) * 4 + e] = gs;
            }
            __builtin_amdgcn_wave_barrier();
        }
    }
    __syncthreads();
    if (t < 32) hist[t] = 0;
    __syncthreads();
    for (int i = t; i < ngr * 64; i += 256) { const int e = pe[i]; if (e >= 0) rank[i] = atomicAdd(&hist[e], 1); }
    __syncthreads();
    if (t < 32) { const int c = hist[t]; base[t] = c ? atomicAdd(&p.counts[t], c) : 0; }
    __syncthreads();
    for (int i = t; i < ngr * 64; i += 256) {
        const int e = pe[i];
        if (e >= 0) { const int gl = i >> 6, gi = vb + gl * nvb; const int slot = (gi * 16 + ((i >> 2) & 15)) * 4 + (i & 3); p.lists[e * T + base[e] + rank[i]] = slot; }
    }
}

__device__ void ph_final(const Params& p, int wv__) {
    const int tid = tid_opaque(), lane = tid & 63, gw = blockIdx.x * 8 + (tid >> 6), nw = gridDim.x * 8;
    for (int tok = gw; tok < T; tok += nw) {
        float v[2][8]; float ss = 0.f;
#pragma unroll
        for (int i = 0; i < 2; ++i) {
            const int c = lane * 8 + 512 * i;
            const float4 xa = *(const float4*)(p.x1 + (size_t)tok * D + c), xb = *(const float4*)(p.x1 + (size_t)tok * D + c + 4);
            v[i][0] = xa.x; v[i][1] = xa.y; v[i][2] = xa.z; v[i][3] = xa.w; v[i][4] = xb.x; v[i][5] = xb.y; v[i][6] = xb.z; v[i][7] = xb.w;
#pragma unroll
            for (int k = 0; k < 4; ++k) {
                const uint2 yy = *(const uint2*)((const unsigned char*)p.y + ((size_t)tok * 4 + k) * D + c);
                const fv2 y01 = __builtin_amdgcn_cvt_pk_f32_fp8((int)yy.x, false), y23 = __builtin_amdgcn_cvt_pk_f32_fp8((int)yy.x, true);
                const fv2 y45 = __builtin_amdgcn_cvt_pk_f32_fp8((int)yy.y, false), y67 = __builtin_amdgcn_cvt_pk_f32_fp8((int)yy.y, true);
                v[i][0] += y01[0] * 0.0625f; v[i][1] += y01[1] * 0.0625f; v[i][2] += y23[0] * 0.0625f; v[i][3] += y23[1] * 0.0625f;
                v[i][4] += y45[0] * 0.0625f; v[i][5] += y45[1] * 0.0625f; v[i][6] += y67[0] * 0.0625f; v[i][7] += y67[1] * 0.0625f;
            }
#pragma unroll
            for (int j = 0; j < 8; ++j) ss += v[i][j] * v[i][j];
        }
        ss = wave_sum(ss);
        const float r = rsqrtf(ss * (1.0f / D) + EPS);
#pragma unroll
        for (int i = 0; i < 2; ++i) {
            const int c = lane * 8 + 512 * i;
            const float4 ga = *(const float4*)(p.gf + c), gb = *(const float4*)(p.gf + c + 4);
            float4 oa, ob;
            oa.x = v[i][0] * r * ga.x; oa.y = v[i][1] * r * ga.y; oa.z = v[i][2] * r * ga.z; oa.w = v[i][3] * r * ga.w;
            ob.x = v[i][4] * r * gb.x; ob.y = v[i][5] * r * gb.y; ob.z = v[i][6] * r * gb.z; ob.w = v[i][7] * r * gb.w;
            *(float4*)(p.out + (size_t)tok * D + c) = oa; *(float4*)(p.out + (size_t)tok * D + c + 4) = ob;
        }
    }
}

#define XB_TMO      128
#define XB_XCNT(j)  (256  + 64 * (j))
#define XB_XSUB(j)  (1280 + 64 * (j))
#define XB_XGEN(j)  (2304 + 64 * (j))
#define XB_TOP      3328
#define XB_TOPGEN   3392
#define XCD_BAR_WORDS 3456
#define XB_SPIN_CAP (1u << 22)
__device__ __forceinline__ unsigned xb_ld(unsigned* p)              { return __hip_atomic_load(p, __ATOMIC_RELAXED, __HIP_MEMORY_SCOPE_AGENT); }
__device__ __forceinline__ unsigned xb_add(unsigned* p, unsigned v) { return __hip_atomic_fetch_add(p, v, __ATOMIC_RELAXED, __HIP_MEMORY_SCOPE_AGENT); }
__device__ __forceinline__ unsigned xb_xcc_id() { return (unsigned)__builtin_amdgcn_s_getreg((3 << 11) | 20) & 0xFu; }
#define XB_SPIN(cond, bar) do { unsigned _sp = 0; while (cond) { __builtin_amdgcn_s_sleep(1); \
    if ((++_sp & 255u) == 0u) { if (xb_ld(&(bar)[XB_TMO])) break; if (_sp > XB_SPIN_CAP) { atomicAdd(&(bar)[XB_TMO], 1u); break; } } } } while (0)
struct XcdBarrier { unsigned* bar; unsigned x; volatile LDS_AS unsigned* st; };
__device__ __forceinline__ XcdBarrier xcd_barrier_post(unsigned* bar, volatile LDS_AS unsigned* st) {
    XcdBarrier b; b.bar = bar; b.x = xb_xcc_id(); b.st = st;
    if (threadIdx.x == 0) (void)xb_add(&bar[XB_XCNT(b.x)], 1u);
    return b;
}
__device__ __forceinline__ void xcd_barrier_complete(unsigned* bar, unsigned x, unsigned& nloc, unsigned& nx) {
    const unsigned G = gridDim.x * gridDim.y * gridDim.z;
    unsigned sum, cnt, mine, sp = 0u;
    for (;;) {
        sum = 0u; cnt = 0u; mine = 0u;
#pragma unroll
        for (unsigned j = 0; j < 16; ++j) { const unsigned c = xb_ld(&bar[XB_XCNT(j)]); sum += c; cnt += (c > 0u) ? 1u : 0u; mine = (j == x) ? c : mine; }
        if (sum == G) break;
        __builtin_amdgcn_s_sleep(1);
        if ((++sp & 255u) == 0u) { if (xb_ld(&bar[XB_TMO])) break; if (sp > XB_SPIN_CAP) { atomicAdd(&bar[XB_TMO], 1u); break; } }
    }
    nloc = mine > 0u ? mine : 1u; nx = cnt > 0u ? cnt : 1u;
}
__device__ __forceinline__ void xcd_barrier(const XcdBarrier& b, int wv__) {
    asm volatile("s_waitcnt vmcnt(0)" ::: "memory");
    __syncthreads();
    if (tid_opaque() == 0) {
        unsigned* bar = b.bar;
        __builtin_amdgcn_s_waitcnt(0);
        unsigned nloc = b.st[0], nx = b.st[1];
        if (nloc == 0u) { xcd_barrier_complete(bar, b.x, nloc, nx); b.st[0] = nloc; b.st[1] = nx; }
        const unsigned old = xb_add(&bar[XB_XSUB(b.x)], 1u);
        const unsigned gen = old / nloc;
        if (old + 1u == (gen + 1u) * nloc) {
            __builtin_amdgcn_fence(__ATOMIC_RELEASE, "agent");
            asm volatile("s_waitcnt vmcnt(0)" ::: "memory");
            const unsigned og = xb_add(&bar[XB_TOP], 1u);
            const unsigned tg = og / nx;
            if (og + 1u == (tg + 1u) * nx) xb_add(&bar[XB_TOPGEN], 1u);
            else XB_SPIN(xb_ld(&bar[XB_TOPGEN]) == tg, bar);
            __builtin_amdgcn_fence(__ATOMIC_ACQUIRE, "agent");
            xb_add(&bar[XB_XGEN(b.x)], 1u);
            asm volatile("s_waitcnt vmcnt(0)" ::: "memory");
        } else {
            XB_SPIN(xb_ld(&bar[XB_XGEN(b.x)]) == gen, bar);
            __builtin_amdgcn_fence(__ATOMIC_ACQUIRE, "agent");
            asm volatile("s_waitcnt vmcnt(0)" ::: "memory");
        }
    }
    __syncthreads();
}


#if defined(FLUSHMASK)
__device__ void ph_flush(const Params& p, int wv__) {
    const int tid = tid_opaque();
    const float4* src = (const float4*)p.w1;
    float acc = 0.f;
    for (size_t i = (size_t)blockIdx.x * 512 + tid; i < (size_t)NE * D * 2 * DFF / 4; i += (size_t)gridDim.x * 512) { const float4 v = src[i]; acc += v.x + v.y + v.z + v.w; }
    if (acc == 123.456f) p.out[0] = acc;
}
#endif
enum { PH_PRO = 0, PH_PROJ, PH_MIX1, PH_MIX2, PH_MIX3, PH_OUTPROJ, PH_ROUTE, PH_MOE1, PH_MOE2, PH_FINAL, PH_END };
constexpr int N_GLA_ITEMS = B * GH * 64, N_ATT_ITEMS = B * AH * 3 * 64;
constexpr int MO_META = LDS_BYTES - 1024;

__device__ __forceinline__ void moe_meta(const Params& p, int* meta, int wv__) {
    __syncthreads();
    if (tid_opaque() == 0) {
        int mp = 0, rbse = 0;
        for (int e = 0; e < NE; ++e) {
            const int c = p.counts[e];
            meta[e] = c; meta[32 + e] = mp; meta[72 + e] = rbse;
            mp += (c + 255) >> 8; rbse += c;
        }
        meta[32 + NE] = mp; meta[72 + NE] = rbse;
    }
    __syncthreads();
}

constexpr int MO_TABA = 128 * 1024, MO_MAXU = 12;
template <class SchedT>
__device__ __forceinline__ void moe_tables(const Params& p, char* lds, const SchedT& S, int wv__) {
    unsigned* tabA = (unsigned*)(lds + MO_TABA);
    const int tid = tid_opaque(), r = tid & 255;
    for (int i = tid >> 8; i < MO_MAXU; i += 2) {
        pg::Unit u;
        if (!S.next(i, u)) break;
        const int slot = p.lists[u.e * T + (u.row0 - S.meta[72 + u.e]) + min(r, u.nvalid - 1)];
        tabA[i * 256 + r] = (unsigned)(slot >> 2) * (unsigned)S.rowb;
    }
    __syncthreads();
}

typedef const __attribute__((address_space(4))) Params* KParams;
#if defined(__HIP_DEVICE_COMPILE__)
#define PHASE_PARAMS() KParams _kq = kp; asm volatile("" : "+s"(_kq)); const Params p = *_kq
#define KP_INIT() KParams kp = (KParams)__builtin_amdgcn_kernarg_segment_ptr(); const int ph_lo = kp->ph_lo, ph_hi = kp->ph_hi; unsigned* const barw = kp->bar
#else
#define PHASE_PARAMS() const Params p = p_unused
#define KP_INIT() const int ph_lo = p_unused.ph_lo, ph_hi = p_unused.ph_hi; unsigned* const barw = p_unused.bar
#endif
__global__ void __launch_bounds__(512, 2) mega(Params p_unused) {
    extern __shared__ __attribute__((aligned(16))) char lds[];
    KP_INIT();
    cg::grid_group grid = cg::this_grid();
    const int wv__ = __builtin_amdgcn_readfirstlane((int)threadIdx.x >> 6);
    volatile LDS_AS unsigned* xst = (volatile LDS_AS unsigned*)(lds + LDS_BYTES - 16);
    if (threadIdx.x == 0) { xst[0] = 0u; xst[1] = 0u; }
    __syncthreads();
    const XcdBarrier xb = xcd_barrier_post(barw, xst);
    if (ph_hi > PH_END) grid.sync();
    for (int ph = ph_lo; ph < ph_hi; ++ph) {
      const int nrep = ((REPMASK >> ph) & 1) ? 2 : 1;
      for (int rep = 0; rep < nrep; ++rep) {
        if (rep) xcd_barrier(xb, wv__);
#if defined(ROUTE2)
        if (rep && ph == PH_ROUTE) { PHASE_PARAMS(); if (blockIdx.x == 0 && threadIdx.x < 32) p.counts[threadIdx.x] = 0; xcd_barrier(xb, wv__); }
#endif
#if defined(FLUSHMASK)
        if (rep && ((FLUSHMASK >> ph) & 1)) { PHASE_PARAMS(); ph_flush(p, wv__); xcd_barrier(xb, wv__); }
#if defined(FLUSHONLY)
        if (rep && ((FLUSHMASK >> ph) & 1)) continue;
#endif
#endif
        switch (ph) {
        case PH_PRO: { PHASE_PARAMS(); ph_prologue(p, wv__); } break;
        case PH_PROJ: {
            PHASE_PARAMS();
            const int G = gridDim.x, ng = G - NCONV;
            if ((int)blockIdx.x < ng) {
                pg::DenseSched S; S.init(p.xn, p.winT, T, PJW, ng, blockIdx.x);
                pg::EpiProj E{p.proj};
                pg::gemm_phase((LDS_AS unsigned char*)lds, S, E, wv__);
            } else {
                const int tid = tid_opaque(), t = tid & 255, st = NCONV * 2;
                const int l = t & 63, w = t >> 6, kg = l & 7, ngq = w * 8 + (l >> 3);
#define CV_DECL(X) f32x4 X##0 = {0.f, 0.f, 0.f, 0.f}, X##1 = X##0, X##2 = X##0, X##3 = X##0, X##4 = X##0, X##5 = X##0, X##6 = X##0, X##7 = X##0
#define CV_LOAD(X, i_) do { const int e_ = (i_) >> 8, j_ = (i_) & 255; const float* s_ = p.w1 + (size_t)e_ * D * 2 * DFF + (size_t)((j_ >> 4) * 64 + 8 * kg) * (2 * DFF) + (j_ & 15) * 128 + 4 * ngq; \
        X##0 = *(const f32x4*)(s_); X##1 = *(const f32x4*)(s_ + 2 * DFF); X##2 = *(const f32x4*)(s_ + 2 * 2 * DFF); X##3 = *(const f32x4*)(s_ + 3 * 2 * DFF); \
        X##4 = *(const f32x4*)(s_ + 4 * 2 * DFF); X##5 = *(const f32x4*)(s_ + 5 * 2 * DFF); X##6 = *(const f32x4*)(s_ + 6 * 2 * DFF); X##7 = *(const f32x4*)(s_ + 7 * 2 * DFF); } while (0)
#define CV_STORE(X, i_) do { const int e_ = (i_) >> 8, j_ = (i_) & 255; unsigned char* d_ = p.w1T8 + (size_t)e_ * 2 * DFF * D + (size_t)((j_ & 15) * 128 + 4 * ngq) * 1024 + (j_ >> 4) * 64 + 8 * kg; \
        _Pragma("unroll") for (int c_ = 0; c_ < 4; ++c_) { \
            int lo_ = __builtin_amdgcn_cvt_pk_fp8_f32(X##0[c_] * 32.0f, X##1[c_] * 32.0f, 0, false); lo_ = __builtin_amdgcn_cvt_pk_fp8_f32(X##2[c_] * 32.0f, X##3[c_] * 32.0f, lo_, true); \
            int hi_ = __builtin_amdgcn_cvt_pk_fp8_f32(X##4[c_] * 32.0f, X##5[c_] * 32.0f, 0, false); hi_ = __builtin_amdgcn_cvt_pk_fp8_f32(X##6[c_] * 32.0f, X##7[c_] * 32.0f, hi_, true); \
            uint2 q_; q_.x = (unsigned)lo_; q_.y = (unsigned)hi_; *(uint2*)(d_ + c_ * 1024) = q_; } } while (0)
                CV_DECL(ra); CV_DECL(rb);
                const int hid = ((int)blockIdx.x - ng) * 2 + (tid >> 8), per = (W1_CONV + st - 1) / st;
                const int i0 = min(hid * per, W1_CONV - 1), ilast = min(i0 + per, W1_CONV) - 1;
                const int npair = (per + 1) / 2;
                CV_LOAD(ra, i0);
                for (int k = 0; k < npair; ++k) {
                    const int ia = min(i0 + 2 * k, ilast), ib = min(ia + 1, ilast), ic = min(ib + 1, ilast);
                    CV_LOAD(rb, ib);
                    CV_STORE(ra, ia);
                    CV_LOAD(ra, ic);
                    CV_STORE(rb, ib);
                }
#undef CV_DECL
#undef CV_LOAD
#undef CV_STORE
            }
            {
                const int tid2 = tid_opaque(), lane = tid2 & 63, i16 = lane & 15, g = lane >> 4;
                for (int task = (G - 1 - (int)blockIdx.x) * 8 + (tid2 >> 6); task < T / 16; task += G * 8) {
                    f32x4 z0 = {0.f, 0.f, 0.f, 0.f}, z1 = {0.f, 0.f, 0.f, 0.f};
                    const u16* ar = p.xn + (size_t)(task * 16 + i16) * D + 8 * g;
                    const u16* w0 = p.wzT + (size_t)i16 * D + 8 * g;
                    const u16* w1 = w0 + 16 * D;
#pragma unroll 8
                    for (int ks = 0; ks < 32; ++ks) {
                        const bf16x8 a = *(const bf16x8*)(ar + ks * 32);
                        z0 = __builtin_amdgcn_mfma_f32_16x16x32_bf16(a, *(const bf16x8*)(w0 + ks * 32), z0, 0, 0, 0);
                        z1 = __builtin_amdgcn_mfma_f32_16x16x32_bf16(a, *(const bf16x8*)(w1 + ks * 32), z1, 0, 0, 0);
                    }
#pragma unroll
                    for (int r = 0; r < 4; ++r) {
                        const size_t row = (size_t)task * 16 + 4 * g + r;
                        p.zbuf[row * 32 + i16] = z0[r]; p.zbuf[row * 32 + 16 + i16] = z1[r];
                    }
                }
            }
        } break;
        case PH_MIX1: {
            PHASE_PARAMS();
            const int tid = tid_opaque(), t = tid & 255, half = tid >> 8;
            char* hl = lds + half * HALF_LDS;
#ifndef MIX1_SKIP_GLA_ON_REP
            for (int it0 = blockIdx.x * 2; it0 < N_GLA_ITEMS; it0 += gridDim.x * 2) gla_ds_item(p, hl, t, min(it0 + half, N_GLA_ITEMS - 1));
#else
            if (!rep) for (int it0 = blockIdx.x * 2; it0 < N_GLA_ITEMS; it0 += gridDim.x * 2) gla_ds_item(p, hl, t, min(it0 + half, N_GLA_ITEMS - 1));
#endif
            {
                AttnRegs AR;
                attn_load(p, t, min((int)blockIdx.x * 2 + half, N_ATT_ITEMS - 1), AR);
                int bgt = blockIdx.x * 2 + half;
                for (int it0 = blockIdx.x * 2; it0 < N_ATT_ITEMS; it0 += gridDim.x * 2, bgt += gridDim.x * 2) {
                    const int nx0 = it0 + gridDim.x * 2;
                    attn_item(p, hl, t, min(it0 + half, N_ATT_ITEMS - 1), nx0 < N_ATT_ITEMS ? min(nx0 + half, N_ATT_ITEMS - 1) : -1, AR, min(bgt, N_BG - 1));
                }
                for (; bgt < N_BG; bgt += gridDim.x * 2) { const float* s_; int ss_; unsigned char* d_; bg_decode(p, bgt, s_, ss_, d_); cvt_tile8(s_, ss_, d_, 0, 0, t); }
            }
        } break;
        case PH_MIX2: {
            PHASE_PARAMS();
            const int tid = tid_opaque();
            for (int gid = blockIdx.x * 512 + tid; gid < (1 << 17); gid += gridDim.x * 512) gla_scan_thread2(p, gid);
            for (int gid = blockIdx.x * 512 + tid; gid < T * 64; gid += gridDim.x * 512) attn_combine_thread(p, gid);
        } break;
        case PH_MIX3: {
            PHASE_PARAMS();
            const int tid = tid_opaque(), t = tid & 255, half = tid >> 8;
            char* hl = lds + half * HALF_LDS;
            for (int it0 = blockIdx.x * 2; it0 < N_GLA_ITEMS; it0 += gridDim.x * 2) gla_out_item(p, hl, t, min(it0 + half, N_GLA_ITEMS - 1));
        } break;
        case PH_OUTPROJ: {
            PHASE_PARAMS();
            pg::DenseSched S; S.init(p.mix, p.woT, T, D, gridDim.x, blockIdx.x);
            pg::EpiOut E{p.x, p.x1};
            pg::gemm_phase((LDS_AS unsigned char*)lds, S, E, wv__);
        } break;
        case PH_ROUTE: { PHASE_PARAMS(); ph_route(p, lds, wv__); } break;
        case PH_MOE1: {
            PHASE_PARAMS();
            int* meta = (int*)(lds + MO_META);
            moe_meta(p, meta, wv__);
            pg::MoeSchedT<true> S{(const u16*)p.xn28, (const u16*)p.w1T8, p.lists, (const LDS_AS int*)meta, 8, meta[32 + NE] * 8, (int)gridDim.x, (int)blockIdx.x, 1024, (const LDS_AS unsigned*)(lds + MO_TABA)};
            moe_tables(p, lds, S, wv__);
            pg::EpiMoe1 E{p.b1, p.act8};
            pg::gemm_phase<pg::EpiMoe1, pg::MoeSchedT<true>, true>((LDS_AS unsigned char*)lds, S, E, wv__);
            {
                const int G = gridDim.x, nun = S.nunits, r = nun % G, nshort = r ? G - r : G, sidx = r ? (int)blockIdx.x - r : (int)blockIdx.x;
                if (sidx >= 0) {
                    const int tid = tid_opaque(), t = tid & 255, hv = tid >> 8;
                    const int per = (W2_LATE - W2_BG + nshort * 2 - 1) / (nshort * 2), ib = W2_BG + (sidx * 2 + hv) * per;
                    for (int i = ib; i < min(ib + per, W2_LATE); ++i) { const int e = i >> 7, j = i & 127; cvt_tile8(p.w2 + (size_t)e * DFF * D, D, p.w2T8 + (size_t)e * D * DFF, (j >> 3) * 64, (j & 7) * 128, t); }
                }
            }
        } break;
        case PH_MOE2: {
            PHASE_PARAMS();
            int* meta = (int*)(lds + MO_META);
            moe_meta(p, meta, wv__);
            pg::MoeSchedT<false> S{(const u16*)p.act8, (const u16*)p.w2T8, p.lists, (const LDS_AS int*)meta, 4, meta[32 + NE] * 4, (int)gridDim.x, (int)blockIdx.x, 1024, nullptr};
            pg::EpiMoe2 E{p.b2, p.gate, p.lists, (const LDS_AS int*)meta, p.y};
            pg::gemm_phase<pg::EpiMoe2, pg::MoeSchedT<false>, true>((LDS_AS unsigned char*)lds, S, E, wv__);
        } break;
        case PH_FINAL: { PHASE_PARAMS(); ph_final(p, wv__); } break;
        default: break;
        }
      }
#ifdef EXTRA_BAR
        if (ph == PH_MIX2) { for (int q = 0; q < EXTRA_BAR; ++q) xcd_barrier(xb, wv__); }
#endif
        if (ph + 1 < ph_hi) xcd_barrier(xb, wv__);
    }
}

#ifndef STAGE
#define STAGE 6
#endif

__global__ void __launch_bounds__(256) cvt_bf16_f32(const u16* __restrict__ src, int lds_, float* __restrict__ dst, int ldd, int rows, int cols) {
    const size_t n = (size_t)rows * cols;
    for (size_t i = (size_t)blockIdx.x * 256 + threadIdx.x; i < n; i += (size_t)gridDim.x * 256) {
        const size_t r = i / cols, c = i % cols;
        dst[r * ldd + c] = bf2f(src[r * lds_ + c]);
    }
}

#include <cstdio>
extern "C" void kernel_launch(void* const* d_in, const int* in_sizes, int n_in, void* d_out, int out_size, void* d_ws, size_t ws_size, hipStream_t stream) {
    const float* x = (const float*)d_in[0];
    const float* norm1_g = (const float*)d_in[1];
    const float* w_in = (const float*)d_in[2];
    const float* rel_bias = (const float*)d_in[3];
    const float* wgf = (const float*)d_in[4];
    const float* bgf = (const float*)d_in[5];
    const float* wgb = (const float*)d_in[6];
    const float* bgb = (const float*)d_in[7];
    const float* gla_ng = (const float*)d_in[8];
    const float* w_out = (const float*)d_in[9];
    const float* norm2_g = (const float*)d_in[10];
    const float* router_w = (const float*)d_in[11];
    const float* router_b = (const float*)d_in[12];
    const float* w1 = (const float*)d_in[13];
    const float* b1 = (const float*)d_in[14];
    const float* w2 = (const float*)d_in[15];
    const float* b2 = (const float*)d_in[16];
    const float* final_g = (const float*)d_in[17];
    float* out = (float*)d_out;

    static int grid_blocks = 0;
    if (!grid_blocks) {
        int dev = 0, cus = 0, per_cu = 0;
        hipGetDevice(&dev);
        hipDeviceGetAttribute(&cus, hipDeviceAttributeMultiprocessorCount, dev);
        hipFuncSetAttribute((const void*)mega, hipFuncAttributeMaxDynamicSharedMemorySize, LDS_BYTES);
        hipOccupancyMaxActiveBlocksPerMultiprocessor(&per_cu, mega, 512, LDS_BYTES);
        if (per_cu > 1) per_cu = 1;
        if (per_cu < 1) per_cu = 1;
        grid_blocks = cus * per_cu;
    }

    char* ws = (char*)d_ws;
    size_t off = 0;
    auto take = [&](size_t bytes) { char* p = ws + off; off += (bytes + 255) & ~(size_t)255; return p; };
    Params p{};
    p.x = x; p.g1 = norm1_g; p.w_in = w_in; p.rel_bias = rel_bias; p.wgf = wgf; p.bgf = bgf; p.wgb = wgb; p.bgb = bgb; p.gla_ng = gla_ng;
    p.w_out = w_out; p.g2 = norm2_g; p.rw = router_w; p.rb = router_b; p.w1 = w1; p.b1 = b1; p.w2 = w2; p.b2 = b2; p.gf = final_g; p.out = out;
    p.winT = (u16*)take((size_t)PJW * D * 2);
    p.wzT = (u16*)take((size_t)32 * D * 2);
    p.woT = (u16*)take((size_t)D * D * 2);
    p.w1T = (u16*)take((size_t)NE * 2 * DFF * D * 2); p.w1T8 = (unsigned char*)p.w1T;
    p.w2T = (u16*)take((size_t)NE * D * DFF * 2); p.w2T8 = (unsigned char*)p.w2T;
    p.zbuf = (float*)take((size_t)T * 32 * 4);
    p.btab = (float*)take((size_t)24 * 704 * 4);
    p.lse = (float*)take((size_t)3 * T * 8 * 4);
    p.dec = (float*)take((size_t)B * GH * 64 * 2 * 64 * 4);
    p.x1 = (float*)take((size_t)T * D * 4);
    p.counts = (int*)take(256);
    p.lists = (int*)take((size_t)NE * T * 4);
    p.gate = (float*)take((size_t)NSLOT * 4);
    p.bar = (unsigned*)take((size_t)XCD_BAR_WORDS * 4);
    p.xn = (u16*)take((size_t)T * D * 2); p.xn2 = p.xn; p.xn28 = (unsigned char*)p.xn;
    { char* ra = take((size_t)T * PJW * 2 + (size_t)3 * T * 512 * 2);
      p.proj = (u16*)ra; p.abr = (u16*)(ra + (size_t)T * PJW * 2); p.act = (u16*)ra; p.act8 = (unsigned char*)ra; }
    { char* rb = take((size_t)B * GH * 64 * 2 * 128 * 64 * 4 + (size_t)B * GH * 64 * 2 * 128 * 64 * 2 + (size_t)T * D * 2);
      p.dS = (float*)rb; p.Sp = (u16*)(rb + (size_t)B * GH * 64 * 2 * 128 * 64 * 4); p.mix = (u16*)(rb + (size_t)B * GH * 64 * 2 * 128 * 64 * 4 + (size_t)B * GH * 64 * 2 * 128 * 64 * 2); p.y = (u16*)rb; }
    const size_t off_shared = off;

    auto run_fast = [&](int lo, int hi) {
        (void)hipMemsetAsync(p.bar, 0, (size_t)XCD_BAR_WORDS * 4, stream);
        p.ph_lo = lo; p.ph_hi = hi;
        void* args[] = {&p};
        hipError_t e = hipLaunchCooperativeKernel((const void*)mega, dim3(grid_blocks), dim3(512), args, LDS_BYTES, stream);
        if (e != hipSuccess) fprintf(stderr, "cooperative launch failed: %s (grid %d)\n", hipGetErrorString(e), grid_blocks);
    };

#if STAGE >= 6
    run_fast(PH_PRO, PH_END);
#else
    off = off_shared;
    float* n_xn = (float*)take((size_t)T * D * 4);
    float* n_x2 = (float*)take((size_t)T * D * 4);
    float* n_mix = (float*)take((size_t)T * D * 4);
    int* n_topi = (int*)take((size_t)T * 4 * 4);
    float* n_hact = (float*)take((size_t)T * DFF * 4);
    float* n_x1 = p.x1;
    int* n_lists = p.lists; int* n_counts = p.counts; float* n_gate = p.gate;
#if STAGE == 3
    run_fast(PH_PRO, PH_MIX3 + 1);
#elif STAGE == 4
    run_fast(PH_PRO, PH_OUTPROJ + 1);
#elif STAGE == 5
    run_fast(PH_PRO, PH_ROUTE + 1);
#else
#error "hybrid STAGE must be 3, 4 or 5"
#endif
#if STAGE == 3
    cvt_bf16_f32<<<2048, 256, 0, stream>>>(p.mix, D, n_mix, D, T, D);
#endif
#if STAGE <= 3
    nv_gemm<EPI_RESID><<<dim3(D / 64, T / 64), 256, 0, stream>>>(n_mix, D, nullptr, 0, nullptr, T, w_out, D, D, D, n_x1, D, x, nullptr);
#endif
#if STAGE <= 4
    nv_route<<<T / 4, 256, 0, stream>>>(n_x1, norm2_g, router_w, router_b, n_xn, n_topi, n_gate);
    nv_lists<<<1, 32, 0, stream>>>(n_topi, n_lists, n_counts);
#endif
#if STAGE == 5
    cvt_bf16_f32<<<2048, 256, 0, stream>>>(p.xn2, D, n_xn, D, T, D);
#endif
    (void)hipMemcpyAsync(n_x2, n_x1, (size_t)T * D * 4, hipMemcpyDeviceToDevice, stream);
    for (int e = 0; e < NE; ++e) {
        nv_gemm<EPI_SWIGLU><<<dim3(2 * DFF / 64, T / 64), 256, 0, stream>>>(n_xn, D, n_lists + (size_t)e * T, 2, n_counts + e, 0,
                                                                          w1 + (size_t)e * D * 2 * DFF, 2 * DFF, 2 * DFF, D, n_hact, DFF, b1 + (size_t)e * 2 * DFF, nullptr);
        nv_moe2<<<dim3(D / 64, T / 64), 256, 0, stream>>>(n_hact, n_lists + (size_t)e * T, n_counts + e, w2 + (size_t)e * DFF * D, n_x2, b2 + (size_t)e * D, n_gate);
    }
    nv_rmsnorm<<<T / 4, 256, 0, stream>>>(n_x2, final_g, out, T);
#endif
}
```

```cpp
#define STAGE 6
#define REPMASK 0
#include <hip/hip_runtime.h>
#include <stdint.h>

namespace cfg {
constexpr int D = 1024, B = 4, S = 4096, T = B * S;
constexpr int AH = 8;
constexpr int GH = 4;
constexpr int INW = 3104;
constexpr int C_AQ = 0, C_AK = 512, C_AV = 1024, C_GQ = 1536, C_GK = 1792, C_GV = 2048, C_GO = 2560, C_GZ = 3072;
constexpr int NE = 32, DFF = 1024;
constexpr float EPS = 1e-5f;
}
using namespace cfg;

__device__ const unsigned char T5TAB[387] = {
11,11,11,11,11,11,11,11,11,11,11,11,11,11,11,10,10,10,10,10,10,10,10,10,10,10,10,10,10,10,10,10,10,10,10,10,10,10,9,9,9,9,9,9,9,9,9,9,9,9,8,8,8,8,8,8,8,7,6,5,4,3,2,1,0,17,18,19,20,21,22,23,24,24,24,24,24,24,24,25,25,25,25,25,25,25,25,25,25,25,25,26,26,26,26,26,26,26,26,26,26,26,26,26,26,26,26,26,26,26,26,26,26,26,27,27,27,27,27,27,27,27,27,27,27,27,27,27,27,
13,13,13,13,13,13,13,13,13,13,13,13,13,13,13,13,13,13,13,13,13,13,13,12,12,12,12,12,12,12,12,12,12,12,12,12,12,12,12,12,12,12,11,11,11,11,11,11,11,11,11,11,10,10,10,10,10,10,9,9,9,8,8,4,0,20,24,24,25,25,25,26,26,26,26,26,26,27,27,27,27,27,27,27,27,27,27,28,28,28,28,28,28,28,28,28,28,28,28,28,28,28,28,28,28,28,29,29,29,29,29,29,29,29,29,29,29,29,29,29,29,29,29,29,29,29,29,29,29,
15,15,15,15,15,15,15,15,15,15,15,15,15,15,15,15,15,15,15,15,15,15,15,15,15,15,15,15,15,15,14,14,14,14,14,14,14,14,14,14,14,14,14,14,14,13,13,13,13,13,13,13,13,13,12,12,12,12,12,11,11,10,10,9,0,25,26,26,27,27,28,28,28,28,28,29,29,29,29,29,29,29,29,29,30,30,30,30,30,30,30,30,30,30,30,30,30,30,30,31,31,31,31,31,31,31,31,31,31,31,31,31,31,31,31,31,31,31,31,31,31,31,31,31,31,31,31,31,31};

template <int MASK> __device__ __forceinline__ float swz_xor(float v) { return __builtin_bit_cast(float, __builtin_amdgcn_ds_swizzle(__builtin_bit_cast(int, v), (MASK << 10) | 0x1F)); }
__device__ __forceinline__ float half_sum(float v) {
    const auto r = __builtin_amdgcn_permlane32_swap(__builtin_bit_cast(unsigned, v), __builtin_bit_cast(unsigned, v), false, false);
    return __builtin_bit_cast(float, (unsigned)r[0]) + __builtin_bit_cast(float, (unsigned)r[1]);
}
__device__ __forceinline__ float half_max(float v) {
    const auto r = __builtin_amdgcn_permlane32_swap(__builtin_bit_cast(unsigned, v), __builtin_bit_cast(unsigned, v), false, false);
    return fmaxf(__builtin_bit_cast(float, (unsigned)r[0]), __builtin_bit_cast(float, (unsigned)r[1]));
}
__device__ __forceinline__ float wave_sum(float v) {
    v += swz_xor<1>(v); v += swz_xor<2>(v); v += swz_xor<4>(v); v += swz_xor<8>(v); v += swz_xor<16>(v);
    return half_sum(v);
}

#include <hip/hip_cooperative_groups.h>
namespace cg = cooperative_groups;

typedef unsigned short u16;
typedef short bf16x8 __attribute__((ext_vector_type(8)));
typedef short s16x4 __attribute__((ext_vector_type(4)));
typedef float f32x4 __attribute__((ext_vector_type(4)));
typedef unsigned u32x4 __attribute__((ext_vector_type(4)));
typedef __bf16 bfv2 __attribute__((ext_vector_type(2)));
typedef float fv2 __attribute__((ext_vector_type(2)));
#define LDS_AS __attribute__((address_space(3)))

constexpr int LDS_BYTES = 160 * 1024;
constexpr int HALF_LDS = 80 * 1024;
constexpr int NSLOT = T * 4;
constexpr int PJW = 3072;
#ifndef REPMASK
#define REPMASK 0
#endif

struct Params {
    const float *x, *g1, *w_in, *rel_bias, *wgf, *bgf, *wgb, *bgb, *gla_ng, *w_out, *g2, *rw, *rb, *w1, *b1, *w2, *b2, *gf;
    float* out;
    u16* winT;
    u16* wzT;
    u16* woT;
    u16* w1T;
    u16* w2T;
    u16* xn;
    u16* proj;
    float* zbuf;
    float* btab;
    u16* abr;
    float* lse;
    float* dS;
    float* dec;
    u16* Sp;
    u16* mix;
    float* x1;
    u16* x1b;
    u16* xn2;
    int* counts;
    int* lists;
    float* gate;
    u16* act;
    u16* y;
    unsigned char* xn28;
    unsigned char* w1T8;
    unsigned char* act8;
    unsigned char* w2T8;
    unsigned* bar;
    int ph_lo, ph_hi;
};

__device__ __forceinline__ int tid_from_wave(int wv) { int l; asm volatile("v_mbcnt_lo_u32_b32 %0, -1, 0\n\tv_mbcnt_hi_u32_b32 %0, -1, %0" : "=v"(l)); return (wv << 6) | l; }
#define tid_opaque() tid_from_wave(wv__)
__device__ __forceinline__ float bf2f(u16 v) { return __uint_as_float((unsigned)v << 16); }
__device__ __forceinline__ unsigned pack2(float a, float b) {
    fv2 v = {a, b};
    bfv2 r = __builtin_convertvector(v, bfv2);
    return __builtin_bit_cast(unsigned, r);
}
__device__ __forceinline__ u16 f2bf(float a) { return (u16)(pack2(a, 0.f) & 0xffffu); }
__device__ __forceinline__ float lo2f(unsigned u) { return __uint_as_float(u << 16); }
__device__ __forceinline__ float hi2f(unsigned u) { return __uint_as_float(u & 0xffff0000u); }
__device__ __forceinline__ int tile_off(int row, int chunk) { return row * 128 + ((chunk ^ (row & 7)) << 4); }
__device__ __forceinline__ bf16x8 lds_frag(const char* base, int row, int chunk) { return *(const bf16x8*)(base + tile_off(row, chunk)); }
__device__ __forceinline__ s16x4 tr_read(const char* p) {
    return __builtin_amdgcn_ds_read_tr16_b64_v4i16((LDS_AS s16x4*)(p));
}
__device__ __forceinline__ bf16x8 cat4(s16x4 a, s16x4 b) { bf16x8 r = {a[0], a[1], a[2], a[3], b[0], b[1], b[2], b[3]}; return r; }
__device__ __forceinline__ float logsig(float a) { return fminf(a, 0.f) - log1pf(expf(-fabsf(a))); }

__device__ __forceinline__ void cvt_tile8(const float* __restrict__ src, int ldsrc, unsigned char* __restrict__ dst, int k0, int n0, int t) {
    const int l = t & 63, w = t >> 6, kg = l & 7, ng = w * 8 + (l >> 3);
    const float* s = src + (size_t)(k0 + 8 * kg) * ldsrc + n0 + 4 * ng;
    f32x4 bv[8];
#pragma unroll
    for (int j = 0; j < 8; ++j) bv[j] = *(const f32x4*)(s + (size_t)j * ldsrc) * 32.0f;
    unsigned char* d = dst + (size_t)(n0 + 4 * ng) * 1024 + k0 + 8 * kg;
#pragma unroll
    for (int c = 0; c < 4; ++c) {
        int lo = __builtin_amdgcn_cvt_pk_fp8_f32(bv[0][c], bv[1][c], 0, false); lo = __builtin_amdgcn_cvt_pk_fp8_f32(bv[2][c], bv[3][c], lo, true);
        int hi = __builtin_amdgcn_cvt_pk_fp8_f32(bv[4][c], bv[5][c], 0, false); hi = __builtin_amdgcn_cvt_pk_fp8_f32(bv[6][c], bv[7][c], hi, true);
        uint2 q; q.x = (unsigned)lo; q.y = (unsigned)hi;
        *(uint2*)(d + c * 1024) = q;
    }
}
__device__ __forceinline__ void cvt_tile(const float* __restrict__ src, int ldsrc, u16* __restrict__ dst, int k0, int n0, int t) {
    const int l = t & 63, w = t >> 6, kg = l & 7, ng = w * 8 + (l >> 3);
    const float* s = src + (size_t)(k0 + 8 * kg) * ldsrc + n0 + 4 * ng;
    float4 bv[8];
#pragma unroll
    for (int j = 0; j < 8; ++j) bv[j] = *(const float4*)(s + (size_t)j * ldsrc);
    u16* d = dst + (size_t)(n0 + 4 * ng) * 1024 + k0 + 8 * kg;
    uint4 q;
    q.x = pack2(bv[0].x, bv[1].x); q.y = pack2(bv[2].x, bv[3].x); q.z = pack2(bv[4].x, bv[5].x); q.w = pack2(bv[6].x, bv[7].x);
    *(uint4*)(d) = q;
    q.x = pack2(bv[0].y, bv[1].y); q.y = pack2(bv[2].y, bv[3].y); q.z = pack2(bv[4].y, bv[5].y); q.w = pack2(bv[6].y, bv[7].y);
    *(uint4*)(d + 1024) = q;
    q.x = pack2(bv[0].z, bv[1].z); q.y = pack2(bv[2].z, bv[3].z); q.z = pack2(bv[4].z, bv[5].z); q.w = pack2(bv[6].z, bv[7].z);
    *(uint4*)(d + 2048) = q;
    q.x = pack2(bv[0].w, bv[1].w); q.y = pack2(bv[2].w, bv[3].w); q.z = pack2(bv[4].w, bv[5].w); q.w = pack2(bv[6].w, bv[7].w);
    *(uint4*)(d + 3072) = q;
}
struct CvtRegs { f32x4 bv[8]; };
__device__ __forceinline__ void cvt_load(const float* __restrict__ src, int ldsrc, int k0, int n0, int t, CvtRegs& R) {
    const int l = t & 63, w = t >> 6, kg = l & 7, ng = w * 8 + (l >> 3);
    const float* s = src + (size_t)(k0 + 8 * kg) * ldsrc + n0 + 4 * ng;
#pragma unroll
    for (int j = 0; j < 8; ++j) R.bv[j] = *(const f32x4*)(s + (size_t)j * ldsrc);
}
__device__ __forceinline__ void cvt_store(u16* __restrict__ dst, int k0, int n0, int t, const CvtRegs& R) {
    const int l = t & 63, w = t >> 6, kg = l & 7, ng = w * 8 + (l >> 3);
    u16* d = dst + (size_t)(n0 + 4 * ng) * 1024 + k0 + 8 * kg;
#pragma unroll
    for (int c = 0; c < 4; ++c) {
        u32x4 q;
        q.x = pack2(R.bv[0][c], R.bv[1][c]); q.y = pack2(R.bv[2][c], R.bv[3][c]); q.z = pack2(R.bv[4][c], R.bv[5][c]); q.w = pack2(R.bv[6][c], R.bv[7][c]);
        *(u32x4*)(d + c * 1024) = q;
    }
}
__device__ __forceinline__ void w1_load(const Params& p, int i, int t, CvtRegs& R) { const int e = i >> 8, j = i & 255; cvt_load(p.w1 + (size_t)e * D * 2 * DFF, 2 * DFF, (j >> 4) * 64, (j & 15) * 128, t, R); }
__device__ __forceinline__ void w1_store(const Params& p, int i, int t, const CvtRegs& R) { const int e = i >> 8, j = i & 255; cvt_store(p.w1T + (size_t)e * 2 * DFF * D, (j >> 4) * 64, (j & 15) * 128, t, R); }
constexpr int CV_WIN = 384, CV_WZ = 1, CV_WO = 128, CV_W1 = NE * 256, CV_W2 = NE * 128;
constexpr int CV_TOTAL = CV_WIN + CV_WZ + CV_WO + CV_W1 + CV_W2;
constexpr int W2_BG = 4096;
constexpr int W2_LATE = 4096;
#ifndef NCONV
#define NCONV 0
#endif
#ifndef W1_CONV
#define W1_CONV 0
#endif
constexpr int N_BG = W2_BG + 8192 - W1_CONV;
__device__ void ph_prologue(const Params& p, int wv__) {
    const int tid = tid_opaque();
    if (blockIdx.x == 0 && tid < 32) p.counts[tid] = 0;
    const int be_ = (int)((gridDim.x - 1 - blockIdx.x) * 512 + tid), bcmb_ = be_ / 704, ben_ = be_ - bcmb_ * 704;
    const bool bact_ = be_ < 24 * 704;
    int bidx_ = 0; bool bok_ = false;
    if (bact_) {
        const int c = ben_ / 176, x = ben_ - c * 176, y = x - c - 16;
        bok_ = (y >= 0) && (y <= 128);
        bidx_ = T5TAB[(bcmb_ >> 3) * 129 + (bok_ ? y : 0)];
    }
    { float zf_; asm volatile("v_mov_b32 %0, 0" : "=v"(zf_));
      for (int zi = (int)(blockIdx.x * 512 + tid); zi < T * 8; zi += (int)gridDim.x * 512) ((f32x4*)p.zbuf)[zi] = (f32x4){zf_, zf_, zf_, zf_}; }
    const int wzi_ = (int)(blockIdx.x * 512 + tid);
    float wz0_ = 0.f, wz1_ = 0.f, wz2_ = 0.f, wz3_ = 0.f, wz4_ = 0.f, wz5_ = 0.f, wz6_ = 0.f, wz7_ = 0.f;
    if (wzi_ < 32 * 128) {
        const float* s = p.w_in + (size_t)((wzi_ & 127) * 8) * INW + PJW + (wzi_ >> 7);
        wz0_ = s[0]; wz1_ = s[INW]; wz2_ = s[2 * INW]; wz3_ = s[3 * INW]; wz4_ = s[4 * INW]; wz5_ = s[5 * INW]; wz6_ = s[6 * INW]; wz7_ = s[7 * INW];
    }
    const int t = tid & 255, vb = blockIdx.x * 2 + (tid >> 8), nvb = gridDim.x * 2;
    constexpr int NTILE = CV_WIN + CV_WO;
#define PRO_TILE(j_) const bool ta_ = (j_) < CV_WIN; const int ti_ = ta_ ? (j_) : (j_) - CV_WIN; const float* tsrc_ = ta_ ? p.w_in : p.w_out; const int tld_ = ta_ ? INW : D; \
        u16* tdst_ = ta_ ? p.winT : p.woT; const int tk0_ = (ta_ ? ti_ / 24 : ti_ >> 3) * 64, tn0_ = (ta_ ? ti_ % 24 : ti_ & 7) * 128
    CvtRegs CR;
    const int j0 = min(vb, NTILE - 1);
    { PRO_TILE(j0); cvt_load(tsrc_, tld_, tk0_, tn0_, t, CR); }
    asm volatile("" ::: "memory");
    {
        const int lane = tid & 63, gw = blockIdx.x * 8 + (tid >> 6), nw = gridDim.x * 8;
        float4 g1v[4];
#pragma unroll
        for (int i = 0; i < 4; ++i) g1v[i] = ((const float4*)p.g1)[lane + 64 * i];
        for (int row0 = gw; row0 < T; row0 += 2 * nw) {
            int rw[2]; rw[0] = row0; rw[1] = (row0 + nw < T) ? row0 + nw : row0;
            float4 v[2][4]; float ss[2] = {0.f, 0.f};
#pragma unroll
            for (int q = 0; q < 2; ++q) {
                const float4* xr = (const float4*)(p.x + (size_t)rw[q] * D);
#pragma unroll
                for (int i = 0; i < 4; ++i) v[q][i] = xr[lane + 64 * i];
            }
#pragma unroll
            for (int q = 0; q < 2; ++q) {
#pragma unroll
                for (int i = 0; i < 4; ++i) ss[q] += v[q][i].x * v[q][i].x + v[q][i].y * v[q][i].y + v[q][i].z * v[q][i].z + v[q][i].w * v[q][i].w;
                const float r = rsqrtf(wave_sum(ss[q]) * (1.0f / D) + EPS);
#pragma unroll
                for (int i = 0; i < 4; ++i) {
                    const float4 g = g1v[i];
                    uint2 o; o.x = pack2(v[q][i].x * r * g.x, v[q][i].y * r * g.y); o.y = pack2(v[q][i].z * r * g.z, v[q][i].w * r * g.w);
                    *(uint2*)(p.xn + (size_t)rw[q] * D + (lane + 64 * i) * 4) = o;
                }
            }
        }
    }
    float bbv_ = 0.f;
    if (bact_) bbv_ = p.rel_bias[bidx_ * AH + (bcmb_ & 7)];
    { PRO_TILE(j0); cvt_store(tdst_, tk0_, tn0_, t, CR); }
    for (int j = vb + nvb; j < NTILE; j += nvb) { PRO_TILE(j); cvt_tile(tsrc_, tld_, tdst_, tk0_, tn0_, t); }
#undef PRO_TILE
    if (bact_) p.btab[be_] = bok_ ? bbv_ * 1.44269504f : -1.0e30f;
    for (int e2 = be_ + (int)gridDim.x * 512; e2 < 24 * 704; e2 += (int)gridDim.x * 512) {
        const int cm2 = e2 / 704, en2 = e2 - cm2 * 704, c = en2 / 176, x = en2 - c * 176, y = x - c - 16;
        const bool ok = (y >= 0) && (y <= 128);
        p.btab[e2] = ok ? p.rel_bias[T5TAB[(cm2 >> 3) * 129 + (ok ? y : 0)] * AH + (cm2 & 7)] * 1.44269504f : -1.0e30f;
    }
    if (wzi_ < 32 * 128) { uint4 q; q.x = pack2(wz0_, wz1_); q.y = pack2(wz2_, wz3_); q.z = pack2(wz4_, wz5_); q.w = pack2(wz6_, wz7_); *(uint4*)(p.wzT + (size_t)(wzi_ >> 7) * 1024 + (wzi_ & 127) * 8) = q; }
    for (int c = wzi_ + (int)gridDim.x * 512; c < 32 * 128; c += (int)gridDim.x * 512) {
        const int n = c >> 7, k8 = (c & 127) * 8;
        const float* s = p.w_in + (size_t)k8 * INW + PJW + n;
        uint4 q;
        q.x = pack2(s[0], s[INW]); q.y = pack2(s[2 * INW], s[3 * INW]); q.z = pack2(s[4 * INW], s[5 * INW]); q.w = pack2(s[6 * INW], s[7 * INW]);
        *(uint4*)(p.wzT + (size_t)n * 1024 + k8) = q;
    }
}

namespace pg {
constexpr int BM = 256, BK = 64, HALF = 128, HTB = HALF * BK * 2, KD = 1024;
__host__ __device__ __forceinline__ int lds_byte(int r, int c) { const int st = (r >> 4) * 2 + (c >> 5), rr = r & 15, cc = c & 31, ob = rr * 64 + cc * 2; return st * 1024 + (ob ^ (((ob >> 9) & 1) << 5)); }
__host__ __device__ __forceinline__ void stage_rc(int b, int& R, int& C) { const int st = b / 1024, sb = b % 1024, swz = sb ^ (((sb >> 9) & 1) << 5); R = (st >> 1) * 16 + swz / 64; C = (st & 1) * 32 + (swz % 64) / 2; }
__host__ __device__ __forceinline__ int perm32(int rho) { const int n = rho >> 4, i = rho & 15; return 8 * (i >> 2) + 4 * n + (i & 3); }

struct Unit { int pn, row0, nvalid, e, ord; };

typedef int v8i32 __attribute__((ext_vector_type(8)));
template <class Epi, class Sched, bool FP8 = false>
__device__ __forceinline__ void gemm_phase(LDS_AS unsigned char* lds, const Sched& S, const Epi& E, int wv__) {
    const int tid = tid_opaque(), wid = __builtin_amdgcn_readfirstlane(tid >> 6), lane = tid & 63, wr = wid >> 2, wc = wid & 3, fr = lane & 15, fq = lane >> 4;
    constexpr int ROWB = FP8 ? KD : KD * 2;
    constexpr int nt = FP8 ? KD / 128 : KD / BK;
    int R0, C0; stage_rc(tid * 16, R0, C0);
    unsigned voffB[2];
#pragma unroll
    for (int i = 0; i < 2; ++i) { const int R = R0 + 64 * i; const int Rb = Epi::PERM ? ((R & ~31) + perm32(R & 31)) : R; voffB[i] = (unsigned)(Rb * ROWB + C0 * 2); }
    const size_t kstep = (size_t)(BK * 2);
    const size_t hstep = (size_t)HALF * ROWB;
    const unsigned ldsw = (unsigned)wid * 1024u;
    const int aoff = lds_byte(wr * 64 + fr, fq * 8), boff = lds_byte(wc * 32 + fr, fq * 8);
    const int aoff8a = lds_byte(wr * 64 + fr, fq * 16), boff8a = lds_byte(wc * 32 + fr, fq * 16);
#define PG_SA(b, h) (((b) * 2 + (h)) * HTB)
#define PG_SB(b, h) ((4 + (b) * 2 + (h)) * HTB)
#define PG_STAGE_B(bufoff, gbase) do { _Pragma("unroll") for (int _i = 0; _i < 2; ++_i) \
        __builtin_amdgcn_global_load_lds((const unsigned*)((const char*)(gbase) + voffB[_i]), (LDS_AS unsigned*)(lds + (bufoff) + ldsw + _i * 8192), 16, 0, 0); } while (0)
#define PG_STAGE_A(bufoff, o0, o1) do { \
        __builtin_amdgcn_global_load_lds((const unsigned*)(Abase + (o0)), (LDS_AS unsigned*)(lds + (bufoff) + ldsw), 16, 0, 0); \
        __builtin_amdgcn_global_load_lds((const unsigned*)(Abase + (o1)), (LDS_AS unsigned*)(lds + (bufoff) + ldsw + 8192), 16, 0, 0); } while (0)
#define PG_LDA16(dst, b, h) do { _Pragma("unroll") for (int m = 0; m < 4; ++m) _Pragma("unroll") for (int k = 0; k < 2; ++k) dst[m][k] = *(const LDS_AS bf16x8*)(lds + PG_SA(b, h) + aoff + m * 2048 + k * 1024); } while (0)
#define PG_LDB16(dst, b, h) do { _Pragma("unroll") for (int n = 0; n < 2; ++n) _Pragma("unroll") for (int k = 0; k < 2; ++k) dst[n][k] = *(const LDS_AS bf16x8*)(lds + PG_SB(b, h) + boff + n * 2048 + k * 1024); } while (0)
#define PG_RD16(off) __builtin_bit_cast(u32x4, *(const LDS_AS bf16x8*)(lds + (off)))
#define PG_LDA8(dst, b, h) do { _Pragma("unroll") for (int m = 0; m < 4; ++m) dst##8[m] = __builtin_bit_cast(v8i32, __builtin_shufflevector(PG_RD16(PG_SA(b, h) + aoff8a + m * 2048), PG_RD16(PG_SA(b, h) + aoff8a + 16 + m * 2048), 0, 1, 2, 3, 4, 5, 6, 7)); } while (0)
#define PG_LDB8(dst, b, h) do { _Pragma("unroll") for (int n = 0; n < 2; ++n) dst##8[n] = __builtin_bit_cast(v8i32, __builtin_shufflevector(PG_RD16(PG_SB(b, h) + boff8a + n * 2048), PG_RD16(PG_SB(b, h) + boff8a + 16 + n * 2048), 0, 1, 2, 3, 4, 5, 6, 7)); } while (0)
#define PG_LDA(dst, b, h) do { if constexpr (FP8) PG_LDA8(dst, b, h); else PG_LDA16(dst, b, h); } while (0)
#define PG_LDB(dst, b, h) do { if constexpr (FP8) PG_LDB8(dst, b, h); else PG_LDB16(dst, b, h); } while (0)
#define PG_MMA(ai, bj, At, Bt) do { __builtin_amdgcn_s_setprio(1); _Pragma("unroll") for (int m = 0; m < 4; ++m) _Pragma("unroll") for (int n = 0; n < 2; ++n) { \
        if constexpr (FP8) asm volatile("v_mfma_scale_f32_16x16x128_f8f6f4 %0, %1, %2, %0, %3, %4 op_sel_hi:[0,0,0]" : "+v"(acc[ai][bj][m][n]) : "v"(Bt##8[n]), "v"(At##8[m]), "v"(sclA), "v"(sclA)); \
        else { _Pragma("unroll") for (int k = 0; k < 2; ++k) acc[ai][bj][m][n] = __builtin_amdgcn_mfma_f32_16x16x32_bf16(Bt[n][k], At[m][k], acc[ai][bj][m][n], 0, 0, 0); } } \
        __builtin_amdgcn_s_setprio(0); } while (0)
#define PG_WAIT_V(n) asm volatile("s_waitcnt vmcnt(" #n ")" ::: "memory")
#define PG_WAIT_L(n) asm volatile("s_waitcnt lgkmcnt(" #n ")" ::: "memory")
#define PG_BAR __builtin_amdgcn_s_barrier()
#define PG_SCHED __builtin_amdgcn_sched_barrier(0)
    Unit cur, nxt; int ui = 0;
    if (!S.next(0, cur, 0)) return;
    f32x4 acc[2][2][4][2];
    E.init(acc, cur, wr, wc, fr, fq);
    bf16x8 At[4][2], B0[2][2], B1[2][2];
    v8i32 At8[4], B08[2], B18[2];
    int sclA = 0x7F7F7F7F;
    asm volatile("" : "+v"(sclA));
    const char* Abase = (const char*)S.A;
    unsigned c00 = S.rowoff(cur, R0) + C0 * 2u, c01 = S.rowoff(cur, R0 + 64) + C0 * 2u, c10 = S.rowoff(cur, R0 + 128) + C0 * 2u, c11 = S.rowoff(cur, R0 + 192) + C0 * 2u;
    const char* cB = S.bbase(cur);
    PG_STAGE_B(PG_SB(0, 0), cB); PG_STAGE_A(PG_SA(0, 0), c00, c01); PG_STAGE_B(PG_SB(0, 1), cB + hstep); PG_STAGE_A(PG_SA(0, 1), c10, c11);
    if (wr == 1) PG_BAR;
    PG_WAIT_V(4); PG_BAR;
    PG_STAGE_B(PG_SB(1, 0), cB + kstep); PG_STAGE_A(PG_SA(1, 0), c00 + 128u, c01 + 128u); PG_STAGE_B(PG_SB(1, 1), cB + hstep + kstep);
    PG_WAIT_V(6); PG_BAR;
    for (;;) {
        const bool has_next = S.next(ui + 1, nxt, cur.e);
        const char* nB = has_next ? S.bbase(nxt) : cB;
        unsigned dnx = 0u;
        if constexpr (Sched::LINEAR) { if (has_next) dnx = S.rowoff(nxt, 0) - S.rowoff(cur, 0); }

#if defined(KREP)
        for (int kr = 0; kr < (FP8 && Sched::LINEAR == (KREP_LINEAR != 0) ? KREP : 1); ++kr) {
        const bool lastrep = kr == (FP8 && Sched::LINEAR == (KREP_LINEAR != 0) ? KREP : 1) - 1;
        if (kr) E.init(acc, cur, wr, wc, fr, fq);
#else
        constexpr bool lastrep = true;
        {
#endif
#pragma unroll 1
        for (int t = 0; t < nt; t += 2) {
            const bool last = (t == nt - 2) && lastrep, wrap = (t == nt - 2);
            const unsigned k1 = (unsigned)(t + 1) * 128u, k2 = wrap ? 0u : (unsigned)(t + 2) * 128u, k3 = k2 + 128u;
            unsigned a2_00, a2_01, a2_10, a2_11, a3_00, a3_01;
            if constexpr (Sched::LINEAR) { const unsigned dl = last ? dnx : 0u; a2_00 = c00 + dl + k2; a2_01 = c01 + dl + k2; a2_10 = c10 + dl + k2; a2_11 = c11 + dl + k2; a3_00 = c00 + dl + k3; a3_01 = c01 + dl + k3; }
            else {
                a2_00 = c00; a2_01 = c01; a2_10 = c10; a2_11 = c11;
                if (last && has_next) { a2_00 = S.rowoff(nxt, R0) + C0 * 2u; a2_01 = S.rowoff(nxt, R0 + 64) + C0 * 2u; a2_10 = S.rowoff(nxt, R0 + 128) + C0 * 2u; a2_11 = S.rowoff(nxt, R0 + 192) + C0 * 2u; }
                a3_00 = a2_00 + k3; a3_01 = a2_01 + k3; a2_00 += k2; a2_01 += k2; a2_10 += k2; a2_11 += k2;
            }
            const char* b2 = last ? nB : (wrap ? cB : cB + (size_t)(t + 2) * kstep);
            const char* b3 = b2 + kstep;
            PG_LDB(B0, 0, 0); PG_SCHED; PG_LDA(At, 0, 0); PG_STAGE_A(PG_SA(1, 1), c10 + k1, c11 + k1);
            PG_WAIT_L(8); PG_BAR; PG_WAIT_L(0); PG_MMA(0, 0, At, B0); PG_BAR; PG_SCHED;
            PG_LDB(B1, 0, 1); PG_STAGE_B(PG_SB(0, 0), b2);
            PG_BAR; PG_WAIT_L(0); PG_MMA(0, 1, At, B1); PG_BAR;
            PG_LDA(At, 0, 1); PG_STAGE_A(PG_SA(0, 0), a2_00, a2_01);
            PG_BAR; PG_WAIT_L(0); PG_MMA(1, 0, At, B0); PG_BAR; PG_SCHED;
            PG_STAGE_B(PG_SB(0, 1), b2 + hstep);
            PG_WAIT_V(6); PG_BAR; PG_MMA(1, 1, At, B1); PG_BAR;
            PG_LDB(B0, 1, 0); PG_SCHED; PG_LDA(At, 1, 0); PG_STAGE_A(PG_SA(0, 1), a2_10, a2_11);
            PG_WAIT_L(8); PG_BAR; PG_WAIT_L(0); PG_MMA(0, 0, At, B0); PG_BAR; PG_SCHED;
            PG_LDB(B1, 1, 1); PG_STAGE_B(PG_SB(1, 0), b3);
            PG_BAR; PG_WAIT_L(0); PG_MMA(0, 1, At, B1); PG_BAR;
            PG_LDA(At, 1, 1); PG_STAGE_A(PG_SA(1, 0), a3_00, a3_01);
            PG_BAR; PG_WAIT_L(0); PG_MMA(1, 0, At, B0); PG_BAR; PG_SCHED;
            PG_STAGE_B(PG_SB(1, 1), b3 + hstep);
            PG_WAIT_V(6); PG_BAR; PG_MMA(1, 1, At, B1); PG_BAR;
        }
        }
#if defined(EREP)
        if constexpr (FP8 && Sched::LINEAR == (EREP_LINEAR != 0)) { for (int er = 1; er < EREP; ++er) E(acc, cur, wr, wc, fr, fq); }
#endif
        E(acc, cur, wr, wc, fr, fq);
        if (!has_next) break;
        E.init(acc, nxt, wr, wc, fr, fq);
        if constexpr (Sched::LINEAR) { c00 += dnx; c01 += dnx; c10 += dnx; c11 += dnx; }
        else { c00 = S.rowoff(nxt, R0) + C0 * 2u; c01 = S.rowoff(nxt, R0 + 64) + C0 * 2u; c10 = S.rowoff(nxt, R0 + 128) + C0 * 2u; c11 = S.rowoff(nxt, R0 + 192) + C0 * 2u; }
        cur = nxt; cB = nB; ++ui;
    }
    PG_WAIT_V(0);
    if (wr == 0) PG_BAR;
    PG_BAR;
#undef PG_SA
#undef PG_SB
#undef PG_STAGE_A
#undef PG_STAGE_B
#undef PG_LDA
#undef PG_LDB
#undef PG_LDA8
#undef PG_LDB8
#undef PG_LDA16
#undef PG_LDB16
#undef PG_RD16
#undef PG_MMA
#undef PG_WAIT_V
#undef PG_WAIT_L
#undef PG_BAR
#undef PG_SCHED
}

struct DenseSched {
    static constexpr bool LINEAR = true;
    const u16* A; const u16* Bt; int nM, nN, nwg, G, c;
    __device__ void init(const u16* A_, const u16* Bt_, int M, int N, int G_, int c_) { A = A_; Bt = Bt_; nM = M / BM; nN = N / BM; nwg = nM * nN; G = G_; c = c_; }
    __device__ __forceinline__ bool next(int i, Unit& u, int) const {
        const int L = i * G + c; if (L >= nwg) return false;
        int wgid = L; { const int q = nwg / 8, r = nwg % 8, xcd = wgid % 8, off = wgid / 8; wgid = (xcd < r ? xcd * (q + 1) : r * (q + 1) + (xcd - r) * q) + off; }
        const int nig = 8 * nN, gid = wgid / nig, fm = gid * 8, gsz = (nM - fm) < 8 ? (nM - fm) : 8;
        u.row0 = (fm + ((wgid % nig) % gsz)) * BM; u.pn = (wgid % nig) / gsz; u.nvalid = BM; u.e = 0; u.ord = i; return true;
    }
    __device__ __forceinline__ unsigned rowoff(const Unit& u, int r) const { return (unsigned)(u.row0 + r) * (unsigned)(KD * 2); }
    __device__ __forceinline__ const char* bbase(const Unit& u) const { return (const char*)Bt + (size_t)u.pn * BM * KD * 2; }
};

template <bool GATHER> struct MoeSchedT {
    static constexpr bool LINEAR = !GATHER;
    const u16* A; const u16* Bt; const int* lists; const LDS_AS int* meta; int NT, nunits, G, c; int rowb; const LDS_AS unsigned* rowtab;
    __device__ __forceinline__ bool next(int i, Unit& u, int e0) const {
        const int L = i * G + c; if (L >= nunits) return false;
        int wgid = L; { const int q = nunits / 8, r = nunits % 8, xcd = wgid % 8, off = wgid / 8; wgid = (xcd < r ? xcd * (q + 1) : r * (q + 1) + (xcd - r) * q) + off; }
        const int gm = wgid / NT; u.pn = wgid % NT;
        int e = e0;
        while (meta[32 + e + 1] <= gm) ++e;
        const int mi = gm - meta[32 + e];
        u.e = e; u.row0 = meta[72 + e] + mi * BM; u.nvalid = min(BM, meta[e] - mi * BM); u.ord = i;
        return true;
    }
    __device__ __forceinline__ unsigned rowoff(const Unit& u, int r) const {
        if constexpr (GATHER) return rowtab[u.ord * BM + r];
        else return (unsigned)(u.row0 + r) * (unsigned)rowb;
    }
    __device__ __forceinline__ const char* bbase(const Unit& u) const { return (const char*)Bt + ((size_t)u.e * NT + u.pn) * BM * (size_t)rowb; }
};

struct EpiProj {
    static constexpr int SCALE_A = 0x7F7F7F7F, SCALE_B = 0x7F7F7F7F;
    static constexpr bool PERM = true;
    u16* O;
    __device__ __forceinline__ void init(f32x4 (&acc)[2][2][4][2], const Unit&, int, int, int, int) const {
#pragma unroll
        for (int a = 0; a < 2; ++a)
#pragma unroll
            for (int b = 0; b < 2; ++b)
#pragma unroll
                for (int m = 0; m < 4; ++m)
#pragma unroll
                    for (int n = 0; n < 2; ++n) acc[a][b][m][n] = (f32x4){0.f, 0.f, 0.f, 0.f};
    }
    __device__ __forceinline__ void operator()(const f32x4 (&acc)[2][2][4][2], const Unit& u, int wr, int wc, int fr, int fq) const {
        const int row0 = u.row0 + wr * 64 + fr, col0 = u.pn * BM + wc * 32 + 8 * fq;
#pragma unroll
        for (int ai = 0; ai < 2; ++ai)
#pragma unroll
            for (int m = 0; m < 4; ++m) { u16* rowp = O + (size_t)(row0 + ai * HALF + m * 16) * PJW + col0;
#pragma unroll
                for (int bj = 0; bj < 2; ++bj) { const f32x4 v0 = acc[ai][bj][m][0], v1 = acc[ai][bj][m][1];
                    u32x4 w; w.x = pack2(v0[0], v0[1]); w.y = pack2(v0[2], v0[3]); w.z = pack2(v1[0], v1[1]); w.w = pack2(v1[2], v1[3]);
                    *(u32x4*)(rowp + bj * HALF) = w; } }
    }
};
struct EpiOut {
    static constexpr int SCALE_A = 0x7F7F7F7F, SCALE_B = 0x7F7F7F7F;
    static constexpr bool PERM = true;
    const float* X; u16* C;
    __device__ __forceinline__ void init(f32x4 (&acc)[2][2][4][2], const Unit& u, int wr, int wc, int fr, int fq) const {
        const int row0 = u.row0 + wr * 64 + fr, col0 = u.pn * BM + wc * 32 + 8 * fq;
#pragma unroll
        for (int ai = 0; ai < 2; ++ai)
#pragma unroll
            for (int m = 0; m < 4; ++m) { const size_t ro = (size_t)(row0 + ai * HALF + m * 16) * D + col0;
#pragma unroll
                for (int bj = 0; bj < 2; ++bj)
#pragma unroll
                    for (int n = 0; n < 2; ++n) acc[ai][bj][m][n] = *(const f32x4*)(X + ro + bj * HALF + n * 4); }
    }
    __device__ __forceinline__ void operator()(const f32x4 (&acc)[2][2][4][2], const Unit& u, int wr, int wc, int fr, int fq) const {
        const int row0 = u.row0 + wr * 64 + fr, col0 = u.pn * BM + wc * 32 + 8 * fq;
#pragma unroll
        for (int ai = 0; ai < 2; ++ai)
#pragma unroll
            for (int m = 0; m < 4; ++m) { u16* rowp = C + (size_t)(row0 + ai * HALF + m * 16) * D + col0;
#pragma unroll
                for (int bj = 0; bj < 2; ++bj) { const f32x4 v0 = acc[ai][bj][m][0], v1 = acc[ai][bj][m][1];
                    u32x4 w; w.x = pack2(v0[0], v0[1]); w.y = pack2(v0[2], v0[3]); w.z = pack2(v1[0], v1[1]); w.w = pack2(v1[2], v1[3]);
                    *(u32x4*)(rowp + bj * HALF) = w; } }
    }
};
struct EpiMoe1 {
    static constexpr int SCALE_A = 0x7F7F7F7F, SCALE_B = 0x7F7F7F7F;
    static constexpr bool PERM = true;
    const LDS_AS float* tabB; unsigned char* act8;
    __device__ __forceinline__ void init(f32x4 (&acc)[2][2][4][2], const Unit&, int, int, int, int) const {
#pragma unroll
        for (int a = 0; a < 2; ++a)
#pragma unroll
            for (int b = 0; b < 2; ++b)
#pragma unroll
                for (int m = 0; m < 4; ++m)
#pragma unroll
                    for (int n = 0; n < 2; ++n) acc[a][b][m][n] = (f32x4){0.f, 0.f, 0.f, 0.f};
    }
    __device__ __forceinline__ void operator()(const f32x4 (&acc)[2][2][4][2], const Unit& u, int wr, int wc, int fr, int fq) const {
        const int r0 = wr * 64 + fr, col0 = u.pn * BM + wc * 32 + 8 * fq;
        const LDS_AS float* be = tabB + u.ord * 256 + wc * 32 + 8 * fq;
        f32x4 bv[2][2];
#pragma unroll
        for (int bj = 0; bj < 2; ++bj)
#pragma unroll
            for (int n = 0; n < 2; ++n) bv[bj][n] = *(const LDS_AS f32x4*)(be + bj * HALF + 4 * n);
#pragma unroll
        for (int ai = 0; ai < 2; ++ai)
#pragma unroll
            for (int m = 0; m < 4; ++m) {
                const int r = r0 + ai * HALF + m * 16;
                if (r < u.nvalid) {
                    unsigned char* rowp = act8 + (size_t)(u.row0 + r) * DFF + (col0 >> 1);
#pragma unroll
                    for (int bj = 0; bj < 2; ++bj) {
                        const f32x4 v0 = acc[ai][bj][m][0] * 0.03125f + bv[bj][0], v1 = acc[ai][bj][m][1] * 0.03125f + bv[bj][1];
                        const float g0 = fminf(v0[0], 7.0f), l0 = __builtin_amdgcn_fmed3f(v0[1], -6.0f, 8.0f);
                        const float g1 = fminf(v0[2], 7.0f), l1 = __builtin_amdgcn_fmed3f(v0[3], -6.0f, 8.0f);
                        const float g2 = fminf(v1[0], 7.0f), l2 = __builtin_amdgcn_fmed3f(v1[1], -6.0f, 8.0f);
                        const float g3 = fminf(v1[2], 7.0f), l3 = __builtin_amdgcn_fmed3f(v1[3], -6.0f, 8.0f);
                        const float a0 = g0 * __builtin_amdgcn_rcpf(1.0f + __builtin_amdgcn_exp2f(-2.45546696f * g0)) * l0, a1 = g1 * __builtin_amdgcn_rcpf(1.0f + __builtin_amdgcn_exp2f(-2.45546696f * g1)) * l1;
                        const float a2 = g2 * __builtin_amdgcn_rcpf(1.0f + __builtin_amdgcn_exp2f(-2.45546696f * g2)) * l2, a3 = g3 * __builtin_amdgcn_rcpf(1.0f + __builtin_amdgcn_exp2f(-2.45546696f * g3)) * l3;
                        int pk = __builtin_amdgcn_cvt_pk_fp8_f32(a0, a1, 0, false);
                        pk = __builtin_amdgcn_cvt_pk_fp8_f32(a2, a3, pk, true);
                        *(int*)(rowp + bj * (HALF / 2)) = pk;
                    }
                }
            }
    }
};
struct EpiMoe2 {
    static constexpr bool PERM = true;
    static constexpr int SCALE_A = 0x7F7F7F7F, SCALE_B = 0x7A7A7A7A;
    const LDS_AS int* tabS; const LDS_AS float* tabG; const LDS_AS float* tabB; u16* y;
    __device__ __forceinline__ void init(f32x4 (&acc)[2][2][4][2], const Unit&, int, int, int, int) const {
#pragma unroll
        for (int a = 0; a < 2; ++a)
#pragma unroll
            for (int b = 0; b < 2; ++b)
#pragma unroll
                for (int m = 0; m < 4; ++m)
#pragma unroll
                    for (int n = 0; n < 2; ++n) acc[a][b][m][n] = (f32x4){0.f, 0.f, 0.f, 0.f};
    }
    __device__ __forceinline__ void operator()(const f32x4 (&acc)[2][2][4][2], const Unit& u, int wr, int wc, int fr, int fq) const {
        const int r0 = wr * 64 + fr, col0 = u.pn * BM + wc * 32 + 8 * fq;
        const LDS_AS float* be = tabB + u.ord * 256 + wc * 32 + 8 * fq;
        f32x4 bv[2][2];
#pragma unroll
        for (int bj = 0; bj < 2; ++bj)
#pragma unroll
            for (int n = 0; n < 2; ++n) bv[bj][n] = *(const LDS_AS f32x4*)(be + bj * HALF + 4 * n);
        int slot[8]; float gt[8];
#pragma unroll
        for (int q = 0; q < 8; ++q) { const int rr = u.ord * 256 + r0 + (q >> 2) * HALF + (q & 3) * 16; slot[q] = tabS[rr]; gt[q] = tabG[rr]; }
#pragma unroll
        for (int ai = 0; ai < 2; ++ai)
#pragma unroll
            for (int m = 0; m < 4; ++m) {
                const int r = r0 + ai * HALF + m * 16;
                if (r < u.nvalid) {
                    unsigned char* rowp = (unsigned char*)y + (size_t)slot[ai * 4 + m] * D + col0;
                    const float g16 = gt[ai * 4 + m];
#pragma unroll
                    for (int bj = 0; bj < 2; ++bj) {
                        const f32x4 v0 = (acc[ai][bj][m][0] * 0.03125f + bv[bj][0]) * g16, v1 = (acc[ai][bj][m][1] * 0.03125f + bv[bj][1]) * g16;
                        int lo = __builtin_amdgcn_cvt_pk_fp8_f32(v0[0], v0[1], 0, false); lo = __builtin_amdgcn_cvt_pk_fp8_f32(v0[2], v0[3], lo, true);
                        int hi = __builtin_amdgcn_cvt_pk_fp8_f32(v1[0], v1[1], 0, false); hi = __builtin_amdgcn_cvt_pk_fp8_f32(v1[2], v1[3], hi, true);
                        uint2 w; w.x = (unsigned)lo; w.y = (unsigned)hi;
                        *(uint2*)(rowp + bj * HALF) = w;
                    }
                }
            }
    }
};
}

__device__ __forceinline__ void bg_decode(const Params& p, int s, const float*& src, int& sstr, unsigned char*& dst) {
    const bool isw2 = s < W2_BG;
    const int wi = isw2 ? s : s - W2_BG + W1_CONV;
    const int e = isw2 ? (wi >> 7) : (wi >> 8), j = isw2 ? (wi & 127) : (wi & 255);
    const int kt = isw2 ? (j >> 3) : (j >> 4), nt = isw2 ? (j & 7) : (j & 15);
    sstr = isw2 ? D : 2 * DFF;
    src = (isw2 ? p.w2 + (size_t)e * DFF * D : p.w1 + (size_t)e * D * 2 * DFF) + (size_t)(kt * 64) * sstr + nt * 128;
    dst = (isw2 ? p.w2T8 + (size_t)e * D * DFF : p.w1T8 + (size_t)e * 2 * DFF * D) + (size_t)(nt * 128) * 1024 + kt * 64;
}
struct BgRegs { f32x4 c[16]; };
__device__ __forceinline__ void bg_issue(const Params& p, int slot, int t, f32x4* c) {
    const int l = t & 63, w = t >> 6, bkg = l & 7, bng = w * 8 + (l >> 3);
    const float* s_; int ss_; unsigned char* dd_;
    bg_decode(p, slot, s_, ss_, dd_);
    s_ += (size_t)(8 * bkg) * ss_ + 4 * bng;
#pragma unroll
    for (int j = 0; j < 8; ++j) c[j] = __builtin_nontemporal_load((const f32x4*)(s_ + (size_t)j * ss_));
}
__device__ __forceinline__ void bg_finish(const Params& p, int slot, int t, const f32x4* c) {
    const int l = t & 63, w = t >> 6, bkg = l & 7, bng = w * 8 + (l >> 3);
    const float* s_; int ss_; unsigned char* d_;
    bg_decode(p, slot, s_, ss_, d_);
    d_ += (size_t)(4 * bng) * 1024 + 8 * bkg;
#pragma unroll
    for (int c_ = 0; c_ < 4; ++c_) {
        int lo_ = __builtin_amdgcn_cvt_pk_fp8_f32(c[0][c_] * 32.0f, c[1][c_] * 32.0f, 0, false); lo_ = __builtin_amdgcn_cvt_pk_fp8_f32(c[2][c_] * 32.0f, c[3][c_] * 32.0f, lo_, true);
        int hi_ = __builtin_amdgcn_cvt_pk_fp8_f32(c[4][c_] * 32.0f, c[5][c_] * 32.0f, 0, false); hi_ = __builtin_amdgcn_cvt_pk_fp8_f32(c[6][c_] * 32.0f, c[7][c_] * 32.0f, hi_, true);
        uint2 q_; q_.x = (unsigned)lo_; q_.y = (unsigned)hi_; *(uint2*)(d_ + c_ * 1024) = q_;
    }
}
#ifndef BG_GD_ST
#define BG_GD_ST 2
#endif
#ifndef BG_GO_ST
#define BG_GO_ST 3
#endif
constexpr int BG_NGD = B * GH * 64 * BG_GD_ST, BG_NGO = B * GH * 64 * BG_GO_ST, BG_NA = N_BG - BG_NGD - BG_NGO;
static_assert(BG_NA >= 6144 && BG_NA <= 12288 && (BG_NA % 2) == 0, "attention items carry one or two tiles each");
constexpr int AT_K = 0, AT_V = 272 * 128, AT_Q = AT_V + 272 * 160, AT_BIAS = AT_Q + 2 * 8192;
constexpr int N_ATT_PAIRS = B * AH * 3 * 32;
struct AttnRegs { float tb[2]; };
__device__ __forceinline__ void attn_load(const Params& p, int tid, int pi, AttnRegs& R) {
    const int gq = pi >> 5, br = gq % 3, h = (gq / 3) & 7;
    const float* bt = p.btab + (br * 8 + h) * 704;
#pragma unroll
    for (int i = 0; i < 2; ++i) { const int en = tid + 512 * i; R.tb[i] = bt[en < 704 ? en : 703]; }
}
template <bool BG, int NT>
__device__ void attn_item(const Params& p, char* lds, int tid, int pi, int npi, AttnRegs& R, int bgt, int bgt2) {
    const int t = tid & 255, hv = tid >> 8;
    const int l = t & 63, w = t >> 6, i16 = l & 15, g = l >> 4;
    const int gq = pi >> 5, idx0 = (pi & 31) * 2, br = gq % 3, h = (gq / 3) & 7, b = gq / 24;
    const int dsh = br * 2, L = S >> dsh, nbl = L >> 6;
    const int res = idx0 / nbl, qb0 = idx0 % nbl, qb = qb0 + hv;
    char* Ks = lds + AT_K; char* Vs = lds + AT_V; char* Qs = lds + AT_Q + hv * 8192; float* biasf = (float*)(lds + AT_BIAS);
    __syncthreads();
    unsigned z0_; asm volatile("v_mov_b32 %0, 0" : "=v"(z0_));
#define AT_LDKV(i) const int kj##i = tid + 512 * i, ki##i = 64 * (qb0 - 1) + (kj##i >> 3); \
        const size_t kb##i = (size_t)(b * S + res + (min(max(ki##i, 0), L - 1) << dsh)) * PJW + h * 64 + (kj##i & 7) * 8; \
        u32x4 kx##i = *(const u32x4*)(p.proj + kb##i + C_AK), vx##i = *(const u32x4*)(p.proj + kb##i + C_AV);
    AT_LDKV(0) AT_LDKV(1) AT_LDKV(2) AT_LDKV(3)
#undef AT_LDKV
    const u32x4 qx0 = *(const u32x4*)(p.proj + (size_t)(b * S + res + ((64 * qb + (t >> 3)) << dsh)) * PJW + C_AQ + h * 64 + (t & 7) * 8);
    const u32x4 qx1 = *(const u32x4*)(p.proj + (size_t)(b * S + res + ((64 * qb + 32 + (t >> 3)) << dsh)) * PJW + C_AQ + h * 64 + (t & 7) * 8);
    const float tbc0 = R.tb[0], tbc1 = R.tb[1];
    attn_load(p, tid, npi >= 0 ? npi : pi, R);
    asm volatile("" ::: "memory");
    BgRegs G;
    if constexpr (BG) { bg_issue(p, bgt, t, G.c); if constexpr (NT == 2) bg_issue(p, bgt2, t, G.c + 8); }
    asm volatile("" ::: "memory");
#define AT_STKV(i) { const int row_ = kj##i >> 3, c_ = kj##i & 7; *(u32x4*)(Ks + tile_off(row_, c_)) = kx##i; *(u32x4*)(Vs + row_ * 160 + c_ * 16) = vx##i; }
    AT_STKV(0) AT_STKV(1) AT_STKV(2) AT_STKV(3)
#undef AT_STKV
    { const u32x4 zz = {z0_, z0_, z0_, z0_};
      if (tid < 160) *(u32x4*)(Vs + 256 * 160 + tid * 16) = zz; else if (tid < 288) *(u32x4*)(Ks + 256 * 128 + (tid - 160) * 16) = zz; }
    *(u32x4*)(Qs + tile_off(t >> 3, t & 7)) = qx0;
    *(u32x4*)(Qs + tile_off(32 + (t >> 3), t & 7)) = qx1;
    biasf[tid] = tbc0; if (tid + 512 < 704) biasf[tid + 512] = tbc1;
    __syncthreads();

    const bf16x8 qf0 = lds_frag(Qs, 16 * w + i16, g), qf1 = lds_frag(Qs, 16 * w + i16, 4 + g);
    const char* Kw = Ks + (64 * hv + 16 * w) * 128;
    f32x4 sc[10];
    sc[9] = (f32x4){0.f, 0.f, 0.f, 0.f};
#pragma unroll
    for (int i = 0; i < 9; ++i) {
        const bf16x8 k0 = lds_frag(Kw, 16 * i + i16, g), k1 = lds_frag(Kw, 16 * i + i16, 4 + g);
        f32x4 a = {0.f, 0.f, 0.f, 0.f};
        a = __builtin_amdgcn_mfma_f32_16x16x32_bf16(k0, qf0, a, 0, 0, 0);
        a = __builtin_amdgcn_mfma_f32_16x16x32_bf16(k1, qf1, a, 0, 0, 0);
        sc[i] = a;
    }
    const int sq = 16 * w + i16;
    const float* tabc = biasf + (i16 & 3) * 176 + 4 * g - 4 * (i16 >> 2) + 16;
    float mx = -3.0e38f;
#pragma unroll
    for (int i = 0; i < 9; ++i) {
        const f32x4 b4 = *(const f32x4*)(tabc + 16 * i);
#pragma unroll
        for (int r = 0; r < 4; ++r) sc[i][r] = fmaf(sc[i][r], 0.125f * 1.44269504f, b4[r]);
    }
    if (qb == 0 || qb == nbl - 1) {
        const int lo = (qb == 0) ? 64 : 0, hi = (qb == nbl - 1) ? 128 : 192;
#pragma unroll
        for (int i = 0; i < 9; ++i)
#pragma unroll
            for (int r = 0; r < 4; ++r) { const int tk = 16 * (w + i) + 4 * g + r; sc[i][r] = (tk >= lo && tk < hi) ? sc[i][r] : -1.0e30f; }
    }
#pragma unroll
    for (int i = 0; i < 9; ++i) mx = fmaxf(mx, fmaxf(fmaxf(sc[i][0], sc[i][1]), fmaxf(sc[i][2], sc[i][3])));
    mx = fmaxf(mx, swz_xor<16>(mx)); mx = half_max(mx);
    float ls = 0.f;
#pragma unroll
    for (int i = 0; i < 9; ++i) {
#pragma unroll
        for (int r = 0; r < 4; ++r) { const float e = __builtin_amdgcn_exp2f(sc[i][r] - mx); sc[i][r] = e; ls += e; }
    }
    ls += swz_xor<16>(ls); ls = half_sum(ls);

    f32x4 oa[4];
#pragma unroll
    for (int e = 0; e < 4; ++e) oa[e] = (f32x4){0.f, 0.f, 0.f, 0.f};
    const char* Vw = Vs + (64 * hv + 16 * w + 4 * g + (i16 >> 2)) * 160 + 4 * (i16 & 3) * 2;
#pragma unroll
    for (int i2 = 0; i2 < 5; ++i2) {
        uint4 pu;
        pu.x = pack2(sc[2 * i2][0], sc[2 * i2][1]); pu.y = pack2(sc[2 * i2][2], sc[2 * i2][3]);
        pu.z = pack2(sc[2 * i2 + 1][0], sc[2 * i2 + 1][1]); pu.w = pack2(sc[2 * i2 + 1][2], sc[2 * i2 + 1][3]);
        const bf16x8 pf = __builtin_bit_cast(bf16x8, pu);
#pragma unroll
        for (int et = 0; et < 4; ++et) {
            const s16x4 va = tr_read(Vw + (32 * i2) * 160 + et * 32);
            const s16x4 vb = tr_read(Vw + (32 * i2 + 16) * 160 + et * 32);
            oa[et] = __builtin_amdgcn_mfma_f32_16x16x32_bf16(cat4(va, vb), pf, oa[et], 0, 0, 0);
        }
    }
    const float inv = 1.0f / ls;
    const size_t tok = (size_t)b * S + res + ((64 * qb + sq) << dsh);
#pragma unroll
    for (int et = 0; et < 4; ++et) {
        uint2 o; o.x = pack2(oa[et][0] * inv, oa[et][1] * inv); o.y = pack2(oa[et][2] * inv, oa[et][3] * inv);
        *(uint2*)(p.abr + ((size_t)br * T + tok) * 512 + h * 64 + 16 * et + 4 * g) = o;
    }
    if (g == 0) p.lse[((size_t)br * T + tok) * 8 + h] = (mx + __log2f(ls)) * 0.69314718f;
    if constexpr (BG) { bg_finish(p, bgt, t, G.c); if constexpr (NT == 2) bg_finish(p, bgt2, t, G.c + 8); }
}

constexpr int GL_ZS = 0, GL_TOT = 8192, GL_GG = 10240, GL_BF = 10752, GL_BS = 68, GL_BB = GL_BF + 64 * GL_BS * 4, GL_R2 = GL_BB + 64 * GL_BS * 4;
__device__ __forceinline__ float logsig_fast(float a) { return fminf(a, 0.f) - __logf(1.0f + __expf(-fabsf(a))); }
__device__ __forceinline__ void gla_prep(const Params& p, char* lds, int t, int h) {
    const int d = t & 63, w = t >> 6;
    float* zs = (float*)(lds + GL_ZS); float* tot = (float*)(lds + GL_TOT); float* GG = (float*)(lds + GL_GG);
    float* BF = (float*)(lds + GL_BF); float* BB = (float*)(lds + GL_BB);
    float wf[16], wb[16];
#pragma unroll
    for (int r = 0; r < 16; ++r) { wf[r] = p.wgf[r * 256 + h * 64 + d]; wb[r] = p.wgb[r * 256 + h * 64 + d]; }
    const float biasf = p.bgf[h * 64 + d], biasb = p.bgb[h * 64 + d];
    __syncthreads();
    float bfv[16], bbv[16];
#pragma unroll
    for (int i = 0; i < 16; ++i) {
        const float4* zr = (const float4*)(zs + (16 * w + i) * 32);
        float af = biasf, ab = biasb;
#pragma unroll
        for (int r4 = 0; r4 < 4; ++r4) {
            const float4 zf = zr[r4], zb = zr[4 + r4];
            af = fmaf(zf.x, wf[4 * r4], af); af = fmaf(zf.y, wf[4 * r4 + 1], af); af = fmaf(zf.z, wf[4 * r4 + 2], af); af = fmaf(zf.w, wf[4 * r4 + 3], af);
            ab = fmaf(zb.x, wb[4 * r4], ab); ab = fmaf(zb.y, wb[4 * r4 + 1], ab); ab = fmaf(zb.z, wb[4 * r4 + 2], ab); ab = fmaf(zb.w, wb[4 * r4 + 3], ab);
        }
        bfv[i] = logsig_fast(af) * (1.0f / 16.0f); bbv[i] = logsig_fast(ab) * (1.0f / 16.0f);
    }
#pragma unroll
    for (int i = 1; i < 16; ++i) bfv[i] += bfv[i - 1];
#pragma unroll
    for (int i = 14; i >= 0; --i) bbv[i] += bbv[i + 1];
    tot[(0 * 4 + w) * 64 + d] = bfv[15];
    tot[(1 * 4 + w) * 64 + d] = bbv[0];
    __syncthreads();
    float offf = 0.f, offb = 0.f, Gf = 0.f, Gb = 0.f;
#pragma unroll
    for (int ww = 0; ww < 4; ++ww) {
        const float a = tot[(0 * 4 + ww) * 64 + d], c = tot[(1 * 4 + ww) * 64 + d];
        Gf += a; Gb += c;
        if (ww < w) offf += a;
        if (ww > w) offb += c;
    }
#pragma unroll
    for (int i = 0; i < 16; ++i) { BF[(16 * w + i) * GL_BS + d] = bfv[i] + offf; BB[(16 * w + i) * GL_BS + d] = bbv[i] + offb; }
    if (w == 0) { GG[d] = Gf; GG[64 + d] = Gb; }
    __syncthreads();
}
__device__ __forceinline__ void unpack8(const uint4 u, float (&f)[8]) {
    f[0] = lo2f(u.x); f[1] = hi2f(u.x); f[2] = lo2f(u.y); f[3] = hi2f(u.y); f[4] = lo2f(u.z); f[5] = hi2f(u.z); f[6] = lo2f(u.w); f[7] = hi2f(u.w);
}
__device__ __forceinline__ uint4 pack8(const float (&f)[8]) { uint4 u; u.x = pack2(f[0], f[1]); u.y = pack2(f[2], f[3]); u.z = pack2(f[4], f[5]); u.w = pack2(f[6], f[7]); return u; }

constexpr int GD_KF = GL_R2, GD_KB = GD_KF + 64 * 160, GD_VT = GL_BF;
__device__ void gla_ds_item(const Params& p, char* lds, int t, int it, int bgs) {
    const int l = t & 63, w = t >> 6, i16 = l & 15, g = l >> 4;
    const int n = it & 63, h = (it >> 6) & 3, b = it >> 8;
    const int t0 = b * S + n * 64;
    float* zs = (float*)(lds + GL_ZS);
    const int sr = t >> 2, sc = t & 3;
    const u16* kp = p.proj + (size_t)(t0 + sr) * PJW + C_GK + h * 64 + sc * 16;
    const uint4 kr0 = *(const uint4*)(kp), kr1 = *(const uint4*)(kp + 8);
    u32x4 vr[4];
#pragma unroll
    for (int i = 0; i < 4; ++i) { const int j = t + 256 * i; vr[i] = *(const u32x4*)(p.proj + (size_t)(t0 + (j >> 4)) * PJW + C_GV + h * 128 + (j & 15) * 8); }
    const float4* zsrc = (const float4*)(p.zbuf + (size_t)t0 * 32);
    const float4 zv0 = zsrc[t], zv1 = zsrc[t + 256];
    f32x4 gc[8];
    if (BG_GD_ST > 0) bg_issue(p, bgs, t, gc);
    asm volatile("" ::: "memory");
    __syncthreads();
    ((float4*)zs)[t] = zv0; ((float4*)zs)[t + 256] = zv1;
    gla_prep(p, lds, t, h);
    const float* BF = (const float*)(lds + GL_BF); const float* BB = (const float*)(lds + GL_BB); const float* GG = (const float*)(lds + GL_GG);
    char* KF = lds + GD_KF; char* KB = lds + GD_KB; char* VT = lds + GD_VT;
    {
        float kk[16];
        { float tmp[8]; unpack8(kr0, tmp);
#pragma unroll
          for (int j = 0; j < 8; ++j) kk[j] = tmp[j];
          unpack8(kr1, tmp);
#pragma unroll
          for (int j = 0; j < 8; ++j) kk[8 + j] = tmp[j]; }
        float of[16], ob[16];
#pragma unroll
        for (int q = 0; q < 4; ++q) {
            const float4 bf4 = *(const float4*)(BF + sr * GL_BS + sc * 16 + 4 * q), bb4 = *(const float4*)(BB + sr * GL_BS + sc * 16 + 4 * q);
            const float4 gf4 = *(const float4*)(GG + sc * 16 + 4 * q), gb4 = *(const float4*)(GG + 64 + sc * 16 + 4 * q);
            of[4 * q + 0] = kk[4 * q + 0] * __expf(gf4.x - bf4.x); of[4 * q + 1] = kk[4 * q + 1] * __expf(gf4.y - bf4.y);
            of[4 * q + 2] = kk[4 * q + 2] * __expf(gf4.z - bf4.z); of[4 * q + 3] = kk[4 * q + 3] * __expf(gf4.w - bf4.w);
            ob[4 * q + 0] = kk[4 * q + 0] * __expf(gb4.x - bb4.x); ob[4 * q + 1] = kk[4 * q + 1] * __expf(gb4.y - bb4.y);
            ob[4 * q + 2] = kk[4 * q + 2] * __expf(gb4.z - bb4.z); ob[4 * q + 3] = kk[4 * q + 3] * __expf(gb4.w - bb4.w);
        }
        uint4 u;
        u.x = pack2(of[0], of[1]); u.y = pack2(of[2], of[3]); u.z = pack2(of[4], of[5]); u.w = pack2(of[6], of[7]);
        *(uint4*)(KF + sr * 160 + sc * 32) = u;
        u.x = pack2(of[8], of[9]); u.y = pack2(of[10], of[11]); u.z = pack2(of[12], of[13]); u.w = pack2(of[14], of[15]);
        *(uint4*)(KF + sr * 160 + sc * 32 + 16) = u;
        u.x = pack2(ob[0], ob[1]); u.y = pack2(ob[2], ob[3]); u.z = pack2(ob[4], ob[5]); u.w = pack2(ob[6], ob[7]);
        *(uint4*)(KB + sr * 160 + sc * 32) = u;
        u.x = pack2(ob[8], ob[9]); u.y = pack2(ob[10], ob[11]); u.z = pack2(ob[12], ob[13]); u.w = pack2(ob[14], ob[15]);
        *(uint4*)(KB + sr * 160 + sc * 32 + 16) = u;
        if (t < 64) { p.dec[((size_t)it * 2 + 0) * 64 + t] = __expf(GG[t]); p.dec[((size_t)it * 2 + 1) * 64 + t] = __expf(GG[64 + t]); }
    }
    __syncthreads();
    if (BG_GD_ST > 1) { bg_finish(p, bgs, t, gc); asm volatile("" ::: "memory"); bg_issue(p, bgs + 1, t, gc); asm volatile("" ::: "memory"); }
#pragma unroll
    for (int i = 0; i < 4; ++i) { const int j = t + 256 * i; *(u32x4*)(VT + (j >> 4) * 288 + (j & 15) * 16) = vr[i]; }
    __syncthreads();
#pragma unroll
    for (int dir = 0; dir < 2; ++dir) {
        const char* KX = dir ? KB : KF;
        f32x4 acc[2][4];
#pragma unroll
        for (int a = 0; a < 2; ++a)
#pragma unroll
            for (int c = 0; c < 4; ++c) acc[a][c] = (f32x4){0.f, 0.f, 0.f, 0.f};
#pragma unroll
        for (int ks = 0; ks < 2; ++ks) {
            const int r0 = ks * 32 + 8 * g + (i16 >> 2);
            bf16x8 vf[2], kf[4];
#pragma unroll
            for (int a = 0; a < 2; ++a) {
                const int e0 = 16 * (2 * w + a) + 4 * (i16 & 3);
                vf[a] = cat4(tr_read(VT + r0 * 288 + e0 * 2), tr_read(VT + (r0 + 4) * 288 + e0 * 2));
            }
#pragma unroll
            for (int c = 0; c < 4; ++c) {
                const int d0 = 16 * c + 4 * (i16 & 3);
                kf[c] = cat4(tr_read(KX + r0 * 160 + d0 * 2), tr_read(KX + (r0 + 4) * 160 + d0 * 2));
            }
#pragma unroll
            for (int a = 0; a < 2; ++a)
#pragma unroll
                for (int c = 0; c < 4; ++c) acc[a][c] = __builtin_amdgcn_mfma_f32_16x16x32_bf16(kf[c], vf[a], acc[a][c], 0, 0, 0);
        }
        u16* dst = (u16*)p.dS + ((size_t)it * 2 + dir) * 128 * 64;
#pragma unroll
        for (int a = 0; a < 2; ++a)
#pragma unroll
            for (int c = 0; c < 4; ++c) { uint2 o; o.x = pack2(acc[a][c][0], acc[a][c][1]); o.y = pack2(acc[a][c][2], acc[a][c][3]); *(uint2*)(dst + (16 * (2 * w + a) + i16) * 64 + 16 * c + 4 * g) = o; }
    }
    if (BG_GD_ST > 0) bg_finish(p, bgs + BG_GD_ST - 1, t, gc);
}

__device__ void gla_scan_thread2(const Params& p, int gid) {
    const int d2 = (gid & 31) * 2, e = (gid >> 5) & 127, dir = (gid >> 12) & 1, bh = gid >> 13;
    float s0 = 0.f, s1 = 0.f;
#pragma unroll 16
    for (int step = 0; step < 64; ++step) {
        const int n = dir ? (63 - step) : step;
        const size_t i0 = ((size_t)(bh * 64 + n)) * 2 + dir;
        const float2 dc = *(const float2*)(p.dec + i0 * 64 + d2);
        const unsigned ds = *(const unsigned*)((const u16*)p.dS + (i0 * 128 + e) * 64 + d2);
        *(unsigned*)(p.Sp + (i0 * 128 + e) * 64 + d2) = pack2(s0, s1);
        s0 = fmaf(dc.x, s0, lo2f(ds)); s1 = fmaf(dc.y, s1, hi2f(ds));
    }
}

__device__ __forceinline__ uint4 attn_combine_mix(const uint4 a0, const uint4 a1, const uint4 a2, float l0, float l1, float l2) {
    const float mm = fmaxf(l0, fmaxf(l1, l2));
    float w0 = __expf(l0 - mm), w1 = __expf(l1 - mm), w2 = __expf(l2 - mm);
    const float inv = 1.0f / (w0 + w1 + w2);
    w0 *= inv; w1 *= inv; w2 *= inv;
    uint4 o;
    o.x = pack2(w0 * lo2f(a0.x) + w1 * lo2f(a1.x) + w2 * lo2f(a2.x), w0 * hi2f(a0.x) + w1 * hi2f(a1.x) + w2 * hi2f(a2.x));
    o.y = pack2(w0 * lo2f(a0.y) + w1 * lo2f(a1.y) + w2 * lo2f(a2.y), w0 * hi2f(a0.y) + w1 * hi2f(a1.y) + w2 * hi2f(a2.y));
    o.z = pack2(w0 * lo2f(a0.z) + w1 * lo2f(a1.z) + w2 * lo2f(a2.z), w0 * hi2f(a0.z) + w1 * hi2f(a1.z) + w2 * hi2f(a2.z));
    o.w = pack2(w0 * lo2f(a0.w) + w1 * lo2f(a1.w) + w2 * lo2f(a2.w), w0 * hi2f(a0.w) + w1 * hi2f(a1.w) + w2 * hi2f(a2.w));
    return o;
}
__device__ void attn_combine_thread(const Params& p, int gid0, int gstride) {
    float l[4][3]; uint4 a[4][3];
#pragma unroll
    for (int q = 0; q < 4; ++q) {
        const int gid = gid0 + q * gstride, tok = gid >> 6, c = gid & 63, h = c >> 3;
#pragma unroll
        for (int br = 0; br < 3; ++br) { l[q][br] = p.lse[((size_t)br * T + tok) * 8 + h]; a[q][br] = *(const uint4*)(p.abr + ((size_t)br * T + tok) * 512 + c * 8); }
    }
#pragma unroll
    for (int q = 0; q < 4; ++q) {
        const int gid = gid0 + q * gstride, tok = gid >> 6, c = gid & 63;
        *(uint4*)(p.mix + (size_t)tok * D + c * 8) = attn_combine_mix(a[q][0], a[q][1], a[q][2], l[q][0], l[q][1], l[q][2]);
    }
}

constexpr int GO_QF = GL_R2, GO_QB = GO_QF + 8192, GO_KF = GO_QB + 8192, GO_KB = GO_KF + 8192, GO_VT = GL_R2, GO_AM = GL_ZS, GO_SF = GL_BF, GO_SB = GL_BF + 16384;
__device__ void gla_out_item(const Params& p, char* lds, int t, int it, int bgs) {
    const int l = t & 63, w = t >> 6, i16 = l & 15, g = l >> 4;
    const int n = it & 63, h = (it >> 6) & 3, b = it >> 8;
    const int t0 = b * S + n * 64;
    float* zs = (float*)(lds + GL_ZS);
    const int sr = t >> 2, sc = t & 3;
    const float4* zsrc = (const float4*)(p.zbuf + (size_t)t0 * 32);
    const float4 zv0 = zsrc[t], zv1 = zsrc[t + 256];
    const u16* qp = p.proj + (size_t)(t0 + sr) * PJW + C_GQ + h * 64 + sc * 16;
    const u16* kp = p.proj + (size_t)(t0 + sr) * PJW + C_GK + h * 64 + sc * 16;
    const uint4 qr0 = *(const uint4*)(qp), qr1 = *(const uint4*)(qp + 8), kr0 = *(const uint4*)(kp), kr1 = *(const uint4*)(kp + 8);
    u32x4 vr[4], sv[8];
#pragma unroll
    for (int i = 0; i < 4; ++i) { const int j = t + 256 * i; vr[i] = *(const u32x4*)(p.proj + (size_t)(t0 + (j >> 4)) * PJW + C_GV + h * 128 + (j & 15) * 8); }
    const u16* SPG = p.Sp + (size_t)it * 2 * 128 * 64;
    f32x4 gc[8];
    if (BG_GO_ST > 0) bg_issue(p, bgs, t, gc);
    asm volatile("" ::: "memory");
    __syncthreads();
    ((float4*)zs)[t] = zv0; ((float4*)zs)[t + 256] = zv1;
#pragma unroll
    for (int i = 0; i < 8; ++i) { const int j = t + 256 * i; sv[i] = *(const u32x4*)(SPG + (size_t)j * 8); }
    gla_prep(p, lds, t, h);
    const float* BF = (const float*)(lds + GL_BF); const float* BB = (const float*)(lds + GL_BB);
    char* QF = lds + GO_QF; char* QB = lds + GO_QB; char* KF = lds + GO_KF; char* KB = lds + GO_KB; char* VT = lds + GO_VT; char* AM = lds + GO_AM;
    char* SF = lds + GO_SF; char* SB = lds + GO_SB;
    {
        float qq[16], kk[16];
        { float tmp[8];
          unpack8(qr0, tmp);
#pragma unroll
          for (int j = 0; j < 8; ++j) qq[j] = tmp[j] * 0.125f;
          unpack8(qr1, tmp);
#pragma unroll
          for (int j = 0; j < 8; ++j) qq[8 + j] = tmp[j] * 0.125f;
          unpack8(kr0, tmp);
#pragma unroll
          for (int j = 0; j < 8; ++j) kk[j] = tmp[j];
          unpack8(kr1, tmp);
#pragma unroll
          for (int j = 0; j < 8; ++j) kk[8 + j] = tmp[j]; }
        float ef[16], eb[16];
#pragma unroll
        for (int q = 0; q < 4; ++q) {
            const float4 bf4 = *(const float4*)(BF + sr * GL_BS + sc * 16 + 4 * q), bb4 = *(const float4*)(BB + sr * GL_BS + sc * 16 + 4 * q);
            ef[4 * q + 0] = __expf(bf4.x); ef[4 * q + 1] = __expf(bf4.y); ef[4 * q + 2] = __expf(bf4.z); ef[4 * q + 3] = __expf(bf4.w);
            eb[4 * q + 0] = __expf(bb4.x); eb[4 * q + 1] = __expf(bb4.y); eb[4 * q + 2] = __expf(bb4.z); eb[4 * q + 3] = __expf(bb4.w);
        }
        float o8[8];
#pragma unroll
        for (int hh = 0; hh < 2; ++hh) {
            const int off = tile_off(sr, 2 * sc + hh);
#pragma unroll
            for (int j = 0; j < 8; ++j) o8[j] = qq[8 * hh + j] * ef[8 * hh + j];
            *(uint4*)(QF + off) = pack8(o8);
#pragma unroll
            for (int j = 0; j < 8; ++j) o8[j] = kk[8 * hh + j] / ef[8 * hh + j];
            *(uint4*)(KF + off) = pack8(o8);
#pragma unroll
            for (int j = 0; j < 8; ++j) o8[j] = qq[8 * hh + j] * eb[8 * hh + j];
            *(uint4*)(QB + off) = pack8(o8);
#pragma unroll
            for (int j = 0; j < 8; ++j) o8[j] = kk[8 * hh + j] / eb[8 * hh + j];
            *(uint4*)(KB + off) = pack8(o8);
        }
    }
    __syncthreads();
    if (BG_GO_ST > 1) { bg_finish(p, bgs, t, gc); asm volatile("" ::: "memory"); bg_issue(p, bgs + 1, t, gc); asm volatile("" ::: "memory"); }
#pragma unroll
    for (int i = 0; i < 8; ++i) { const int j = t + 256 * i; *(u32x4*)((j >> 10 ? SB : SF) + tile_off((j >> 3) & 127, j & 7)) = sv[i]; }
    const int cq = 16 * w + i16;
    const bf16x8 qf0 = lds_frag(QF, cq, g), qf1 = lds_frag(QF, cq, 4 + g);
    const bf16x8 qb0 = lds_frag(QB, cq, g), qb1 = lds_frag(QB, cq, 4 + g);
    uint2 amo[4];
#pragma unroll
    for (int st = 0; st < 4; ++st) {
        f32x4 af = {0.f, 0.f, 0.f, 0.f}, ab = {0.f, 0.f, 0.f, 0.f};
        af = __builtin_amdgcn_mfma_f32_16x16x32_bf16(lds_frag(KF, 16 * st + i16, g), qf0, af, 0, 0, 0);
        af = __builtin_amdgcn_mfma_f32_16x16x32_bf16(lds_frag(KF, 16 * st + i16, 4 + g), qf1, af, 0, 0, 0);
        ab = __builtin_amdgcn_mfma_f32_16x16x32_bf16(lds_frag(KB, 16 * st + i16, g), qb0, ab, 0, 0, 0);
        ab = __builtin_amdgcn_mfma_f32_16x16x32_bf16(lds_frag(KB, 16 * st + i16, 4 + g), qb1, ab, 0, 0, 0);
        float am[4];
#pragma unroll
        for (int r = 0; r < 4; ++r) {
            const int s = 16 * st + 4 * g + r;
            am[r] = (s <= cq ? af[r] : 0.f) + (s >= cq ? ab[r] : 0.f);
        }
        amo[st].x = pack2(am[0], am[1]); amo[st].y = pack2(am[2], am[3]);
    }
#pragma unroll
    for (int st = 0; st < 4; ++st) { const int s0 = 16 * st + 4 * g; *(uint2*)(AM + tile_off(cq, s0 >> 3) + (s0 & 7) * 2) = amo[st]; }
    __syncthreads();
#pragma unroll
    for (int i = 0; i < 4; ++i) { const int j = t + 256 * i; *(u32x4*)(VT + (j >> 4) * 288 + (j & 15) * 16) = vr[i]; }
    __syncthreads();
    const size_t tok = (size_t)t0 + cq;
    uint2 ggr[8];
#pragma unroll
    for (int et = 0; et < 8; ++et) ggr[et] = *(const uint2*)(p.proj + tok * PJW + C_GO + h * 128 + 16 * et + 4 * g);
    f32x4 oc[8];
#pragma unroll
    for (int et = 0; et < 8; ++et) oc[et] = (f32x4){0.f, 0.f, 0.f, 0.f};
#pragma unroll
    for (int ks = 0; ks < 2; ++ks) {
        const bf16x8 amf = lds_frag(AM, cq, ks * 4 + g);
        const bf16x8 qff = ks ? qf1 : qf0, qbf = ks ? qb1 : qb0;
        const int r0 = ks * 32 + 8 * g + (i16 >> 2);
#pragma unroll
        for (int et = 0; et < 8; ++et) {
            const int e0 = 16 * et + 4 * (i16 & 3);
            const bf16x8 vf = cat4(tr_read(VT + r0 * 288 + e0 * 2), tr_read(VT + (r0 + 4) * 288 + e0 * 2));
            oc[et] = __builtin_amdgcn_mfma_f32_16x16x32_bf16(vf, amf, oc[et], 0, 0, 0);
            oc[et] = __builtin_amdgcn_mfma_f32_16x16x32_bf16(lds_frag(SF, 16 * et + i16, ks * 4 + g), qff, oc[et], 0, 0, 0);
            oc[et] = __builtin_amdgcn_mfma_f32_16x16x32_bf16(lds_frag(SB, 16 * et + i16, ks * 4 + g), qbf, oc[et], 0, 0, 0);
        }
    }
    if (BG_GO_ST > 2) { bg_finish(p, bgs + 1, t, gc); asm volatile("" ::: "memory"); bg_issue(p, bgs + 2, t, gc); asm volatile("" ::: "memory"); }
    float ss = 0.f;
#pragma unroll
    for (int et = 0; et < 8; ++et)
#pragma unroll
        for (int r = 0; r < 4; ++r) ss += oc[et][r] * oc[et][r];
    ss += swz_xor<16>(ss); ss = half_sum(ss);
    const float rstd = rsqrtf(ss * (1.0f / 128.0f) + EPS);
#pragma unroll
    for (int et = 0; et < 8; ++et) {
        const int e = 16 * et + 4 * g;
        const uint2 gg = ggr[et];
        const float4 ng = *(const float4*)(p.gla_ng + h * 128 + e);
        const float g0 = lo2f(gg.x), g1 = hi2f(gg.x), g2 = lo2f(gg.y), g3 = hi2f(gg.y);
        uint2 o;
        o.x = pack2(oc[et][0] * rstd * ng.x * (g0 / (1.0f + __expf(-g0))), oc[et][1] * rstd * ng.y * (g1 / (1.0f + __expf(-g1))));
        o.y = pack2(oc[et][2] * rstd * ng.z * (g2 / (1.0f + __expf(-g2))), oc[et][3] * rstd * ng.w * (g3 / (1.0f + __expf(-g3))));
        *(uint2*)(p.mix + tok * D + 512 + h * 128 + e) = o;
    }
    if (BG_GO_ST > 0) bg_finish(p, bgs + BG_GO_ST - 1, t, gc);
}

constexpr int RT_WS = 1028;
constexpr int RT_H0 = 32 * RT_WS * 4, RT_HSZ = 12 * 1024;
constexpr int RT_PART = 0, RT_SSP = 8192, RT_SEL = 8448, RT_PE = 8704, RT_RANK = 9728, RT_HIST = 10752, RT_BASE = 10880;
static_assert(RT_H0 + 2 * RT_HSZ <= LDS_BYTES - 1024, "route LDS");
__device__ void ph_route(const Params& p, char* ldsall, int wv__) {
    const int tid = tid_opaque(), t = tid & 255, half = tid >> 8, lane = t & 63, w = t >> 6;
    float* rwT = (float*)ldsall;
    char* lds = ldsall + RT_H0 + half * RT_HSZ;
    const int vb = blockIdx.x * 2 + half, nvb = gridDim.x * 2;
    float* part = (float*)(lds + RT_PART); float* ssp = (float*)(lds + RT_SSP); float* selb = (float*)(lds + RT_SEL);
    int* pe = (int*)(lds + RT_PE); int* rank = (int*)(lds + RT_RANK); int* hist = (int*)(lds + RT_HIST); int* base = (int*)(lds + RT_BASE);
    const int ngr = (T / 16 + nvb - 1) / nvb;
    const int i16 = lane & 15, kq = lane >> 4, k0 = 256 * w + 64 * kq;
    u32x4 xq[8];
    {
        f32x4 st[16];
#pragma unroll
        for (int j = 0; j < 16; ++j) { const int i = tid + 512 * j; st[j] = *(const f32x4*)(p.rw + (size_t)(i >> 3) * 32 + (i & 7) * 4); }
        {
            const int tokf = (vb < T / 16 ? vb : 0) * 16;
            const u32x4* xr = (const u32x4*)(p.x1b + (size_t)(tokf + i16) * D + k0);
#pragma unroll
            for (int j = 0; j < 8; ++j) xq[j] = xr[j];
        }
#pragma unroll
        for (int j = 0; j < 16; ++j) {
            const int i = tid + 512 * j, k = i >> 3, e4 = (i & 7) * 4;
            rwT[(e4 + 0) * RT_WS + k] = st[j][0]; rwT[(e4 + 1) * RT_WS + k] = st[j][1]; rwT[(e4 + 2) * RT_WS + k] = st[j][2]; rwT[(e4 + 3) * RT_WS + k] = st[j][3];
        }
    }
    for (int gl = 0; gl < ngr; ++gl) {
        const int gi = vb + gl * nvb;
        const bool live = gi < T / 16;
        const int tok0 = (live ? gi : 0) * 16;
        f32x4 av[16];
        float ss = 0.f;
#pragma unroll
        for (int j = 0; j < 8; ++j) {
            const f32x4 ga = *(const f32x4*)(p.g2 + k0 + 8 * j), gb = *(const f32x4*)(p.g2 + k0 + 8 * j + 4);
            const f32x4 xa = {__uint_as_float(xq[j][0] << 16), __uint_as_float(xq[j][0] & 0xffff0000u), __uint_as_float(xq[j][1] << 16), __uint_as_float(xq[j][1] & 0xffff0000u)};
            const f32x4 xb = {__uint_as_float(xq[j][2] << 16), __uint_as_float(xq[j][2] & 0xffff0000u), __uint_as_float(xq[j][3] << 16), __uint_as_float(xq[j][3] & 0xffff0000u)};
            ss += xa[0] * xa[0] + xa[1] * xa[1] + xa[2] * xa[2] + xa[3] * xa[3] + xb[0] * xb[0] + xb[1] * xb[1] + xb[2] * xb[2] + xb[3] * xb[3];
            av[2 * j] = xa * ga; av[2 * j + 1] = xb * gb;
        }
        if (gl + 1 < ngr) {
            const int gn = gi + nvb, tokn = (gn < T / 16 ? gn : 0) * 16;
            const u32x4* xr = (const u32x4*)(p.x1b + (size_t)(tokn + i16) * D + k0);
#pragma unroll
            for (int j = 0; j < 8; ++j) xq[j] = xr[j];
        }
        ss += swz_xor<16>(ss); ss = half_sum(ss);
        __syncthreads();
        if (kq == 0) ssp[w * 16 + i16] = ss;
        {
            f32x4 a0 = {0.f, 0.f, 0.f, 0.f}, a1 = {0.f, 0.f, 0.f, 0.f};
            const float* w0 = rwT + i16 * RT_WS + k0;
            const float* w1 = rwT + (16 + i16) * RT_WS + k0;
#pragma unroll
            for (int j = 0; j < 16; ++j) {
                const f32x4 b0 = *(const f32x4*)(w0 + 4 * j), b1 = *(const f32x4*)(w1 + 4 * j);
                a0 = __builtin_amdgcn_mfma_f32_16x16x4f32(av[j][0], b0[0], a0, 0, 0, 0); a1 = __builtin_amdgcn_mfma_f32_16x16x4f32(av[j][0], b1[0], a1, 0, 0, 0);
                a0 = __builtin_amdgcn_mfma_f32_16x16x4f32(av[j][1], b0[1], a0, 0, 0, 0); a1 = __builtin_amdgcn_mfma_f32_16x16x4f32(av[j][1], b1[1], a1, 0, 0, 0);
                a0 = __builtin_amdgcn_mfma_f32_16x16x4f32(av[j][2], b0[2], a0, 0, 0, 0); a1 = __builtin_amdgcn_mfma_f32_16x16x4f32(av[j][2], b1[2], a1, 0, 0, 0);
                a0 = __builtin_amdgcn_mfma_f32_16x16x4f32(av[j][3], b0[3], a0, 0, 0, 0); a1 = __builtin_amdgcn_mfma_f32_16x16x4f32(av[j][3], b1[3], a1, 0, 0, 0);
            }
#pragma unroll
            for (int r = 0; r < 4; ++r) { part[(w * 16 + 4 * kq + r) * 32 + i16] = a0[r]; part[(w * 16 + 4 * kq + r) * 32 + 16 + i16] = a1[r]; }
        }
        __syncthreads();
        {
            const float rn = rsqrtf(((ssp[i16] + ssp[16 + i16]) + (ssp[32 + i16] + ssp[48 + i16])) * (1.0f / D) + EPS);
            if (live) {
                unsigned char* dq = p.xn28 + (size_t)(tok0 + i16) * D + k0;
#pragma unroll
                for (int j = 0; j < 4; ++j) {
                    u32x4 o;
#pragma unroll
                    for (int c = 0; c < 4; ++c) {
                        const f32x4 yv = av[4 * j + c] * rn;
                        int pk = __builtin_amdgcn_cvt_pk_fp8_f32(yv[0], yv[1], 0, false); pk = __builtin_amdgcn_cvt_pk_fp8_f32(yv[2], yv[3], pk, true);
                        o[c] = (unsigned)pk;
                    }
                    *(u32x4*)(dq + 16 * j) = o;
                }
            }
        }
#pragma unroll
        for (int ro = 0; ro < 2; ++ro) {
            const int tk = 4 * w + 2 * ro + (lane >> 5), e = lane & 31;
            const float rt = rsqrtf(((ssp[tk] + ssp[16 + tk]) + (ssp[32 + tk] + ssp[48 + tk])) * (1.0f / D) + EPS);
            float v = p.rb[e] + rt * ((part[(0 * 16 + tk) * 32 + e] + part[(1 * 16 + tk) * 32 + e]) + (part[(2 * 16 + tk) * 32 + e] + part[(3 * 16 + tk) * 32 + e]));
            int rk = 0;
#pragma unroll
            for (int j = 0; j < 64; ++j) {
                const float bj = __builtin_bit_cast(float, __builtin_amdgcn_readlane(__builtin_bit_cast(int, v), j));
                if ((j >> 5) == (lane >> 5)) rk += (bj > v || (bj == v && (j & 31) < e)) ? 1 : 0;
            }
            float* selv = selb + (w * 2 + (lane >> 5)) * 8;
            if (rk < 4) { selv[rk] = v; selv[4 + rk] = __builtin_bit_cast(float, e); }
            __builtin_amdgcn_s_waitcnt(0xc07f);
            __builtin_amdgcn_wave_barrier();
            const float b0 = selv[0], b1 = selv[1], b2 = selv[2], b3 = selv[3];
            const float e1 = expf(b1 - b0), e2 = expf(b2 - b0), e3 = expf(b3 - b0);
            const float inv = 1.0f / (1.0f + e1 + e2 + e3);
            if (e < 4) {
                const int sel = __builtin_bit_cast(int, selv[4 + e]);
                const float gs = (e == 0) ? inv : (e == 1) ? e1 * inv : (e == 2) ? e2 * inv : e3 * inv;
                pe[gl * 64 + tk * 4 + e] = live ? (sel & 31) : -1;
                if (live) p.gate[(size_t)(tok0 + tk) * 4 + e] = gs;
            }
            __builtin_amdgcn_wave_barrier();
        }
    }
    __syncthreads();
    if (t < 32) hist[t] = 0;
    __syncthreads();
    for (int i = t; i < ngr * 64; i += 256) { const int e = pe[i]; if (e >= 0) rank[i] = atomicAdd(&hist[e], 1); }
    __syncthreads();
    if (tid < 32) {
        char* h0 = ldsall + RT_H0; char* h1 = h0 + RT_HSZ;
        const int c0 = ((int*)(h0 + RT_HIST))[tid], c1 = ((int*)(h1 + RT_HIST))[tid];
        const int b = (c0 + c1) ? atomicAdd(&p.counts[tid], c0 + c1) : 0;
        ((int*)(h0 + RT_BASE))[tid] = b; ((int*)(h1 + RT_BASE))[tid] = b + c0;
    }
    __syncthreads();
    for (int i = t; i < ngr * 64; i += 256) {
        const int e = pe[i];
        if (e >= 0) { const int gl = i >> 6, gi = vb + gl * nvb; const int slot = (gi * 16 + ((i >> 2) & 15)) * 4 + (i & 3); p.lists[e * T + base[e] + rank[i]] = slot; }
    }
}

__device__ void ph_final(const Params& p, int wv__) {
    const int tid = tid_opaque(), lane = tid & 63, gw = blockIdx.x * 8 + (tid >> 6), nw = gridDim.x * 8;
    float4 gfa[2], gfb[2];
#pragma unroll
    for (int i = 0; i < 2; ++i) { const int c = lane * 8 + 512 * i; gfa[i] = *(const float4*)(p.gf + c); gfb[i] = *(const float4*)(p.gf + c + 4); }
    for (int tok0 = gw; tok0 < T; tok0 += 2 * nw) {
        float v[2][2][8]; float ss[2] = {0.f, 0.f};
        int tk[2]; tk[0] = tok0; tk[1] = (tok0 + nw < T) ? tok0 + nw : tok0;
        u32x4 xq[2][2]; uint2 yy[2][2][4];
#pragma unroll
        for (int q = 0; q < 2; ++q)
#pragma unroll
            for (int i = 0; i < 2; ++i) {
                const int c = lane * 8 + 512 * i;
                xq[q][i] = *(const u32x4*)(p.x1b + (size_t)tk[q] * D + c);
#pragma unroll
                for (int k = 0; k < 4; ++k) yy[q][i][k] = *(const uint2*)((const unsigned char*)p.y + ((size_t)tk[q] * 4 + k) * D + c);
            }
#pragma unroll
        for (int q = 0; q < 2; ++q) {
#pragma unroll
            for (int i = 0; i < 2; ++i) {
#pragma unroll
                for (int j = 0; j < 4; ++j) { v[q][i][2 * j] = __uint_as_float(xq[q][i][j] << 16); v[q][i][2 * j + 1] = __uint_as_float(xq[q][i][j] & 0xffff0000u); }
#pragma unroll
                for (int k = 0; k < 4; ++k) {
                    const fv2 y01 = __builtin_amdgcn_cvt_pk_f32_fp8((int)yy[q][i][k].x, false), y23 = __builtin_amdgcn_cvt_pk_f32_fp8((int)yy[q][i][k].x, true);
                    const fv2 y45 = __builtin_amdgcn_cvt_pk_f32_fp8((int)yy[q][i][k].y, false), y67 = __builtin_amdgcn_cvt_pk_f32_fp8((int)yy[q][i][k].y, true);
                    v[q][i][0] += y01[0] * 0.0625f; v[q][i][1] += y01[1] * 0.0625f; v[q][i][2] += y23[0] * 0.0625f; v[q][i][3] += y23[1] * 0.0625f;
                    v[q][i][4] += y45[0] * 0.0625f; v[q][i][5] += y45[1] * 0.0625f; v[q][i][6] += y67[0] * 0.0625f; v[q][i][7] += y67[1] * 0.0625f;
                }
#pragma unroll
                for (int j = 0; j < 8; ++j) ss[q] += v[q][i][j] * v[q][i][j];
            }
        }
#pragma unroll
        for (int q = 0; q < 2; ++q) {
            const float r = rsqrtf(wave_sum(ss[q]) * (1.0f / D) + EPS);
#pragma unroll
            for (int i = 0; i < 2; ++i) {
                const int c = lane * 8 + 512 * i;
                const float4 ga = gfa[i], gb = gfb[i];
                float4 oa, ob;
                oa.x = v[q][i][0] * r * ga.x; oa.y = v[q][i][1] * r * ga.y; oa.z = v[q][i][2] * r * ga.z; oa.w = v[q][i][3] * r * ga.w;
                ob.x = v[q][i][4] * r * gb.x; ob.y = v[q][i][5] * r * gb.y; ob.z = v[q][i][6] * r * gb.z; ob.w = v[q][i][7] * r * gb.w;
                *(float4*)(p.out + (size_t)tk[q] * D + c) = oa; *(float4*)(p.out + (size_t)tk[q] * D + c + 4) = ob;
            }
        }
    }
}

#define XB_TMO      128
#define XB_XCNT(j)  (256  + 64 * (j))
#define XB_XSUB(j)  (1280 + 64 * (j))
#define XB_XGEN(j)  (2304 + 64 * (j))
#define XB_TOP      3328
#define XB_TOPGEN   3392
#define XCD_BAR_WORDS 3456
#define XB_SPIN_CAP (1u << 22)
__device__ __forceinline__ unsigned xb_ld(unsigned* p)              { return __hip_atomic_load(p, __ATOMIC_RELAXED, __HIP_MEMORY_SCOPE_AGENT); }
__device__ __forceinline__ unsigned xb_add(unsigned* p, unsigned v) { return __hip_atomic_fetch_add(p, v, __ATOMIC_RELAXED, __HIP_MEMORY_SCOPE_AGENT); }
__device__ __forceinline__ unsigned xb_xcc_id() { return (unsigned)__builtin_amdgcn_s_getreg((3 << 11) | 20) & 0xFu; }
#define XB_SPIN(cond, bar) do { unsigned _sp = 0; while (cond) { __builtin_amdgcn_s_sleep(1); \
    if ((++_sp & 255u) == 0u) { if (xb_ld(&(bar)[XB_TMO])) break; if (_sp > XB_SPIN_CAP) { atomicAdd(&(bar)[XB_TMO], 1u); break; } } } } while (0)
struct XcdBarrier { unsigned* bar; unsigned x; volatile LDS_AS unsigned* st; };
__device__ __forceinline__ XcdBarrier xcd_barrier_post(unsigned* bar, volatile LDS_AS unsigned* st) {
    XcdBarrier b; b.bar = bar; b.x = xb_xcc_id(); b.st = st;
    if (threadIdx.x == 0) (void)xb_add(&bar[XB_XCNT(b.x)], 1u);
    return b;
}
__device__ __forceinline__ void xcd_barrier_complete(unsigned* bar, unsigned x, unsigned& nloc, unsigned& nx) {
    const unsigned G = gridDim.x * gridDim.y * gridDim.z;
    unsigned sum, cnt, mine, sp = 0u;
    for (;;) {
        sum = 0u; cnt = 0u; mine = 0u;
#pragma unroll
        for (unsigned j = 0; j < 16; ++j) { const unsigned c = xb_ld(&bar[XB_XCNT(j)]); sum += c; cnt += (c > 0u) ? 1u : 0u; mine = (j == x) ? c : mine; }
        if (sum == G) break;
        __builtin_amdgcn_s_sleep(1);
        if ((++sp & 255u) == 0u) { if (xb_ld(&bar[XB_TMO])) break; if (sp > XB_SPIN_CAP) { atomicAdd(&bar[XB_TMO], 1u); break; } }
    }
    nloc = mine > 0u ? mine : 1u; nx = cnt > 0u ? cnt : 1u;
}
__device__ __forceinline__ void xcd_barrier(const XcdBarrier& b, int wv__) {
    asm volatile("s_waitcnt vmcnt(0)" ::: "memory");
    __syncthreads();
    if (tid_opaque() == 0) {
        unsigned* bar = b.bar;
        __builtin_amdgcn_s_waitcnt(0);
        unsigned nloc = b.st[0], nx = b.st[1];
        if (nloc == 0u) { xcd_barrier_complete(bar, b.x, nloc, nx); b.st[0] = nloc; b.st[1] = nx; }
        const unsigned old = xb_add(&bar[XB_XSUB(b.x)], 1u);
        const unsigned gen = old / nloc;
        if (old + 1u == (gen + 1u) * nloc) {
            __builtin_amdgcn_fence(__ATOMIC_RELEASE, "agent");
            asm volatile("s_waitcnt vmcnt(0)" ::: "memory");
            const unsigned og = xb_add(&bar[XB_TOP], 1u);
            const unsigned tg = og / nx;
            if (og + 1u == (tg + 1u) * nx) xb_add(&bar[XB_TOPGEN], 1u);
            else XB_SPIN(xb_ld(&bar[XB_TOPGEN]) == tg, bar);
            __builtin_amdgcn_fence(__ATOMIC_ACQUIRE, "agent");
            xb_add(&bar[XB_XGEN(b.x)], 1u);
            asm volatile("s_waitcnt vmcnt(0)" ::: "memory");
        } else {
            XB_SPIN(xb_ld(&bar[XB_XGEN(b.x)]) == gen, bar);
            __builtin_amdgcn_fence(__ATOMIC_ACQUIRE, "agent");
            asm volatile("s_waitcnt vmcnt(0)" ::: "memory");
        }
    }
    __syncthreads();
}


#if defined(FLUSHMASK)
__device__ void ph_flush(const Params& p, int wv__) {
    const int tid = tid_opaque();
    const float4* src = (const float4*)p.w1;
    float acc = 0.f;
    for (size_t i = (size_t)blockIdx.x * 512 + tid; i < (size_t)NE * D * 2 * DFF / 4; i += (size_t)gridDim.x * 512) { const float4 v = src[i]; acc += v.x + v.y + v.z + v.w; }
    if (acc == 123.456f) p.out[0] = acc;
}
#endif
enum { PH_PRO = 0, PH_PROJ, PH_MIX1, PH_MIX2, PH_MIX3, PH_OUTPROJ, PH_ROUTE, PH_MOE1, PH_MOE2, PH_FINAL, PH_END };
constexpr int N_GLA_ITEMS = B * GH * 64, N_ATT_ITEMS = B * AH * 3 * 64;
constexpr int MO_META = LDS_BYTES - 1024;

__device__ __forceinline__ void moe_meta(const Params& p, int* meta, int wv__) {
    const int t = tid_opaque();
    __syncthreads();
    if (t < NE) meta[t] = p.counts[t];
    __syncthreads();
    if (t <= NE) {
        int mp = 0, rbse = 0;
#pragma unroll
        for (int j = 0; j < NE; ++j) { const int c = (j < t) ? meta[j] : 0; mp += (c + 255) >> 8; rbse += c; }
        meta[32 + t] = mp; meta[72 + t] = rbse;
    }
    __syncthreads();
}

constexpr int MO_TABA = 128 * 1024, MO_MAXU = 10;
constexpr int MO_TABG = MO_TABA + MO_MAXU * 1024, MO_TABB = MO_TABG + MO_MAXU * 1024;
static_assert(MO_TABB + MO_MAXU * 1024 <= MO_META, "MoE LDS tables");
constexpr int MO_UPH = MO_MAXU / 2;
template <class SchedT>
__device__ __forceinline__ void moe_tables(const Params& p, char* lds, const SchedT& S, int wv__) {
    unsigned* tabA = (unsigned*)(lds + MO_TABA); float* tabB = (float*)(lds + MO_TABB);
    const int tid = tid_opaque(), r = tid & 255, hv = tid >> 8;
    int slot[MO_UPH]; float bb[MO_UPH]; bool ok[MO_UPH];
    int eh = 0;
#pragma unroll
    for (int j = 0; j < MO_UPH; ++j) {
        pg::Unit u;
        ok[j] = S.next(hv + 2 * j, u, eh);
        if (!ok[j]) { u.e = eh; u.row0 = S.meta[72 + eh]; u.nvalid = 1; u.pn = 0; }
        eh = u.e;
        slot[j] = p.lists[u.e * T + (u.row0 - S.meta[72 + u.e]) + min(r, u.nvalid - 1)];
        bb[j] = p.b1[(size_t)u.e * 2 * DFF + u.pn * 256 + r];
    }
#pragma unroll
    for (int j = 0; j < MO_UPH; ++j) if (ok[j]) {
        tabA[(hv + 2 * j) * 256 + r] = (unsigned)(slot[j] >> 2) * (unsigned)S.rowb;
        tabB[(hv + 2 * j) * 256 + r] = bb[j] + ((r & 1) ? 1.0f : 0.f);
    }
    __syncthreads();
}
template <class SchedT>
__device__ __forceinline__ void moe_tables2(const Params& p, char* lds, const SchedT& S, int wv__) {
    int* tabS = (int*)(lds + MO_TABA); float* tabG = (float*)(lds + MO_TABG); float* tabB = (float*)(lds + MO_TABB);
    const int tid = tid_opaque(), r = tid & 255, hv = tid >> 8;
    int slot[MO_UPH]; float bb[MO_UPH], gg[MO_UPH]; bool ok[MO_UPH];
    int eh = 0;
#pragma unroll
    for (int j = 0; j < MO_UPH; ++j) {
        pg::Unit u;
        ok[j] = S.next(hv + 2 * j, u, eh);
        if (!ok[j]) { u.e = eh; u.row0 = S.meta[72 + eh]; u.nvalid = 1; u.pn = 0; }
        eh = u.e;
        slot[j] = p.lists[u.e * T + (u.row0 - S.meta[72 + u.e]) + min(r, u.nvalid - 1)];
        bb[j] = p.b2[(size_t)u.e * D + u.pn * 256 + r];
    }
#pragma unroll
    for (int j = 0; j < MO_UPH; ++j) gg[j] = p.gate[slot[j] & (T * 4 - 1)];
#pragma unroll
    for (int j = 0; j < MO_UPH; ++j) if (ok[j]) {
        tabS[(hv + 2 * j) * 256 + r] = slot[j];
        tabB[(hv + 2 * j) * 256 + r] = bb[j];
        tabG[(hv + 2 * j) * 256 + r] = gg[j] * 16.0f;
    }
    __syncthreads();
}

typedef const __attribute__((address_space(4))) Params* KParams;
#if defined(__HIP_DEVICE_COMPILE__)
#define PHASE_PARAMS() KParams _kq = kp; asm volatile("" : "+s"(_kq)); const Params p = *_kq
#define KP_INIT() KParams kp = (KParams)__builtin_amdgcn_kernarg_segment_ptr(); const int ph_lo = kp->ph_lo, ph_hi = kp->ph_hi; unsigned* const barw = kp->bar
#else
#define PHASE_PARAMS() const Params p = p_unused
#define KP_INIT() const int ph_lo = p_unused.ph_lo, ph_hi = p_unused.ph_hi; unsigned* const barw = p_unused.bar
#endif
__global__ void __launch_bounds__(512, 2) mega(Params p_unused) {
    extern __shared__ __attribute__((aligned(16))) char lds[];
    KP_INIT();
    cg::grid_group grid = cg::this_grid();
    const int wv__ = __builtin_amdgcn_readfirstlane((int)threadIdx.x >> 6);
    volatile LDS_AS unsigned* xst = (volatile LDS_AS unsigned*)(lds + LDS_BYTES - 16);
    if (threadIdx.x == 0) { xst[0] = 0u; xst[1] = 0u; }
    __syncthreads();
    const XcdBarrier xb = xcd_barrier_post(barw, xst);
    if (ph_hi > PH_END) grid.sync();
    for (int ph = ph_lo; ph < ph_hi; ++ph) {
      const int nrep = ((REPMASK >> ph) & 1) ? 2 : 1;
      for (int rep = 0; rep < nrep; ++rep) {
        if (rep) xcd_barrier(xb, wv__);
#if defined(ROUTE2)
        if (rep && ph == PH_ROUTE) { PHASE_PARAMS(); const int tq_ = tid_opaque(); if (blockIdx.x == 0 && tq_ < 32) p.counts[tq_] = 0; xcd_barrier(xb, wv__); }
#endif
#if defined(FLUSHMASK)
        if (rep && ((FLUSHMASK >> ph) & 1)) { PHASE_PARAMS(); ph_flush(p, wv__); xcd_barrier(xb, wv__); }
#if defined(FLUSHONLY)
        if (rep && ((FLUSHMASK >> ph) & 1)) continue;
#endif
#endif
        switch (ph) {
        case PH_PRO: { PHASE_PARAMS(); ph_prologue(p, wv__); } break;
        case PH_PROJ: {
            PHASE_PARAMS();
            const int G = gridDim.x, ng = G - NCONV;
            if ((int)blockIdx.x < ng) {
                pg::DenseSched S; S.init(p.xn, p.winT, T, PJW, ng, blockIdx.x);
                pg::EpiProj E{p.proj};
                pg::gemm_phase((LDS_AS unsigned char*)lds, S, E, wv__);
            }
#if NCONV > 0
            else {
                const int tid = tid_opaque(), t = tid & 255, st = NCONV * 2;
                const int l = t & 63, w = t >> 6, kg = l & 7, ngq = w * 8 + (l >> 3);
#define CV_DECL(X) f32x4 X##0 = {0.f, 0.f, 0.f, 0.f}, X##1 = X##0, X##2 = X##0, X##3 = X##0, X##4 = X##0, X##5 = X##0, X##6 = X##0, X##7 = X##0
#define CV_LOAD(X, i_) do { const int e_ = (i_) >> 8, j_ = (i_) & 255; const float* s_ = p.w1 + (size_t)e_ * D * 2 * DFF + (size_t)((j_ >> 4) * 64 + 8 * kg) * (2 * DFF) + (j_ & 15) * 128 + 4 * ngq; \
        X##0 = *(const f32x4*)(s_); X##1 = *(const f32x4*)(s_ + 2 * DFF); X##2 = *(const f32x4*)(s_ + 2 * 2 * DFF); X##3 = *(const f32x4*)(s_ + 3 * 2 * DFF); \
        X##4 = *(const f32x4*)(s_ + 4 * 2 * DFF); X##5 = *(const f32x4*)(s_ + 5 * 2 * DFF); X##6 = *(const f32x4*)(s_ + 6 * 2 * DFF); X##7 = *(const f32x4*)(s_ + 7 * 2 * DFF); } while (0)
#define CV_STORE(X, i_) do { const int e_ = (i_) >> 8, j_ = (i_) & 255; unsigned char* d_ = p.w1T8 + (size_t)e_ * 2 * DFF * D + (size_t)((j_ & 15) * 128 + 4 * ngq) * 1024 + (j_ >> 4) * 64 + 8 * kg; \
        _Pragma("unroll") for (int c_ = 0; c_ < 4; ++c_) { \
            int lo_ = __builtin_amdgcn_cvt_pk_fp8_f32(X##0[c_] * 32.0f, X##1[c_] * 32.0f, 0, false); lo_ = __builtin_amdgcn_cvt_pk_fp8_f32(X##2[c_] * 32.0f, X##3[c_] * 32.0f, lo_, true); \
            int hi_ = __builtin_amdgcn_cvt_pk_fp8_f32(X##4[c_] * 32.0f, X##5[c_] * 32.0f, 0, false); hi_ = __builtin_amdgcn_cvt_pk_fp8_f32(X##6[c_] * 32.0f, X##7[c_] * 32.0f, hi_, true); \
            uint2 q_; q_.x = (unsigned)lo_; q_.y = (unsigned)hi_; *(uint2*)(d_ + c_ * 1024) = q_; } } while (0)
                CV_DECL(ra); CV_DECL(rb);
                const int hid = ((int)blockIdx.x - ng) * 2 + (tid >> 8), per = (W1_CONV + st - 1) / st;
                const int i0 = min(hid * per, W1_CONV - 1), ilast = min(i0 + per, W1_CONV) - 1;
                const int npair = (per + 1) / 2;
                CV_LOAD(ra, i0);
                for (int k = 0; k < npair; ++k) {
                    const int ia = min(i0 + 2 * k, ilast), ib = min(ia + 1, ilast), ic = min(ib + 1, ilast);
                    CV_LOAD(rb, ib);
                    CV_STORE(ra, ia);
                    CV_LOAD(ra, ic);
                    CV_STORE(rb, ib);
                }
#undef CV_DECL
#undef CV_LOAD
#undef CV_STORE
            }
#endif
            {
                const int tid2 = tid_opaque(), lane = tid2 & 63, i16 = lane & 15, g = lane >> 4;
                for (int ht = (int)blockIdx.x * 8 + (tid2 >> 6); ht < 2 * (T / 16); ht += G * 8) {
                    const int task = ht >> 1, kh = ht & 1;
                    f32x4 z0 = {0.f, 0.f, 0.f, 0.f}, z1 = {0.f, 0.f, 0.f, 0.f};
                    const u16* ar = p.xn + (size_t)(task * 16 + i16) * D + 8 * g + kh * 512;
                    const u16* w0 = p.wzT + (size_t)i16 * D + 8 * g + kh * 512;
                    const u16* w1 = w0 + 16 * D;
#pragma unroll 8
                    for (int ks = 0; ks < 16; ++ks) {
                        const bf16x8 a = *(const bf16x8*)(ar + ks * 32);
                        z0 = __builtin_amdgcn_mfma_f32_16x16x32_bf16(a, *(const bf16x8*)(w0 + ks * 32), z0, 0, 0, 0);
                        z1 = __builtin_amdgcn_mfma_f32_16x16x32_bf16(a, *(const bf16x8*)(w1 + ks * 32), z1, 0, 0, 0);
                    }
#pragma unroll
                    for (int r = 0; r < 4; ++r) {
                        const size_t row = (size_t)task * 16 + 4 * g + r;
                        atomicAdd(p.zbuf + row * 32 + i16, z0[r]); atomicAdd(p.zbuf + row * 32 + 16 + i16, z1[r]);
                    }
                }
            }
        } break;
        case PH_MIX1: {
            PHASE_PARAMS();
            const int tid = tid_opaque(), t = tid & 255, half = tid >> 8;
            char* hl = lds + half * HALF_LDS;
#ifndef MIX1_SKIP_GLA_ON_REP
            for (int it0 = blockIdx.x * 2; it0 < N_GLA_ITEMS; it0 += gridDim.x * 2) gla_ds_item(p, hl, t, min(it0 + half, N_GLA_ITEMS - 1), BG_NA + min(it0 + half, N_GLA_ITEMS - 1) * BG_GD_ST);
#else
            if (!rep) for (int it0 = blockIdx.x * 2; it0 < N_GLA_ITEMS; it0 += gridDim.x * 2) gla_ds_item(p, hl, t, min(it0 + half, N_GLA_ITEMS - 1), BG_NA + min(it0 + half, N_GLA_ITEMS - 1) * BG_GD_ST);
#endif
            {
                AttnRegs AR;
                const bool xg = gridDim.x == 256;
                const int pstep = xg ? 256 : (int)gridDim.x, pfirst = xg ? ((int)(blockIdx.x & 7) * 32 + (int)(blockIdx.x >> 3)) : (int)blockIdx.x;
                attn_load(p, tid, min(pfirst, N_ATT_PAIRS - 1), AR);
                for (int pi = pfirst; pi < N_ATT_PAIRS; pi += pstep) {
                    const int nx = pi + pstep, itq = pi * 2 + half, npi = nx < N_ATT_PAIRS ? nx : -1;
#if defined(PROBE_NOBG_ON_REP)
                    if (rep) attn_item<false, 1>(p, lds, tid, pi, npi, AR, 0, 0); else
#endif
                    if (2 * pi + N_ATT_ITEMS < BG_NA) attn_item<true, 2>(p, lds, tid, pi, npi, AR, itq, itq + N_ATT_ITEMS);
                    else attn_item<true, 1>(p, lds, tid, pi, npi, AR, itq, 0);
                }
            }
        } break;
        case PH_MIX2: {
            PHASE_PARAMS();
            const int tid = tid_opaque();
            for (int gid = blockIdx.x * 512 + tid; gid < (1 << 17); gid += gridDim.x * 512) gla_scan_thread2(p, gid);
            for (int gid = blockIdx.x * 512 + tid; gid < T * 16; gid += gridDim.x * 512) attn_combine_thread(p, gid, T * 16);
        } break;
        case PH_MIX3: {
            PHASE_PARAMS();
            const int tid = tid_opaque(), t = tid & 255, half = tid >> 8;
            char* hl = lds + half * HALF_LDS;
            for (int it0 = blockIdx.x * 2; it0 < N_GLA_ITEMS; it0 += gridDim.x * 2) gla_out_item(p, hl, t, min(it0 + half, N_GLA_ITEMS - 1), BG_NA + BG_NGD + min(it0 + half, N_GLA_ITEMS - 1) * BG_GO_ST);
        } break;
        case PH_OUTPROJ: {
            PHASE_PARAMS();
            pg::DenseSched S; S.init(p.mix, p.woT, T, D, gridDim.x, blockIdx.x);
            pg::EpiOut E{p.x, p.x1b};
            pg::gemm_phase((LDS_AS unsigned char*)lds, S, E, wv__);
        } break;
        case PH_ROUTE: { PHASE_PARAMS(); ph_route(p, lds, wv__); } break;
        case PH_MOE1: {
            PHASE_PARAMS();
            int* meta = (int*)(lds + MO_META);
            moe_meta(p, meta, wv__);
            pg::MoeSchedT<true> S{(const u16*)p.xn28, (const u16*)p.w1T8, p.lists, (const LDS_AS int*)meta, 8, meta[32 + NE] * 8, (int)gridDim.x, (int)blockIdx.x, 1024, (const LDS_AS unsigned*)(lds + MO_TABA)};
            moe_tables(p, lds, S, wv__);
            pg::EpiMoe1 E{(const LDS_AS float*)(lds + MO_TABB), p.act8};
            pg::gemm_phase<pg::EpiMoe1, pg::MoeSchedT<true>, true>((LDS_AS unsigned char*)lds, S, E, wv__);
            {
                const int G = gridDim.x, nun = S.nunits, r = nun % G, nshort = r ? G - r : G, sidx = r ? (int)blockIdx.x - r : (int)blockIdx.x;
                if (sidx >= 0) {
                    const int tid = tid_opaque(), t = tid & 255, hv = tid >> 8;
                    const int per = (W2_LATE - W2_BG + nshort * 2 - 1) / (nshort * 2), ib = W2_BG + (sidx * 2 + hv) * per;
                    for (int i = ib; i < min(ib + per, W2_LATE); ++i) { const int e = i >> 7, j = i & 127; cvt_tile8(p.w2 + (size_t)e * DFF * D, D, p.w2T8 + (size_t)e * D * DFF, (j >> 3) * 64, (j & 7) * 128, t); }
                }
            }
        } break;
        case PH_MOE2: {
            PHASE_PARAMS();
            int* meta = (int*)(lds + MO_META);
            if (ph_lo > PH_MOE1) moe_meta(p, meta, wv__);
            pg::MoeSchedT<false> S{(const u16*)p.act8, (const u16*)p.w2T8, p.lists, (const LDS_AS int*)meta, 4, meta[32 + NE] * 4, (int)gridDim.x, (int)blockIdx.x, 1024, nullptr};
            moe_tables2(p, lds, S, wv__);
            pg::EpiMoe2 E{(const LDS_AS int*)(lds + MO_TABA), (const LDS_AS float*)(lds + MO_TABG), (const LDS_AS float*)(lds + MO_TABB), p.y};
            pg::gemm_phase<pg::EpiMoe2, pg::MoeSchedT<false>, true>((LDS_AS unsigned char*)lds, S, E, wv__);
        } break;
        case PH_FINAL: { PHASE_PARAMS(); ph_final(p, wv__); } break;
        default: break;
        }
      }
#ifdef EXTRA_BAR
        if (ph == PH_MIX2) { for (int q = 0; q < EXTRA_BAR; ++q) xcd_barrier(xb, wv__); }
#endif
        if (ph + 1 < ph_hi) xcd_barrier(xb, wv__);
    }
}


#include <cstdio>
extern "C" void kernel_launch(void* const* d_in, const int* in_sizes, int n_in, void* d_out, int out_size, void* d_ws, size_t ws_size, hipStream_t stream) {
    const float* x = (const float*)d_in[0];
    const float* norm1_g = (const float*)d_in[1];
    const float* w_in = (const float*)d_in[2];
    const float* rel_bias = (const float*)d_in[3];
    const float* wgf = (const float*)d_in[4];
    const float* bgf = (const float*)d_in[5];
    const float* wgb = (const float*)d_in[6];
    const float* bgb = (const float*)d_in[7];
    const float* gla_ng = (const float*)d_in[8];
    const float* w_out = (const float*)d_in[9];
    const float* norm2_g = (const float*)d_in[10];
    const float* router_w = (const float*)d_in[11];
    const float* router_b = (const float*)d_in[12];
    const float* w1 = (const float*)d_in[13];
    const float* b1 = (const float*)d_in[14];
    const float* w2 = (const float*)d_in[15];
    const float* b2 = (const float*)d_in[16];
    const float* final_g = (const float*)d_in[17];
    float* out = (float*)d_out;

    static int grid_blocks = 0;
    if (!grid_blocks) {
        int dev = 0, cus = 0, per_cu = 0;
        hipGetDevice(&dev);
        hipDeviceGetAttribute(&cus, hipDeviceAttributeMultiprocessorCount, dev);
        hipFuncSetAttribute((const void*)mega, hipFuncAttributeMaxDynamicSharedMemorySize, LDS_BYTES);
        hipOccupancyMaxActiveBlocksPerMultiprocessor(&per_cu, mega, 512, LDS_BYTES);
        if (per_cu > 1) per_cu = 1;
        if (per_cu < 1) per_cu = 1;
        grid_blocks = cus * per_cu;
    }

    char* ws = (char*)d_ws;
    size_t off = 0;
    auto take = [&](size_t bytes) { char* p = ws + off; off += (bytes + 255) & ~(size_t)255; return p; };
    Params p{};
    p.x = x; p.g1 = norm1_g; p.w_in = w_in; p.rel_bias = rel_bias; p.wgf = wgf; p.bgf = bgf; p.wgb = wgb; p.bgb = bgb; p.gla_ng = gla_ng;
    p.w_out = w_out; p.g2 = norm2_g; p.rw = router_w; p.rb = router_b; p.w1 = w1; p.b1 = b1; p.w2 = w2; p.b2 = b2; p.gf = final_g; p.out = out;
    p.winT = (u16*)take((size_t)PJW * D * 2);
    p.wzT = (u16*)take((size_t)32 * D * 2);
    p.woT = (u16*)take((size_t)D * D * 2);
    p.w1T = (u16*)take((size_t)NE * 2 * DFF * D * 2); p.w1T8 = (unsigned char*)p.w1T;
    p.w2T = (u16*)take((size_t)NE * D * DFF * 2); p.w2T8 = (unsigned char*)p.w2T;
    p.zbuf = (float*)take((size_t)T * 32 * 4);
    p.btab = (float*)take((size_t)24 * 704 * 4);
    p.lse = (float*)take((size_t)3 * T * 8 * 4);
    p.dec = (float*)take((size_t)B * GH * 64 * 2 * 64 * 4);
    p.x1 = (float*)take((size_t)T * D * 4);
    p.x1b = (u16*)p.x1;
    p.counts = (int*)take(256);
    p.lists = (int*)take((size_t)NE * T * 4);
    p.gate = (float*)take((size_t)NSLOT * 4);
    p.bar = (unsigned*)take((size_t)XCD_BAR_WORDS * 4);
    p.xn = (u16*)take((size_t)T * D * 2); p.xn2 = p.xn; p.xn28 = (unsigned char*)p.xn;
    { char* ra = take((size_t)T * PJW * 2 + (size_t)3 * T * 512 * 2);
      p.proj = (u16*)ra; p.abr = (u16*)(ra + (size_t)T * PJW * 2); p.act = (u16*)ra; p.act8 = (unsigned char*)ra; }
    { char* rb = take((size_t)B * GH * 64 * 2 * 128 * 64 * 4 + (size_t)B * GH * 64 * 2 * 128 * 64 * 2 + (size_t)T * D * 2);
      p.dS = (float*)rb; p.Sp = (u16*)(rb + (size_t)B * GH * 64 * 2 * 128 * 64 * 4); p.mix = (u16*)(rb + (size_t)B * GH * 64 * 2 * 128 * 64 * 4 + (size_t)B * GH * 64 * 2 * 128 * 64 * 2); p.y = (u16*)rb; }

    auto run_fast = [&](int lo, int hi) {
        (void)hipMemsetAsync(p.bar, 0, (size_t)XCD_BAR_WORDS * 4, stream);
        p.ph_lo = lo; p.ph_hi = hi;
        void* args[] = {&p};
        hipError_t e = hipLaunchCooperativeKernel((const void*)mega, dim3(grid_blocks), dim3(512), args, LDS_BYTES, stream);
        if (e != hipSuccess) fprintf(stderr, "cooperative launch failed: %s (grid %d)\n", hipGetErrorString(e), grid_blocks);
    };

    run_fast(PH_PRO, PH_END);

}
```
